# Optimizing an MI355X kernel written in HIP

```python
import math
import jax, jax.numpy as jnp
from jax import lax
import numpy as np

D_MODEL = 1024
BATCH = 8
SEQ = 4096
DEPTH = 2

PLE_DIM = 256
N_MIXERS = 2
N_GLA_LAYERS = (DEPTH + 1) // 2
N_SWA_LAYERS = DEPTH // 2

GLA_HEADS = 4
GLA_DK = D_MODEL // 2 // GLA_HEADS
GLA_DV = D_MODEL // GLA_HEADS
GLA_LOWRANK = 16
GLA_TAU = 16.0
GLA_CHUNK = 64
GLA_IN_COLS = 2 * GLA_HEADS * GLA_DK + 2 * GLA_HEADS * GLA_DV + GLA_LOWRANK

SWA_HEAD_DIM = 64
SWA_Q_HEADS = D_MODEL // SWA_HEAD_DIM
SWA_KV_HEADS = 4
SWA_WINDOW = 128
SWA_BLOCK = 128
SWA_IN_COLS = (SWA_Q_HEADS + 2 * SWA_KV_HEADS) * SWA_HEAD_DIM

D_FF = 4 * D_MODEL

DEEPNORM_ALPHA = (2.0 * DEPTH) ** 0.25
DEEPNORM_BETA = (8.0 * DEPTH) ** -0.25
LN_EPS = 1e-5
RMS_EPS = 1e-5

kernel_name = 'hybrid_gla_swa_sink_deepnorm'


def layer_norm(x, g, b):
    xf = x.astype(jnp.float32)
    mu = jnp.mean(xf, axis=-1, keepdims=True)
    var = jnp.mean(jnp.square(xf - mu), axis=-1, keepdims=True)
    return ((xf - mu) * lax.rsqrt(var + LN_EPS) * g.astype(jnp.float32) + b.astype(jnp.float32)).astype(x.dtype)


def gla_mixer(x, w_in, w_gk_up, b_gk, norm_g, w_out):
    B, S, _ = x.shape
    H, DK, DV, C = GLA_HEADS, GLA_DK, GLA_DV, GLA_CHUNK
    nc = S // C
    f32 = jnp.float32
    proj = x @ w_in
    q, k, v, r, gk_low = jnp.split(
        proj, [H * DK, 2 * H * DK, 2 * H * DK + H * DV, 2 * H * DK + 2 * H * DV], axis=-1)
    log_a = jax.nn.log_sigmoid((gk_low @ w_gk_up + b_gk).astype(f32)) / GLA_TAU

    def to_chunks(t, d):
        return t.astype(f32).reshape(B, nc, C, H, d).transpose(1, 0, 3, 2, 4)

    qc = to_chunks(q, DK) * (DK ** -0.5)
    kc = to_chunks(k, DK)
    vc = to_chunks(v, DV)
    gc = to_chunks(log_a, DK)
    causal = jnp.tril(jnp.ones((C, C), dtype=bool))[:, :, None]

    def step(state, inp):
        qb, kb, vb, gb = inp
        bcum = jnp.cumsum(gb, axis=2)
        b_last = bcum[:, :, -1:, :]
        o_inter = jnp.einsum('bhcd,bhde->bhce', qb * jnp.exp(bcum), state)
        diff = bcum[:, :, :, None, :] - bcum[:, :, None, :, :]
        decay = jnp.exp(jnp.where(causal, diff, -jnp.inf))
        attn = jnp.einsum('bhid,bhjd,bhijd->bhij', qb, kb, decay)
        o = o_inter + jnp.einsum('bhij,bhje->bhie', attn, vb)
        new_state = jnp.exp(b_last[:, :, 0, :])[..., None] * state + jnp.einsum(
            'bhcd,bhce->bhde', kb * jnp.exp(b_last - bcum), vb)
        return new_state, o

    state0 = jnp.zeros((B, H, DK, DV), f32)
    _, oc = lax.scan(step, state0, (qc, kc, vc, gc))
    o = oc.transpose(1, 0, 3, 2, 4).reshape(B, S, H, DV)
    o = o * lax.rsqrt(jnp.mean(o * o, axis=-1, keepdims=True) + RMS_EPS) * norm_g.astype(f32)
    o = o.reshape(B, S, H * DV) * jax.nn.silu(r.astype(f32))
    return o.astype(x.dtype) @ w_out


def swa_mixer(x, w_qkv, b_qkv, sinks, w_out, b_out):
    B, S, _ = x.shape
    Hq, Hkv, hd, BLK = SWA_Q_HEADS, SWA_KV_HEADS, SWA_HEAD_DIM, SWA_BLOCK
    G = Hq // Hkv
    nb = S // BLK
    f32 = jnp.float32
    qkv = x @ w_qkv + b_qkv
    q, k, v = jnp.split(qkv, [Hq * hd, (Hq + Hkv) * hd], axis=-1)
    q = q.astype(f32).reshape(B, nb, BLK, Hkv, G, hd)
    k = k.astype(f32).reshape(B, nb, BLK, Hkv, hd)
    v = v.astype(f32).reshape(B, nb, BLK, Hkv, hd)
    pad = ((0, 0), (1, 0), (0, 0), (0, 0), (0, 0))
    k_band = jnp.concatenate([jnp.pad(k, pad)[:, :-1], k], axis=2)
    v_band = jnp.concatenate([jnp.pad(v, pad)[:, :-1], v], axis=2)
    scores = jnp.einsum('bnqhgd,bnjhd->bnhgqj', q, k_band) * (hd ** -0.5)
    qi = jnp.arange(BLK)[:, None]
    jj = jnp.arange(2 * BLK)[None, :]
    rel = jj - BLK - qi
    valid = (rel <= 0) & (rel > -SWA_WINDOW)
    scores = jnp.where(valid, scores, -jnp.inf)
    sink = sinks.astype(f32).reshape(Hkv, G)[None, None, :, :, None, None]
    m = jnp.maximum(jnp.max(scores, axis=-1, keepdims=True), sink)
    pr = jnp.exp(scores - m)
    denom = jnp.sum(pr, axis=-1, keepdims=True) + jnp.exp(sink - m)
    out = jnp.einsum('bnhgqj,bnjhd->bnqhgd', pr / denom, v_band)
    out = out.reshape(B, S, Hq * hd).astype(x.dtype)
    return out @ w_out + b_out


def sqrelu_mlp(x, w_up, w_down):
    h = jax.nn.relu(x @ w_up)
    return (h * h) @ w_down


def setup_inputs(seed: int = 0) -> dict:
    key = jax.random.key(seed)
    ks = jax.random.split(key, 22)
    nrm = jax.random.normal
    f32 = jnp.float32
    D = D_MODEL
    x = nrm(ks[0], (BATCH, SEQ, D), f32)
    p = nrm(ks[1], (DEPTH, BATCH, SEQ, PLE_DIM), f32)
    gla_w_in = nrm(ks[2], (N_GLA_LAYERS, D, GLA_IN_COLS), f32) * D ** -0.5
    gla_w_gk_up = nrm(ks[3], (N_GLA_LAYERS, GLA_LOWRANK, GLA_HEADS * GLA_DK), f32) * GLA_LOWRANK ** -0.5
    gla_b_gk = 0.1 * nrm(ks[4], (N_GLA_LAYERS, GLA_HEADS * GLA_DK), f32)
    gla_norm_g = 1.0 + 0.02 * nrm(ks[5], (N_GLA_LAYERS, GLA_DV), f32)
    gla_w_out = nrm(ks[6], (N_GLA_LAYERS, GLA_HEADS * GLA_DV, D), f32) * (GLA_HEADS * GLA_DV) ** -0.5 * DEEPNORM_BETA
    swa_w_qkv = nrm(ks[7], (N_SWA_LAYERS, D, SWA_IN_COLS), f32) * D ** -0.5
    swa_b_qkv = 0.02 * nrm(ks[8], (N_SWA_LAYERS, SWA_IN_COLS), f32)
    swa_sinks = 0.5 * nrm(ks[9], (N_SWA_LAYERS, SWA_Q_HEADS), f32)
    swa_w_out = nrm(ks[10], (N_SWA_LAYERS, SWA_Q_HEADS * SWA_HEAD_DIM, D), f32) * (SWA_Q_HEADS * SWA_HEAD_DIM) ** -0.5 * DEEPNORM_BETA
    swa_b_out = 0.02 * nrm(ks[11], (N_SWA_LAYERS, D), f32)
    mlp_w_up = nrm(ks[12], (DEPTH, D, D_FF), f32) * D ** -0.5
    mlp_w_down = nrm(ks[13], (DEPTH, D_FF, D), f32) * D_FF ** -0.5 * DEEPNORM_BETA
    ln1_g = 1.0 + 0.02 * nrm(ks[14], (DEPTH, D), f32)
    ln1_b = 0.02 * nrm(ks[15], (DEPTH, D), f32)
    ln2_g = 1.0 + 0.02 * nrm(ks[16], (DEPTH, D), f32)
    ln2_b = 0.02 * nrm(ks[17], (DEPTH, D), f32)
    ple_w_proj = nrm(ks[18], (DEPTH, PLE_DIM, D), f32) * PLE_DIM ** -0.5
    ple_w_gate = nrm(ks[19], (DEPTH, D, D), f32) * D ** -0.5
    ple_b_gate = 0.02 * nrm(ks[20], (DEPTH, D), f32)
    return {'x': x, 'p': p,
            'gla_w_in': gla_w_in, 'gla_w_gk_up': gla_w_gk_up, 'gla_b_gk': gla_b_gk,
            'gla_norm_g': gla_norm_g, 'gla_w_out': gla_w_out,
            'swa_w_qkv': swa_w_qkv, 'swa_b_qkv': swa_b_qkv, 'swa_sinks': swa_sinks,
            'swa_w_out': swa_w_out, 'swa_b_out': swa_b_out,
            'mlp_w_up': mlp_w_up, 'mlp_w_down': mlp_w_down,
            'ln1_g': ln1_g, 'ln1_b': ln1_b, 'ln2_g': ln2_g, 'ln2_b': ln2_b,
            'ple_w_proj': ple_w_proj, 'ple_w_gate': ple_w_gate, 'ple_b_gate': ple_b_gate}


def reference(x, p, gla_w_in, gla_w_gk_up, gla_b_gk, gla_norm_g, gla_w_out,
              swa_w_qkv, swa_b_qkv, swa_sinks, swa_w_out, swa_b_out,
              mlp_w_up, mlp_w_down, ln1_g, ln1_b, ln2_g, ln2_b,
              ple_w_proj, ple_w_gate, ple_b_gate):
    h = x
    for i in range(DEPTH):
        j = i // N_MIXERS
        if i % N_MIXERS == 0:
            mix = gla_mixer(h, gla_w_in[j], gla_w_gk_up[j], gla_b_gk[j], gla_norm_g[j], gla_w_out[j])
        else:
            mix = swa_mixer(h, swa_w_qkv[j], swa_b_qkv[j], swa_sinks[j], swa_w_out[j], swa_b_out[j])
        h = layer_norm(DEEPNORM_ALPHA * h + mix, ln1_g[i], ln1_b[i])
        h = layer_norm(DEEPNORM_ALPHA * h + sqrelu_mlp(h, mlp_w_up[i], mlp_w_down[i]), ln2_g[i], ln2_b[i])
        gate = jax.nn.sigmoid(h @ ple_w_gate[i] + ple_b_gate[i])
        h = h + gate * (p[i] @ ple_w_proj[i])
    return h
```

```cpp
#include <hip/hip_runtime.h>
#include <hip/hip_cooperative_groups.h>
#include <cstdio>
#include <cstdint>
namespace cg = cooperative_groups;
namespace pg8 {
#define PG8_LAS __attribute__((address_space(3)))
typedef unsigned short bf16_t;
typedef short bf16x8 __attribute__((ext_vector_type(8)));
typedef float f32x4 __attribute__((ext_vector_type(4)));
typedef unsigned u32x4 __attribute__((ext_vector_type(4)));
constexpr int BM = 256, BK = 64, HALF = 128, HTB = HALF * BK * 2  , STAGE_BYTES = 8 * HTB, NXCD = 8, WGM = 8;

__host__ __device__ __forceinline__ int lds_byte(int r, int c) { const int st = (r >> 4) * 2 + (c >> 5), rr = r & 15, cc = c & 31, ob = rr * 64 + cc * 2; return st * 1024 + (ob ^ (((ob >> 9) & 1) << 5)); }
__host__ __device__ __forceinline__ void stage_rc(int b, int& R, int& C) { const int st = b / 1024, sb = b % 1024, swz = sb ^ (((sb >> 9) & 1) << 5); R = (st >> 1) * 16 + swz / 64; C = (st & 1) * 32 + (swz % 64) / 2; }
__host__ __device__ __forceinline__ int perm32(int rho) { const int n = rho >> 4, i = rho & 15; return 8 * (i >> 2) + 4 * n + (i & 3); }

struct Unit { int pm, pn; };
struct Gemm { const bf16_t* A; const bf16_t* Bt; int M, N, K, lda, ldb; };

struct StaticOrder {
    int nM, nN, nwg, G, c;
    __host__ __device__ void init(int M, int N, int G_, int c_) { nM = M / BM; nN = N / BM; nwg = nM * nN; G = G_; c = c_; }
    __host__ __device__ bool next(int i, Unit& u) const {
        const long L = (long)i * G + c; if (L >= nwg) return false;
        int wgid = (int)L; { const int q = nwg / NXCD, r = nwg % NXCD, xcd = wgid % NXCD, off = wgid / NXCD; wgid = (xcd < r ? xcd * (q + 1) : r * (q + 1) + (xcd - r) * q) + off; }
        const int nig = WGM * nN, gid = wgid / nig, fm = gid * WGM, gsz = (nM - fm) < WGM ? (nM - fm) : WGM;
        u.pm = fm + ((wgid % nig) % gsz); u.pn = (wgid % nig) / gsz; return true;
    }
    __device__ __forceinline__ void a_ready(const Unit&) const {}
    __device__ __forceinline__ void done(const Unit&) const {}
};


__device__ __forceinline__ unsigned cvt_pk_bf16(float lo, float hi) { unsigned r; asm volatile("v_cvt_pk_bf16_f32 %0, %1, %2" : "=v"(r) : "v"(lo), "v"(hi)); return r; }
typedef unsigned u32x2 __attribute__((ext_vector_type(2)));
typedef float f32x2 __attribute__((ext_vector_type(2)));
__device__ __forceinline__ float bf2f(unsigned short b) { return __uint_as_float(((unsigned)b) << 16); }
__device__ __forceinline__ void unpack8(const u32x4 w, float (&v)[8]) {
    v[0] = __uint_as_float(w.x << 16); v[1] = __uint_as_float(w.x & 0xffff0000u); v[2] = __uint_as_float(w.y << 16); v[3] = __uint_as_float(w.y & 0xffff0000u);
    v[4] = __uint_as_float(w.z << 16); v[5] = __uint_as_float(w.z & 0xffff0000u); v[6] = __uint_as_float(w.w << 16); v[7] = __uint_as_float(w.w & 0xffff0000u);
}
constexpr float EPI_LN_EPS = 1e-5f;
__device__ __forceinline__ void stats_pre(const float* ST, int pm, int slot, int tid, PG8_LAS float* sx) {
    if (tid < 256) {
        const f32x4* p = (const f32x4*)(ST + (size_t)(pm * BM + tid) * 32); float s = 0.f, q = 0.f;
#pragma unroll
        for (int i = 0; i < 8; ++i) { const f32x4 v = p[i]; s += v[0] + v[2]; q += v[1] + v[3]; }
        const float mean = s * (1.0f / 1024.0f), var = fmaxf(q * (1.0f / 1024.0f) - mean * mean, 0.f);
        *(PG8_LAS f32x2*)(sx + (slot * 256 + tid) * 2) = (f32x2){mean, 1.0f / sqrtf(var + EPI_LN_EPS)};
    }
}

struct EpiBf16 {
    static constexpr bool PERM = true, AFTER_DRAIN = false;
    bf16_t* O; int ldc; const float* bias; int gk_tile; float* GK;
    __device__ __forceinline__ void pre(const Unit&, int, int, PG8_LAS float*) const {}
    __device__ __forceinline__ void operator()(const f32x4 (&acc)[2][2][4][2], const Unit& u, int wr, int wc, int fr, int fq, int, PG8_LAS float*) const {
        const int row0 = u.pm * BM + wr * 64 + fr;
        if (u.pn >= gk_tile) {
            if (wc == 0 && fq < 2) {
#pragma unroll
                for (int ai = 0; ai < 2; ++ai)
#pragma unroll
                    for (int m = 0; m < 4; ++m) { float* gp = GK + (size_t)(row0 + ai * HALF + m * 16) * 16 + 8 * fq;
                        *(f32x4*)(gp) = acc[ai][0][m][0]; *(f32x4*)(gp + 4) = acc[ai][0][m][1]; }
            }
            return;
        }
        const int col0 = u.pn * BM + wc * 32 + 8 * fq;
#pragma unroll
        for (int bj = 0; bj < 2; ++bj) {
            f32x4 b0 = (f32x4){0.f, 0.f, 0.f, 0.f}, b1 = b0;
            if (bias) { b0 = *(const f32x4*)(bias + col0 + bj * HALF); b1 = *(const f32x4*)(bias + col0 + bj * HALF + 4); }
#pragma unroll
            for (int ai = 0; ai < 2; ++ai)
#pragma unroll
                for (int m = 0; m < 4; ++m) { const f32x4 v0 = acc[ai][bj][m][0] + b0, v1 = acc[ai][bj][m][1] + b1;
                    u32x4 w; w.x = cvt_pk_bf16(v0[0], v0[1]); w.y = cvt_pk_bf16(v0[2], v0[3]); w.z = cvt_pk_bf16(v1[0], v1[1]); w.w = cvt_pk_bf16(v1[2], v1[3]);
                    *(u32x4*)(O + (size_t)(row0 + ai * HALF + m * 16) * ldc + col0 + bj * HALF) = w; } }
    }
};

template <bool LN> struct EpiY {
    static constexpr bool PERM = true, AFTER_DRAIN = false;
    const void* res; int res_bf16; const float* bias; const float* g; const float* b; const float* ST_IN; bf16_t* Y; float* ST; float alpha;
    __device__ __forceinline__ void pre(const Unit& u, int slot, int tid, PG8_LAS float* sx) const { if (LN) stats_pre(ST_IN, u.pm, slot, tid, sx); }
    __device__ __forceinline__ void operator()(const f32x4 (&acc)[2][2][4][2], const Unit& u, int wr, int wc, int fr, int fq, int slot, PG8_LAS float* sx) const {
        const int col0 = u.pn * BM + wc * 32 + 8 * fq, rl0 = wr * 64 + fr; const size_t roff0 = (size_t)(u.pm * BM + rl0) * 1024;
        const bf16_t* R = (const bf16_t*)res;
        float ps[8], pq[8];
#pragma unroll
        for (int r = 0; r < 8; ++r) { ps[r] = 0.f; pq[r] = 0.f; }
#pragma unroll
        for (int bj = 0; bj < 2; ++bj) { const int c = col0 + bj * HALF;
            u32x4 rr[8];
#pragma unroll
            for (int r = 0; r < 8; ++r) rr[r] = *(const u32x4*)(R + roff0 + (size_t)((r >> 2) * HALF + (r & 3) * 16) * 1024 + c);
            f32x4 g0, g1, b0, b1, bb0, bb1;
            if (LN) { g0 = *(const f32x4*)(g + c); g1 = *(const f32x4*)(g + c + 4); b0 = *(const f32x4*)(b + c); b1 = *(const f32x4*)(b + c + 4); }
            if (bias) { bb0 = *(const f32x4*)(bias + c); bb1 = *(const f32x4*)(bias + c + 4); }
#pragma unroll
            for (int r = 0; r < 8; ++r) { const int ai = r >> 2, m = r & 3, rl = rl0 + ai * HALF + m * 16;
                float rv[8]; unpack8(rr[r], rv);
                if (LN) { const f32x2 mr = *(const PG8_LAS f32x2*)(sx + (slot * 256 + rl) * 2);
#pragma unroll
                    for (int i = 0; i < 4; ++i) { rv[i] = (rv[i] - mr[0]) * mr[1] * g0[i] + b0[i]; rv[4 + i] = (rv[4 + i] - mr[0]) * mr[1] * g1[i] + b1[i]; } }
                f32x4 v0 = acc[ai][bj][m][0], v1 = acc[ai][bj][m][1];
                if (bias) { v0 += bb0; v1 += bb1; }
                float y[8];
#pragma unroll
                for (int i = 0; i < 4; ++i) { y[i] = alpha * rv[i] + v0[i]; y[4 + i] = alpha * rv[4 + i] + v1[i]; }
                u32x4 w; w.x = cvt_pk_bf16(y[0], y[1]); w.y = cvt_pk_bf16(y[2], y[3]); w.z = cvt_pk_bf16(y[4], y[5]); w.w = cvt_pk_bf16(y[6], y[7]);
                *(u32x4*)(Y + roff0 + (size_t)(ai * HALF + m * 16) * 1024 + c) = w;
                float yr[8]; unpack8(w, yr);
#pragma unroll
                for (int i = 0; i < 8; ++i) { ps[r] += yr[i]; pq[r] += yr[i] * yr[i]; } }
        }
#pragma unroll
        for (int r = 0; r < 8; ++r) { float a = ps[r], q = pq[r];
            a += __shfl_xor(a, 16); a += __shfl_xor(a, 32); q += __shfl_xor(q, 16); q += __shfl_xor(q, 32);
            if (fq == 0) *(f32x2*)(ST + (size_t)(u.pm * BM + rl0 + (r >> 2) * HALF + (r & 3) * 16) * 32 + (u.pn * 4 + wc) * 2) = (f32x2){a, q}; }
    }
};

struct EpiUpLN {
    static constexpr bool PERM = true, AFTER_DRAIN = false;
    const float* ST_IN; const float* colsum; const float* bw; bf16_t* O; int ldc;
    __device__ __forceinline__ void pre(const Unit& u, int slot, int tid, PG8_LAS float* sx) const { stats_pre(ST_IN, u.pm, slot, tid, sx); }
    __device__ __forceinline__ void operator()(const f32x4 (&acc)[2][2][4][2], const Unit& u, int wr, int wc, int fr, int fq, int slot, PG8_LAS float* sx) const {
        const int col0 = u.pn * BM + wc * 32 + 8 * fq, rl0 = wr * 64 + fr;
#pragma unroll
        for (int bj = 0; bj < 2; ++bj) { const int c = col0 + bj * HALF;
            const f32x4 c0 = *(const f32x4*)(colsum + c), c1 = *(const f32x4*)(colsum + c + 4), w0 = *(const f32x4*)(bw + c), w1 = *(const f32x4*)(bw + c + 4);
#pragma unroll
            for (int r = 0; r < 8; ++r) { const int ai = r >> 2, m = r & 3, rl = rl0 + ai * HALF + m * 16;
                const f32x2 mr = *(const PG8_LAS f32x2*)(sx + (slot * 256 + rl) * 2);
                f32x4 v0 = (acc[ai][bj][m][0] - c0 * mr[0]) * mr[1] + w0, v1 = (acc[ai][bj][m][1] - c1 * mr[0]) * mr[1] + w1;
#pragma unroll
                for (int i = 0; i < 4; ++i) { const float a = fmaxf(v0[i], 0.f), b2 = fmaxf(v1[i], 0.f); v0[i] = a * a; v1[i] = b2 * b2; }
                u32x4 w; w.x = cvt_pk_bf16(v0[0], v0[1]); w.y = cvt_pk_bf16(v0[2], v0[3]); w.z = cvt_pk_bf16(v1[0], v1[1]); w.w = cvt_pk_bf16(v1[2], v1[3]);
                *(u32x4*)(O + (size_t)(u.pm * BM + rl) * ldc + c) = w; } }
    }
};

struct EpiPP {
    static constexpr bool PERM = true, AFTER_DRAIN = false;
    bf16_t* O; int ldc;
    __device__ __forceinline__ void pre(const Unit&, int, int, PG8_LAS float*) const {}
    __device__ __forceinline__ void operator()(const f32x4 (&acc)[2][2][4][2], const Unit& u, int wr, int wc, int fr, int fq, int, PG8_LAS float*) const {
        const int row0 = u.pm * BM + wr * 64 + fr, col0 = u.pn * BM + wc * 32 + 8 * fq;
#pragma unroll
        for (int ai = 0; ai < 2; ++ai)
#pragma unroll
            for (int m = 0; m < 4; ++m) { bf16_t* rowp = O + (size_t)(row0 + ai * HALF + m * 16) * ldc + col0;
#pragma unroll
                for (int bj = 0; bj < 2; ++bj) { const f32x4 v0 = acc[ai][bj][m][0], v1 = acc[ai][bj][m][1];
                    u32x4 w; w.x = cvt_pk_bf16(v0[0], v0[1]); w.y = cvt_pk_bf16(v0[2], v0[3]); w.z = cvt_pk_bf16(v1[0], v1[1]); w.w = cvt_pk_bf16(v1[2], v1[3]);
                    *(u32x4*)(rowp + bj * HALF) = w; } }
    }
};

struct EpiGateLN {
    static constexpr bool PERM = true, AFTER_DRAIN = false;
    const float* ST_IN; const bf16_t* YB; const bf16_t* pp; const float* colsum; const float* bz; const float* g; const float* b; float* out; bf16_t* ob;
    __device__ __forceinline__ void pre(const Unit& u, int slot, int tid, PG8_LAS float* sx) const { stats_pre(ST_IN, u.pm, slot, tid, sx); }
    __device__ __forceinline__ void operator()(const f32x4 (&acc)[2][2][4][2], const Unit& u, int wr, int wc, int fr, int fq, int slot, PG8_LAS float* sx) const {
        const int col0 = u.pn * BM + wc * 32 + 8 * fq, rl0 = wr * 64 + fr; const size_t roff0 = (size_t)(u.pm * BM + rl0) * 1024;
#pragma unroll
        for (int bj = 0; bj < 2; ++bj) { const int c = col0 + bj * HALF;
            f32x4 cs[2], zb[2], gg[2], bb[2];
#pragma unroll
            for (int hh = 0; hh < 2; ++hh) { cs[hh] = *(const f32x4*)(colsum + c + 4 * hh); zb[hh] = *(const f32x4*)(bz + c + 4 * hh); gg[hh] = *(const f32x4*)(g + c + 4 * hh); bb[hh] = *(const f32x4*)(b + c + 4 * hh); }
#pragma unroll
            for (int ai = 0; ai < 2; ++ai) {
                u32x4 yy[4], pw[4];
#pragma unroll
                for (int m = 0; m < 4; ++m) { const size_t o2 = roff0 + (size_t)(ai * HALF + m * 16) * 1024 + c; yy[m] = *(const u32x4*)(YB + o2); pw[m] = *(const u32x4*)(pp + o2); }
#pragma unroll
                for (int m = 0; m < 4; ++m) { const int rl = rl0 + ai * HALF + m * 16; const size_t o2 = roff0 + (size_t)(ai * HALF + m * 16) * 1024 + c;
                    const f32x2 mr = *(const PG8_LAS f32x2*)(sx + (slot * 256 + rl) * 2);
                    float y[8], p[8], o[8]; unpack8(yy[m], y); unpack8(pw[m], p);
#pragma unroll
                    for (int hh = 0; hh < 2; ++hh) { const f32x4 z = (acc[ai][bj][m][hh] - cs[hh] * mr[0]) * mr[1] + zb[hh];
#pragma unroll
                        for (int i = 0; i < 4; ++i) { const float h2 = (y[4 * hh + i] - mr[0]) * mr[1] * gg[hh][i] + bb[hh][i]; o[4 * hh + i] = h2 + p[4 * hh + i] * __builtin_amdgcn_rcpf(1.0f + __expf(-z[i])); } }
                    if (ob) { u32x4 w; w.x = cvt_pk_bf16(o[0], o[1]); w.y = cvt_pk_bf16(o[2], o[3]); w.z = cvt_pk_bf16(o[4], o[5]); w.w = cvt_pk_bf16(o[6], o[7]); *(u32x4*)(ob + o2) = w; }
                    else { *(f32x4*)(out + o2) = (f32x4){o[0], o[1], o[2], o[3]}; *(f32x4*)(out + o2 + 4) = (f32x4){o[4], o[5], o[6], o[7]}; } }
                asm volatile("" ::: "memory");
            } }
    }
};

template <class Epi, class Sched, bool ALIGN_EPI = false, bool SP2 = false>
__device__ __forceinline__ void gemm_phase(PG8_LAS unsigned char* lds, const Gemm g, const Sched& S, const Epi& E, PG8_LAS float* sx) {
    int tid_ = threadIdx.x; asm volatile("" : "+v"(tid_));
    const int tid = tid_, wid = __builtin_amdgcn_readfirstlane(tid >> 6), lane = tid & 63, wr = wid >> 2, wc = wid & 3, fr = lane & 15, fq = lane >> 4;
    const int K = g.K, nt = K / BK;
    unsigned voffA[2], voffB[2];
#pragma unroll
    for (int i = 0; i < 2; ++i) { int R, C; stage_rc(tid * 16 + i * 8192, R, C); const int Rb = Epi::PERM ? ((R & ~31) + perm32(R & 31)) : R;
        voffA[i] = (unsigned)(R * g.lda + C) * 2u; voffB[i] = (unsigned)(Rb * g.ldb + C) * 2u; }
    const size_t kstep = (size_t)(BK * 2);
    const size_t hstepA = (size_t)HALF * g.lda * 2, hstepB = (size_t)HALF * g.ldb * 2;
    const size_t tstepA = 2 * hstepA, tstepB = 2 * hstepB;
    const unsigned ldsw = (unsigned)wid * 1024u;
    const int aoff = lds_byte(wr * 64 + fr, fq * 8), boff = lds_byte(wc * 32 + fr, fq * 8);
#define PG8_SA(b, h) (((b) * 2 + (h)) * HTB)
#define PG8_SB(b, h) ((4 + (b) * 2 + (h)) * HTB)
#define PG8_STAGE(bufoff, gbase, voff) do { _Pragma("unroll") for (int _i = 0; _i < 2; ++_i) \
        __builtin_amdgcn_global_load_lds((const unsigned*)((const char*)(gbase) + (voff)[_i]), (PG8_LAS unsigned*)(lds + (bufoff) + ldsw + _i * 8192), 16, 0, 0); } while (0)
#define PG8_LDA(dst, b, h) do { _Pragma("unroll") for (int m = 0; m < 4; ++m) _Pragma("unroll") for (int k = 0; k < 2; ++k) dst[m][k] = *(const PG8_LAS bf16x8*)(lds + PG8_SA(b, h) + aoff + m * 2048 + k * 1024); } while (0)
#define PG8_LDB(dst, b, h) do { _Pragma("unroll") for (int n = 0; n < 2; ++n) _Pragma("unroll") for (int k = 0; k < 2; ++k) dst[n][k] = *(const PG8_LAS bf16x8*)(lds + PG8_SB(b, h) + boff + n * 2048 + k * 1024); } while (0)
#define PG8_MMA(ai, bj, At, Bt) do { __builtin_amdgcn_s_setprio(1); _Pragma("unroll") for (int m = 0; m < 4; ++m) _Pragma("unroll") for (int n = 0; n < 2; ++n) _Pragma("unroll") for (int k = 0; k < 2; ++k) \
        acc[ai][bj][m][n] = __builtin_amdgcn_mfma_f32_16x16x32_bf16(Bt[n][k], At[m][k], acc[ai][bj][m][n], 0, 0, 0); __builtin_amdgcn_s_setprio(0); } while (0)
#define PG8_WAIT_V(n) asm volatile("s_waitcnt vmcnt(" #n ")" ::: "memory")
#define PG8_WAIT_L(n) asm volatile("s_waitcnt lgkmcnt(" #n ")" ::: "memory")
#define PG8_BAR __builtin_amdgcn_s_barrier()
#define PG8_SCHED __builtin_amdgcn_sched_barrier(0)
    Unit cur, nxt; int ui = 0;
    if (!S.next(0, cur)) return;
    f32x4 acc[2][2][4][2];
#pragma unroll
    for (int a = 0; a < 2; ++a)
#pragma unroll
        for (int b = 0; b < 2; ++b)
#pragma unroll
            for (int m = 0; m < 4; ++m)
#pragma unroll
                for (int n = 0; n < 2; ++n) acc[a][b][m][n] = (f32x4){0.f, 0.f, 0.f, 0.f};
    bf16x8 At[4][2], B0[2][2], B1[2][2];
    const char* cA = (const char*)g.A + (size_t)cur.pm * tstepA; const char* cB = (const char*)g.Bt + (size_t)cur.pn * tstepB;
    S.a_ready(cur); E.pre(cur, 0, tid, sx);
    if constexpr (SP2) {
        PG8_STAGE(PG8_SB(0, 0), cB, voffB); PG8_STAGE(PG8_SB(0, 1), cB + hstepB, voffB); PG8_STAGE(PG8_SA(0, 0), cA, voffA); PG8_STAGE(PG8_SA(0, 1), cA + hstepA, voffA);
        if (wr == 1) PG8_BAR;
        PG8_WAIT_V(2); PG8_BAR;
        PG8_STAGE(PG8_SB(1, 0), cB + kstep, voffB); PG8_STAGE(PG8_SA(1, 0), cA + kstep, voffA); PG8_STAGE(PG8_SB(1, 1), cB + hstepB + kstep, voffB);
        PG8_WAIT_V(6); PG8_BAR;
    } else {
        PG8_STAGE(PG8_SB(0, 0), cB, voffB); PG8_STAGE(PG8_SA(0, 0), cA, voffA); PG8_STAGE(PG8_SB(0, 1), cB + hstepB, voffB); PG8_STAGE(PG8_SA(0, 1), cA + hstepA, voffA);
        if (wr == 1) PG8_BAR;
        PG8_WAIT_V(4); PG8_BAR;
        PG8_STAGE(PG8_SB(1, 0), cB + kstep, voffB); PG8_STAGE(PG8_SA(1, 0), cA + kstep, voffA); PG8_STAGE(PG8_SB(1, 1), cB + hstepB + kstep, voffB);
        PG8_WAIT_V(6); PG8_BAR;
    }
    for (;;) {
        const bool has_next = S.next(ui + 1, nxt);
        const char* nA = has_next ? (const char*)g.A + (size_t)nxt.pm * tstepA : cA; const char* nB = has_next ? (const char*)g.Bt + (size_t)nxt.pn * tstepB : cB;
        for (int t = 0; t < nt; t += 2) {
            const bool last = (t == nt - 2);
            const char* a1 = cA + (size_t)(t + 1) * kstep;
            const char* a2 = last ? nA : cA + (size_t)(t + 2) * kstep; const char* b2 = last ? nB : cB + (size_t)(t + 2) * kstep;
            const char* a3 = a2 + kstep; const char* b3 = b2 + kstep;
            if (last && has_next) { S.a_ready(nxt); E.pre(nxt, (ui + 1) & 1, tid, sx); }
            if constexpr (SP2) {
            PG8_LDB(B0, 0, 0); PG8_LDB(B1, 0, 1); PG8_SCHED; PG8_LDA(At, 0, 0); PG8_STAGE(PG8_SA(1, 1), a1 + hstepA, voffA);
            PG8_WAIT_V(8); PG8_WAIT_L(0); PG8_BAR; PG8_MMA(0, 0, At, B0); PG8_MMA(0, 1, At, B1); PG8_BAR; PG8_SCHED;
            PG8_LDA(At, 0, 1); PG8_STAGE(PG8_SB(0, 0), b2, voffB); PG8_STAGE(PG8_SB(0, 1), b2 + hstepB, voffB); PG8_STAGE(PG8_SA(0, 0), a2, voffA);
            PG8_WAIT_V(8); PG8_WAIT_L(0); PG8_BAR; PG8_MMA(1, 0, At, B0); PG8_MMA(1, 1, At, B1); PG8_BAR; PG8_SCHED;
            PG8_LDB(B0, 1, 0); PG8_LDB(B1, 1, 1); PG8_SCHED; PG8_LDA(At, 1, 0); PG8_STAGE(PG8_SA(0, 1), a2 + hstepA, voffA);
            PG8_WAIT_V(8); PG8_WAIT_L(0); PG8_BAR; PG8_MMA(0, 0, At, B0); PG8_MMA(0, 1, At, B1); PG8_BAR; PG8_SCHED;
            PG8_LDA(At, 1, 1); PG8_STAGE(PG8_SB(1, 0), b3, voffB); PG8_STAGE(PG8_SB(1, 1), b3 + hstepB, voffB); PG8_STAGE(PG8_SA(1, 0), a3, voffA);
            PG8_WAIT_V(8); PG8_WAIT_L(0); PG8_BAR; PG8_MMA(1, 0, At, B0); PG8_MMA(1, 1, At, B1); PG8_BAR; PG8_SCHED;
            } else {
            PG8_LDB(B0, 0, 0); PG8_SCHED; PG8_LDA(At, 0, 0); PG8_STAGE(PG8_SA(1, 1), a1 + hstepA, voffA);
            PG8_WAIT_L(8); PG8_BAR; PG8_WAIT_L(0); PG8_MMA(0, 0, At, B0); PG8_BAR; PG8_SCHED;
            PG8_LDB(B1, 0, 1); PG8_STAGE(PG8_SB(0, 0), b2, voffB);
            PG8_BAR; PG8_WAIT_L(0); PG8_MMA(0, 1, At, B1); PG8_BAR;
            PG8_LDA(At, 0, 1); PG8_STAGE(PG8_SA(0, 0), a2, voffA);
            PG8_BAR; PG8_WAIT_L(0); PG8_MMA(1, 0, At, B0); PG8_BAR; PG8_SCHED;
            PG8_STAGE(PG8_SB(0, 1), b2 + hstepB, voffB);
            PG8_WAIT_V(6); PG8_BAR; PG8_MMA(1, 1, At, B1); PG8_BAR;
            PG8_LDB(B0, 1, 0); PG8_SCHED; PG8_LDA(At, 1, 0); PG8_STAGE(PG8_SA(0, 1), a2 + hstepA, voffA);
            PG8_WAIT_L(8); PG8_BAR; PG8_WAIT_L(0); PG8_MMA(0, 0, At, B0); PG8_BAR; PG8_SCHED;
            PG8_LDB(B1, 1, 1); PG8_STAGE(PG8_SB(1, 0), b3, voffB);
            PG8_BAR; PG8_WAIT_L(0); PG8_MMA(0, 1, At, B1); PG8_BAR;
            PG8_LDA(At, 1, 1); PG8_STAGE(PG8_SA(1, 0), a3, voffA);
            PG8_BAR; PG8_WAIT_L(0); PG8_MMA(1, 0, At, B0); PG8_BAR; PG8_SCHED;
            PG8_STAGE(PG8_SB(1, 1), b3 + hstepB, voffB);
            PG8_WAIT_V(6); PG8_BAR; PG8_MMA(1, 1, At, B1); PG8_BAR;
            }
        }
        if constexpr (ALIGN_EPI) { if (wr == 0) PG8_BAR; }
        if constexpr (!Epi::AFTER_DRAIN) { E(acc, cur, wr, wc, fr, fq, ui & 1, sx); S.done(cur); }
        if (!has_next) break;
#pragma unroll
        for (int a = 0; a < 2; ++a)
#pragma unroll
            for (int b = 0; b < 2; ++b)
#pragma unroll
                for (int m = 0; m < 4; ++m)
#pragma unroll
                    for (int n = 0; n < 2; ++n) acc[a][b][m][n] = (f32x4){0.f, 0.f, 0.f, 0.f};
        cur = nxt; cA = nA; cB = nB; ++ui;
        if constexpr (ALIGN_EPI) { if (wr == 1) PG8_BAR; }
    }
    PG8_WAIT_V(0);
    if constexpr (!ALIGN_EPI) { if (wr == 0) PG8_BAR; }
    PG8_BAR;
    if constexpr (Epi::AFTER_DRAIN) { E.fused(acc, cur, wr, wc, fr, fq, lds, wid, lane); S.done(cur); }
#undef PG8_SA
#undef PG8_SB
#undef PG8_STAGE
#undef PG8_LDA
#undef PG8_LDB
#undef PG8_MMA
#undef PG8_WAIT_V
#undef PG8_WAIT_L
#undef PG8_BAR
#undef PG8_SCHED
}
}

#define LAS __attribute__((address_space(3)))
typedef unsigned short bf16;
typedef unsigned u32x4 __attribute__((ext_vector_type(4)));
typedef unsigned u32x2 __attribute__((ext_vector_type(2)));
typedef float f32x4 __attribute__((ext_vector_type(4)));
typedef short bf16x8 __attribute__((ext_vector_type(8)));
typedef short s16x4 __attribute__((ext_vector_type(4)));

constexpr int NTHREADS = 512, NWAVES = 8;
constexpr int BATCH = 8, SEQ = 4096, D = 1024, M = BATCH * SEQ, FF = 4096, PLE = 256;
constexpr int GLA_COLS = 3088, PROJ_LD = 3072;
constexpr int QKV_LD = 1536;
constexpr float LN_EPS = 1e-5f, RMS_EPS = 1e-5f;
constexpr float ALPHA = 1.4142135623730951f;
constexpr size_t MiB = 1u << 20;
constexpr size_t W_IN_T = 1 * MiB;
constexpr size_t W_GOUT_T = 7 * MiB;
constexpr size_t W_UP_T = 9 * MiB;
constexpr size_t W_DN_T = 17 * MiB;
constexpr size_t W_GATE_T = 25 * MiB;
constexpr size_t W_PP_T = 27 * MiB;
constexpr size_t W_QKV_T = 28 * MiB;
constexpr size_t W_SOUT_T = 31 * MiB;
constexpr size_t W_LSTRIDE = 24 * MiB;
constexpr size_t PB1_OFF = 1 * MiB;
constexpr size_t R0 = 56 * MiB;
constexpr size_t R1 = 120 * MiB;
constexpr size_t R2 = 248 * MiB;
constexpr size_t R2_GK = R2 + 192 * MiB;
constexpr size_t R2_PB = R2;
constexpr size_t R2_PP = R2 + 16 * MiB;
constexpr size_t R2_H3B = R2 + 80 * MiB;
constexpr size_t R2_QKV = R2 + 144 * MiB;
constexpr size_t R0_BL = R1 + 80 * MiB;
constexpr size_t WS_END = 512 * MiB;
constexpr int LDS_BYTES = 147456;

__device__ __forceinline__ int opq(int v) { asm volatile("" : "+s"(v)); return v; }
struct Params { const float* in[21]; float* out; unsigned char* ws; };
#define LBAR() do { asm volatile("s_waitcnt lgkmcnt(0)" ::: "memory"); __builtin_amdgcn_s_barrier(); asm volatile("" ::: "memory"); } while (0)

struct Ctx { LAS unsigned char* lds; int tid, lane, wave; };

__device__ __forceinline__ float wave_sum(float v) {
#pragma unroll
    for (int o = 1; o < 64; o <<= 1) v += __shfl_xor(v, o);
    return v;
}
__device__ __forceinline__ unsigned pk2(float lo, float hi) { return pg8::cvt_pk_bf16(lo, hi); }
__device__ __forceinline__ float bf2f(unsigned short b) { return __uint_as_float(((unsigned)b) << 16); }
__device__ __forceinline__ bf16x8 pack8(const f32x4 a, const f32x4 b) {
    u32x4 w; w.x = pk2(a[0], a[1]); w.y = pk2(a[2], a[3]); w.z = pk2(b[0], b[1]); w.w = pk2(b[2], b[3]); return __builtin_bit_cast(bf16x8, w);
}
#define MFMA16(a, b, c) __builtin_amdgcn_mfma_f32_16x16x32_bf16((a), (b), (c), 0, 0, 0)
__device__ __forceinline__ bf16x8 lds16(const LAS unsigned char* p) { return *(const LAS bf16x8*)p; }
__device__ __forceinline__ bf16x8 lds8x2(const LAS unsigned char* p0, const LAS unsigned char* p1) {
    const s16x4 lo = *(const LAS s16x4*)p0, hi = *(const LAS s16x4*)p1; return __builtin_shufflevector(lo, hi, 0, 1, 2, 3, 4, 5, 6, 7);
}

template <bool FOLD>
__device__ __forceinline__ void transpose_item(const float* W, int ldw, int nblk, int K, bf16* WT, LAS float* scr, int item, int lane,
                                               const float* gv = nullptr, const float* bv = nullptr, float* csp = nullptr, float* bwp = nullptr) {
    const int kb = item / nblk, nb = item % nblk, k0 = 64 * kb, n0 = 32 * nb;
    { const int r8 = lane >> 3, c4 = lane & 7;
      f32x4 v[8];
#pragma unroll
      for (int it = 0; it < 8; ++it) v[it] = *(const f32x4*)(W + (size_t)(k0 + 8 * it + r8) * ldw + n0 + 4 * c4);
#pragma unroll
      for (int it = 0; it < 8; ++it) { LAS float* d = scr + (8 * it + r8) * 33 + 4 * c4; d[0] = v[it][0]; d[1] = v[it][1]; d[2] = v[it][2]; d[3] = v[it][3]; } }
    asm volatile("s_waitcnt lgkmcnt(0)" ::: "memory");
    const int c = lane & 7;
    float gk[8], bk[8];
    if (FOLD) {
#pragma unroll
        for (int i = 0; i < 8; ++i) { gk[i] = gv[k0 + 8 * c + i]; bk[i] = bv[k0 + 8 * c + i]; }
    }
#pragma unroll
    for (int j = 0; j < 4; ++j) { const int n = (lane >> 3) + 8 * j; const LAS float* sp = scr + (8 * c) * 33 + n;
        float v[8];
#pragma unroll
        for (int i = 0; i < 8; ++i) v[i] = sp[i * 33];
        float bwv = 0.f;
        if (FOLD) {
#pragma unroll
            for (int i = 0; i < 8; ++i) { bwv += bk[i] * v[i]; v[i] *= gk[i]; }
        }
        u32x4 o; o.x = pk2(v[0], v[1]); o.y = pk2(v[2], v[3]); o.z = pk2(v[4], v[5]); o.w = pk2(v[6], v[7]);
        *(u32x4*)(WT + (size_t)(n0 + n) * K + k0 + 8 * c) = o;
        if (FOLD) {
            float r[8]; pg8::unpack8(o, r); float cs = ((r[0] + r[1]) + (r[2] + r[3])) + ((r[4] + r[5]) + (r[6] + r[7]));
            cs += __shfl_xor(cs, 1); cs += __shfl_xor(cs, 2); cs += __shfl_xor(cs, 4);
            bwv += __shfl_xor(bwv, 1); bwv += __shfl_xor(bwv, 2); bwv += __shfl_xor(bwv, 4);
            if (c == 0) { const int N = 32 * nblk; csp[(size_t)kb * N + n0 + n] = cs; bwp[(size_t)kb * N + n0 + n] = bwv; }
        }
    }
    asm volatile("s_waitcnt lgkmcnt(0)" ::: "memory");
}
constexpr size_t VEC = 52 * MiB;
__device__ __host__ constexpr size_t CSP_UP(int l) { return VEC + (size_t)l * 512 * 1024; }
__device__ __host__ constexpr size_t CSP_G(int l) { return VEC + MiB + (size_t)l * 128 * 1024; }
__device__ __host__ constexpr size_t FIN(int l) { return VEC + MiB + 512 * 1024 + (size_t)l * 64 * 1024; }
__device__ __forceinline__ void fold_finalize(const Params& P, int gtid, int gthreads) {
    for (int idx = gtid; idx < 2 * 5120; idx += gthreads) {
        const int l = idx / 5120, r = idx % 5120;
        float* fin = (float*)(P.ws + FIN(l));
        if (r < 4096) { const float* cp = (const float*)(P.ws + CSP_UP(l)); const float* bp = cp + 16 * 4096; float cs = 0.f, bw = 0.f;
#pragma unroll
            for (int kb = 0; kb < 16; ++kb) { cs += cp[kb * 4096 + r]; bw += bp[kb * 4096 + r]; }
            fin[r] = cs; fin[4096 + r] = bw; }
        else { const int n = r - 4096; const float* cp = (const float*)(P.ws + CSP_G(l)); const float* bp = cp + 16 * 1024; float cs = 0.f, bw = 0.f;
#pragma unroll
            for (int kb = 0; kb < 16; ++kb) { cs += cp[kb * 1024 + n]; bw += bp[kb * 1024 + n]; }
            fin[8192 + n] = cs; fin[9216 + n] = bw + P.in[20][l * D + n]; }
    }
}
__device__ __forceinline__ void p0_prologue(const Ctx& F, const Params& P) {
    LAS float* scr = (LAS float*)(F.lds + F.wave * 16384);
    const int gw = blockIdx.x * NWAVES + F.wave, NGW = gridDim.x * NWAVES;
    unsigned char* ws = P.ws;
    constexpr int I_IN = 16 * 96, I_SQ = 16 * 32, I_QKV = 16 * 48, I_UP = 16 * 128, I_DN = 64 * 32, I_PP = 4 * 32;
    constexpr int NITEMS = I_IN + 2 * I_SQ + I_QKV + 2 * I_UP + 2 * I_DN + 2 * I_SQ + 2 * I_PP;
    for (int it = gw; it < NITEMS; it += NGW) {
        int r = it;
        if (r < I_IN) { transpose_item<false>(P.in[2], GLA_COLS, 96, D, (bf16*)(ws + W_IN_T), scr, r, F.lane); continue; } r -= I_IN;
        if (r < I_SQ) { transpose_item<false>(P.in[6], D, 32, D, (bf16*)(ws + W_GOUT_T), scr, r, F.lane); continue; } r -= I_SQ;
        if (r < I_SQ) { transpose_item<false>(P.in[10], D, 32, D, (bf16*)(ws + W_SOUT_T), scr, r, F.lane); continue; } r -= I_SQ;
        if (r < I_QKV) { transpose_item<false>(P.in[7], QKV_LD, 48, D, (bf16*)(ws + W_QKV_T), scr, r, F.lane); continue; } r -= I_QKV;
        if (r < 2 * I_UP) { const int l = r / I_UP; transpose_item<true>(P.in[12] + (size_t)l * D * FF, FF, 128, D, (bf16*)(ws + W_UP_T + (size_t)l * W_LSTRIDE), scr, r % I_UP, F.lane, P.in[14] + l * D, P.in[15] + l * D, (float*)(ws + CSP_UP(l)), (float*)(ws + CSP_UP(l)) + 16 * 4096); continue; } r -= 2 * I_UP;
        if (r < 2 * I_DN) { const int l = r / I_DN; transpose_item<false>(P.in[13] + (size_t)l * D * FF, D, 32, FF, (bf16*)(ws + W_DN_T + (size_t)l * W_LSTRIDE), scr, r % I_DN, F.lane); continue; } r -= 2 * I_DN;
        if (r < 2 * I_SQ) { const int l = r / I_SQ; transpose_item<true>(P.in[19] + (size_t)l * D * D, D, 32, D, (bf16*)(ws + W_GATE_T + (size_t)l * W_LSTRIDE), scr, r % I_SQ, F.lane, P.in[16] + l * D, P.in[17] + l * D, (float*)(ws + CSP_G(l)), (float*)(ws + CSP_G(l)) + 16 * 1024); continue; } r -= 2 * I_SQ;
        { const int l = r / I_PP; transpose_item<false>(P.in[18] + (size_t)l * PLE * D, D, 32, PLE, (bf16*)(ws + W_PP_T + (size_t)l * W_LSTRIDE), scr, r % I_PP, F.lane); }
    }
    const int gtid = blockIdx.x * NTHREADS + F.tid, gthreads = gridDim.x * NTHREADS;
    {
        LAS float* wg = (LAS float*)F.lds;
        __syncthreads();
        for (int i = F.tid; i < 4096; i += NTHREADS) { const int k = i >> 2, c4 = i & 3, pos = (k & 3) * 256 + (k >> 2); *(LAS f32x4*)(wg + pos * 20 + 4 * c4) = *(const f32x4*)(P.in[2] + (size_t)k * GLA_COLS + 3072 + 4 * c4); }
        __syncthreads();
        const float* x = P.in[0]; bf16* xb = (bf16*)(ws + R0); float* GK = (float*)(ws + R2_GK);
        const int lane = F.lane;
#pragma unroll 1
        for (int r0 = gw * 4; r0 < M; r0 += NGW * 4) {
            f32x4 acc[16];
#pragma unroll
            for (int i = 0; i < 16; ++i) acc[i] = (f32x4){0.f, 0.f, 0.f, 0.f};
#pragma unroll 1
            for (int j = 0; j < 4; ++j) {
                float xs[4][4];
#pragma unroll
                for (int rr = 0; rr < 4; ++rr) { const f32x4 v = *(const f32x4*)(x + (size_t)(r0 + rr) * D + 256 * j + 4 * lane);
                    u32x2 o; o.x = pk2(v[0], v[1]); o.y = pk2(v[2], v[3]); *(u32x2*)(xb + (size_t)(r0 + rr) * D + 256 * j + 4 * lane) = o;
                    xs[rr][0] = v[0]; xs[rr][1] = v[1]; xs[rr][2] = v[2]; xs[rr][3] = v[3]; }
#pragma unroll
                for (int i = 0; i < 4; ++i) { const LAS float* wp = wg + (i * 256 + 64 * j + lane) * 20;
                    const f32x4 w0 = *(const LAS f32x4*)(wp), w1 = *(const LAS f32x4*)(wp + 4), w2 = *(const LAS f32x4*)(wp + 8), w3 = *(const LAS f32x4*)(wp + 12);
#pragma unroll
                    for (int rr = 0; rr < 4; ++rr) { const float xv = xs[rr][i]; acc[rr * 4 + 0] += w0 * xv; acc[rr * 4 + 1] += w1 * xv; acc[rr * 4 + 2] += w2 * xv; acc[rr * 4 + 3] += w3 * xv; } }
            }
            float a[64];
#pragma unroll
            for (int i = 0; i < 16; ++i) { a[4 * i] = acc[i][0]; a[4 * i + 1] = acc[i][1]; a[4 * i + 2] = acc[i][2]; a[4 * i + 3] = acc[i][3]; }
#define TR_STEP(n) do { const bool hi_ = (lane & (n)) != 0; _Pragma("unroll") for (int i = 0; i < (n); ++i) { const float send = hi_ ? a[i] : a[i + (n)], keep = hi_ ? a[i + (n)] : a[i]; a[i] = keep + __shfl_xor(send, (n)); } } while (0)
            TR_STEP(32); TR_STEP(16); TR_STEP(8); TR_STEP(4); TR_STEP(2); TR_STEP(1);
#undef TR_STEP
            GK[(size_t)r0 * 16 + lane] = a[0];
        }
    }
}

__device__ __forceinline__ void gla_prep_unit(const Ctx& F, const Params& P, int b, int c, int h, size_t pgrp) {
    LAS float* gk_s = (LAS float*)(F.lds);
    LAS float* part = (LAS float*)(F.lds + 4096);
    const int tid = F.tid, d = tid & 127, g = tid >> 7;
    bf16* PROJ = (bf16*)(P.ws + R2); const float* GK = (const float*)(P.ws + R2_GK);
    float* BL = (float*)(P.ws + R0_BL);
    const float* wup = P.in[3]; const float* bgk = P.in[4];
    const int u = (b * 64 + c) * 4 + h;
    const size_t m0 = (size_t)b * SEQ + (size_t)c * 64;
    if (tid < 256) ((LAS f32x4*)gk_s)[tid] = *(const f32x4*)(GK + m0 * 16 + (size_t)tid * 4);
    bf16* qp = PROJ + (m0 + 16 * g) * PROJ_LD + h * 128 + d; bf16* kp = qp + 512;
    { const f32x4 a = *(const f32x4*)(P.in[1] + pgrp * 8), a2 = *(const f32x4*)(P.in[1] + pgrp * 8 + 4);
      u32x4 o; o.x = pk2(a[0], a[1]); o.y = pk2(a[2], a[3]); o.z = pk2(a2[0], a2[1]); o.w = pk2(a2[2], a2[3]); *(u32x4*)((bf16*)P.out + pgrp * 8) = o; }
    unsigned short qraw[16], kraw[16];
#pragma unroll
    for (int tt = 0; tt < 16; ++tt) { qraw[tt] = qp[(size_t)tt * PROJ_LD]; kraw[tt] = kp[(size_t)tt * PROJ_LD]; }
    float w[16];
#pragma unroll
    for (int r = 0; r < 16; ++r) w[r] = wup[r * 512 + h * 128 + d];
    const float bias = bgk[h * 128 + d];
    LBAR();
    float cs[16]; float run = 0.f;
#pragma unroll
    for (int tt = 0; tt < 16; ++tt) {
        const int t = 16 * g + tt; float z = bias;
#pragma unroll
        for (int r4 = 0; r4 < 4; ++r4) { const f32x4 a = ((const LAS f32x4*)gk_s)[t * 4 + r4]; z += a[0] * w[4 * r4] + a[1] * w[4 * r4 + 1] + a[2] * w[4 * r4 + 2] + a[3] * w[4 * r4 + 3]; }
        const float ls = fminf(z, 0.f) - __logf(1.0f + __expf(-fabsf(z)));
        run += ls * (1.0f / 16.0f); cs[tt] = run;
    }
    part[g * 128 + d] = run;
    LBAR();
    float off = 0.f, tot = 0.f;
#pragma unroll
    for (int gg = 0; gg < 4; ++gg) { const float pv = part[gg * 128 + d]; tot += pv; if (gg < g) off += pv; }
#pragma unroll
    for (int tt = 0; tt < 16; ++tt) {
        const float bc = cs[tt] + off;
        const float qv = bf2f(qraw[tt]), kv = bf2f(kraw[tt]);
        const float e1 = __expf(bc), e2 = __expf(-bc);
        qp[(size_t)tt * PROJ_LD] = (bf16)(pk2(qv * 0.08838834764831845f * e1, 0.f) & 0xffffu);
        kp[(size_t)tt * PROJ_LD] = (bf16)(pk2(kv * e2, 0.f) & 0xffffu);
    }
    if (g == 0) BL[(size_t)u * 128 + d] = tot;
    LBAR();
}

typedef short v4i16_t __attribute__((ext_vector_type(4)));
__device__ __forceinline__ s16x4 ldtr(const LAS unsigned char* p) { return __builtin_bit_cast(s16x4, __builtin_amdgcn_ds_read_tr16_b64_v4i16((LAS v4i16_t*)p)); }
constexpr int GS_Q = 0, GS_K = 17408, GS_V = 34816, GS_ATT = 68608, GS_RS = 77824, GS_RSTD = 79872, GS_BL = 80128;
constexpr size_t R0_SLOC = R1, R0_GSEG = R1 + 40 * MiB;
template <bool FULL>
__device__ __forceinline__ void gla_scan_pass(const Ctx& F, const Params& P) {
    LAS unsigned char* L = F.lds;
    const int tid = F.tid, lane = F.lane, w = F.wave, l15 = lane & 15, quad = lane >> 4;
    bf16* PROJ = (bf16*)(P.ws + R2);
    const float* BL = (const float*)(P.ws + R0_BL);
    float* SLOC = (float*)(P.ws + R0_SLOC); float* GSEG = (float*)(P.ws + R0_GSEG);
    const float* norm_g = P.in[5];
    for (int item = blockIdx.x; item < BATCH * 4 * 8; item += gridDim.x) {
        const int seg = item & 7, bh = item >> 3, b = bh >> 2, h = bh & 3;
        if (!FULL) {
#pragma unroll 1
            for (int cc = 0; cc < 8; ++cc) gla_prep_unit(F, P, b, seg * 8 + cc, h, ((size_t)(item * 8 + cc)) * 512 + tid);
            asm volatile("s_waitcnt vmcnt(0)" ::: "memory"); __builtin_amdgcn_s_barrier();
            __builtin_amdgcn_fence(__ATOMIC_ACQUIRE, "agent"); asm volatile("s_waitcnt vmcnt(0)" ::: "memory");
            __builtin_amdgcn_s_barrier(); asm volatile("" ::: "memory");
            if (seg == 7) continue;
        }
        f32x4 S[8][2];
#pragma unroll
        for (int dt = 0; dt < 8; ++dt) { S[dt][0] = (f32x4){0.f, 0.f, 0.f, 0.f}; S[dt][1] = (f32x4){0.f, 0.f, 0.f, 0.f}; }
        if (FULL) {
#pragma unroll 1
            for (int j = 0; j < seg; ++j) {
                const float* gj = GSEG + (size_t)(bh * 8 + j) * 128 + 4 * quad; const f32x4* sl = (const f32x4*)(SLOC + (size_t)(bh * 8 + j) * 32768) + tid;
#pragma unroll
                for (int dt = 0; dt < 8; ++dt) { const f32x4 gg = *(const f32x4*)(gj + 16 * dt);
                    f32x4 dec; dec[0] = __expf(gg[0]); dec[1] = __expf(gg[1]); dec[2] = __expf(gg[2]); dec[3] = __expf(gg[3]);
                    S[dt][0] = S[dt][0] * dec + sl[(dt * 2 + 0) * 512]; S[dt][1] = S[dt][1] * dec + sl[(dt * 2 + 1) * 512]; }
            }
        }
        float gsum = 0.f;
        u32x4 pq[2], pk[2], pv[4]; float pbl = 0.f;
#define GS_LOADC(cidx) do { const int u_ = (b * 64 + (cidx)) * 4 + h; const size_t m_ = (size_t)b * SEQ + (size_t)(cidx) * 64; int tl_ = tid; asm volatile("" : "+v"(tl_)); \
            _Pragma("unroll") for (int i = 0; i < 2; ++i) { const int idx = tl_ + 512 * i, row = idx >> 4, pc = idx & 15; const bf16* src = PROJ + (m_ + row) * PROJ_LD + h * 128 + pc * 8; \
                if (FULL) pq[i] = *(const u32x4*)(src); pk[i] = *(const u32x4*)(src + 512); } \
            _Pragma("unroll") for (int i = 0; i < 4; ++i) { const int idx = tl_ + 512 * i, row = idx >> 5, pc = idx & 31; pv[i] = *(const u32x4*)(PROJ + (m_ + row) * PROJ_LD + 1024 + h * 256 + pc * 8); } \
            if (tl_ < 128) pbl = BL[(size_t)u_ * 128 + tl_]; } while (0)
        GS_LOADC(seg * 8);
#pragma unroll 1
        for (int cc = 0; cc < 8; ++cc) {
            const int c = seg * 8 + cc;
            const size_t m0 = (size_t)b * SEQ + (size_t)c * 64;
#pragma unroll
            for (int i = 0; i < 2; ++i) { const int idx = tid + 512 * i, row = idx >> 4, pc = idx & 15;
                if (FULL) *(LAS u32x4*)(L + GS_Q + row * 272 + pc * 16) = pq[i];
                *(LAS u32x4*)(L + GS_K + row * 272 + pc * 16) = pk[i]; }
#pragma unroll
            for (int i = 0; i < 4; ++i) { const int idx = tid + 512 * i, row = idx >> 5, pc = idx & 31; *(LAS u32x4*)(L + GS_V + row * 528 + pc * 16) = pv[i]; }
            if (tid < 128) { ((LAS float*)(L + GS_BL))[tid] = pbl; gsum += pbl; }
            LBAR();
            if (cc < 7) GS_LOADC(c + 1);
#define GS_VF(dst) do { _Pragma("unroll") for (int s2 = 0; s2 < 2; ++s2) _Pragma("unroll") for (int et = 0; et < 2; ++et) { \
                const LAS unsigned char* a_ = L + GS_V + (32 * s2 + 8 * quad + (l15 >> 2)) * 528 + (32 * w + 16 * et) * 2 + 8 * (l15 & 3); \
                const s16x4 lo_ = ldtr(a_), hi_ = ldtr(a_ + 4 * 528); dst[s2][et] = __builtin_shufflevector(lo_, hi_, 0, 1, 2, 3, 4, 5, 6, 7); } } while (0)
            f32x4 o[4][2];
            if (FULL) {
                { const int it = w >> 1;
#pragma unroll
                  for (int x = 0; x < 2; ++x) { const int jt = 2 * (w & 1) + x; f32x4 a = (f32x4){0.f, 0.f, 0.f, 0.f};
                      if (jt <= it) {
#pragma unroll
                          for (int ks = 0; ks < 4; ++ks) { const bf16x8 kf = lds16(L + GS_K + (16 * jt + l15) * 272 + ks * 64 + quad * 16), qf = lds16(L + GS_Q + (16 * it + l15) * 272 + ks * 64 + quad * 16);
                              a = MFMA16(kf, qf, a); }
                          const int ii = 16 * it + l15, j0 = 16 * jt + 4 * quad;
#pragma unroll
                          for (int j = 0; j < 4; ++j) if (j0 + j > ii) a[j] = 0.f;
                      }
                      u32x2 ww; ww.x = pk2(a[0], a[1]); ww.y = pk2(a[2], a[3]);
                      *(LAS u32x2*)(L + GS_ATT + (16 * it + l15) * 144 + (16 * jt + 4 * quad) * 2) = ww; } }
                LBAR();
#pragma unroll
                for (int it = 0; it < 4; ++it) { o[it][0] = (f32x4){0.f, 0.f, 0.f, 0.f}; o[it][1] = (f32x4){0.f, 0.f, 0.f, 0.f}; }
#pragma unroll
                for (int s2 = 0; s2 < 4; ++s2) {
                    bf16x8 sf[2]; sf[0] = pack8(S[2 * s2][0], S[2 * s2 + 1][0]); sf[1] = pack8(S[2 * s2][1], S[2 * s2 + 1][1]);
#pragma unroll
                    for (int it = 0; it < 4; ++it) { const LAS unsigned char* qb = L + GS_Q + (16 * it + l15) * 272 + (32 * s2 + 4 * quad) * 2;
                        const bf16x8 qf = lds8x2(qb, qb + 32);
                        o[it][0] = MFMA16(sf[0], qf, o[it][0]); o[it][1] = MFMA16(sf[1], qf, o[it][1]); }
                }
                { bf16x8 vf[2][2]; GS_VF(vf);
#pragma unroll
                  for (int s2 = 0; s2 < 2; ++s2)
#pragma unroll
                    for (int it = 0; it < 4; ++it) { const bf16x8 af = lds16(L + GS_ATT + (16 * it + l15) * 144 + s2 * 64 + quad * 16);
                        o[it][0] = MFMA16(vf[s2][0], af, o[it][0]); o[it][1] = MFMA16(vf[s2][1], af, o[it][1]); } }
            }
            bf16x8 vf[2][2]; GS_VF(vf);
#pragma unroll
            for (int dt = 0; dt < 8; ++dt) {
                const f32x4 bl = *(const LAS f32x4*)(L + GS_BL + (16 * dt + 4 * quad) * 4);
                f32x4 dec; dec[0] = __expf(bl[0]); dec[1] = __expf(bl[1]); dec[2] = __expf(bl[2]); dec[3] = __expf(bl[3]);
#pragma unroll
                for (int s2 = 0; s2 < 2; ++s2) {
                    const LAS unsigned char* ka = L + GS_K + (32 * s2 + 8 * quad + (l15 >> 2)) * 272 + (16 * dt) * 2 + 8 * (l15 & 3);
                    const s16x4 klo = ldtr(ka), khi = ldtr(ka + 4 * 272); const bf16x8 kf = __builtin_shufflevector(klo, khi, 0, 1, 2, 3, 4, 5, 6, 7);
                    S[dt][0] = MFMA16(kf, vf[s2][0], S[dt][0]); S[dt][1] = MFMA16(kf, vf[s2][1], S[dt][1]); }
                S[dt][0] = S[dt][0] * dec; S[dt][1] = S[dt][1] * dec;
            }
            u32x2 rw[4][2];
            if (FULL) {
#pragma unroll
                for (int it = 0; it < 4; ++it)
#pragma unroll
                    for (int et = 0; et < 2; ++et) rw[it][et] = *(const u32x2*)(PROJ + (m0 + 16 * it + l15) * PROJ_LD + 2048 + h * 256 + 32 * w + 16 * et + 4 * quad);
#pragma unroll
                for (int it = 0; it < 4; ++it) { float ss = 0.f;
#pragma unroll
                    for (int et = 0; et < 2; ++et) ss += (o[it][et][0] * o[it][et][0] + o[it][et][1] * o[it][et][1]) + (o[it][et][2] * o[it][et][2] + o[it][et][3] * o[it][et][3]);
                    ss += __shfl_xor(ss, 16); ss += __shfl_xor(ss, 32);
                    if (quad == 0) ((LAS float*)(L + GS_RS))[w * 64 + 16 * it + l15] = ss; }
            }
            LBAR();
            if (FULL) {
                if (tid < 64) { float t = 0.f;
#pragma unroll
                    for (int ww = 0; ww < 8; ++ww) t += ((const LAS float*)(L + GS_RS))[ww * 64 + tid];
                    ((LAS float*)(L + GS_RSTD))[tid] = 1.0f / sqrtf(t * (1.0f / 256.0f) + RMS_EPS); }
                LBAR();
#pragma unroll
                for (int it = 0; it < 4; ++it) { const float rs = ((const LAS float*)(L + GS_RSTD))[16 * it + l15];
#pragma unroll
                    for (int et = 0; et < 2; ++et) { const int e0 = 32 * w + 16 * et + 4 * quad;
                        bf16* wp = PROJ + (m0 + 16 * it + l15) * PROJ_LD + 2048 + h * 256 + e0;
                        const u32x2 r2 = rw[it][et]; const f32x4 gg = *(const f32x4*)(norm_g + e0);
                        float rv[4]; rv[0] = __uint_as_float(r2.x << 16); rv[1] = __uint_as_float(r2.x & 0xffff0000u); rv[2] = __uint_as_float(r2.y << 16); rv[3] = __uint_as_float(r2.y & 0xffff0000u);
                        float ov[4];
#pragma unroll
                        for (int j = 0; j < 4; ++j) ov[j] = o[it][et][j] * rs * gg[j] * (rv[j] * __builtin_amdgcn_rcpf(1.0f + __expf(-rv[j])));
                        u32x2 ow; ow.x = pk2(ov[0], ov[1]); ow.y = pk2(ov[2], ov[3]); *(u32x2*)wp = ow; } }
            }
        }
#undef GS_LOADC
#undef GS_VF
        if (!FULL) {
            f32x4* sl = (f32x4*)(SLOC + (size_t)(bh * 8 + seg) * 32768) + tid;
#pragma unroll
            for (int dt = 0; dt < 8; ++dt) { sl[(dt * 2 + 0) * 512] = S[dt][0]; sl[(dt * 2 + 1) * 512] = S[dt][1]; }
            if (tid < 128) GSEG[(size_t)(bh * 8 + seg) * 128 + tid] = gsum;
        }
        LBAR();
    }
}

constexpr int SW_K = 0, SW_V = 36864;
__device__ __forceinline__ void swa_phase(const Ctx& F, const Params& P) {
    LAS unsigned char* L = F.lds;
    const int tid = F.tid, lane = F.lane, w = F.wave, l15 = lane & 15, quad = lane >> 4;
    const bf16* QKV = (const bf16*)(P.ws + R2_QKV); bf16* AO = (bf16*)(P.ws + R0);
    const float* sinks = P.in[9];
    for (int u = blockIdx.x; u < BATCH * 32 * 4; u += gridDim.x) {
        const int kvh = u & 3, n = (u >> 2) & 31, b = u >> 7;
        const long mb = (long)b * SEQ + (long)n * 128;
        const int g = w >> 1, hq = kvh * 4 + g;
        const bf16* qbase = QKV + (size_t)(mb + 64 * (w & 1) + l15) * QKV_LD + hq * 64 + quad * 8;
        bf16x8 qc0 = *(const bf16x8*)(qbase), qc1 = *(const bf16x8*)(qbase + 32);
        u32x4 kv[4], vv[4];
#pragma unroll
        for (int i = 0; i < 4; ++i) { const int idx = tid + 512 * i, jj = idx >> 3, pc = idx & 7;
            kv[i] = (u32x4){0u, 0u, 0u, 0u}; vv[i] = (u32x4){0u, 0u, 0u, 0u};
            if (n > 0 || jj >= 128) { const bf16* src = QKV + (size_t)(mb - 128 + jj) * QKV_LD + 1024 + kvh * 64 + pc * 8; kv[i] = *(const u32x4*)(src); vv[i] = *(const u32x4*)(src + 256); } }
#pragma unroll
        for (int i = 0; i < 2; ++i) { const size_t pg = (size_t)u * 1024 + tid + 512 * i; const float* src = P.in[1] + (size_t)M * PLE + pg * 8;
            const f32x4 a = *(const f32x4*)(src), a2 = *(const f32x4*)(src + 4);
            u32x4 o; o.x = pk2(a[0], a[1]); o.y = pk2(a[2], a[3]); o.z = pk2(a2[0], a2[1]); o.w = pk2(a2[2], a2[3]); *(u32x4*)((bf16*)(P.ws + PB1_OFF) + pg * 8) = o; }
        LBAR();
#pragma unroll
        for (int i = 0; i < 4; ++i) { const int idx = tid + 512 * i, jj = idx >> 3, pc = idx & 7;
            *(LAS u32x4*)(L + SW_K + jj * 144 + pc * 16) = kv[i]; *(LAS u32x4*)(L + SW_V + jj * 144 + pc * 16) = vv[i]; }
        LBAR();
        const float sink = sinks[hq];
#pragma unroll 1
        for (int qt = 0; qt < 4; ++qt) {
            const int q0 = 64 * (w & 1) + 16 * qt, kt0 = q0 >> 4, qi = q0 + l15;
            const bf16* qn = qbase + (size_t)(qt < 3 ? 16 * (qt + 1) : 0) * QKV_LD;
            const bf16x8 qn0 = *(const bf16x8*)(qn), qn1 = *(const bf16x8*)(qn + 32);
            f32x4 sc[9];
#pragma unroll
            for (int t = 0; t < 9; ++t) { const LAS unsigned char* kb = L + SW_K + (16 * (kt0 + t) + l15) * 144 + quad * 16;
                f32x4 a = (f32x4){0.f, 0.f, 0.f, 0.f}; a = MFMA16(lds16(kb), qc0, a); a = MFMA16(lds16(kb + 64), qc1, a); sc[t] = a; }
            constexpr float C2 = 0.125f * 1.4426950408889634f;
            const float sink2 = sink * 1.4426950408889634f;
#pragma unroll
            for (int j = 0; j < 4; ++j) { if (!(4 * quad + j > l15)) sc[0][j] = -INFINITY; if (!(4 * quad + j <= l15)) sc[8][j] = -INFINITY; }
            float mraw = -INFINITY;
#pragma unroll
            for (int t = 0; t < 9; ++t)
#pragma unroll
                for (int j = 0; j < 4; ++j) mraw = fmaxf(mraw, sc[t][j]);
            mraw = fmaxf(mraw, __shfl_xor(mraw, 16)); mraw = fmaxf(mraw, __shfl_xor(mraw, 32));
            const float m2 = fmaxf(mraw * C2, sink2);
            float den = 0.f;
#pragma unroll
            for (int t = 0; t < 9; ++t)
#pragma unroll
                for (int j = 0; j < 4; ++j) { const float p = __builtin_amdgcn_exp2f(sc[t][j] * C2 - m2); sc[t][j] = p; den += p; }
            den += __shfl_xor(den, 16); den += __shfl_xor(den, 32);
            den += __builtin_amdgcn_exp2f(sink2 - m2);
            const float rden = __builtin_amdgcn_rcpf(den);
            f32x4 ot[4];
#pragma unroll
            for (int dt = 0; dt < 4; ++dt) ot[dt] = (f32x4){0.f, 0.f, 0.f, 0.f};
#pragma unroll
            for (int s2 = 0; s2 < 5; ++s2) {
                const f32x4 z4 = (f32x4){0.f, 0.f, 0.f, 0.f};
                const bf16x8 pf = pack8(sc[2 * s2], (s2 < 4) ? sc[(2 * s2 + 1 < 9) ? 2 * s2 + 1 : 8] : z4);
                const int ka = 16 * (kt0 + 2 * s2), kb2 = (s2 < 4) ? ka + 16 : ka;
#pragma unroll
                for (int dt = 0; dt < 4; ++dt) { const LAS unsigned char* vb = L + SW_V + (4 * quad + (l15 >> 2)) * 144 + 32 * dt + 8 * (l15 & 3);
                    const s16x4 lo = ldtr(vb + ka * 144), hi = ldtr(vb + kb2 * 144);
                    const bf16x8 vf = __builtin_shufflevector(lo, hi, 0, 1, 2, 3, 4, 5, 6, 7);
                    ot[dt] = MFMA16(vf, pf, ot[dt]); }
            }
            bf16* op = AO + (size_t)(mb + qi) * D + hq * 64 + 4 * quad;
#pragma unroll
            for (int dt = 0; dt < 4; ++dt) { u32x2 ow; ow.x = pk2(ot[dt][0] * rden, ot[dt][1] * rden); ow.y = pk2(ot[dt][2] * rden, ot[dt][3] * rden); *(u32x2*)(op + 16 * dt) = ow; }
            qc0 = qn0; qc1 = qn1;
        }
    }
    LBAR();
}

#define XB_TMO      128
#define XB_XCNT(j)  (256  + 64 * (j))
#define XB_XSUB(j)  (1280 + 64 * (j))
#define XB_XGEN(j)  (2304 + 64 * (j))
#define XB_TOP      3328
#define XB_TOPGEN   3392
#define XCD_BAR_WORDS 3456
#define XB_SPIN_CAP (1u << 18)

__device__ __forceinline__ unsigned xb_ld(unsigned* p)              { return __hip_atomic_load(p, __ATOMIC_RELAXED, __HIP_MEMORY_SCOPE_AGENT); }
__device__ __forceinline__ unsigned xb_add(unsigned* p, unsigned v) { return __hip_atomic_fetch_add(p, v, __ATOMIC_RELAXED, __HIP_MEMORY_SCOPE_AGENT); }
__device__ __forceinline__ unsigned xb_xcc_id() { return (unsigned)__builtin_amdgcn_s_getreg((3 << 11) | 20) & 0xFu; }
#define XB_SPIN(cond, bar) do { unsigned _sp = 0; while (cond) { __builtin_amdgcn_s_sleep(1); \
    if ((++_sp & 255u) == 0u) { if (xb_ld(&(bar)[XB_TMO])) break; if (_sp > XB_SPIN_CAP) { atomicAdd(&(bar)[XB_TMO], 1u); break; } } } } while (0)

struct XcdBarrier {
    unsigned* bar; unsigned x;
    volatile LAS unsigned* st;
};

__device__ __forceinline__ XcdBarrier xcd_barrier_post(unsigned* bar, volatile LAS unsigned* st) {
    XcdBarrier b; b.bar = bar; b.x = xb_xcc_id(); b.st = st;
    if (threadIdx.x == 0) (void)xb_add(&bar[XB_XCNT(b.x)], 1u);
    return b;
}
__device__ __forceinline__ void xcd_barrier_complete(unsigned* bar, unsigned x, unsigned& nloc, unsigned& nx) {
    const unsigned G = gridDim.x * gridDim.y * gridDim.z;
    unsigned sum, cnt, mine, sp = 0u;
    for (;;) {
        sum = 0u; cnt = 0u; mine = 0u;
#pragma unroll
        for (unsigned j = 0; j < 16; ++j) { const unsigned c = xb_ld(&bar[XB_XCNT(j)]); sum += c; cnt += (c > 0u) ? 1u : 0u; mine = (j == x) ? c : mine; }
        if (sum == G) break;
        __builtin_amdgcn_s_sleep(1);
        if ((++sp & 255u) == 0u) { if (xb_ld(&bar[XB_TMO])) break; if (sp > XB_SPIN_CAP) { atomicAdd(&bar[XB_TMO], 1u); break; } }
    }
    nloc = mine > 0u ? mine : 1u; nx = cnt > 0u ? cnt : 1u;
}

__device__ __forceinline__ void xcd_barrier(const XcdBarrier& b) {
    asm volatile("s_waitcnt vmcnt(0)" ::: "memory");
    __syncthreads();
    if (threadIdx.x == 0) {
        unsigned* bar = b.bar;
        __builtin_amdgcn_s_waitcnt(0);
        unsigned nloc = b.st[0], nx = b.st[1];
        if (nloc == 0u) { xcd_barrier_complete(bar, b.x, nloc, nx); b.st[0] = nloc; b.st[1] = nx; }
        const unsigned old = xb_add(&bar[XB_XSUB(b.x)], 1u);
        const unsigned gen = old / nloc;
        if (old + 1u == (gen + 1u) * nloc) {
            __builtin_amdgcn_fence(__ATOMIC_RELEASE, "agent");
            asm volatile("s_waitcnt vmcnt(0)" ::: "memory");
            const unsigned og = xb_add(&bar[XB_TOP], 1u);
            const unsigned tg = og / nx;
            if (og + 1u == (tg + 1u) * nx) xb_add(&bar[XB_TOPGEN], 1u);
            else XB_SPIN(xb_ld(&bar[XB_TOPGEN]) == tg, bar);
            __builtin_amdgcn_fence(__ATOMIC_ACQUIRE, "agent");
            xb_add(&bar[XB_XGEN(b.x)], 1u);
            asm volatile("s_waitcnt vmcnt(0)" ::: "memory");
        } else {
            XB_SPIN(xb_ld(&bar[XB_XGEN(b.x)]) == gen, bar);
            __builtin_amdgcn_fence(__ATOMIC_ACQUIRE, "agent");
            asm volatile("s_waitcnt vmcnt(0)" ::: "memory");
        }
    }
    __syncthreads();
}

__global__ void __launch_bounds__(NTHREADS, 2) mega_fwd(Params P) {
    extern __shared__ __attribute__((aligned(16))) unsigned char lds_raw[];
    cg::grid_group grid = cg::this_grid();
    Ctx F; F.lds = (LAS unsigned char*)lds_raw;
#define GSYNC() do { XcdBarrier b2_ = bar; unsigned long long bp_ = (unsigned long long)b2_.bar; unsigned bx_ = __builtin_amdgcn_readfirstlane(b2_.x); asm volatile("" : "+s"(bp_), "+s"(bx_)); b2_.bar = (unsigned*)bp_; b2_.x = bx_; xcd_barrier(b2_); } while (0)
#define REFRESH() do { int t_ = threadIdx.x; asm volatile("" : "+v"(t_)); F.tid = t_; F.lane = t_ & 63; F.wave = __builtin_amdgcn_readfirstlane(t_ >> 6); } while (0)
    REFRESH();
    unsigned char* ws = P.ws;
    const int G = gridDim.x, cid = blockIdx.x;
    volatile LAS unsigned* MISC = (volatile LAS unsigned*)(F.lds + 131072 + 320);
    if (threadIdx.x < 32) MISC[threadIdx.x] = 0u;
    __syncthreads();
    XcdBarrier bar = xcd_barrier_post((unsigned*)(ws) + 1024, MISC + 8);
    bf16* A16 = (bf16*)(ws + R0); bf16* U16 = (bf16*)(ws + R2);
    bf16* Y1B = (bf16*)(ws + R1); bf16* Y2B = (bf16*)(ws + R1 + 64 * MiB); bf16* H3B = (bf16*)(ws + R2_H3B);
    float* ST1 = (float*)(ws + 504 * MiB); float* ST2 = (float*)(ws + 508 * MiB);
    LAS float* SX = (LAS float*)(F.lds + 131072 + 1024);

    grid.sync();
    p0_prologue(F, P);
    GSYNC();
    {
        pg8::Gemm g{A16, (const bf16*)(ws + W_IN_T), M, PROJ_LD, opq(D), D, D}; pg8::StaticOrder S; S.init(M, PROJ_LD, G, cid);
        pg8::EpiBf16 E{U16, PROJ_LD, nullptr, 1 << 30, nullptr};
        pg8::gemm_phase<pg8::EpiBf16, pg8::StaticOrder, true, true>(F.lds, g, S, E, SX);
    }
    GSYNC();
    REFRESH(); gla_scan_pass<false>(F, P);
    fold_finalize(P, cid * NTHREADS + F.tid, G * NTHREADS);
    GSYNC();
    REFRESH(); gla_scan_pass<true>(F, P);
    GSYNC();
#pragma unroll 1
    for (int layer = 0; layer < 2; ++layer) {
        const float* fin = (const float*)(ws + FIN(0)) + (size_t)layer * (64 * 1024 / 4);
        if (layer == 1) {
            {
                pg8::Gemm g{H3B, (const bf16*)(ws + W_QKV_T), M, QKV_LD, opq(D), D, D}; pg8::StaticOrder S; S.init(M, QKV_LD, G, cid);
                pg8::EpiBf16 E{(bf16*)(ws + R2_QKV), QKV_LD, P.in[8], 1 << 30, nullptr};
                pg8::gemm_phase<pg8::EpiBf16, pg8::StaticOrder, true, true>(F.lds, g, S, E, SX);
            }
            GSYNC();
            REFRESH(); swa_phase(F, P);
            GSYNC();
        }
        {
            const bf16* A = layer == 0 ? (const bf16*)(ws + R2) + 2048 : (const bf16*)A16;
            pg8::Gemm g{A, (const bf16*)(ws + (layer == 0 ? W_GOUT_T : W_SOUT_T)), M, D, opq(D), layer == 0 ? PROJ_LD : D, D}; pg8::StaticOrder S; S.init(M, D, G, cid);
            pg8::EpiY<false> E{layer == 0 ? (const void*)A16 : (const void*)H3B, 1, layer == 0 ? nullptr : P.in[11], nullptr, nullptr, nullptr, Y1B, ST1, ALPHA};
            pg8::gemm_phase<pg8::EpiY<false>, pg8::StaticOrder, true, true>(F.lds, g, S, E, SX);
        }
        GSYNC();
        {
            pg8::Gemm g{Y1B, (const bf16*)(ws + W_UP_T + (size_t)layer * W_LSTRIDE), M, FF, opq(D), D, D}; pg8::StaticOrder S; S.init(M, FF, G, cid);
            pg8::EpiUpLN E{ST1, fin, fin + 4096, U16, FF};
            pg8::gemm_phase<pg8::EpiUpLN, pg8::StaticOrder, true, true>(F.lds, g, S, E, SX);
        }
        GSYNC();
        {
            pg8::Gemm g{U16, (const bf16*)(ws + W_DN_T + (size_t)layer * W_LSTRIDE), M, D, opq(FF), FF, FF}; pg8::StaticOrder S; S.init(M, D, G, cid);
            pg8::EpiY<true> E{(const void*)Y1B, 1, nullptr, P.in[14] + layer * D, P.in[15] + layer * D, ST1, Y2B, ST2, ALPHA};
            pg8::gemm_phase<pg8::EpiY<true>, pg8::StaticOrder, true, true>(F.lds, g, S, E, SX);
        }
        GSYNC();
        {
            int kpp = opq(PLE); pg8::Gemm g{layer == 0 ? (const bf16*)P.out : (const bf16*)(ws + PB1_OFF), (const bf16*)(ws + W_PP_T + (size_t)layer * W_LSTRIDE), M, D, kpp, kpp, kpp}; pg8::StaticOrder S; S.init(M, D, G, cid);
            pg8::EpiPP E{(bf16*)(ws + R2_PP), D};
            pg8::gemm_phase<pg8::EpiPP, pg8::StaticOrder, true, true>(F.lds, g, S, E, SX);
        }
        __syncthreads();
        {
            pg8::Gemm g{Y2B, (const bf16*)(ws + W_GATE_T + (size_t)layer * W_LSTRIDE), M, D, opq(D), D, D}; pg8::StaticOrder S; S.init(M, D, G, cid);
            pg8::EpiGateLN E{ST2, Y2B, (const bf16*)(ws + R2_PP), fin + 8192, fin + 9216, P.in[16] + layer * D, P.in[17] + layer * D, P.out, layer == 0 ? H3B : nullptr};
            pg8::gemm_phase<pg8::EpiGateLN, pg8::StaticOrder, true, true>(F.lds, g, S, E, SX);
        }
        if (layer == 0) GSYNC();
    }
}

extern "C" void kernel_launch(void* const* d_in, const int* in_sizes, int n_in, void* d_out, int out_size, void* d_ws, size_t ws_size, hipStream_t stream) {
    static int grid = 0;
    if (grid == 0) {
        if (n_in != 21 || in_sizes[0] != M * D || out_size != M * D || ws_size < WS_END) { fprintf(stderr, "kernel_launch: unexpected shapes (n_in %d, in0 %d, out %d, ws %zu)\n", n_in, n_in > 0 ? in_sizes[0] : -1, out_size, ws_size); grid = -1; return; }
        int dev = 0, cus = 0, per_cu = 0;
        hipGetDevice(&dev); hipDeviceGetAttribute(&cus, hipDeviceAttributeMultiprocessorCount, dev);
        if (hipFuncSetAttribute((const void*)mega_fwd, hipFuncAttributeMaxDynamicSharedMemorySize, LDS_BYTES) != hipSuccess) { fprintf(stderr, "kernel_launch: hipFuncSetAttribute failed\n"); grid = -1; return; }
        if (hipOccupancyMaxActiveBlocksPerMultiprocessor(&per_cu, (const void*)mega_fwd, NTHREADS, LDS_BYTES) != hipSuccess || per_cu < 1) { fprintf(stderr, "kernel_launch: occupancy query says %d\n", per_cu); (void)hipGetLastError(); per_cu = 1; }
        grid = cus * 1;
        if (grid <= 0) grid = 256;
    }
    if (grid < 0) return;
    if (hipMemsetAsync(d_ws, 0, 65536, stream) != hipSuccess) { fprintf(stderr, "kernel_launch: memset failed\n"); return; }
    Params p{};
    for (int i = 0; i < 21; ++i) p.in[i] = (const float*)d_in[i];
    p.out = (float*)d_out; p.ws = (unsigned char*)d_ws;
    void* args[] = {&p};
    hipError_t e = hipLaunchCooperativeKernel((const void*)mega_fwd, dim3(grid), dim3(NTHREADS), args, LDS_BYTES, stream);
    if (e != hipSuccess) fprintf(stderr, "cooperative launch failed: %s (grid %d)\n", hipGetErrorString(e), grid);
}
```

```cpp
#include <hip/hip_runtime.h>
#include <hip/hip_cooperative_groups.h>
#include <cstdio>
#include <cstdint>
namespace cg = cooperative_groups;
namespace pg8 {
#define PG8_LAS __attribute__((address_space(3)))
typedef unsigned short bf16_t;
typedef short bf16x8 __attribute__((ext_vector_type(8)));
typedef float f32x4 __attribute__((ext_vector_type(4)));
typedef unsigned u32x4 __attribute__((ext_vector_type(4)));
constexpr int BM = 256, BK = 64, HALF = 128, HTB = HALF * BK * 2  , STAGE_BYTES = 8 * HTB, NXCD = 8, WGM = 8;

__host__ __device__ __forceinline__ int lds_byte(int r, int c) { const int st = (r >> 4) * 2 + (c >> 5), rr = r & 15, cc = c & 31, ob = rr * 64 + cc * 2; return st * 1024 + (ob ^ (((ob >> 9) & 1) << 5)); }
__host__ __device__ __forceinline__ void stage_rc(int b, int& R, int& C) { const int st = b / 1024, sb = b % 1024, swz = sb ^ (((sb >> 9) & 1) << 5); R = (st >> 1) * 16 + swz / 64; C = (st & 1) * 32 + (swz % 64) / 2; }
__host__ __device__ __forceinline__ int perm32(int rho) { const int n = rho >> 4, i = rho & 15; return 8 * (i >> 2) + 4 * n + (i & 3); }

struct Unit { int pm, pn; };
struct Gemm { const bf16_t* A; const bf16_t* Bt; int M, N, K, lda, ldb; };

struct StaticOrder {
    int nM, nN, nwg, G, c;
    __host__ __device__ void init(int M, int N, int G_, int c_) { nM = M / BM; nN = N / BM; nwg = nM * nN; G = G_; c = c_; }
    __host__ __device__ bool next(int i, Unit& u) const {
        const long L = (long)i * G + c; if (L >= nwg) return false;
        int wgid = (int)L; { const int q = nwg / NXCD, r = nwg % NXCD, xcd = wgid % NXCD, off = wgid / NXCD; wgid = (xcd < r ? xcd * (q + 1) : r * (q + 1) + (xcd - r) * q) + off; }
        const int nig = WGM * nN, gid = wgid / nig, fm = gid * WGM, gsz = (nM - fm) < WGM ? (nM - fm) : WGM;
        u.pm = fm + ((wgid % nig) % gsz); u.pn = (wgid % nig) / gsz; return true;
    }
    __device__ __forceinline__ void a_ready(const Unit&) const {}
    __device__ __forceinline__ void done(const Unit&) const {}
};


__device__ __forceinline__ unsigned cvt_pk_bf16(float lo, float hi) { unsigned r; asm volatile("v_cvt_pk_bf16_f32 %0, %1, %2" : "=v"(r) : "v"(lo), "v"(hi)); return r; }
typedef unsigned u32x2 __attribute__((ext_vector_type(2)));
typedef float f32x2 __attribute__((ext_vector_type(2)));
__device__ __forceinline__ float bf2f(unsigned short b) { return __uint_as_float(((unsigned)b) << 16); }
__device__ __forceinline__ void unpack8(const u32x4 w, float (&v)[8]) {
    v[0] = __uint_as_float(w.x << 16); v[1] = __uint_as_float(w.x & 0xffff0000u); v[2] = __uint_as_float(w.y << 16); v[3] = __uint_as_float(w.y & 0xffff0000u);
    v[4] = __uint_as_float(w.z << 16); v[5] = __uint_as_float(w.z & 0xffff0000u); v[6] = __uint_as_float(w.w << 16); v[7] = __uint_as_float(w.w & 0xffff0000u);
}
constexpr float EPI_LN_EPS = 1e-5f;
__device__ __forceinline__ void stats_pre(const float* ST, int pm, int slot, int tid, PG8_LAS float* sx) {
    if (tid < 256) {
        const f32x4* p = (const f32x4*)(ST + (size_t)(pm * BM + tid) * 32); float s = 0.f, q = 0.f;
#pragma unroll
        for (int i = 0; i < 8; ++i) { const f32x4 v = p[i]; s += v[0] + v[2]; q += v[1] + v[3]; }
        const float mean = s * (1.0f / 1024.0f), var = fmaxf(q * (1.0f / 1024.0f) - mean * mean, 0.f);
        *(PG8_LAS f32x2*)(sx + (slot * 256 + tid) * 2) = (f32x2){mean, 1.0f / sqrtf(var + EPI_LN_EPS)};
    }
}

struct EpiBf16 {
    static constexpr bool PERM = true, AFTER_DRAIN = false;
    bf16_t* O; int ldc; const float* bias; int gk_tile; float* GK;
    __device__ __forceinline__ void pre(const Unit&, int, int, PG8_LAS float*) const {}
    __device__ __forceinline__ void operator()(const f32x4 (&acc)[2][2][4][2], const Unit& u, int wr, int wc, int fr, int fq, int, PG8_LAS float*) const {
        const int row0 = u.pm * BM + wr * 64 + fr;
        if (u.pn >= gk_tile) {
            if (wc == 0 && fq < 2) {
#pragma unroll
                for (int ai = 0; ai < 2; ++ai)
#pragma unroll
                    for (int m = 0; m < 4; ++m) { float* gp = GK + (size_t)(row0 + ai * HALF + m * 16) * 16 + 8 * fq;
                        *(f32x4*)(gp) = acc[ai][0][m][0]; *(f32x4*)(gp + 4) = acc[ai][0][m][1]; }
            }
            return;
        }
        const int col0 = u.pn * BM + wc * 32 + 8 * fq;
#pragma unroll
        for (int bj = 0; bj < 2; ++bj) {
            f32x4 b0 = (f32x4){0.f, 0.f, 0.f, 0.f}, b1 = b0;
            if (bias) { b0 = *(const f32x4*)(bias + col0 + bj * HALF); b1 = *(const f32x4*)(bias + col0 + bj * HALF + 4); }
#pragma unroll
            for (int ai = 0; ai < 2; ++ai)
#pragma unroll
                for (int m = 0; m < 4; ++m) { const f32x4 v0 = acc[ai][bj][m][0] + b0, v1 = acc[ai][bj][m][1] + b1;
                    u32x4 w; w.x = cvt_pk_bf16(v0[0], v0[1]); w.y = cvt_pk_bf16(v0[2], v0[3]); w.z = cvt_pk_bf16(v1[0], v1[1]); w.w = cvt_pk_bf16(v1[2], v1[3]);
                    *(u32x4*)(O + (size_t)(row0 + ai * HALF + m * 16) * ldc + col0 + bj * HALF) = w; } }
    }
};

template <bool LN> struct EpiY {
    static constexpr bool PERM = true, AFTER_DRAIN = false;
    const void* res; int res_bf16; const float* bias; const float* g; const float* b; const float* ST_IN; bf16_t* Y; float* ST; float alpha;
    __device__ __forceinline__ void pre(const Unit& u, int slot, int tid, PG8_LAS float* sx) const { if (LN) stats_pre(ST_IN, u.pm, slot, tid, sx); }
    __device__ __forceinline__ void operator()(const f32x4 (&acc)[2][2][4][2], const Unit& u, int wr, int wc, int fr, int fq, int slot, PG8_LAS float* sx) const {
        const int col0 = u.pn * BM + wc * 32 + 8 * fq, rl0 = wr * 64 + fr; const size_t roff0 = (size_t)(u.pm * BM + rl0) * 1024;
        const bf16_t* R = (const bf16_t*)res;
        float ps[8], pq[8];
#pragma unroll
        for (int r = 0; r < 8; ++r) { ps[r] = 0.f; pq[r] = 0.f; }
#pragma unroll
        for (int bj = 0; bj < 2; ++bj) { const int c = col0 + bj * HALF;
            u32x4 rr[8];
#pragma unroll
            for (int r = 0; r < 8; ++r) rr[r] = *(const u32x4*)(R + roff0 + (size_t)((r >> 2) * HALF + (r & 3) * 16) * 1024 + c);
            f32x4 g0, g1, b0, b1, bb0, bb1;
            if (LN) { g0 = *(const f32x4*)(g + c); g1 = *(const f32x4*)(g + c + 4); b0 = *(const f32x4*)(b + c); b1 = *(const f32x4*)(b + c + 4); }
            if (bias) { bb0 = *(const f32x4*)(bias + c); bb1 = *(const f32x4*)(bias + c + 4); }
#pragma unroll
            for (int r = 0; r < 8; ++r) { const int ai = r >> 2, m = r & 3, rl = rl0 + ai * HALF + m * 16;
                float rv[8]; unpack8(rr[r], rv);
                if (LN) { const f32x2 mr = *(const PG8_LAS f32x2*)(sx + (slot * 256 + rl) * 2);
#pragma unroll
                    for (int i = 0; i < 4; ++i) { rv[i] = (rv[i] - mr[0]) * mr[1] * g0[i] + b0[i]; rv[4 + i] = (rv[4 + i] - mr[0]) * mr[1] * g1[i] + b1[i]; } }
                f32x4 v0 = acc[ai][bj][m][0], v1 = acc[ai][bj][m][1];
                if (bias) { v0 += bb0; v1 += bb1; }
                float y[8];
#pragma unroll
                for (int i = 0; i < 4; ++i) { y[i] = alpha * rv[i] + v0[i]; y[4 + i] = alpha * rv[4 + i] + v1[i]; }
                u32x4 w; w.x = cvt_pk_bf16(y[0], y[1]); w.y = cvt_pk_bf16(y[2], y[3]); w.z = cvt_pk_bf16(y[4], y[5]); w.w = cvt_pk_bf16(y[6], y[7]);
                *(u32x4*)(Y + roff0 + (size_t)(ai * HALF + m * 16) * 1024 + c) = w;
                float yr[8]; unpack8(w, yr);
#pragma unroll
                for (int i = 0; i < 8; ++i) { ps[r] += yr[i]; pq[r] += yr[i] * yr[i]; } }
        }
#pragma unroll
        for (int r = 0; r < 8; ++r) { float a = ps[r], q = pq[r];
            a += __shfl_xor(a, 16); a += __shfl_xor(a, 32); q += __shfl_xor(q, 16); q += __shfl_xor(q, 32);
            if (fq == 0) *(f32x2*)(ST + (size_t)(u.pm * BM + rl0 + (r >> 2) * HALF + (r & 3) * 16) * 32 + (u.pn * 4 + wc) * 2) = (f32x2){a, q}; }
    }
};

struct EpiUpLN {
    static constexpr bool PERM = true, AFTER_DRAIN = false;
    const float* ST_IN; const float* colsum; const float* bw; bf16_t* O; int ldc;
    __device__ __forceinline__ void pre(const Unit& u, int slot, int tid, PG8_LAS float* sx) const { stats_pre(ST_IN, u.pm, slot, tid, sx); }
    __device__ __forceinline__ void operator()(const f32x4 (&acc)[2][2][4][2], const Unit& u, int wr, int wc, int fr, int fq, int slot, PG8_LAS float* sx) const {
        const int col0 = u.pn * BM + wc * 32 + 8 * fq, rl0 = wr * 64 + fr;
#pragma unroll
        for (int bj = 0; bj < 2; ++bj) { const int c = col0 + bj * HALF;
            const f32x4 c0 = *(const f32x4*)(colsum + c), c1 = *(const f32x4*)(colsum + c + 4), w0 = *(const f32x4*)(bw + c), w1 = *(const f32x4*)(bw + c + 4);
#pragma unroll
            for (int r = 0; r < 8; ++r) { const int ai = r >> 2, m = r & 3, rl = rl0 + ai * HALF + m * 16;
                const f32x2 mr = *(const PG8_LAS f32x2*)(sx + (slot * 256 + rl) * 2);
                f32x4 v0 = (acc[ai][bj][m][0] - c0 * mr[0]) * mr[1] + w0, v1 = (acc[ai][bj][m][1] - c1 * mr[0]) * mr[1] + w1;
#pragma unroll
                for (int i = 0; i < 4; ++i) { const float a = fmaxf(v0[i], 0.f), b2 = fmaxf(v1[i], 0.f); v0[i] = a * a; v1[i] = b2 * b2; }
                u32x4 w; w.x = cvt_pk_bf16(v0[0], v0[1]); w.y = cvt_pk_bf16(v0[2], v0[3]); w.z = cvt_pk_bf16(v1[0], v1[1]); w.w = cvt_pk_bf16(v1[2], v1[3]);
                *(u32x4*)(O + (size_t)(u.pm * BM + rl) * ldc + c) = w; } }
    }
};

struct EpiPP {
    static constexpr bool PERM = true, AFTER_DRAIN = false;
    bf16_t* O; int ldc;
    __device__ __forceinline__ void pre(const Unit&, int, int, PG8_LAS float*) const {}
    __device__ __forceinline__ void operator()(const f32x4 (&acc)[2][2][4][2], const Unit& u, int wr, int wc, int fr, int fq, int, PG8_LAS float*) const {
        const int row0 = u.pm * BM + wr * 64 + fr, col0 = u.pn * BM + wc * 32 + 8 * fq;
#pragma unroll
        for (int ai = 0; ai < 2; ++ai)
#pragma unroll
            for (int m = 0; m < 4; ++m) { bf16_t* rowp = O + (size_t)(row0 + ai * HALF + m * 16) * ldc + col0;
#pragma unroll
                for (int bj = 0; bj < 2; ++bj) { const f32x4 v0 = acc[ai][bj][m][0], v1 = acc[ai][bj][m][1];
                    u32x4 w; w.x = cvt_pk_bf16(v0[0], v0[1]); w.y = cvt_pk_bf16(v0[2], v0[3]); w.z = cvt_pk_bf16(v1[0], v1[1]); w.w = cvt_pk_bf16(v1[2], v1[3]);
                    *(u32x4*)(rowp + bj * HALF) = w; } }
    }
};

struct EpiGateLN {
    static constexpr bool PERM = true, AFTER_DRAIN = false;
    const float* ST_IN; const bf16_t* YB; const bf16_t* pp; const float* colsum; const float* bz; const float* g; const float* b; float* out; bf16_t* ob;
    __device__ __forceinline__ void pre(const Unit& u, int slot, int tid, PG8_LAS float* sx) const { stats_pre(ST_IN, u.pm, slot, tid, sx); }
    __device__ __forceinline__ void operator()(const f32x4 (&acc)[2][2][4][2], const Unit& u, int wr, int wc, int fr, int fq, int slot, PG8_LAS float* sx) const {
        const int col0 = u.pn * BM + wc * 32 + 8 * fq, rl0 = wr * 64 + fr; const size_t roff0 = (size_t)(u.pm * BM + rl0) * 1024;
#pragma unroll
        for (int bj = 0; bj < 2; ++bj) { const int c = col0 + bj * HALF;
            f32x4 cs[2], zb[2], gg[2], bb[2];
#pragma unroll
            for (int hh = 0; hh < 2; ++hh) { cs[hh] = *(const f32x4*)(colsum + c + 4 * hh); zb[hh] = *(const f32x4*)(bz + c + 4 * hh); gg[hh] = *(const f32x4*)(g + c + 4 * hh); bb[hh] = *(const f32x4*)(b + c + 4 * hh); }
#pragma unroll
            for (int ai = 0; ai < 2; ++ai) {
                u32x4 yy[4], pw[4];
#pragma unroll
                for (int m = 0; m < 4; ++m) { const size_t o2 = roff0 + (size_t)(ai * HALF + m * 16) * 1024 + c; yy[m] = *(const u32x4*)(YB + o2); pw[m] = *(const u32x4*)(pp + o2); }
#pragma unroll
                for (int m = 0; m < 4; ++m) { const int rl = rl0 + ai * HALF + m * 16; const size_t o2 = roff0 + (size_t)(ai * HALF + m * 16) * 1024 + c;
                    const f32x2 mr = *(const PG8_LAS f32x2*)(sx + (slot * 256 + rl) * 2);
                    float y[8], p[8], o[8]; unpack8(yy[m], y); unpack8(pw[m], p);
#pragma unroll
                    for (int hh = 0; hh < 2; ++hh) { const f32x4 z = (acc[ai][bj][m][hh] - cs[hh] * mr[0]) * mr[1] + zb[hh];
#pragma unroll
                        for (int i = 0; i < 4; ++i) { const float h2 = (y[4 * hh + i] - mr[0]) * mr[1] * gg[hh][i] + bb[hh][i]; o[4 * hh + i] = h2 + p[4 * hh + i] * __builtin_amdgcn_rcpf(1.0f + __expf(-z[i])); } }
                    if (ob) { u32x4 w; w.x = cvt_pk_bf16(o[0], o[1]); w.y = cvt_pk_bf16(o[2], o[3]); w.z = cvt_pk_bf16(o[4], o[5]); w.w = cvt_pk_bf16(o[6], o[7]); *(u32x4*)(ob + o2) = w; }
                    else { *(f32x4*)(out + o2) = (f32x4){o[0], o[1], o[2], o[3]}; *(f32x4*)(out + o2 + 4) = (f32x4){o[4], o[5], o[6], o[7]}; } }
                asm volatile("" ::: "memory");
            } }
    }
};

template <class Epi, class Sched, bool ALIGN_EPI = false, bool SP2 = false>
__device__ __forceinline__ void gemm_phase(PG8_LAS unsigned char* lds, const Gemm g, const Sched& S, const Epi& E, PG8_LAS float* sx) {
    int tid_ = threadIdx.x; asm volatile("" : "+v"(tid_));
    const int tid = tid_, wid = __builtin_amdgcn_readfirstlane(tid >> 6), lane = tid & 63, wr = wid >> 2, wc = wid & 3, fr = lane & 15, fq = lane >> 4;
    const int K = g.K, nt = K / BK;
    unsigned voffA[2], voffB[2];
#pragma unroll
    for (int i = 0; i < 2; ++i) { int R, C; stage_rc(tid * 16 + i * 8192, R, C); const int Rb = Epi::PERM ? ((R & ~31) + perm32(R & 31)) : R;
        voffA[i] = (unsigned)(R * g.lda + C) * 2u; voffB[i] = (unsigned)(Rb * g.ldb + C) * 2u; }
    const size_t kstep = (size_t)(BK * 2);
    const size_t hstepA = (size_t)HALF * g.lda * 2, hstepB = (size_t)HALF * g.ldb * 2;
    const size_t tstepA = 2 * hstepA, tstepB = 2 * hstepB;
    const unsigned ldsw = (unsigned)wid * 1024u;
    const int aoff = lds_byte(wr * 64 + fr, fq * 8), boff = lds_byte(wc * 32 + fr, fq * 8);
#define PG8_SA(b, h) (((b) * 2 + (h)) * HTB)
#define PG8_SB(b, h) ((4 + (b) * 2 + (h)) * HTB)
#define PG8_STAGE(bufoff, gbase, voff) do { _Pragma("unroll") for (int _i = 0; _i < 2; ++_i) \
        __builtin_amdgcn_global_load_lds((const unsigned*)((const char*)(gbase) + (voff)[_i]), (PG8_LAS unsigned*)(lds + (bufoff) + ldsw + _i * 8192), 16, 0, 0); } while (0)
#define PG8_LDA(dst, b, h) do { _Pragma("unroll") for (int m = 0; m < 4; ++m) _Pragma("unroll") for (int k = 0; k < 2; ++k) dst[m][k] = *(const PG8_LAS bf16x8*)(lds + PG8_SA(b, h) + aoff + m * 2048 + k * 1024); } while (0)
#define PG8_LDB(dst, b, h) do { _Pragma("unroll") for (int n = 0; n < 2; ++n) _Pragma("unroll") for (int k = 0; k < 2; ++k) dst[n][k] = *(const PG8_LAS bf16x8*)(lds + PG8_SB(b, h) + boff + n * 2048 + k * 1024); } while (0)
#define PG8_MMA(ai, bj, At, Bt) do { __builtin_amdgcn_s_setprio(1); _Pragma("unroll") for (int m = 0; m < 4; ++m) _Pragma("unroll") for (int n = 0; n < 2; ++n) _Pragma("unroll") for (int k = 0; k < 2; ++k) \
        acc[ai][bj][m][n] = __builtin_amdgcn_mfma_f32_16x16x32_bf16(Bt[n][k], At[m][k], acc[ai][bj][m][n], 0, 0, 0); __builtin_amdgcn_s_setprio(0); } while (0)
#define PG8_WAIT_V(n) asm volatile("s_waitcnt vmcnt(" #n ")" ::: "memory")
#define PG8_WAIT_L(n) asm volatile("s_waitcnt lgkmcnt(" #n ")" ::: "memory")
#define PG8_BAR __builtin_amdgcn_s_barrier()
#define PG8_SCHED __builtin_amdgcn_sched_barrier(0)
    Unit cur, nxt; int ui = 0;
    if (!S.next(0, cur)) return;
    f32x4 acc[2][2][4][2];
#pragma unroll
    for (int a = 0; a < 2; ++a)
#pragma unroll
        for (int b = 0; b < 2; ++b)
#pragma unroll
            for (int m = 0; m < 4; ++m)
#pragma unroll
                for (int n = 0; n < 2; ++n) acc[a][b][m][n] = (f32x4){0.f, 0.f, 0.f, 0.f};
    bf16x8 At[4][2], B0[2][2], B1[2][2];
    const char* cA = (const char*)g.A + (size_t)cur.pm * tstepA; const char* cB = (const char*)g.Bt + (size_t)cur.pn * tstepB;
    S.a_ready(cur); E.pre(cur, 0, tid, sx);
    if constexpr (SP2) {
        PG8_STAGE(PG8_SB(0, 0), cB, voffB); PG8_STAGE(PG8_SB(0, 1), cB + hstepB, voffB); PG8_STAGE(PG8_SA(0, 0), cA, voffA); PG8_STAGE(PG8_SA(0, 1), cA + hstepA, voffA);
        if (wr == 1) PG8_BAR;
        PG8_WAIT_V(2); PG8_BAR;
        PG8_STAGE(PG8_SB(1, 0), cB + kstep, voffB); PG8_STAGE(PG8_SA(1, 0), cA + kstep, voffA); PG8_STAGE(PG8_SB(1, 1), cB + hstepB + kstep, voffB);
        PG8_WAIT_V(6); PG8_BAR;
    } else {
        PG8_STAGE(PG8_SB(0, 0), cB, voffB); PG8_STAGE(PG8_SA(0, 0), cA, voffA); PG8_STAGE(PG8_SB(0, 1), cB + hstepB, voffB); PG8_STAGE(PG8_SA(0, 1), cA + hstepA, voffA);
        if (wr == 1) PG8_BAR;
        PG8_WAIT_V(4); PG8_BAR;
        PG8_STAGE(PG8_SB(1, 0), cB + kstep, voffB); PG8_STAGE(PG8_SA(1, 0), cA + kstep, voffA); PG8_STAGE(PG8_SB(1, 1), cB + hstepB + kstep, voffB);
        PG8_WAIT_V(6); PG8_BAR;
    }
    for (;;) {
        const bool has_next = S.next(ui + 1, nxt);
        const char* nA = has_next ? (const char*)g.A + (size_t)nxt.pm * tstepA : cA; const char* nB = has_next ? (const char*)g.Bt + (size_t)nxt.pn * tstepB : cB;
        for (int t = 0; t < nt; t += 2) {
            const bool last = (t == nt - 2);
            const char* a1 = cA + (size_t)(t + 1) * kstep;
            const char* a2 = last ? nA : cA + (size_t)(t + 2) * kstep; const char* b2 = last ? nB : cB + (size_t)(t + 2) * kstep;
            const char* a3 = a2 + kstep; const char* b3 = b2 + kstep;
            if (last && has_next) { S.a_ready(nxt); E.pre(nxt, (ui + 1) & 1, tid, sx); }
            if constexpr (SP2) {
            PG8_LDB(B0, 0, 0); PG8_LDB(B1, 0, 1); PG8_SCHED; PG8_LDA(At, 0, 0); PG8_STAGE(PG8_SA(1, 1), a1 + hstepA, voffA);
            PG8_WAIT_V(8); PG8_WAIT_L(0); PG8_BAR; PG8_MMA(0, 0, At, B0); PG8_MMA(0, 1, At, B1); PG8_BAR; PG8_SCHED;
            PG8_LDA(At, 0, 1); PG8_STAGE(PG8_SB(0, 0), b2, voffB); PG8_STAGE(PG8_SB(0, 1), b2 + hstepB, voffB); PG8_STAGE(PG8_SA(0, 0), a2, voffA);
            PG8_WAIT_V(8); PG8_WAIT_L(0); PG8_BAR; PG8_MMA(1, 0, At, B0); PG8_MMA(1, 1, At, B1); PG8_BAR; PG8_SCHED;
            PG8_LDB(B0, 1, 0); PG8_LDB(B1, 1, 1); PG8_SCHED; PG8_LDA(At, 1, 0); PG8_STAGE(PG8_SA(0, 1), a2 + hstepA, voffA);
            PG8_WAIT_V(8); PG8_WAIT_L(0); PG8_BAR; PG8_MMA(0, 0, At, B0); PG8_MMA(0, 1, At, B1); PG8_BAR; PG8_SCHED;
            PG8_LDA(At, 1, 1); PG8_STAGE(PG8_SB(1, 0), b3, voffB); PG8_STAGE(PG8_SB(1, 1), b3 + hstepB, voffB); PG8_STAGE(PG8_SA(1, 0), a3, voffA);
            PG8_WAIT_V(8); PG8_WAIT_L(0); PG8_BAR; PG8_MMA(1, 0, At, B0); PG8_MMA(1, 1, At, B1); PG8_BAR; PG8_SCHED;
            } else {
            PG8_LDB(B0, 0, 0); PG8_SCHED; PG8_LDA(At, 0, 0); PG8_STAGE(PG8_SA(1, 1), a1 + hstepA, voffA);
            PG8_WAIT_L(8); PG8_BAR; PG8_WAIT_L(0); PG8_MMA(0, 0, At, B0); PG8_BAR; PG8_SCHED;
            PG8_LDB(B1, 0, 1); PG8_STAGE(PG8_SB(0, 0), b2, voffB);
            PG8_BAR; PG8_WAIT_L(0); PG8_MMA(0, 1, At, B1); PG8_BAR;
            PG8_LDA(At, 0, 1); PG8_STAGE(PG8_SA(0, 0), a2, voffA);
            PG8_BAR; PG8_WAIT_L(0); PG8_MMA(1, 0, At, B0); PG8_BAR; PG8_SCHED;
            PG8_STAGE(PG8_SB(0, 1), b2 + hstepB, voffB);
            PG8_WAIT_V(6); PG8_BAR; PG8_MMA(1, 1, At, B1); PG8_BAR;
            PG8_LDB(B0, 1, 0); PG8_SCHED; PG8_LDA(At, 1, 0); PG8_STAGE(PG8_SA(0, 1), a2 + hstepA, voffA);
            PG8_WAIT_L(8); PG8_BAR; PG8_WAIT_L(0); PG8_MMA(0, 0, At, B0); PG8_BAR; PG8_SCHED;
            PG8_LDB(B1, 1, 1); PG8_STAGE(PG8_SB(1, 0), b3, voffB);
            PG8_BAR; PG8_WAIT_L(0); PG8_MMA(0, 1, At, B1); PG8_BAR;
            PG8_LDA(At, 1, 1); PG8_STAGE(PG8_SA(1, 0), a3, voffA);
            PG8_BAR; PG8_WAIT_L(0); PG8_MMA(1, 0, At, B0); PG8_BAR; PG8_SCHED;
            PG8_STAGE(PG8_SB(1, 1), b3 + hstepB, voffB);
            PG8_WAIT_V(6); PG8_BAR; PG8_MMA(1, 1, At, B1); PG8_BAR;
            }
        }
        if constexpr (ALIGN_EPI) { if (wr == 0) PG8_BAR; }
        if constexpr (!Epi::AFTER_DRAIN) { E(acc, cur, wr, wc, fr, fq, ui & 1, sx); S.done(cur); }
        if (!has_next) break;
#pragma unroll
        for (int a = 0; a < 2; ++a)
#pragma unroll
            for (int b = 0; b < 2; ++b)
#pragma unroll
                for (int m = 0; m < 4; ++m)
#pragma unroll
                    for (int n = 0; n < 2; ++n) acc[a][b][m][n] = (f32x4){0.f, 0.f, 0.f, 0.f};
        cur = nxt; cA = nA; cB = nB; ++ui;
        if constexpr (ALIGN_EPI) { if (wr == 1) PG8_BAR; }
    }
    PG8_WAIT_V(0);
    if constexpr (!ALIGN_EPI) { if (wr == 0) PG8_BAR; }
    PG8_BAR;
    if constexpr (Epi::AFTER_DRAIN) { E.fused(acc, cur, wr, wc, fr, fq, lds, wid, lane); S.done(cur); }
#undef PG8_SA
#undef PG8_SB
#undef PG8_STAGE
#undef PG8_LDA
#undef PG8_LDB
#undef PG8_MMA
#undef PG8_WAIT_V
#undef PG8_WAIT_L
#undef PG8_BAR
#undef PG8_SCHED
}
}

#define LAS __attribute__((address_space(3)))
typedef unsigned short bf16;
typedef unsigned u32x4 __attribute__((ext_vector_type(4)));
typedef unsigned u32x2 __attribute__((ext_vector_type(2)));
typedef float f32x4 __attribute__((ext_vector_type(4)));
typedef short bf16x8 __attribute__((ext_vector_type(8)));
typedef short s16x4 __attribute__((ext_vector_type(4)));

constexpr int NTHREADS = 512, NWAVES = 8;
constexpr int BATCH = 8, SEQ = 4096, D = 1024, M = BATCH * SEQ, FF = 4096, PLE = 256;
constexpr int GLA_COLS = 3088, PROJ_LD = 3072;
constexpr int QKV_LD = 1536;
constexpr float LN_EPS = 1e-5f, RMS_EPS = 1e-5f;
constexpr float ALPHA = 1.4142135623730951f;
constexpr size_t MiB = 1u << 20;
constexpr size_t W_IN_T = 1 * MiB;
constexpr size_t W_GOUT_T = 7 * MiB;
constexpr size_t W_UP_T = 9 * MiB;
constexpr size_t W_DN_T = 17 * MiB;
constexpr size_t W_GATE_T = 25 * MiB;
constexpr size_t W_PP_T = 27 * MiB;
constexpr size_t W_QKV_T = 28 * MiB;
constexpr size_t W_SOUT_T = 31 * MiB;
constexpr size_t W_LSTRIDE = 24 * MiB;
constexpr size_t PB1_OFF = 1 * MiB;
constexpr size_t R0 = 56 * MiB;
constexpr size_t R1 = 120 * MiB;
constexpr size_t R2 = 248 * MiB;
constexpr size_t R2_GK = R2 + 192 * MiB;
constexpr size_t R2_PB = R2;
constexpr size_t R2_PP = R2 + 16 * MiB;
constexpr size_t R2_H3B = R2 + 80 * MiB;
constexpr size_t R2_QKV = R2 + 144 * MiB;
constexpr size_t R0_BL = R1 + 80 * MiB;
constexpr size_t WS_END = 512 * MiB;
constexpr int LDS_BYTES = 147456;

__device__ __forceinline__ int opq(int v) { asm volatile("" : "+s"(v)); return v; }
struct Params { const float* in[21]; float* out; unsigned char* ws; };
#define LBAR() do { asm volatile("s_waitcnt lgkmcnt(0)" ::: "memory"); __builtin_amdgcn_s_barrier(); asm volatile("" ::: "memory"); } while (0)

struct Ctx { LAS unsigned char* lds; int tid, lane, wave; };

__device__ __forceinline__ float wave_sum(float v) {
#pragma unroll
    for (int o = 1; o < 64; o <<= 1) v += __shfl_xor(v, o);
    return v;
}
__device__ __forceinline__ unsigned pk2(float lo, float hi) { return pg8::cvt_pk_bf16(lo, hi); }
__device__ __forceinline__ float bf2f(unsigned short b) { return __uint_as_float(((unsigned)b) << 16); }
__device__ __forceinline__ bf16x8 pack8(const f32x4 a, const f32x4 b) {
    u32x4 w; w.x = pk2(a[0], a[1]); w.y = pk2(a[2], a[3]); w.z = pk2(b[0], b[1]); w.w = pk2(b[2], b[3]); return __builtin_bit_cast(bf16x8, w);
}
#define MFMA16(a, b, c) __builtin_amdgcn_mfma_f32_16x16x32_bf16((a), (b), (c), 0, 0, 0)
__device__ __forceinline__ bf16x8 lds16(const LAS unsigned char* p) { return *(const LAS bf16x8*)p; }
__device__ __forceinline__ bf16x8 lds8x2(const LAS unsigned char* p0, const LAS unsigned char* p1) {
    const s16x4 lo = *(const LAS s16x4*)p0, hi = *(const LAS s16x4*)p1; return __builtin_shufflevector(lo, hi, 0, 1, 2, 3, 4, 5, 6, 7);
}

template <bool FOLD>
__device__ __forceinline__ void transpose_item(const float* W, int ldw, int nblk, int K, bf16* WT, LAS float* scr, int item, int lane,
                                               const float* gv = nullptr, const float* bv = nullptr, float* csp = nullptr, float* bwp = nullptr) {
    const int kb = item / nblk, nb = item % nblk, k0 = 64 * kb, n0 = 32 * nb;
    { const int r8 = lane >> 3, c4 = lane & 7;
      f32x4 v[8];
#pragma unroll
      for (int it = 0; it < 8; ++it) v[it] = *(const f32x4*)(W + (size_t)(k0 + 8 * it + r8) * ldw + n0 + 4 * c4);
#pragma unroll
      for (int it = 0; it < 8; ++it) { LAS float* d = scr + (8 * it + r8) * 33 + 4 * c4; d[0] = v[it][0]; d[1] = v[it][1]; d[2] = v[it][2]; d[3] = v[it][3]; } }
    asm volatile("s_waitcnt lgkmcnt(0)" ::: "memory");
    const int c = lane & 7;
    float gk[8], bk[8];
    if (FOLD) {
#pragma unroll
        for (int i = 0; i < 8; ++i) { gk[i] = gv[k0 + 8 * c + i]; bk[i] = bv[k0 + 8 * c + i]; }
    }
#pragma unroll
    for (int j = 0; j < 4; ++j) { const int n = (lane >> 3) + 8 * j; const LAS float* sp = scr + (8 * c) * 33 + n;
        float v[8];
#pragma unroll
        for (int i = 0; i < 8; ++i) v[i] = sp[i * 33];
        float bwv = 0.f;
        if (FOLD) {
#pragma unroll
            for (int i = 0; i < 8; ++i) { bwv += bk[i] * v[i]; v[i] *= gk[i]; }
        }
        u32x4 o; o.x = pk2(v[0], v[1]); o.y = pk2(v[2], v[3]); o.z = pk2(v[4], v[5]); o.w = pk2(v[6], v[7]);
        *(u32x4*)(WT + (size_t)(n0 + n) * K + k0 + 8 * c) = o;
        if (FOLD) {
            float r[8]; pg8::unpack8(o, r); float cs = ((r[0] + r[1]) + (r[2] + r[3])) + ((r[4] + r[5]) + (r[6] + r[7]));
            cs += __shfl_xor(cs, 1); cs += __shfl_xor(cs, 2); cs += __shfl_xor(cs, 4);
            bwv += __shfl_xor(bwv, 1); bwv += __shfl_xor(bwv, 2); bwv += __shfl_xor(bwv, 4);
            if (c == 0) { const int N = 32 * nblk; csp[(size_t)kb * N + n0 + n] = cs; bwp[(size_t)kb * N + n0 + n] = bwv; }
        }
    }
    asm volatile("s_waitcnt lgkmcnt(0)" ::: "memory");
}
constexpr size_t VEC = 52 * MiB;
__device__ __host__ constexpr size_t CSP_UP(int l) { return VEC + (size_t)l * 512 * 1024; }
__device__ __host__ constexpr size_t CSP_G(int l) { return VEC + MiB + (size_t)l * 128 * 1024; }
__device__ __host__ constexpr size_t FIN(int l) { return VEC + MiB + 512 * 1024 + (size_t)l * 64 * 1024; }
__device__ __forceinline__ void fold_finalize(const Params& P, int gtid, int gthreads) {
    for (int idx = gtid; idx < 2 * 5120; idx += gthreads) {
        const int l = idx / 5120, r = idx % 5120;
        float* fin = (float*)(P.ws + FIN(l));
        if (r < 4096) { const float* cp = (const float*)(P.ws + CSP_UP(l)); const float* bp = cp + 16 * 4096; float cs = 0.f, bw = 0.f;
#pragma unroll
            for (int kb = 0; kb < 16; ++kb) { cs += cp[kb * 4096 + r]; bw += bp[kb * 4096 + r]; }
            fin[r] = cs; fin[4096 + r] = bw; }
        else { const int n = r - 4096; const float* cp = (const float*)(P.ws + CSP_G(l)); const float* bp = cp + 16 * 1024; float cs = 0.f, bw = 0.f;
#pragma unroll
            for (int kb = 0; kb < 16; ++kb) { cs += cp[kb * 1024 + n]; bw += bp[kb * 1024 + n]; }
            fin[8192 + n] = cs; fin[9216 + n] = bw + P.in[20][l * D + n]; }
    }
}
__device__ __forceinline__ void p0_prologue(const Ctx& F, const Params& P) {
    LAS float* scr = (LAS float*)(F.lds + F.wave * 16384);
    const int gw = blockIdx.x * NWAVES + F.wave, NGW = gridDim.x * NWAVES;
    unsigned char* ws = P.ws;
    constexpr int I_IN = 16 * 96, I_SQ = 16 * 32, I_QKV = 16 * 48, I_UP = 16 * 128, I_DN = 64 * 32, I_PP = 4 * 32;
    constexpr int NITEMS = I_IN + 2 * I_SQ + I_QKV + 2 * I_UP + 2 * I_DN + 2 * I_SQ + 2 * I_PP;
    for (int it = gw; it < NITEMS; it += NGW) {
        int r = it;
        if (r < I_IN) { transpose_item<false>(P.in[2], GLA_COLS, 96, D, (bf16*)(ws + W_IN_T), scr, r, F.lane); continue; } r -= I_IN;
        if (r < I_SQ) { transpose_item<false>(P.in[6], D, 32, D, (bf16*)(ws + W_GOUT_T), scr, r, F.lane); continue; } r -= I_SQ;
        if (r < I_SQ) { transpose_item<false>(P.in[10], D, 32, D, (bf16*)(ws + W_SOUT_T), scr, r, F.lane); continue; } r -= I_SQ;
        if (r < I_QKV) { transpose_item<false>(P.in[7], QKV_LD, 48, D, (bf16*)(ws + W_QKV_T), scr, r, F.lane); continue; } r -= I_QKV;
        if (r < 2 * I_UP) { const int l = r / I_UP; transpose_item<true>(P.in[12] + (size_t)l * D * FF, FF, 128, D, (bf16*)(ws + W_UP_T + (size_t)l * W_LSTRIDE), scr, r % I_UP, F.lane, P.in[14] + l * D, P.in[15] + l * D, (float*)(ws + CSP_UP(l)), (float*)(ws + CSP_UP(l)) + 16 * 4096); continue; } r -= 2 * I_UP;
        if (r < 2 * I_DN) { const int l = r / I_DN; transpose_item<false>(P.in[13] + (size_t)l * D * FF, D, 32, FF, (bf16*)(ws + W_DN_T + (size_t)l * W_LSTRIDE), scr, r % I_DN, F.lane); continue; } r -= 2 * I_DN;
        if (r < 2 * I_SQ) { const int l = r / I_SQ; transpose_item<true>(P.in[19] + (size_t)l * D * D, D, 32, D, (bf16*)(ws + W_GATE_T + (size_t)l * W_LSTRIDE), scr, r % I_SQ, F.lane, P.in[16] + l * D, P.in[17] + l * D, (float*)(ws + CSP_G(l)), (float*)(ws + CSP_G(l)) + 16 * 1024); continue; } r -= 2 * I_SQ;
        { const int l = r / I_PP; transpose_item<false>(P.in[18] + (size_t)l * PLE * D, D, 32, PLE, (bf16*)(ws + W_PP_T + (size_t)l * W_LSTRIDE), scr, r % I_PP, F.lane); }
    }
    const int gtid = blockIdx.x * NTHREADS + F.tid, gthreads = gridDim.x * NTHREADS;
    {
        LAS float* wg = (LAS float*)F.lds;
        __syncthreads();
        for (int i = F.tid; i < 4096; i += NTHREADS) { const int k = i >> 2, c4 = i & 3, pos = (k & 3) * 256 + (k >> 2); *(LAS f32x4*)(wg + pos * 20 + 4 * c4) = *(const f32x4*)(P.in[2] + (size_t)k * GLA_COLS + 3072 + 4 * c4); }
        __syncthreads();
        const float* x = P.in[0]; bf16* xb = (bf16*)(ws + R0); float* GK = (float*)(ws + R2_GK);
        const int lane = F.lane;
#pragma unroll 1
        for (int r0 = gw * 4; r0 < M; r0 += NGW * 4) {
            f32x4 acc[16];
#pragma unroll
            for (int i = 0; i < 16; ++i) acc[i] = (f32x4){0.f, 0.f, 0.f, 0.f};
#pragma unroll 1
            for (int j = 0; j < 4; ++j) {
                float xs[4][4];
#pragma unroll
                for (int rr = 0; rr < 4; ++rr) { const f32x4 v = *(const f32x4*)(x + (size_t)(r0 + rr) * D + 256 * j + 4 * lane);
                    u32x2 o; o.x = pk2(v[0], v[1]); o.y = pk2(v[2], v[3]); *(u32x2*)(xb + (size_t)(r0 + rr) * D + 256 * j + 4 * lane) = o;
                    xs[rr][0] = v[0]; xs[rr][1] = v[1]; xs[rr][2] = v[2]; xs[rr][3] = v[3]; }
#pragma unroll
                for (int i = 0; i < 4; ++i) { const LAS float* wp = wg + (i * 256 + 64 * j + lane) * 20;
                    const f32x4 w0 = *(const LAS f32x4*)(wp), w1 = *(const LAS f32x4*)(wp + 4), w2 = *(const LAS f32x4*)(wp + 8), w3 = *(const LAS f32x4*)(wp + 12);
#pragma unroll
                    for (int rr = 0; rr < 4; ++rr) { const float xv = xs[rr][i]; acc[rr * 4 + 0] += w0 * xv; acc[rr * 4 + 1] += w1 * xv; acc[rr * 4 + 2] += w2 * xv; acc[rr * 4 + 3] += w3 * xv; } }
            }
            float a[64];
#pragma unroll
            for (int i = 0; i < 16; ++i) { a[4 * i] = acc[i][0]; a[4 * i + 1] = acc[i][1]; a[4 * i + 2] = acc[i][2]; a[4 * i + 3] = acc[i][3]; }
#define TR_STEP(n) do { const bool hi_ = (lane & (n)) != 0; _Pragma("unroll") for (int i = 0; i < (n); ++i) { const float send = hi_ ? a[i] : a[i + (n)], keep = hi_ ? a[i + (n)] : a[i]; a[i] = keep + __shfl_xor(send, (n)); } } while (0)
            TR_STEP(32); TR_STEP(16); TR_STEP(8); TR_STEP(4); TR_STEP(2); TR_STEP(1);
#undef TR_STEP
            GK[(size_t)r0 * 16 + lane] = a[0];
        }
    }
}

__device__ __forceinline__ void gla_prep_unit(const Ctx& F, const Params& P, int b, int c, int h, size_t pgrp) {
    LAS float* gk_s = (LAS float*)(F.lds);
    LAS float* part = (LAS float*)(F.lds + 4096);
    const int tid = F.tid, d = tid & 127, g = tid >> 7;
    bf16* PROJ = (bf16*)(P.ws + R2); const float* GK = (const float*)(P.ws + R2_GK);
    float* BL = (float*)(P.ws + R0_BL);
    const float* wup = P.in[3]; const float* bgk = P.in[4];
    const int u = (b * 64 + c) * 4 + h;
    const size_t m0 = (size_t)b * SEQ + (size_t)c * 64;
    if (tid < 256) ((LAS f32x4*)gk_s)[tid] = *(const f32x4*)(GK + m0 * 16 + (size_t)tid * 4);
    bf16* qp = PROJ + (m0 + 16 * g) * PROJ_LD + h * 128 + d; bf16* kp = qp + 512;
    { const f32x4 a = *(const f32x4*)(P.in[1] + pgrp * 8), a2 = *(const f32x4*)(P.in[1] + pgrp * 8 + 4);
      u32x4 o; o.x = pk2(a[0], a[1]); o.y = pk2(a[2], a[3]); o.z = pk2(a2[0], a2[1]); o.w = pk2(a2[2], a2[3]); *(u32x4*)((bf16*)P.out + pgrp * 8) = o; }
    unsigned short qraw[16], kraw[16];
#pragma unroll
    for (int tt = 0; tt < 16; ++tt) { qraw[tt] = qp[(size_t)tt * PROJ_LD]; kraw[tt] = kp[(size_t)tt * PROJ_LD]; }
    float w[16];
#pragma unroll
    for (int r = 0; r < 16; ++r) w[r] = wup[r * 512 + h * 128 + d];
    const float bias = bgk[h * 128 + d];
    LBAR();
    float cs[16]; float run = 0.f;
#pragma unroll
    for (int tt = 0; tt < 16; ++tt) {
        const int t = 16 * g + tt; float z = bias;
#pragma unroll
        for (int r4 = 0; r4 < 4; ++r4) { const f32x4 a = ((const LAS f32x4*)gk_s)[t * 4 + r4]; z += a[0] * w[4 * r4] + a[1] * w[4 * r4 + 1] + a[2] * w[4 * r4 + 2] + a[3] * w[4 * r4 + 3]; }
        const float ls = fminf(z, 0.f) - __logf(1.0f + __expf(-fabsf(z)));
        run += ls * (1.0f / 16.0f); cs[tt] = run;
    }
    part[g * 128 + d] = run;
    LBAR();
    float off = 0.f, tot = 0.f;
#pragma unroll
    for (int gg = 0; gg < 4; ++gg) { const float pv = part[gg * 128 + d]; tot += pv; if (gg < g) off += pv; }
#pragma unroll
    for (int tt = 0; tt < 16; ++tt) {
        const float bc = cs[tt] + off;
        const float qv = bf2f(qraw[tt]), kv = bf2f(kraw[tt]);
        const float e1 = __expf(bc), e2 = __expf(-bc);
        qp[(size_t)tt * PROJ_LD] = (bf16)(pk2(qv * 0.08838834764831845f * e1, 0.f) & 0xffffu);
        kp[(size_t)tt * PROJ_LD] = (bf16)(pk2(kv * e2, 0.f) & 0xffffu);
    }
    if (g == 0) BL[(size_t)u * 128 + d] = tot;
    LBAR();
}

typedef short v4i16_t __attribute__((ext_vector_type(4)));
__device__ __forceinline__ s16x4 ldtr(const LAS unsigned char* p) { return __builtin_bit_cast(s16x4, __builtin_amdgcn_ds_read_tr16_b64_v4i16((LAS v4i16_t*)p)); }
constexpr int GS_Q = 0, GS_K = 17408, GS_V = 34816, GS_ATT = 68608, GS_RS = 77824, GS_RSTD = 79872, GS_BL = 80128;
constexpr size_t R0_SLOC = R1, R0_GSEG = R1 + 40 * MiB;
template <bool FULL>
__device__ __forceinline__ void gla_scan_pass(const Ctx& F, const Params& P) {
    LAS unsigned char* L = F.lds;
    const int tid = F.tid, lane = F.lane, w = F.wave, l15 = lane & 15, quad = lane >> 4;
    bf16* PROJ = (bf16*)(P.ws + R2);
    const float* BL = (const float*)(P.ws + R0_BL);
    float* SLOC = (float*)(P.ws + R0_SLOC); float* GSEG = (float*)(P.ws + R0_GSEG);
    const float* norm_g = P.in[5];
    for (int item = blockIdx.x; item < BATCH * 4 * 8; item += gridDim.x) {
        const int seg = item & 7, bh = item >> 3, b = bh >> 2, h = bh & 3;
        if (!FULL) {
#pragma unroll 1
            for (int cc = 0; cc < 8; ++cc) gla_prep_unit(F, P, b, seg * 8 + cc, h, ((size_t)(item * 8 + cc)) * 512 + tid);
            asm volatile("s_waitcnt vmcnt(0)" ::: "memory"); __builtin_amdgcn_s_barrier();
            __builtin_amdgcn_fence(__ATOMIC_ACQUIRE, "agent"); asm volatile("s_waitcnt vmcnt(0)" ::: "memory");
            __builtin_amdgcn_s_barrier(); asm volatile("" ::: "memory");
            if (seg == 7) continue;
        }
        f32x4 S[8][2];
#pragma unroll
        for (int dt = 0; dt < 8; ++dt) { S[dt][0] = (f32x4){0.f, 0.f, 0.f, 0.f}; S[dt][1] = (f32x4){0.f, 0.f, 0.f, 0.f}; }
        if (FULL) {
#pragma unroll 1
            for (int j = 0; j < seg; ++j) {
                const float* gj = GSEG + (size_t)(bh * 8 + j) * 128 + 4 * quad; const f32x4* sl = (const f32x4*)(SLOC + (size_t)(bh * 8 + j) * 32768) + tid;
#pragma unroll
                for (int dt = 0; dt < 8; ++dt) { const f32x4 gg = *(const f32x4*)(gj + 16 * dt);
                    f32x4 dec; dec[0] = __expf(gg[0]); dec[1] = __expf(gg[1]); dec[2] = __expf(gg[2]); dec[3] = __expf(gg[3]);
                    S[dt][0] = S[dt][0] * dec + sl[(dt * 2 + 0) * 512]; S[dt][1] = S[dt][1] * dec + sl[(dt * 2 + 1) * 512]; }
            }
        }
        float gsum = 0.f;
        u32x4 pq[2], pk[2], pv[4]; float pbl = 0.f;
#define GS_LOADC(cidx) do { const int u_ = (b * 64 + (cidx)) * 4 + h; const size_t m_ = (size_t)b * SEQ + (size_t)(cidx) * 64; int tl_ = tid; asm volatile("" : "+v"(tl_)); \
            _Pragma("unroll") for (int i = 0; i < 2; ++i) { const int idx = tl_ + 512 * i, row = idx >> 4, pc = idx & 15; const bf16* src = PROJ + (m_ + row) * PROJ_LD + h * 128 + pc * 8; \
                if (FULL) pq[i] = *(const u32x4*)(src); pk[i] = *(const u32x4*)(src + 512); } \
            _Pragma("unroll") for (int i = 0; i < 4; ++i) { const int idx = tl_ + 512 * i, row = idx >> 5, pc = idx & 31; pv[i] = *(const u32x4*)(PROJ + (m_ + row) * PROJ_LD + 1024 + h * 256 + pc * 8); } \
            if (tl_ < 128) pbl = BL[(size_t)u_ * 128 + tl_]; } while (0)
        GS_LOADC(seg * 8);
#pragma unroll 1
        for (int cc = 0; cc < 8; ++cc) {
            const int c = seg * 8 + cc;
            const size_t m0 = (size_t)b * SEQ + (size_t)c * 64;
#pragma unroll
            for (int i = 0; i < 2; ++i) { const int idx = tid + 512 * i, row = idx >> 4, pc = idx & 15;
                if (FULL) *(LAS u32x4*)(L + GS_Q + row * 272 + pc * 16) = pq[i];
                *(LAS u32x4*)(L + GS_K + row * 272 + pc * 16) = pk[i]; }
#pragma unroll
            for (int i = 0; i < 4; ++i) { const int idx = tid + 512 * i, row = idx >> 5, pc = idx & 31; *(LAS u32x4*)(L + GS_V + row * 528 + pc * 16) = pv[i]; }
            if (tid < 128) { ((LAS float*)(L + GS_BL))[tid] = pbl; gsum += pbl; }
            LBAR();
            if (cc < 7) GS_LOADC(c + 1);
#define GS_VF(dst) do { _Pragma("unroll") for (int s2 = 0; s2 < 2; ++s2) _Pragma("unroll") for (int et = 0; et < 2; ++et) { \
                const LAS unsigned char* a_ = L + GS_V + (32 * s2 + 8 * quad + (l15 >> 2)) * 528 + (32 * w + 16 * et) * 2 + 8 * (l15 & 3); \
                const s16x4 lo_ = ldtr(a_), hi_ = ldtr(a_ + 4 * 528); dst[s2][et] = __builtin_shufflevector(lo_, hi_, 0, 1, 2, 3, 4, 5, 6, 7); } } while (0)
            f32x4 o[4][2];
            if (FULL) {
                { const int it = w >> 1;
#pragma unroll
                  for (int x = 0; x < 2; ++x) { const int jt = 2 * (w & 1) + x; f32x4 a = (f32x4){0.f, 0.f, 0.f, 0.f};
                      if (jt <= it) {
#pragma unroll
                          for (int ks = 0; ks < 4; ++ks) { const bf16x8 kf = lds16(L + GS_K + (16 * jt + l15) * 272 + ks * 64 + quad * 16), qf = lds16(L + GS_Q + (16 * it + l15) * 272 + ks * 64 + quad * 16);
                              a = MFMA16(kf, qf, a); }
                          const int ii = 16 * it + l15, j0 = 16 * jt + 4 * quad;
#pragma unroll
                          for (int j = 0; j < 4; ++j) if (j0 + j > ii) a[j] = 0.f;
                      }
                      u32x2 ww; ww.x = pk2(a[0], a[1]); ww.y = pk2(a[2], a[3]);
                      *(LAS u32x2*)(L + GS_ATT + (16 * it + l15) * 144 + (16 * jt + 4 * quad) * 2) = ww; } }
                LBAR();
#pragma unroll
                for (int it = 0; it < 4; ++it) { o[it][0] = (f32x4){0.f, 0.f, 0.f, 0.f}; o[it][1] = (f32x4){0.f, 0.f, 0.f, 0.f}; }
#pragma unroll
                for (int s2 = 0; s2 < 4; ++s2) {
                    bf16x8 sf[2]; sf[0] = pack8(S[2 * s2][0], S[2 * s2 + 1][0]); sf[1] = pack8(S[2 * s2][1], S[2 * s2 + 1][1]);
#pragma unroll
                    for (int it = 0; it < 4; ++it) { const LAS unsigned char* qb = L + GS_Q + (16 * it + l15) * 272 + (32 * s2 + 4 * quad) * 2;
                        const bf16x8 qf = lds8x2(qb, qb + 32);
                        o[it][0] = MFMA16(sf[0], qf, o[it][0]); o[it][1] = MFMA16(sf[1], qf, o[it][1]); }
                }
                { bf16x8 vf[2][2]; GS_VF(vf);
#pragma unroll
                  for (int s2 = 0; s2 < 2; ++s2)
#pragma unroll
                    for (int it = 0; it < 4; ++it) { const bf16x8 af = lds16(L + GS_ATT + (16 * it + l15) * 144 + s2 * 64 + quad * 16);
                        o[it][0] = MFMA16(vf[s2][0], af, o[it][0]); o[it][1] = MFMA16(vf[s2][1], af, o[it][1]); } }
            }
            bf16x8 vf[2][2]; GS_VF(vf);
#pragma unroll
            for (int dt = 0; dt < 8; ++dt) {
                const f32x4 bl = *(const LAS f32x4*)(L + GS_BL + (16 * dt + 4 * quad) * 4);
                f32x4 dec; dec[0] = __expf(bl[0]); dec[1] = __expf(bl[1]); dec[2] = __expf(bl[2]); dec[3] = __expf(bl[3]);
#pragma unroll
                for (int s2 = 0; s2 < 2; ++s2) {
                    const LAS unsigned char* ka = L + GS_K + (32 * s2 + 8 * quad + (l15 >> 2)) * 272 + (16 * dt) * 2 + 8 * (l15 & 3);
                    const s16x4 klo = ldtr(ka), khi = ldtr(ka + 4 * 272); const bf16x8 kf = __builtin_shufflevector(klo, khi, 0, 1, 2, 3, 4, 5, 6, 7);
                    S[dt][0] = MFMA16(kf, vf[s2][0], S[dt][0]); S[dt][1] = MFMA16(kf, vf[s2][1], S[dt][1]); }
                S[dt][0] = S[dt][0] * dec; S[dt][1] = S[dt][1] * dec;
            }
            u32x2 rw[4][2];
            if (FULL) {
#pragma unroll
                for (int it = 0; it < 4; ++it)
#pragma unroll
                    for (int et = 0; et < 2; ++et) rw[it][et] = *(const u32x2*)(PROJ + (m0 + 16 * it + l15) * PROJ_LD + 2048 + h * 256 + 32 * w + 16 * et + 4 * quad);
#pragma unroll
                for (int it = 0; it < 4; ++it) { float ss = 0.f;
#pragma unroll
                    for (int et = 0; et < 2; ++et) ss += (o[it][et][0] * o[it][et][0] + o[it][et][1] * o[it][et][1]) + (o[it][et][2] * o[it][et][2] + o[it][et][3] * o[it][et][3]);
                    ss += __shfl_xor(ss, 16); ss += __shfl_xor(ss, 32);
                    if (quad == 0) ((LAS float*)(L + GS_RS))[w * 64 + 16 * it + l15] = ss; }
            }
            LBAR();
            if (FULL) {
                if (tid < 64) { float t = 0.f;
#pragma unroll
                    for (int ww = 0; ww < 8; ++ww) t += ((const LAS float*)(L + GS_RS))[ww * 64 + tid];
                    ((LAS float*)(L + GS_RSTD))[tid] = 1.0f / sqrtf(t * (1.0f / 256.0f) + RMS_EPS); }
                LBAR();
#pragma unroll
                for (int it = 0; it < 4; ++it) { const float rs = ((const LAS float*)(L + GS_RSTD))[16 * it + l15];
#pragma unroll
                    for (int et = 0; et < 2; ++et) { const int e0 = 32 * w + 16 * et + 4 * quad;
                        bf16* wp = PROJ + (m0 + 16 * it + l15) * PROJ_LD + 2048 + h * 256 + e0;
                        const u32x2 r2 = rw[it][et]; const f32x4 gg = *(const f32x4*)(norm_g + e0);
                        float rv[4]; rv[0] = __uint_as_float(r2.x << 16); rv[1] = __uint_as_float(r2.x & 0xffff0000u); rv[2] = __uint_as_float(r2.y << 16); rv[3] = __uint_as_float(r2.y & 0xffff0000u);
                        float ov[4];
#pragma unroll
                        for (int j = 0; j < 4; ++j) ov[j] = o[it][et][j] * rs * gg[j] * (rv[j] * __builtin_amdgcn_rcpf(1.0f + __expf(-rv[j])));
                        u32x2 ow; ow.x = pk2(ov[0], ov[1]); ow.y = pk2(ov[2], ov[3]); *(u32x2*)wp = ow; } }
            }
        }
#undef GS_LOADC
#undef GS_VF
        if (!FULL) {
            f32x4* sl = (f32x4*)(SLOC + (size_t)(bh * 8 + seg) * 32768) + tid;
#pragma unroll
            for (int dt = 0; dt < 8; ++dt) { sl[(dt * 2 + 0) * 512] = S[dt][0]; sl[(dt * 2 + 1) * 512] = S[dt][1]; }
            if (tid < 128) GSEG[(size_t)(bh * 8 + seg) * 128 + tid] = gsum;
        }
        LBAR();
    }
}

constexpr int SW_K = 0, SW_V = 36864;
__device__ __forceinline__ void swa_phase(const Ctx& F, const Params& P) {
    LAS unsigned char* L = F.lds;
    const int tid = F.tid, lane = F.lane, w = F.wave, l15 = lane & 15, quad = lane >> 4;
    const bf16* QKV = (const bf16*)(P.ws + R2_QKV); bf16* AO = (bf16*)(P.ws + R0);
    const float* sinks = P.in[9];
    for (int u = blockIdx.x; u < BATCH * 32 * 4; u += gridDim.x) {
        const int kvh = u & 3, n = (u >> 2) & 31, b = u >> 7;
        const long mb = (long)b * SEQ + (long)n * 128;
        const int g = w >> 1, hq = kvh * 4 + g;
        const bf16* qbase = QKV + (size_t)(mb + 64 * (w & 1) + l15) * QKV_LD + hq * 64 + quad * 8;
        bf16x8 qc0 = *(const bf16x8*)(qbase), qc1 = *(const bf16x8*)(qbase + 32);
        u32x4 kv[4], vv[4];
#pragma unroll
        for (int i = 0; i < 4; ++i) { const int idx = tid + 512 * i, jj = idx >> 3, pc = idx & 7;
            kv[i] = (u32x4){0u, 0u, 0u, 0u}; vv[i] = (u32x4){0u, 0u, 0u, 0u};
            if (n > 0 || jj >= 128) { const bf16* src = QKV + (size_t)(mb - 128 + jj) * QKV_LD + 1024 + kvh * 64 + pc * 8; kv[i] = *(const u32x4*)(src); vv[i] = *(const u32x4*)(src + 256); } }
#pragma unroll
        for (int i = 0; i < 2; ++i) { const size_t pg = (size_t)u * 1024 + tid + 512 * i; const float* src = P.in[1] + (size_t)M * PLE + pg * 8;
            const f32x4 a = *(const f32x4*)(src), a2 = *(const f32x4*)(src + 4);
            u32x4 o; o.x = pk2(a[0], a[1]); o.y = pk2(a[2], a[3]); o.z = pk2(a2[0], a2[1]); o.w = pk2(a2[2], a2[3]); *(u32x4*)((bf16*)(P.ws + PB1_OFF) + pg * 8) = o; }
        LBAR();
#pragma unroll
        for (int i = 0; i < 4; ++i) { const int idx = tid + 512 * i, jj = idx >> 3, pc = idx & 7;
            *(LAS u32x4*)(L + SW_K + jj * 144 + pc * 16) = kv[i]; *(LAS u32x4*)(L + SW_V + jj * 144 + pc * 16) = vv[i]; }
        LBAR();
        const float sink = sinks[hq];
#pragma unroll 1
        for (int qt = 0; qt < 4; ++qt) {
            const int q0 = 64 * (w & 1) + 16 * qt, kt0 = q0 >> 4, qi = q0 + l15;
            const bf16* qn = qbase + (size_t)(qt < 3 ? 16 * (qt + 1) : 0) * QKV_LD;
            const bf16x8 qn0 = *(const bf16x8*)(qn), qn1 = *(const bf16x8*)(qn + 32);
            f32x4 sc[9];
#pragma unroll
            for (int t = 0; t < 9; ++t) { const LAS unsigned char* kb = L + SW_K + (16 * (kt0 + t) + l15) * 144 + quad * 16;
                f32x4 a = (f32x4){0.f, 0.f, 0.f, 0.f}; a = MFMA16(lds16(kb), qc0, a); a = MFMA16(lds16(kb + 64), qc1, a); sc[t] = a; }
            constexpr float C2 = 0.125f * 1.4426950408889634f;
            const float sink2 = sink * 1.4426950408889634f;
#pragma unroll
            for (int j = 0; j < 4; ++j) { if (!(4 * quad + j > l15)) sc[0][j] = -INFINITY; if (!(4 * quad + j <= l15)) sc[8][j] = -INFINITY; }
            float mraw = -INFINITY;
#pragma unroll
            for (int t = 0; t < 9; ++t)
#pragma unroll
                for (int j = 0; j < 4; ++j) mraw = fmaxf(mraw, sc[t][j]);
            mraw = fmaxf(mraw, __shfl_xor(mraw, 16)); mraw = fmaxf(mraw, __shfl_xor(mraw, 32));
            const float m2 = fmaxf(mraw * C2, sink2);
            float den = 0.f;
#pragma unroll
            for (int t = 0; t < 9; ++t)
#pragma unroll
                for (int j = 0; j < 4; ++j) { const float p = __builtin_amdgcn_exp2f(sc[t][j] * C2 - m2); sc[t][j] = p; den += p; }
            den += __shfl_xor(den, 16); den += __shfl_xor(den, 32);
            den += __builtin_amdgcn_exp2f(sink2 - m2);
            const float rden = __builtin_amdgcn_rcpf(den);
            f32x4 ot[4];
#pragma unroll
            for (int dt = 0; dt < 4; ++dt) ot[dt] = (f32x4){0.f, 0.f, 0.f, 0.f};
#pragma unroll
            for (int s2 = 0; s2 < 5; ++s2) {
                const f32x4 z4 = (f32x4){0.f, 0.f, 0.f, 0.f};
                const bf16x8 pf = pack8(sc[2 * s2], (s2 < 4) ? sc[(2 * s2 + 1 < 9) ? 2 * s2 + 1 : 8] : z4);
                const int ka = 16 * (kt0 + 2 * s2), kb2 = (s2 < 4) ? ka + 16 : ka;
#pragma unroll
                for (int dt = 0; dt < 4; ++dt) { const LAS unsigned char* vb = L + SW_V + (4 * quad + (l15 >> 2)) * 144 + 32 * dt + 8 * (l15 & 3);
                    const s16x4 lo = ldtr(vb + ka * 144), hi = ldtr(vb + kb2 * 144);
                    const bf16x8 vf = __builtin_shufflevector(lo, hi, 0, 1, 2, 3, 4, 5, 6, 7);
                    ot[dt] = MFMA16(vf, pf, ot[dt]); }
            }
            bf16* op = AO + (size_t)(mb + qi) * D + hq * 64 + 4 * quad;
#pragma unroll
            for (int dt = 0; dt < 4; ++dt) { u32x2 ow; ow.x = pk2(ot[dt][0] * rden, ot[dt][1] * rden); ow.y = pk2(ot[dt][2] * rden, ot[dt][3] * rden); *(u32x2*)(op + 16 * dt) = ow; }
            qc0 = qn0; qc1 = qn1;
        }
    }
    LBAR();
}

#define XB_TMO      128
#define XB_XCNT(j)  (256  + 64 * (j))
#define XB_XSUB(j)  (1280 + 64 * (j))
#define XB_XGEN(j)  (2304 + 64 * (j))
#define XB_TOP      3328
#define XB_TOPGEN   3392
#define XCD_BAR_WORDS 3456
#define XB_SPIN_CAP (1u << 18)

__device__ __forceinline__ unsigned xb_ld(unsigned* p)              { return __hip_atomic_load(p, __ATOMIC_RELAXED, __HIP_MEMORY_SCOPE_AGENT); }
__device__ __forceinline__ unsigned xb_add(unsigned* p, unsigned v) { return __hip_atomic_fetch_add(p, v, __ATOMIC_RELAXED, __HIP_MEMORY_SCOPE_AGENT); }
__device__ __forceinline__ unsigned xb_xcc_id() { return (unsigned)__builtin_amdgcn_s_getreg((3 << 11) | 20) & 0xFu; }
#define XB_SPIN(cond, bar) do { unsigned _sp = 0; while (cond) { __builtin_amdgcn_s_sleep(1); \
    if ((++_sp & 255u) == 0u) { if (xb_ld(&(bar)[XB_TMO])) break; if (_sp > XB_SPIN_CAP) { atomicAdd(&(bar)[XB_TMO], 1u); break; } } } } while (0)

struct XcdBarrier {
    unsigned* bar; unsigned x;
    volatile LAS unsigned* st;
};

__device__ __forceinline__ XcdBarrier xcd_barrier_post(unsigned* bar, volatile LAS unsigned* st) {
    XcdBarrier b; b.bar = bar; b.x = xb_xcc_id(); b.st = st;
    if (threadIdx.x == 0) (void)xb_add(&bar[XB_XCNT(b.x)], 1u);
    return b;
}
__device__ __forceinline__ void xcd_barrier_complete(unsigned* bar, unsigned x, unsigned& nloc, unsigned& nx) {
    const unsigned G = gridDim.x * gridDim.y * gridDim.z;
    unsigned sum, cnt, mine, sp = 0u;
    for (;;) {
        sum = 0u; cnt = 0u; mine = 0u;
#pragma unroll
        for (unsigned j = 0; j < 16; ++j) { const unsigned c = xb_ld(&bar[XB_XCNT(j)]); sum += c; cnt += (c > 0u) ? 1u : 0u; mine = (j == x) ? c : mine; }
        if (sum == G) break;
        __builtin_amdgcn_s_sleep(1);
        if ((++sp & 255u) == 0u) { if (xb_ld(&bar[XB_TMO])) break; if (sp > XB_SPIN_CAP) { atomicAdd(&bar[XB_TMO], 1u); break; } }
    }
    nloc = mine > 0u ? mine : 1u; nx = cnt > 0u ? cnt : 1u;
}

__device__ __forceinline__ void xcd_barrier(const XcdBarrier& b) {
    asm volatile("s_waitcnt vmcnt(0)" ::: "memory");
    __syncthreads();
    if (threadIdx.x == 0) {
        unsigned* bar = b.bar;
        __builtin_amdgcn_s_waitcnt(0);
        unsigned nloc = b.st[0], nx = b.st[1];
        if (nloc == 0u) { xcd_barrier_complete(bar, b.x, nloc, nx); b.st[0] = nloc; b.st[1] = nx; }
        const unsigned old = xb_add(&bar[XB_XSUB(b.x)], 1u);
        const unsigned gen = old / nloc;
        if (old + 1u == (gen + 1u) * nloc) {
            __builtin_amdgcn_fence(__ATOMIC_RELEASE, "agent");
            asm volatile("s_waitcnt vmcnt(0)" ::: "memory");
            const unsigned og = xb_add(&bar[XB_TOP], 1u);
            const unsigned tg = og / nx;
            if (og + 1u == (tg + 1u) * nx) xb_add(&bar[XB_TOPGEN], 1u);
            else XB_SPIN(xb_ld(&bar[XB_TOPGEN]) == tg, bar);
            __builtin_amdgcn_fence(__ATOMIC_ACQUIRE, "agent");
            xb_add(&bar[XB_XGEN(b.x)], 1u);
            asm volatile("s_waitcnt vmcnt(0)" ::: "memory");
        } else {
            XB_SPIN(xb_ld(&bar[XB_XGEN(b.x)]) == gen, bar);
            __builtin_amdgcn_fence(__ATOMIC_ACQUIRE, "agent");
            asm volatile("s_waitcnt vmcnt(0)" ::: "memory");
        }
    }
    __syncthreads();
}

__global__ void __launch_bounds__(NTHREADS, 2) mega_fwd(Params P) {
    extern __shared__ __attribute__((aligned(16))) unsigned char lds_raw[];
    cg::grid_group grid = cg::this_grid();
    Ctx F; F.lds = (LAS unsigned char*)lds_raw;
#define GSYNC() do { XcdBarrier b2_ = bar; unsigned long long bp_ = (unsigned long long)b2_.bar; unsigned bx_ = __builtin_amdgcn_readfirstlane(b2_.x); asm volatile("" : "+s"(bp_), "+s"(bx_)); b2_.bar = (unsigned*)bp_; b2_.x = bx_; xcd_barrier(b2_); } while (0)
#define REFRESH() do { int t_ = threadIdx.x; asm volatile("" : "+v"(t_)); F.tid = t_; F.lane = t_ & 63; F.wave = __builtin_amdgcn_readfirstlane(t_ >> 6); } while (0)
    REFRESH();
    unsigned char* ws = P.ws;
    const int G = gridDim.x, cid = blockIdx.x;
    volatile LAS unsigned* MISC = (volatile LAS unsigned*)(F.lds + 131072 + 320);
    if (threadIdx.x < 32) MISC[threadIdx.x] = 0u;
    __syncthreads();
    if (cid == 0) for (int i = threadIdx.x; i < XCD_BAR_WORDS; i += NTHREADS) __hip_atomic_store((unsigned*)(ws) + 1024 + i, 0u, __ATOMIC_RELAXED, __HIP_MEMORY_SCOPE_AGENT);
    grid.sync();
    XcdBarrier bar = xcd_barrier_post((unsigned*)(ws) + 1024, MISC + 8);
    bf16* A16 = (bf16*)(ws + R0); bf16* U16 = (bf16*)(ws + R2);
    bf16* Y1B = (bf16*)(ws + R1); bf16* Y2B = (bf16*)(ws + R1 + 64 * MiB); bf16* H3B = (bf16*)(ws + R2_H3B);
    float* ST1 = (float*)(ws + 504 * MiB); float* ST2 = (float*)(ws + 508 * MiB);
    LAS float* SX = (LAS float*)(F.lds + 131072 + 1024);

    p0_prologue(F, P);
    GSYNC();
    {
        pg8::Gemm g{A16, (const bf16*)(ws + W_IN_T), M, PROJ_LD, opq(D), D, D}; pg8::StaticOrder S; S.init(M, PROJ_LD, G, cid);
        pg8::EpiBf16 E{U16, PROJ_LD, nullptr, 1 << 30, nullptr};
        pg8::gemm_phase<pg8::EpiBf16, pg8::StaticOrder, true, true>(F.lds, g, S, E, SX);
    }
    GSYNC();
    REFRESH(); gla_scan_pass<false>(F, P);
    fold_finalize(P, cid * NTHREADS + F.tid, G * NTHREADS);
    GSYNC();
    REFRESH(); gla_scan_pass<true>(F, P);
    GSYNC();
#pragma unroll 1
    for (int layer = 0; layer < 2; ++layer) {
        const float* fin = (const float*)(ws + FIN(0)) + (size_t)layer * (64 * 1024 / 4);
        if (layer == 1) {
            {
                pg8::Gemm g{H3B, (const bf16*)(ws + W_QKV_T), M, QKV_LD, opq(D), D, D}; pg8::StaticOrder S; S.init(M, QKV_LD, G, cid);
                pg8::EpiBf16 E{(bf16*)(ws + R2_QKV), QKV_LD, P.in[8], 1 << 30, nullptr};
                pg8::gemm_phase<pg8::EpiBf16, pg8::StaticOrder, true, true>(F.lds, g, S, E, SX);
            }
            GSYNC();
            REFRESH(); swa_phase(F, P);
            GSYNC();
        }
        {
            const bf16* A = layer == 0 ? (const bf16*)(ws + R2) + 2048 : (const bf16*)A16;
            pg8::Gemm g{A, (const bf16*)(ws + (layer == 0 ? W_GOUT_T : W_SOUT_T)), M, D, opq(D), layer == 0 ? PROJ_LD : D, D}; pg8::StaticOrder S; S.init(M, D, G, cid);
            pg8::EpiY<false> E{layer == 0 ? (const void*)A16 : (const void*)H3B, 1, layer == 0 ? nullptr : P.in[11], nullptr, nullptr, nullptr, Y1B, ST1, ALPHA};
            pg8::gemm_phase<pg8::EpiY<false>, pg8::StaticOrder, true, true>(F.lds, g, S, E, SX);
        }
        GSYNC();
        {
            pg8::Gemm g{Y1B, (const bf16*)(ws + W_UP_T + (size_t)layer * W_LSTRIDE), M, FF, opq(D), D, D}; pg8::StaticOrder S; S.init(M, FF, G, cid);
            pg8::EpiUpLN E{ST1, fin, fin + 4096, U16, FF};
            pg8::gemm_phase<pg8::EpiUpLN, pg8::StaticOrder, true, true>(F.lds, g, S, E, SX);
        }
        GSYNC();
        {
            pg8::Gemm g{U16, (const bf16*)(ws + W_DN_T + (size_t)layer * W_LSTRIDE), M, D, opq(FF), FF, FF}; pg8::StaticOrder S; S.init(M, D, G, cid);
            pg8::EpiY<true> E{(const void*)Y1B, 1, nullptr, P.in[14] + layer * D, P.in[15] + layer * D, ST1, Y2B, ST2, ALPHA};
            pg8::gemm_phase<pg8::EpiY<true>, pg8::StaticOrder, true, true>(F.lds, g, S, E, SX);
        }
        GSYNC();
        {
            int kpp = opq(PLE); pg8::Gemm g{layer == 0 ? (const bf16*)P.out : (const bf16*)(ws + PB1_OFF), (const bf16*)(ws + W_PP_T + (size_t)layer * W_LSTRIDE), M, D, kpp, kpp, kpp}; pg8::StaticOrder S; S.init(M, D, G, cid);
            pg8::EpiPP E{(bf16*)(ws + R2_PP), D};
            pg8::gemm_phase<pg8::EpiPP, pg8::StaticOrder, true, true>(F.lds, g, S, E, SX);
        }
        __syncthreads();
        {
            pg8::Gemm g{Y2B, (const bf16*)(ws + W_GATE_T + (size_t)layer * W_LSTRIDE), M, D, opq(D), D, D}; pg8::StaticOrder S; S.init(M, D, G, cid);
            pg8::EpiGateLN E{ST2, Y2B, (const bf16*)(ws + R2_PP), fin + 8192, fin + 9216, P.in[16] + layer * D, P.in[17] + layer * D, P.out, layer == 0 ? H3B : nullptr};
            pg8::gemm_phase<pg8::EpiGateLN, pg8::StaticOrder, true, true>(F.lds, g, S, E, SX);
        }
        if (layer == 0) GSYNC();
    }
}

extern "C" void kernel_launch(void* const* d_in, const int* in_sizes, int n_in, void* d_out, int out_size, void* d_ws, size_t ws_size, hipStream_t stream) {
    static int grid = 0;
    if (grid == 0) {
        if (n_in != 21 || in_sizes[0] != M * D || out_size != M * D || ws_size < WS_END) { fprintf(stderr, "kernel_launch: unexpected shapes (n_in %d, in0 %d, out %d, ws %zu)\n", n_in, n_in > 0 ? in_sizes[0] : -1, out_size, ws_size); grid = -1; return; }
        int dev = 0, cus = 0, per_cu = 0;
        hipGetDevice(&dev); hipDeviceGetAttribute(&cus, hipDeviceAttributeMultiprocessorCount, dev);
        if (hipFuncSetAttribute((const void*)mega_fwd, hipFuncAttributeMaxDynamicSharedMemorySize, LDS_BYTES) != hipSuccess) { fprintf(stderr, "kernel_launch: hipFuncSetAttribute failed\n"); grid = -1; return; }
        if (hipOccupancyMaxActiveBlocksPerMultiprocessor(&per_cu, (const void*)mega_fwd, NTHREADS, LDS_BYTES) != hipSuccess || per_cu < 1) { fprintf(stderr, "kernel_launch: occupancy query says %d\n", per_cu); (void)hipGetLastError(); per_cu = 1; }
        grid = cus * 1;
        if (grid <= 0) grid = 256;
    }
    if (grid < 0) return;
    Params p{};
    for (int i = 0; i < 21; ++i) p.in[i] = (const float*)d_in[i];
    p.out = (float*)d_out; p.ws = (unsigned char*)d_ws;
    void* args[] = {&p};
    hipError_t e = hipLaunchCooperativeKernel((const void*)mega_fwd, dim3(grid), dim3(NTHREADS), args, LDS_BYTES, stream);
    if (e != hipSuccess) fprintf(stderr, "cooperative launch failed: %s (grid %d)\n", hipGetErrorString(e), grid);
}
```

```cpp
#include <hip/hip_runtime.h>
#include <hip/hip_cooperative_groups.h>
#include <cstdio>
#include <cstdint>
namespace cg = cooperative_groups;
namespace pg8 {
#define PG8_LAS __attribute__((address_space(3)))
typedef unsigned short bf16_t;
typedef short bf16x8 __attribute__((ext_vector_type(8)));
typedef float f32x4 __attribute__((ext_vector_type(4)));
typedef unsigned u32x4 __attribute__((ext_vector_type(4)));
constexpr int BM = 256, BK = 64, HALF = 128, HTB = HALF * BK * 2  , STAGE_BYTES = 8 * HTB, NXCD = 8, WGM = 8;

__host__ __device__ __forceinline__ int lds_byte(int r, int c) { const int st = (r >> 4) * 2 + (c >> 5), rr = r & 15, cc = c & 31, ob = rr * 64 + cc * 2; return st * 1024 + (ob ^ (((ob >> 9) & 1) << 5)); }
__host__ __device__ __forceinline__ void stage_rc(int b, int& R, int& C) { const int st = b / 1024, sb = b % 1024, swz = sb ^ (((sb >> 9) & 1) << 5); R = (st >> 1) * 16 + swz / 64; C = (st & 1) * 32 + (swz % 64) / 2; }
__host__ __device__ __forceinline__ int perm32(int rho) { const int n = rho >> 4, i = rho & 15; return 8 * (i >> 2) + 4 * n + (i & 3); }

struct Unit { int pm, pn; };
struct Gemm { const bf16_t* A; const bf16_t* Bt; int M, N, K, lda, ldb; };

struct StaticOrder {
    int nM, nN, nwg, G, c;
    __host__ __device__ void init(int M, int N, int G_, int c_) { nM = M / BM; nN = N / BM; nwg = nM * nN; G = G_; c = c_; }
    __host__ __device__ bool next(int i, Unit& u) const {
        const long L = (long)i * G + c; if (L >= nwg) return false;
        int wgid = (int)L; { const int q = nwg / NXCD, r = nwg % NXCD, xcd = wgid % NXCD, off = wgid / NXCD; wgid = (xcd < r ? xcd * (q + 1) : r * (q + 1) + (xcd - r) * q) + off; }
        const int nig = WGM * nN, gid = wgid / nig, fm = gid * WGM, gsz = (nM - fm) < WGM ? (nM - fm) : WGM;
        u.pm = fm + ((wgid % nig) % gsz); u.pn = (wgid % nig) / gsz; return true;
    }
    __device__ __forceinline__ void a_ready(const Unit&) const {}
    __device__ __forceinline__ void done(const Unit&) const {}
};


__device__ __forceinline__ unsigned cvt_pk_bf16(float lo, float hi) { unsigned r; asm volatile("v_cvt_pk_bf16_f32 %0, %1, %2" : "=v"(r) : "v"(lo), "v"(hi)); return r; }
typedef unsigned u32x2 __attribute__((ext_vector_type(2)));
typedef float f32x2 __attribute__((ext_vector_type(2)));
__device__ __forceinline__ float bf2f(unsigned short b) { return __uint_as_float(((unsigned)b) << 16); }
__device__ __forceinline__ void unpack8(const u32x4 w, float (&v)[8]) {
    v[0] = __uint_as_float(w.x << 16); v[1] = __uint_as_float(w.x & 0xffff0000u); v[2] = __uint_as_float(w.y << 16); v[3] = __uint_as_float(w.y & 0xffff0000u);
    v[4] = __uint_as_float(w.z << 16); v[5] = __uint_as_float(w.z & 0xffff0000u); v[6] = __uint_as_float(w.w << 16); v[7] = __uint_as_float(w.w & 0xffff0000u);
}
constexpr float EPI_LN_EPS = 1e-5f;
__device__ __forceinline__ void stats_pre(const float* ST, int pm, int slot, int tid, PG8_LAS float* sx) {
    if (tid < 256) {
        const f32x4* p = (const f32x4*)(ST + (size_t)(pm * BM + tid) * 32); float s = 0.f, q = 0.f;
#pragma unroll
        for (int i = 0; i < 8; ++i) { const f32x4 v = p[i]; s += v[0] + v[2]; q += v[1] + v[3]; }
        const float mean = s * (1.0f / 1024.0f), var = fmaxf(q * (1.0f / 1024.0f) - mean * mean, 0.f);
        *(PG8_LAS f32x2*)(sx + (slot * 256 + tid) * 2) = (f32x2){mean, 1.0f / sqrtf(var + EPI_LN_EPS)};
    }
}

struct EpiBf16 {
    static constexpr bool PERM = true, AFTER_DRAIN = false;
    bf16_t* O; int ldc; const float* bias; int gk_tile; float* GK;
    __device__ __forceinline__ void pre(const Unit&, int, int, PG8_LAS float*) const {}
    __device__ __forceinline__ void operator()(const f32x4 (&acc)[2][2][4][2], const Unit& u, int wr, int wc, int fr, int fq, int, PG8_LAS float*) const {
        const int row0 = u.pm * BM + wr * 64 + fr;
        if (u.pn >= gk_tile) {
            if (wc == 0 && fq < 2) {
#pragma unroll
                for (int ai = 0; ai < 2; ++ai)
#pragma unroll
                    for (int m = 0; m < 4; ++m) { float* gp = GK + (size_t)(row0 + ai * HALF + m * 16) * 16 + 8 * fq;
                        *(f32x4*)(gp) = acc[ai][0][m][0]; *(f32x4*)(gp + 4) = acc[ai][0][m][1]; }
            }
            return;
        }
        const int col0 = u.pn * BM + wc * 32 + 8 * fq;
#pragma unroll
        for (int bj = 0; bj < 2; ++bj) {
            f32x4 b0 = (f32x4){0.f, 0.f, 0.f, 0.f}, b1 = b0;
            if (bias) { b0 = *(const f32x4*)(bias + col0 + bj * HALF); b1 = *(const f32x4*)(bias + col0 + bj * HALF + 4); }
#pragma unroll
            for (int ai = 0; ai < 2; ++ai)
#pragma unroll
                for (int m = 0; m < 4; ++m) { const f32x4 v0 = acc[ai][bj][m][0] + b0, v1 = acc[ai][bj][m][1] + b1;
                    u32x4 w; w.x = cvt_pk_bf16(v0[0], v0[1]); w.y = cvt_pk_bf16(v0[2], v0[3]); w.z = cvt_pk_bf16(v1[0], v1[1]); w.w = cvt_pk_bf16(v1[2], v1[3]);
                    *(u32x4*)(O + (size_t)(row0 + ai * HALF + m * 16) * ldc + col0 + bj * HALF) = w; } }
    }
};

template <bool LN> struct EpiY {
    static constexpr bool PERM = true, AFTER_DRAIN = false;
    const void* res; int res_bf16; const float* bias; const float* g; const float* b; const float* ST_IN; bf16_t* Y; float* ST; float alpha;
    __device__ __forceinline__ void pre(const Unit& u, int slot, int tid, PG8_LAS float* sx) const { if (LN) stats_pre(ST_IN, u.pm, slot, tid, sx); }
    __device__ __forceinline__ void operator()(const f32x4 (&acc)[2][2][4][2], const Unit& u, int wr, int wc, int fr, int fq, int slot, PG8_LAS float* sx) const {
        const int col0 = u.pn * BM + wc * 32 + 8 * fq, rl0 = wr * 64 + fr; const size_t roff0 = (size_t)(u.pm * BM + rl0) * 1024;
        const bf16_t* R = (const bf16_t*)res;
        float ps[8], pq[8];
#pragma unroll
        for (int r = 0; r < 8; ++r) { ps[r] = 0.f; pq[r] = 0.f; }
#pragma unroll
        for (int bj = 0; bj < 2; ++bj) { const int c = col0 + bj * HALF;
            u32x4 rr[8];
#pragma unroll
            for (int r = 0; r < 8; ++r) rr[r] = *(const u32x4*)(R + roff0 + (size_t)((r >> 2) * HALF + (r & 3) * 16) * 1024 + c);
            f32x4 g0, g1, b0, b1, bb0, bb1;
            if (LN) { g0 = *(const f32x4*)(g + c); g1 = *(const f32x4*)(g + c + 4); b0 = *(const f32x4*)(b + c); b1 = *(const f32x4*)(b + c + 4); }
            if (bias) { bb0 = *(const f32x4*)(bias + c); bb1 = *(const f32x4*)(bias + c + 4); }
#pragma unroll
            for (int r = 0; r < 8; ++r) { const int ai = r >> 2, m = r & 3, rl = rl0 + ai * HALF + m * 16;
                float rv[8]; unpack8(rr[r], rv);
                if (LN) { const f32x2 mr = *(const PG8_LAS f32x2*)(sx + (slot * 256 + rl) * 2);
#pragma unroll
                    for (int i = 0; i < 4; ++i) { rv[i] = (rv[i] - mr[0]) * mr[1] * g0[i] + b0[i]; rv[4 + i] = (rv[4 + i] - mr[0]) * mr[1] * g1[i] + b1[i]; } }
                f32x4 v0 = acc[ai][bj][m][0], v1 = acc[ai][bj][m][1];
                if (bias) { v0 += bb0; v1 += bb1; }
                float y[8];
#pragma unroll
                for (int i = 0; i < 4; ++i) { y[i] = alpha * rv[i] + v0[i]; y[4 + i] = alpha * rv[4 + i] + v1[i]; }
                u32x4 w; w.x = cvt_pk_bf16(y[0], y[1]); w.y = cvt_pk_bf16(y[2], y[3]); w.z = cvt_pk_bf16(y[4], y[5]); w.w = cvt_pk_bf16(y[6], y[7]);
                *(u32x4*)(Y + roff0 + (size_t)(ai * HALF + m * 16) * 1024 + c) = w;
                float yr[8]; unpack8(w, yr);
#pragma unroll
                for (int i = 0; i < 8; ++i) { ps[r] += yr[i]; pq[r] += yr[i] * yr[i]; } }
        }
#pragma unroll
        for (int r = 0; r < 8; ++r) { float a = ps[r], q = pq[r];
            a += __shfl_xor(a, 16); a += __shfl_xor(a, 32); q += __shfl_xor(q, 16); q += __shfl_xor(q, 32);
            if (fq == 0) *(f32x2*)(ST + (size_t)(u.pm * BM + rl0 + (r >> 2) * HALF + (r & 3) * 16) * 32 + (u.pn * 4 + wc) * 2) = (f32x2){a, q}; }
    }
};

struct EpiUpLN {
    static constexpr bool PERM = true, AFTER_DRAIN = false;
    const float* ST_IN; const float* colsum; const float* bw; bf16_t* O; int ldc;
    __device__ __forceinline__ void pre(const Unit& u, int slot, int tid, PG8_LAS float* sx) const { stats_pre(ST_IN, u.pm, slot, tid, sx); }
    __device__ __forceinline__ void operator()(const f32x4 (&acc)[2][2][4][2], const Unit& u, int wr, int wc, int fr, int fq, int slot, PG8_LAS float* sx) const {
        const int col0 = u.pn * BM + wc * 32 + 8 * fq, rl0 = wr * 64 + fr;
#pragma unroll
        for (int bj = 0; bj < 2; ++bj) { const int c = col0 + bj * HALF;
            const f32x4 c0 = *(const f32x4*)(colsum + c), c1 = *(const f32x4*)(colsum + c + 4), w0 = *(const f32x4*)(bw + c), w1 = *(const f32x4*)(bw + c + 4);
#pragma unroll
            for (int r = 0; r < 8; ++r) { const int ai = r >> 2, m = r & 3, rl = rl0 + ai * HALF + m * 16;
                const f32x2 mr = *(const PG8_LAS f32x2*)(sx + (slot * 256 + rl) * 2);
                f32x4 v0 = (acc[ai][bj][m][0] - c0 * mr[0]) * mr[1] + w0, v1 = (acc[ai][bj][m][1] - c1 * mr[0]) * mr[1] + w1;
#pragma unroll
                for (int i = 0; i < 4; ++i) { const float a = fmaxf(v0[i], 0.f), b2 = fmaxf(v1[i], 0.f); v0[i] = a * a; v1[i] = b2 * b2; }
                u32x4 w; w.x = cvt_pk_bf16(v0[0], v0[1]); w.y = cvt_pk_bf16(v0[2], v0[3]); w.z = cvt_pk_bf16(v1[0], v1[1]); w.w = cvt_pk_bf16(v1[2], v1[3]);
                *(u32x4*)(O + (size_t)(u.pm * BM + rl) * ldc + c) = w; } }
    }
};

struct EpiPP {
    static constexpr bool PERM = true, AFTER_DRAIN = false;
    bf16_t* O; int ldc;
    __device__ __forceinline__ void pre(const Unit&, int, int, PG8_LAS float*) const {}
    __device__ __forceinline__ void operator()(const f32x4 (&acc)[2][2][4][2], const Unit& u, int wr, int wc, int fr, int fq, int, PG8_LAS float*) const {
        const int row0 = u.pm * BM + wr * 64 + fr, col0 = u.pn * BM + wc * 32 + 8 * fq;
#pragma unroll
        for (int ai = 0; ai < 2; ++ai)
#pragma unroll
            for (int m = 0; m < 4; ++m) { bf16_t* rowp = O + (size_t)(row0 + ai * HALF + m * 16) * ldc + col0;
#pragma unroll
                for (int bj = 0; bj < 2; ++bj) { const f32x4 v0 = acc[ai][bj][m][0], v1 = acc[ai][bj][m][1];
                    u32x4 w; w.x = cvt_pk_bf16(v0[0], v0[1]); w.y = cvt_pk_bf16(v0[2], v0[3]); w.z = cvt_pk_bf16(v1[0], v1[1]); w.w = cvt_pk_bf16(v1[2], v1[3]);
                    *(u32x4*)(rowp + bj * HALF) = w; } }
    }
};

struct EpiGateLN {
    static constexpr bool PERM = true, AFTER_DRAIN = false;
    const float* ST_IN; const bf16_t* YB; const bf16_t* pp; const float* colsum; const float* bz; const float* g; const float* b; float* out; bf16_t* ob;
    __device__ __forceinline__ void pre(const Unit& u, int slot, int tid, PG8_LAS float* sx) const { stats_pre(ST_IN, u.pm, slot, tid, sx); }
    __device__ __forceinline__ void operator()(const f32x4 (&acc)[2][2][4][2], const Unit& u, int wr, int wc, int fr, int fq, int slot, PG8_LAS float* sx) const {
        const int col0 = u.pn * BM + wc * 32 + 8 * fq, rl0 = wr * 64 + fr; const size_t roff0 = (size_t)(u.pm * BM + rl0) * 1024;
#pragma unroll
        for (int bj = 0; bj < 2; ++bj) { const int c = col0 + bj * HALF;
            f32x4 cs[2], zb[2], gg[2], bb[2];
#pragma unroll
            for (int hh = 0; hh < 2; ++hh) { cs[hh] = *(const f32x4*)(colsum + c + 4 * hh); zb[hh] = *(const f32x4*)(bz + c + 4 * hh); gg[hh] = *(const f32x4*)(g + c + 4 * hh); bb[hh] = *(const f32x4*)(b + c + 4 * hh); }
#pragma unroll
            for (int ai = 0; ai < 2; ++ai) {
                u32x4 yy[4], pw[4];
#pragma unroll
                for (int m = 0; m < 4; ++m) { const size_t o2 = roff0 + (size_t)(ai * HALF + m * 16) * 1024 + c; yy[m] = *(const u32x4*)(YB + o2); pw[m] = *(const u32x4*)(pp + o2); }
#pragma unroll
                for (int m = 0; m < 4; ++m) { const int rl = rl0 + ai * HALF + m * 16; const size_t o2 = roff0 + (size_t)(ai * HALF + m * 16) * 1024 + c;
                    const f32x2 mr = *(const PG8_LAS f32x2*)(sx + (slot * 256 + rl) * 2);
                    float y[8], p[8], o[8]; unpack8(yy[m], y); unpack8(pw[m], p);
#pragma unroll
                    for (int hh = 0; hh < 2; ++hh) { const f32x4 z = (acc[ai][bj][m][hh] - cs[hh] * mr[0]) * mr[1] + zb[hh];
#pragma unroll
                        for (int i = 0; i < 4; ++i) { const float h2 = (y[4 * hh + i] - mr[0]) * mr[1] * gg[hh][i] + bb[hh][i]; o[4 * hh + i] = h2 + p[4 * hh + i] * __builtin_amdgcn_rcpf(1.0f + __expf(-z[i])); } }
                    if (ob) { u32x4 w; w.x = cvt_pk_bf16(o[0], o[1]); w.y = cvt_pk_bf16(o[2], o[3]); w.z = cvt_pk_bf16(o[4], o[5]); w.w = cvt_pk_bf16(o[6], o[7]); *(u32x4*)(ob + o2) = w; }
                    else { *(f32x4*)(out + o2) = (f32x4){o[0], o[1], o[2], o[3]}; *(f32x4*)(out + o2 + 4) = (f32x4){o[4], o[5], o[6], o[7]}; } }
                asm volatile("" ::: "memory");
            } }
    }
};

template <class Epi, class Sched, bool ALIGN_EPI = false, bool SP2 = false>
__device__ __forceinline__ void gemm_phase(PG8_LAS unsigned char* lds, const Gemm g, const Sched& S, const Epi& E, PG8_LAS float* sx) {
    int tid_ = threadIdx.x; asm volatile("" : "+v"(tid_));
    const int tid = tid_, wid = __builtin_amdgcn_readfirstlane(tid >> 6), lane = tid & 63, wr = wid >> 2, wc = wid & 3, fr = lane & 15, fq = lane >> 4;
    const int K = g.K, nt = K / BK;
    unsigned voffA[2], voffB[2];
#pragma unroll
    for (int i = 0; i < 2; ++i) { int R, C; stage_rc(tid * 16 + i * 8192, R, C); const int Rb = Epi::PERM ? ((R & ~31) + perm32(R & 31)) : R;
        voffA[i] = (unsigned)(R * g.lda + C) * 2u; voffB[i] = (unsigned)(Rb * g.ldb + C) * 2u; }
    const size_t kstep = (size_t)(BK * 2);
    const size_t hstepA = (size_t)HALF * g.lda * 2, hstepB = (size_t)HALF * g.ldb * 2;
    const size_t tstepA = 2 * hstepA, tstepB = 2 * hstepB;
    const unsigned ldsw = (unsigned)wid * 1024u;
    const int aoff = lds_byte(wr * 64 + fr, fq * 8), boff = lds_byte(wc * 32 + fr, fq * 8);
#define PG8_SA(b, h) (((b) * 2 + (h)) * HTB)
#define PG8_SB(b, h) ((4 + (b) * 2 + (h)) * HTB)
#define PG8_STAGE(bufoff, gbase, voff) do { _Pragma("unroll") for (int _i = 0; _i < 2; ++_i) \
        __builtin_amdgcn_global_load_lds((const unsigned*)((const char*)(gbase) + (voff)[_i]), (PG8_LAS unsigned*)(lds + (bufoff) + ldsw + _i * 8192), 16, 0, 0); } while (0)
#define PG8_LDA(dst, b, h) do { _Pragma("unroll") for (int m = 0; m < 4; ++m) _Pragma("unroll") for (int k = 0; k < 2; ++k) dst[m][k] = *(const PG8_LAS bf16x8*)(lds + PG8_SA(b, h) + aoff + m * 2048 + k * 1024); } while (0)
#define PG8_LDB(dst, b, h) do { _Pragma("unroll") for (int n = 0; n < 2; ++n) _Pragma("unroll") for (int k = 0; k < 2; ++k) dst[n][k] = *(const PG8_LAS bf16x8*)(lds + PG8_SB(b, h) + boff + n * 2048 + k * 1024); } while (0)
#define PG8_MMA(ai, bj, At, Bt) do { __builtin_amdgcn_s_setprio(1); _Pragma("unroll") for (int m = 0; m < 4; ++m) _Pragma("unroll") for (int n = 0; n < 2; ++n) _Pragma("unroll") for (int k = 0; k < 2; ++k) \
        acc[ai][bj][m][n] = __builtin_amdgcn_mfma_f32_16x16x32_bf16(Bt[n][k], At[m][k], acc[ai][bj][m][n], 0, 0, 0); __builtin_amdgcn_s_setprio(0); } while (0)
#define PG8_WAIT_V(n) asm volatile("s_waitcnt vmcnt(" #n ")" ::: "memory")
#define PG8_WAIT_L(n) asm volatile("s_waitcnt lgkmcnt(" #n ")" ::: "memory")
#define PG8_BAR __builtin_amdgcn_s_barrier()
#define PG8_SCHED __builtin_amdgcn_sched_barrier(0)
    Unit cur, nxt; int ui = 0;
    if (!S.next(0, cur)) return;
    f32x4 acc[2][2][4][2];
#pragma unroll
    for (int a = 0; a < 2; ++a)
#pragma unroll
        for (int b = 0; b < 2; ++b)
#pragma unroll
            for (int m = 0; m < 4; ++m)
#pragma unroll
                for (int n = 0; n < 2; ++n) acc[a][b][m][n] = (f32x4){0.f, 0.f, 0.f, 0.f};
    bf16x8 At[4][2], B0[2][2], B1[2][2];
    const char* cA = (const char*)g.A + (size_t)cur.pm * tstepA; const char* cB = (const char*)g.Bt + (size_t)cur.pn * tstepB;
    S.a_ready(cur); E.pre(cur, 0, tid, sx);
    if constexpr (SP2) {
        PG8_STAGE(PG8_SB(0, 0), cB, voffB); PG8_STAGE(PG8_SB(0, 1), cB + hstepB, voffB); PG8_STAGE(PG8_SA(0, 0), cA, voffA); PG8_STAGE(PG8_SA(0, 1), cA + hstepA, voffA);
        if (wr == 1) PG8_BAR;
        PG8_WAIT_V(2); PG8_BAR;
        PG8_STAGE(PG8_SB(1, 0), cB + kstep, voffB); PG8_STAGE(PG8_SA(1, 0), cA + kstep, voffA); PG8_STAGE(PG8_SB(1, 1), cB + hstepB + kstep, voffB);
        PG8_WAIT_V(6); PG8_BAR;
    } else {
        PG8_STAGE(PG8_SB(0, 0), cB, voffB); PG8_STAGE(PG8_SA(0, 0), cA, voffA); PG8_STAGE(PG8_SB(0, 1), cB + hstepB, voffB); PG8_STAGE(PG8_SA(0, 1), cA + hstepA, voffA);
        if (wr == 1) PG8_BAR;
        PG8_WAIT_V(4); PG8_BAR;
        PG8_STAGE(PG8_SB(1, 0), cB + kstep, voffB); PG8_STAGE(PG8_SA(1, 0), cA + kstep, voffA); PG8_STAGE(PG8_SB(1, 1), cB + hstepB + kstep, voffB);
        PG8_WAIT_V(6); PG8_BAR;
    }
    for (;;) {
        const bool has_next = S.next(ui + 1, nxt);
        const char* nA = has_next ? (const char*)g.A + (size_t)nxt.pm * tstepA : cA; const char* nB = has_next ? (const char*)g.Bt + (size_t)nxt.pn * tstepB : cB;
        for (int t = 0; t < nt; t += 2) {
            const bool last = (t == nt - 2);
            const char* a1 = cA + (size_t)(t + 1) * kstep;
            const char* a2 = last ? nA : cA + (size_t)(t + 2) * kstep; const char* b2 = last ? nB : cB + (size_t)(t + 2) * kstep;
            const char* a3 = a2 + kstep; const char* b3 = b2 + kstep;
            if (last && has_next) { S.a_ready(nxt); E.pre(nxt, (ui + 1) & 1, tid, sx); }
            if constexpr (SP2) {
            PG8_LDB(B0, 0, 0); PG8_LDB(B1, 0, 1); PG8_SCHED; PG8_LDA(At, 0, 0); PG8_STAGE(PG8_SA(1, 1), a1 + hstepA, voffA);
            PG8_WAIT_V(8); PG8_WAIT_L(0); PG8_BAR; PG8_MMA(0, 0, At, B0); PG8_MMA(0, 1, At, B1); PG8_BAR; PG8_SCHED;
            PG8_LDA(At, 0, 1); PG8_STAGE(PG8_SB(0, 0), b2, voffB); PG8_STAGE(PG8_SB(0, 1), b2 + hstepB, voffB); PG8_STAGE(PG8_SA(0, 0), a2, voffA);
            PG8_WAIT_V(8); PG8_WAIT_L(0); PG8_BAR; PG8_MMA(1, 0, At, B0); PG8_MMA(1, 1, At, B1); PG8_BAR; PG8_SCHED;
            PG8_LDB(B0, 1, 0); PG8_LDB(B1, 1, 1); PG8_SCHED; PG8_LDA(At, 1, 0); PG8_STAGE(PG8_SA(0, 1), a2 + hstepA, voffA);
            PG8_WAIT_V(8); PG8_WAIT_L(0); PG8_BAR; PG8_MMA(0, 0, At, B0); PG8_MMA(0, 1, At, B1); PG8_BAR; PG8_SCHED;
            PG8_LDA(At, 1, 1); PG8_STAGE(PG8_SB(1, 0), b3, voffB); PG8_STAGE(PG8_SB(1, 1), b3 + hstepB, voffB); PG8_STAGE(PG8_SA(1, 0), a3, voffA);
            PG8_WAIT_V(8); PG8_WAIT_L(0); PG8_BAR; PG8_MMA(1, 0, At, B0); PG8_MMA(1, 1, At, B1); PG8_BAR; PG8_SCHED;
            } else {
            PG8_LDB(B0, 0, 0); PG8_SCHED; PG8_LDA(At, 0, 0); PG8_STAGE(PG8_SA(1, 1), a1 + hstepA, voffA);
            PG8_WAIT_L(8); PG8_BAR; PG8_WAIT_L(0); PG8_MMA(0, 0, At, B0); PG8_BAR; PG8_SCHED;
            PG8_LDB(B1, 0, 1); PG8_STAGE(PG8_SB(0, 0), b2, voffB);
            PG8_BAR; PG8_WAIT_L(0); PG8_MMA(0, 1, At, B1); PG8_BAR;
            PG8_LDA(At, 0, 1); PG8_STAGE(PG8_SA(0, 0), a2, voffA);
            PG8_BAR; PG8_WAIT_L(0); PG8_MMA(1, 0, At, B0); PG8_BAR; PG8_SCHED;
            PG8_STAGE(PG8_SB(0, 1), b2 + hstepB, voffB);
            PG8_WAIT_V(6); PG8_BAR; PG8_MMA(1, 1, At, B1); PG8_BAR;
            PG8_LDB(B0, 1, 0); PG8_SCHED; PG8_LDA(At, 1, 0); PG8_STAGE(PG8_SA(0, 1), a2 + hstepA, voffA);
            PG8_WAIT_L(8); PG8_BAR; PG8_WAIT_L(0); PG8_MMA(0, 0, At, B0); PG8_BAR; PG8_SCHED;
            PG8_LDB(B1, 1, 1); PG8_STAGE(PG8_SB(1, 0), b3, voffB);
            PG8_BAR; PG8_WAIT_L(0); PG8_MMA(0, 1, At, B1); PG8_BAR;
            PG8_LDA(At, 1, 1); PG8_STAGE(PG8_SA(1, 0), a3, voffA);
            PG8_BAR; PG8_WAIT_L(0); PG8_MMA(1, 0, At, B0); PG8_BAR; PG8_SCHED;
            PG8_STAGE(PG8_SB(1, 1), b3 + hstepB, voffB);
            PG8_WAIT_V(6); PG8_BAR; PG8_MMA(1, 1, At, B1); PG8_BAR;
            }
        }
        if constexpr (ALIGN_EPI) { if (wr == 0) PG8_BAR; }
        if constexpr (!Epi::AFTER_DRAIN) { E(acc, cur, wr, wc, fr, fq, ui & 1, sx); S.done(cur); }
        if (!has_next) break;
#pragma unroll
        for (int a = 0; a < 2; ++a)
#pragma unroll
            for (int b = 0; b < 2; ++b)
#pragma unroll
                for (int m = 0; m < 4; ++m)
#pragma unroll
                    for (int n = 0; n < 2; ++n) acc[a][b][m][n] = (f32x4){0.f, 0.f, 0.f, 0.f};
        cur = nxt; cA = nA; cB = nB; ++ui;
        if constexpr (ALIGN_EPI) { if (wr == 1) PG8_BAR; }
    }
    PG8_WAIT_V(0);
    if constexpr (!ALIGN_EPI) { if (wr == 0) PG8_BAR; }
    PG8_BAR;
    if constexpr (Epi::AFTER_DRAIN) { E.fused(acc, cur, wr, wc, fr, fq, lds, wid, lane); S.done(cur); }
#undef PG8_SA
#undef PG8_SB
#undef PG8_STAGE
#undef PG8_LDA
#undef PG8_LDB
#undef PG8_MMA
#undef PG8_WAIT_V
#undef PG8_WAIT_L
#undef PG8_BAR
#undef PG8_SCHED
}
}

#define LAS __attribute__((address_space(3)))
typedef unsigned short bf16;
typedef unsigned u32x4 __attribute__((ext_vector_type(4)));
typedef unsigned u32x2 __attribute__((ext_vector_type(2)));
typedef float f32x4 __attribute__((ext_vector_type(4)));
typedef short bf16x8 __attribute__((ext_vector_type(8)));
typedef short s16x4 __attribute__((ext_vector_type(4)));

constexpr int NTHREADS = 512, NWAVES = 8;
constexpr int BATCH = 8, SEQ = 4096, D = 1024, M = BATCH * SEQ, FF = 4096, PLE = 256;
constexpr int GLA_COLS = 3088, PROJ_LD = 3072;
constexpr int QKV_LD = 1536;
constexpr float LN_EPS = 1e-5f, RMS_EPS = 1e-5f;
constexpr float ALPHA = 1.4142135623730951f;
constexpr size_t MiB = 1u << 20;
constexpr size_t W_IN_T = 1 * MiB;
constexpr size_t W_GOUT_T = 7 * MiB;
constexpr size_t W_UP_T = 9 * MiB;
constexpr size_t W_DN_T = 17 * MiB;
constexpr size_t W_GATE_T = 25 * MiB;
constexpr size_t W_PP_T = 27 * MiB;
constexpr size_t W_QKV_T = 28 * MiB;
constexpr size_t W_SOUT_T = 31 * MiB;
constexpr size_t W_LSTRIDE = 24 * MiB;
constexpr size_t PB1_OFF = 1 * MiB;
constexpr size_t R0 = 56 * MiB;
constexpr size_t R1 = 120 * MiB;
constexpr size_t R2 = 248 * MiB;
constexpr size_t R2_GK = R2 + 192 * MiB;
constexpr size_t R2_PP = R2 + 16 * MiB;
constexpr size_t R2_H3B = R2 + 80 * MiB;
constexpr size_t R2_QKV = R2 + 144 * MiB;
constexpr size_t R0_BL = R1 + 80 * MiB;
constexpr size_t WS_END = 512 * MiB;
constexpr int LDS_BYTES = 147456;

__device__ __forceinline__ int opq(int v) { asm volatile("" : "+s"(v)); return v; }
struct Params { const float* in[21]; float* out; unsigned char* ws; };
#define LBAR() do { asm volatile("s_waitcnt lgkmcnt(0)" ::: "memory"); __builtin_amdgcn_s_barrier(); asm volatile("" ::: "memory"); } while (0)

struct Ctx { LAS unsigned char* lds; int tid, lane, wave; };

__device__ __forceinline__ float wave_sum(float v) {
#pragma unroll
    for (int o = 1; o < 64; o <<= 1) v += __shfl_xor(v, o);
    return v;
}
__device__ __forceinline__ unsigned pk2(float lo, float hi) { return pg8::cvt_pk_bf16(lo, hi); }
__device__ __forceinline__ float bf2f(unsigned short b) { return __uint_as_float(((unsigned)b) << 16); }
__device__ __forceinline__ bf16x8 pack8(const f32x4 a, const f32x4 b) {
    u32x4 w; w.x = pk2(a[0], a[1]); w.y = pk2(a[2], a[3]); w.z = pk2(b[0], b[1]); w.w = pk2(b[2], b[3]); return __builtin_bit_cast(bf16x8, w);
}
#define MFMA16(a, b, c) __builtin_amdgcn_mfma_f32_16x16x32_bf16((a), (b), (c), 0, 0, 0)
__device__ __forceinline__ bf16x8 lds16(const LAS unsigned char* p) { return *(const LAS bf16x8*)p; }
__device__ __forceinline__ bf16x8 lds8x2(const LAS unsigned char* p0, const LAS unsigned char* p1) {
    const s16x4 lo = *(const LAS s16x4*)p0, hi = *(const LAS s16x4*)p1; return __builtin_shufflevector(lo, hi, 0, 1, 2, 3, 4, 5, 6, 7);
}

template <bool FOLD>
__device__ __forceinline__ void transpose_item(const float* W, int ldw, int nblk, int K, bf16* WT, LAS float* scr, int item, int lane,
                                               const float* gv = nullptr, const float* bv = nullptr, float* csp = nullptr, float* bwp = nullptr) {
    const int kb = item / nblk, nb = item % nblk, k0 = 64 * kb, n0 = 32 * nb;
    { const int r8 = lane >> 3, c4 = lane & 7;
      f32x4 v[8];
#pragma unroll
      for (int it = 0; it < 8; ++it) v[it] = *(const f32x4*)(W + (size_t)(k0 + 8 * it + r8) * ldw + n0 + 4 * c4);
#pragma unroll
      for (int it = 0; it < 8; ++it) { LAS float* d = scr + (8 * it + r8) * 33 + 4 * c4; d[0] = v[it][0]; d[1] = v[it][1]; d[2] = v[it][2]; d[3] = v[it][3]; } }
    asm volatile("s_waitcnt lgkmcnt(0)" ::: "memory");
    const int c = lane & 7;
    float gk[8], bk[8];
    if (FOLD) {
#pragma unroll
        for (int i = 0; i < 8; ++i) { gk[i] = gv[k0 + 8 * c + i]; bk[i] = bv[k0 + 8 * c + i]; }
    }
#pragma unroll
    for (int j = 0; j < 4; ++j) { const int n = (lane >> 3) + 8 * j; const LAS float* sp = scr + (8 * c) * 33 + n;
        float v[8];
#pragma unroll
        for (int i = 0; i < 8; ++i) v[i] = sp[i * 33];
        float bwv = 0.f;
        if (FOLD) {
#pragma unroll
            for (int i = 0; i < 8; ++i) { bwv += bk[i] * v[i]; v[i] *= gk[i]; }
        }
        u32x4 o; o.x = pk2(v[0], v[1]); o.y = pk2(v[2], v[3]); o.z = pk2(v[4], v[5]); o.w = pk2(v[6], v[7]);
        *(u32x4*)(WT + (size_t)(n0 + n) * K + k0 + 8 * c) = o;
        if (FOLD) {
            float r[8]; pg8::unpack8(o, r); float cs = ((r[0] + r[1]) + (r[2] + r[3])) + ((r[4] + r[5]) + (r[6] + r[7]));
            cs += __shfl_xor(cs, 1); cs += __shfl_xor(cs, 2); cs += __shfl_xor(cs, 4);
            bwv += __shfl_xor(bwv, 1); bwv += __shfl_xor(bwv, 2); bwv += __shfl_xor(bwv, 4);
            if (c == 0) { const int N = 32 * nblk; csp[(size_t)kb * N + n0 + n] = cs; bwp[(size_t)kb * N + n0 + n] = bwv; }
        }
    }
    asm volatile("s_waitcnt lgkmcnt(0)" ::: "memory");
}
constexpr size_t VEC = 52 * MiB;
__device__ __host__ constexpr size_t CSP_UP(int l) { return VEC + (size_t)l * 512 * 1024; }
__device__ __host__ constexpr size_t CSP_G(int l) { return VEC + MiB + (size_t)l * 128 * 1024; }
__device__ __host__ constexpr size_t FIN(int l) { return VEC + MiB + 512 * 1024 + (size_t)l * 64 * 1024; }
__device__ __forceinline__ void fold_finalize(const Params& P, int gtid, int gthreads) {
    for (int idx = gtid; idx < 2 * 5120; idx += gthreads) {
        const int l = idx / 5120, r = idx % 5120;
        float* fin = (float*)(P.ws + FIN(l));
        if (r < 4096) { const float* cp = (const float*)(P.ws + CSP_UP(l)); const float* bp = cp + 16 * 4096; float cs = 0.f, bw = 0.f;
#pragma unroll
            for (int kb = 0; kb < 16; ++kb) { cs += cp[kb * 4096 + r]; bw += bp[kb * 4096 + r]; }
            fin[r] = cs; fin[4096 + r] = bw; }
        else { const int n = r - 4096; const float* cp = (const float*)(P.ws + CSP_G(l)); const float* bp = cp + 16 * 1024; float cs = 0.f, bw = 0.f;
#pragma unroll
            for (int kb = 0; kb < 16; ++kb) { cs += cp[kb * 1024 + n]; bw += bp[kb * 1024 + n]; }
            fin[8192 + n] = cs; fin[9216 + n] = bw + P.in[20][l * D + n]; }
    }
}
__device__ __forceinline__ void p0_prologue(const Ctx& F, const Params& P) {
    LAS float* scr = (LAS float*)(F.lds + F.wave * 16384);
    const int gw = blockIdx.x * NWAVES + F.wave, NGW = gridDim.x * NWAVES;
    unsigned char* ws = P.ws;
    constexpr int I_IN = 16 * 96, I_SQ = 16 * 32, I_QKV = 16 * 48, I_UP = 16 * 128, I_DN = 64 * 32, I_PP = 4 * 32;
    constexpr int NITEMS = I_IN + 2 * I_SQ + I_QKV + 2 * I_UP + 2 * I_DN + 2 * I_SQ + 2 * I_PP;
    for (int it = gw; it < NITEMS; it += NGW) {
        int r = it;
        if (r < I_IN) { transpose_item<false>(P.in[2], GLA_COLS, 96, D, (bf16*)(ws + W_IN_T), scr, r, F.lane); continue; } r -= I_IN;
        if (r < I_SQ) { transpose_item<false>(P.in[6], D, 32, D, (bf16*)(ws + W_GOUT_T), scr, r, F.lane); continue; } r -= I_SQ;
        if (r < I_SQ) { transpose_item<false>(P.in[10], D, 32, D, (bf16*)(ws + W_SOUT_T), scr, r, F.lane); continue; } r -= I_SQ;
        if (r < I_QKV) { transpose_item<false>(P.in[7], QKV_LD, 48, D, (bf16*)(ws + W_QKV_T), scr, r, F.lane); continue; } r -= I_QKV;
        if (r < 2 * I_UP) { const int l = r / I_UP; transpose_item<true>(P.in[12] + (size_t)l * D * FF, FF, 128, D, (bf16*)(ws + W_UP_T + (size_t)l * W_LSTRIDE), scr, r % I_UP, F.lane, P.in[14] + l * D, P.in[15] + l * D, (float*)(ws + CSP_UP(l)), (float*)(ws + CSP_UP(l)) + 16 * 4096); continue; } r -= 2 * I_UP;
        if (r < 2 * I_DN) { const int l = r / I_DN; transpose_item<false>(P.in[13] + (size_t)l * D * FF, D, 32, FF, (bf16*)(ws + W_DN_T + (size_t)l * W_LSTRIDE), scr, r % I_DN, F.lane); continue; } r -= 2 * I_DN;
        if (r < 2 * I_SQ) { const int l = r / I_SQ; transpose_item<true>(P.in[19] + (size_t)l * D * D, D, 32, D, (bf16*)(ws + W_GATE_T + (size_t)l * W_LSTRIDE), scr, r % I_SQ, F.lane, P.in[16] + l * D, P.in[17] + l * D, (float*)(ws + CSP_G(l)), (float*)(ws + CSP_G(l)) + 16 * 1024); continue; } r -= 2 * I_SQ;
        { const int l = r / I_PP; transpose_item<false>(P.in[18] + (size_t)l * PLE * D, D, 32, PLE, (bf16*)(ws + W_PP_T + (size_t)l * W_LSTRIDE), scr, r % I_PP, F.lane); }
    }
    const int gtid = blockIdx.x * NTHREADS + F.tid, gthreads = gridDim.x * NTHREADS;
    {
        LAS float* wg = (LAS float*)F.lds;
        __syncthreads();
        for (int i = F.tid; i < 4096; i += NTHREADS) { const int k = i >> 2, c4 = i & 3, pos = (k & 3) * 256 + (k >> 2); *(LAS f32x4*)(wg + pos * 20 + 4 * c4) = *(const f32x4*)(P.in[2] + (size_t)k * GLA_COLS + 3072 + 4 * c4); }
        __syncthreads();
        const float* x = P.in[0]; bf16* xb = (bf16*)(ws + R0); float* GK = (float*)(ws + R2_GK);
        const int lane = F.lane;
#pragma unroll 1
        for (int r0 = gw * 4; r0 < M; r0 += NGW * 4) {
            f32x4 acc[16];
#pragma unroll
            for (int i = 0; i < 16; ++i) acc[i] = (f32x4){0.f, 0.f, 0.f, 0.f};
#pragma unroll 1
            for (int j = 0; j < 4; ++j) {
                float xs[4][4];
#pragma unroll
                for (int rr = 0; rr < 4; ++rr) { const f32x4 v = *(const f32x4*)(x + (size_t)(r0 + rr) * D + 256 * j + 4 * lane);
                    u32x2 o; o.x = pk2(v[0], v[1]); o.y = pk2(v[2], v[3]); *(u32x2*)(xb + (size_t)(r0 + rr) * D + 256 * j + 4 * lane) = o;
                    xs[rr][0] = v[0]; xs[rr][1] = v[1]; xs[rr][2] = v[2]; xs[rr][3] = v[3]; }
#pragma unroll
                for (int i = 0; i < 4; ++i) { const LAS float* wp = wg + (i * 256 + 64 * j + lane) * 20;
                    const f32x4 w0 = *(const LAS f32x4*)(wp), w1 = *(const LAS f32x4*)(wp + 4), w2 = *(const LAS f32x4*)(wp + 8), w3 = *(const LAS f32x4*)(wp + 12);
#pragma unroll
                    for (int rr = 0; rr < 4; ++rr) { const float xv = xs[rr][i]; acc[rr * 4 + 0] += w0 * xv; acc[rr * 4 + 1] += w1 * xv; acc[rr * 4 + 2] += w2 * xv; acc[rr * 4 + 3] += w3 * xv; } }
            }
            float a[64];
#pragma unroll
            for (int i = 0; i < 16; ++i) { a[4 * i] = acc[i][0]; a[4 * i + 1] = acc[i][1]; a[4 * i + 2] = acc[i][2]; a[4 * i + 3] = acc[i][3]; }
#define TR_STEP(n) do { const bool hi_ = (lane & (n)) != 0; _Pragma("unroll") for (int i = 0; i < (n); ++i) { const float send = hi_ ? a[i] : a[i + (n)], keep = hi_ ? a[i + (n)] : a[i]; a[i] = keep + __shfl_xor(send, (n)); } } while (0)
            TR_STEP(32); TR_STEP(16); TR_STEP(8); TR_STEP(4); TR_STEP(2); TR_STEP(1);
#undef TR_STEP
            GK[(size_t)r0 * 16 + lane] = a[0];
        }
    }
}

__device__ __forceinline__ void gla_prep_unit(const Ctx& F, const Params& P, int b, int c, int h, size_t pgrp) {
    LAS float* gk_s = (LAS float*)(F.lds);
    LAS float* part = (LAS float*)(F.lds + 4096);
    const int tid = F.tid, d = tid & 127, g = tid >> 7;
    bf16* PROJ = (bf16*)(P.ws + R2); const float* GK = (const float*)(P.ws + R2_GK);
    float* BL = (float*)(P.ws + R0_BL);
    const float* wup = P.in[3]; const float* bgk = P.in[4];
    const int u = (b * 64 + c) * 4 + h;
    const size_t m0 = (size_t)b * SEQ + (size_t)c * 64;
    if (tid < 256) ((LAS f32x4*)gk_s)[tid] = *(const f32x4*)(GK + m0 * 16 + (size_t)tid * 4);
    bf16* qp = PROJ + (m0 + 16 * g) * PROJ_LD + h * 128 + d; bf16* kp = qp + 512;
    { const f32x4 a = *(const f32x4*)(P.in[1] + pgrp * 8), a2 = *(const f32x4*)(P.in[1] + pgrp * 8 + 4);
      u32x4 o; o.x = pk2(a[0], a[1]); o.y = pk2(a[2], a[3]); o.z = pk2(a2[0], a2[1]); o.w = pk2(a2[2], a2[3]); *(u32x4*)((bf16*)P.out + pgrp * 8) = o; }
    unsigned short qraw[16], kraw[16];
#pragma unroll
    for (int tt = 0; tt < 16; ++tt) { qraw[tt] = qp[(size_t)tt * PROJ_LD]; kraw[tt] = kp[(size_t)tt * PROJ_LD]; }
    float w[16];
#pragma unroll
    for (int r = 0; r < 16; ++r) w[r] = wup[r * 512 + h * 128 + d];
    const float bias = bgk[h * 128 + d];
    LBAR();
    float cs[16]; float run = 0.f;
#pragma unroll
    for (int tt = 0; tt < 16; ++tt) {
        const int t = 16 * g + tt; float z = bias;
#pragma unroll
        for (int r4 = 0; r4 < 4; ++r4) { const f32x4 a = ((const LAS f32x4*)gk_s)[t * 4 + r4]; z += a[0] * w[4 * r4] + a[1] * w[4 * r4 + 1] + a[2] * w[4 * r4 + 2] + a[3] * w[4 * r4 + 3]; }
        const float ls = fminf(z, 0.f) - __logf(1.0f + __expf(-fabsf(z)));
        run += ls * (1.0f / 16.0f); cs[tt] = run;
    }
    part[g * 128 + d] = run;
    LBAR();
    float off = 0.f, tot = 0.f;
#pragma unroll
    for (int gg = 0; gg < 4; ++gg) { const float pv = part[gg * 128 + d]; tot += pv; if (gg < g) off += pv; }
#pragma unroll
    for (int tt = 0; tt < 16; ++tt) {
        const float bc = cs[tt] + off;
        const float qv = bf2f(qraw[tt]), kv = bf2f(kraw[tt]);
        const float e1 = __expf(bc), e2 = __expf(-bc);
        qp[(size_t)tt * PROJ_LD] = (bf16)(pk2(qv * 0.08838834764831845f * e1, 0.f) & 0xffffu);
        kp[(size_t)tt * PROJ_LD] = (bf16)(pk2(kv * e2, 0.f) & 0xffffu);
    }
    if (g == 0) BL[(size_t)u * 128 + d] = tot;
    LBAR();
}

typedef short v4i16_t __attribute__((ext_vector_type(4)));
__device__ __forceinline__ s16x4 ldtr(const LAS unsigned char* p) { return __builtin_bit_cast(s16x4, __builtin_amdgcn_ds_read_tr16_b64_v4i16((LAS v4i16_t*)p)); }
constexpr int GS_Q = 0, GS_K = 17408, GS_V = 34816, GS_ATT = 68608, GS_RS = 77824, GS_RSTD = 79872, GS_BL = 80128;
constexpr size_t R0_SLOC = R1, R0_GSEG = R1 + 40 * MiB;
template <bool FULL>
__device__ __forceinline__ void gla_scan_pass(const Ctx& F, const Params& P) {
    LAS unsigned char* L = F.lds;
    const int tid = F.tid, lane = F.lane, w = F.wave, l15 = lane & 15, quad = lane >> 4;
    bf16* PROJ = (bf16*)(P.ws + R2);
    const float* BL = (const float*)(P.ws + R0_BL);
    float* SLOC = (float*)(P.ws + R0_SLOC); float* GSEG = (float*)(P.ws + R0_GSEG);
    const float* norm_g = P.in[5];
    for (int item = blockIdx.x; item < BATCH * 4 * 8; item += gridDim.x) {
        const int seg = item & 7, bh = item >> 3, b = bh >> 2, h = bh & 3;
        if (!FULL) {
#pragma unroll 1
            for (int cc = 0; cc < 8; ++cc) gla_prep_unit(F, P, b, seg * 8 + cc, h, ((size_t)(item * 8 + cc)) * 512 + tid);
            asm volatile("s_waitcnt vmcnt(0)" ::: "memory"); __builtin_amdgcn_s_barrier();
            __builtin_amdgcn_fence(__ATOMIC_ACQUIRE, "agent"); asm volatile("s_waitcnt vmcnt(0)" ::: "memory");
            __builtin_amdgcn_s_barrier(); asm volatile("" ::: "memory");
            if (seg == 7) continue;
        }
        f32x4 S[8][2];
#pragma unroll
        for (int dt = 0; dt < 8; ++dt) { S[dt][0] = (f32x4){0.f, 0.f, 0.f, 0.f}; S[dt][1] = (f32x4){0.f, 0.f, 0.f, 0.f}; }
        if (FULL) {
#pragma unroll 1
            for (int j = 0; j < seg; ++j) {
                const float* gj = GSEG + (size_t)(bh * 8 + j) * 128 + 4 * quad; const f32x4* sl = (const f32x4*)(SLOC + (size_t)(bh * 8 + j) * 32768) + tid;
#pragma unroll
                for (int dt = 0; dt < 8; ++dt) { const f32x4 gg = *(const f32x4*)(gj + 16 * dt);
                    f32x4 dec; dec[0] = __expf(gg[0]); dec[1] = __expf(gg[1]); dec[2] = __expf(gg[2]); dec[3] = __expf(gg[3]);
                    S[dt][0] = S[dt][0] * dec + sl[(dt * 2 + 0) * 512]; S[dt][1] = S[dt][1] * dec + sl[(dt * 2 + 1) * 512]; }
            }
        }
        float gsum = 0.f;
        u32x4 pq[2], pk[2], pv[4]; float pbl = 0.f;
#define GS_LOADC(cidx) do { const int u_ = (b * 64 + (cidx)) * 4 + h; const size_t m_ = (size_t)b * SEQ + (size_t)(cidx) * 64; int tl_ = tid; asm volatile("" : "+v"(tl_)); \
            _Pragma("unroll") for (int i = 0; i < 2; ++i) { const int idx = tl_ + 512 * i, row = idx >> 4, pc = idx & 15; const bf16* src = PROJ + (m_ + row) * PROJ_LD + h * 128 + pc * 8; \
                if (FULL) pq[i] = *(const u32x4*)(src); pk[i] = *(const u32x4*)(src + 512); } \
            _Pragma("unroll") for (int i = 0; i < 4; ++i) { const int idx = tl_ + 512 * i, row = idx >> 5, pc = idx & 31; pv[i] = *(const u32x4*)(PROJ + (m_ + row) * PROJ_LD + 1024 + h * 256 + pc * 8); } \
            if (tl_ < 128) pbl = BL[(size_t)u_ * 128 + tl_]; } while (0)
        GS_LOADC(seg * 8);
#pragma unroll 1
        for (int cc = 0; cc < 8; ++cc) {
            const int c = seg * 8 + cc;
            const size_t m0 = (size_t)b * SEQ + (size_t)c * 64;
#pragma unroll
            for (int i = 0; i < 2; ++i) { const int idx = tid + 512 * i, row = idx >> 4, pc = idx & 15;
                if (FULL) *(LAS u32x4*)(L + GS_Q + row * 272 + pc * 16) = pq[i];
                *(LAS u32x4*)(L + GS_K + row * 272 + pc * 16) = pk[i]; }
#pragma unroll
            for (int i = 0; i < 4; ++i) { const int idx = tid + 512 * i, row = idx >> 5, pc = idx & 31; *(LAS u32x4*)(L + GS_V + row * 528 + pc * 16) = pv[i]; }
            if (tid < 128) { ((LAS float*)(L + GS_BL))[tid] = pbl; gsum += pbl; }
            LBAR();
            if (cc < 7) GS_LOADC(c + 1);
#define GS_VF(dst) do { _Pragma("unroll") for (int s2 = 0; s2 < 2; ++s2) _Pragma("unroll") for (int et = 0; et < 2; ++et) { \
                const LAS unsigned char* a_ = L + GS_V + (32 * s2 + 8 * quad + (l15 >> 2)) * 528 + (32 * w + 16 * et) * 2 + 8 * (l15 & 3); \
                const s16x4 lo_ = ldtr(a_), hi_ = ldtr(a_ + 4 * 528); dst[s2][et] = __builtin_shufflevector(lo_, hi_, 0, 1, 2, 3, 4, 5, 6, 7); } } while (0)
            f32x4 o[4][2];
            if (FULL) {
                { const int it = w >> 1;
#pragma unroll
                  for (int x = 0; x < 2; ++x) { const int jt = 2 * (w & 1) + x; f32x4 a = (f32x4){0.f, 0.f, 0.f, 0.f};
                      if (jt <= it) {
#pragma unroll
                          for (int ks = 0; ks < 4; ++ks) { const bf16x8 kf = lds16(L + GS_K + (16 * jt + l15) * 272 + ks * 64 + quad * 16), qf = lds16(L + GS_Q + (16 * it + l15) * 272 + ks * 64 + quad * 16);
                              a = MFMA16(kf, qf, a); }
                          const int ii = 16 * it + l15, j0 = 16 * jt + 4 * quad;
#pragma unroll
                          for (int j = 0; j < 4; ++j) if (j0 + j > ii) a[j] = 0.f;
                      }
                      u32x2 ww; ww.x = pk2(a[0], a[1]); ww.y = pk2(a[2], a[3]);
                      *(LAS u32x2*)(L + GS_ATT + (16 * it + l15) * 144 + (16 * jt + 4 * quad) * 2) = ww; } }
                LBAR();
#pragma unroll
                for (int it = 0; it < 4; ++it) { o[it][0] = (f32x4){0.f, 0.f, 0.f, 0.f}; o[it][1] = (f32x4){0.f, 0.f, 0.f, 0.f}; }
#pragma unroll
                for (int s2 = 0; s2 < 4; ++s2) {
                    bf16x8 sf[2]; sf[0] = pack8(S[2 * s2][0], S[2 * s2 + 1][0]); sf[1] = pack8(S[2 * s2][1], S[2 * s2 + 1][1]);
#pragma unroll
                    for (int it = 0; it < 4; ++it) { const LAS unsigned char* qb = L + GS_Q + (16 * it + l15) * 272 + (32 * s2 + 4 * quad) * 2;
                        const bf16x8 qf = lds8x2(qb, qb + 32);
                        o[it][0] = MFMA16(sf[0], qf, o[it][0]); o[it][1] = MFMA16(sf[1], qf, o[it][1]); }
                }
                { bf16x8 vf[2][2]; GS_VF(vf);
#pragma unroll
                  for (int s2 = 0; s2 < 2; ++s2)
#pragma unroll
                    for (int it = 0; it < 4; ++it) { const bf16x8 af = lds16(L + GS_ATT + (16 * it + l15) * 144 + s2 * 64 + quad * 16);
                        o[it][0] = MFMA16(vf[s2][0], af, o[it][0]); o[it][1] = MFMA16(vf[s2][1], af, o[it][1]); } }
            }
            bf16x8 vf[2][2]; GS_VF(vf);
#pragma unroll
            for (int dt = 0; dt < 8; ++dt) {
                const f32x4 bl = *(const LAS f32x4*)(L + GS_BL + (16 * dt + 4 * quad) * 4);
                f32x4 dec; dec[0] = __expf(bl[0]); dec[1] = __expf(bl[1]); dec[2] = __expf(bl[2]); dec[3] = __expf(bl[3]);
#pragma unroll
                for (int s2 = 0; s2 < 2; ++s2) {
                    const LAS unsigned char* ka = L + GS_K + (32 * s2 + 8 * quad + (l15 >> 2)) * 272 + (16 * dt) * 2 + 8 * (l15 & 3);
                    const s16x4 klo = ldtr(ka), khi = ldtr(ka + 4 * 272); const bf16x8 kf = __builtin_shufflevector(klo, khi, 0, 1, 2, 3, 4, 5, 6, 7);
                    S[dt][0] = MFMA16(kf, vf[s2][0], S[dt][0]); S[dt][1] = MFMA16(kf, vf[s2][1], S[dt][1]); }
                S[dt][0] = S[dt][0] * dec; S[dt][1] = S[dt][1] * dec;
            }
            u32x2 rw[4][2];
            if (FULL) {
#pragma unroll
                for (int it = 0; it < 4; ++it)
#pragma unroll
                    for (int et = 0; et < 2; ++et) rw[it][et] = *(const u32x2*)(PROJ + (m0 + 16 * it + l15) * PROJ_LD + 2048 + h * 256 + 32 * w + 16 * et + 4 * quad);
#pragma unroll
                for (int it = 0; it < 4; ++it) { float ss = 0.f;
#pragma unroll
                    for (int et = 0; et < 2; ++et) ss += (o[it][et][0] * o[it][et][0] + o[it][et][1] * o[it][et][1]) + (o[it][et][2] * o[it][et][2] + o[it][et][3] * o[it][et][3]);
                    ss += __shfl_xor(ss, 16); ss += __shfl_xor(ss, 32);
                    if (quad == 0) ((LAS float*)(L + GS_RS))[w * 64 + 16 * it + l15] = ss; }
            }
            LBAR();
            if (FULL) {
                if (tid < 64) { float t = 0.f;
#pragma unroll
                    for (int ww = 0; ww < 8; ++ww) t += ((const LAS float*)(L + GS_RS))[ww * 64 + tid];
                    ((LAS float*)(L + GS_RSTD))[tid] = 1.0f / sqrtf(t * (1.0f / 256.0f) + RMS_EPS); }
                LBAR();
#pragma unroll
                for (int it = 0; it < 4; ++it) { const float rs = ((const LAS float*)(L + GS_RSTD))[16 * it + l15];
#pragma unroll
                    for (int et = 0; et < 2; ++et) { const int e0 = 32 * w + 16 * et + 4 * quad;
                        bf16* wp = PROJ + (m0 + 16 * it + l15) * PROJ_LD + 2048 + h * 256 + e0;
                        const u32x2 r2 = rw[it][et]; const f32x4 gg = *(const f32x4*)(norm_g + e0);
                        float rv[4]; rv[0] = __uint_as_float(r2.x << 16); rv[1] = __uint_as_float(r2.x & 0xffff0000u); rv[2] = __uint_as_float(r2.y << 16); rv[3] = __uint_as_float(r2.y & 0xffff0000u);
                        float ov[4];
#pragma unroll
                        for (int j = 0; j < 4; ++j) ov[j] = o[it][et][j] * rs * gg[j] * (rv[j] * __builtin_amdgcn_rcpf(1.0f + __expf(-rv[j])));
                        u32x2 ow; ow.x = pk2(ov[0], ov[1]); ow.y = pk2(ov[2], ov[3]); *(u32x2*)wp = ow; } }
            }
        }
#undef GS_LOADC
#undef GS_VF
        if (!FULL) {
            f32x4* sl = (f32x4*)(SLOC + (size_t)(bh * 8 + seg) * 32768) + tid;
#pragma unroll
            for (int dt = 0; dt < 8; ++dt) { sl[(dt * 2 + 0) * 512] = S[dt][0]; sl[(dt * 2 + 1) * 512] = S[dt][1]; }
            if (tid < 128) GSEG[(size_t)(bh * 8 + seg) * 128 + tid] = gsum;
        }
        LBAR();
    }
}

constexpr int SW_K = 0, SW_V = 36864;
__device__ __forceinline__ void swa_phase(const Ctx& F, const Params& P) {
    LAS unsigned char* L = F.lds;
    const int tid = F.tid, lane = F.lane, w = F.wave, l15 = lane & 15, quad = lane >> 4;
    const bf16* QKV = (const bf16*)(P.ws + R2_QKV); bf16* AO = (bf16*)(P.ws + R0);
    const float* sinks = P.in[9];
    for (int u = blockIdx.x; u < BATCH * 32 * 4; u += gridDim.x) {
        const int kvh = u & 3, n = (u >> 2) & 31, b = u >> 7;
        const long mb = (long)b * SEQ + (long)n * 128;
        const int g = w >> 1, hq = kvh * 4 + g;
        const bf16* qbase = QKV + (size_t)(mb + 64 * (w & 1) + l15) * QKV_LD + hq * 64 + quad * 8;
        bf16x8 qc0 = *(const bf16x8*)(qbase), qc1 = *(const bf16x8*)(qbase + 32);
        u32x4 kv[4], vv[4];
#pragma unroll
        for (int i = 0; i < 4; ++i) { const int idx = tid + 512 * i, jj = idx >> 3, pc = idx & 7;
            kv[i] = (u32x4){0u, 0u, 0u, 0u}; vv[i] = (u32x4){0u, 0u, 0u, 0u};
            if (n > 0 || jj >= 128) { const bf16* src = QKV + (size_t)(mb - 128 + jj) * QKV_LD + 1024 + kvh * 64 + pc * 8; kv[i] = *(const u32x4*)(src); vv[i] = *(const u32x4*)(src + 256); } }
#pragma unroll
        for (int i = 0; i < 2; ++i) { const size_t pg = (size_t)u * 1024 + tid + 512 * i; const float* src = P.in[1] + (size_t)M * PLE + pg * 8;
            const f32x4 a = *(const f32x4*)(src), a2 = *(const f32x4*)(src + 4);
            u32x4 o; o.x = pk2(a[0], a[1]); o.y = pk2(a[2], a[3]); o.z = pk2(a2[0], a2[1]); o.w = pk2(a2[2], a2[3]); *(u32x4*)((bf16*)(P.ws + PB1_OFF) + pg * 8) = o; }
        LBAR();
#pragma unroll
        for (int i = 0; i < 4; ++i) { const int idx = tid + 512 * i, jj = idx >> 3, pc = idx & 7;
            *(LAS u32x4*)(L + SW_K + jj * 144 + pc * 16) = kv[i]; *(LAS u32x4*)(L + SW_V + jj * 144 + pc * 16) = vv[i]; }
        LBAR();
        const float sink = sinks[hq];
#pragma unroll 1
        for (int qt = 0; qt < 4; ++qt) {
            const int q0 = 64 * (w & 1) + 16 * qt, kt0 = q0 >> 4, qi = q0 + l15;
            const bf16* qn = qbase + (size_t)(qt < 3 ? 16 * (qt + 1) : 0) * QKV_LD;
            const bf16x8 qn0 = *(const bf16x8*)(qn), qn1 = *(const bf16x8*)(qn + 32);
            f32x4 sc[9];
#pragma unroll
            for (int t = 0; t < 9; ++t) { const LAS unsigned char* kb = L + SW_K + (16 * (kt0 + t) + l15) * 144 + quad * 16;
                f32x4 a = (f32x4){0.f, 0.f, 0.f, 0.f}; a = MFMA16(lds16(kb), qc0, a); a = MFMA16(lds16(kb + 64), qc1, a); sc[t] = a; }
            constexpr float C2 = 0.125f * 1.4426950408889634f;
            const float sink2 = sink * 1.4426950408889634f;
#pragma unroll
            for (int j = 0; j < 4; ++j) { if (!(4 * quad + j > l15)) sc[0][j] = -INFINITY; if (!(4 * quad + j <= l15)) sc[8][j] = -INFINITY; }
            float mraw = -INFINITY;
#pragma unroll
            for (int t = 0; t < 9; ++t)
#pragma unroll
                for (int j = 0; j < 4; ++j) mraw = fmaxf(mraw, sc[t][j]);
            mraw = fmaxf(mraw, __shfl_xor(mraw, 16)); mraw = fmaxf(mraw, __shfl_xor(mraw, 32));
            const float m2 = fmaxf(mraw * C2, sink2);
            float den = 0.f;
#pragma unroll
            for (int t = 0; t < 9; ++t)
#pragma unroll
                for (int j = 0; j < 4; ++j) { const float p = __builtin_amdgcn_exp2f(sc[t][j] * C2 - m2); sc[t][j] = p; den += p; }
            den += __shfl_xor(den, 16); den += __shfl_xor(den, 32);
            den += __builtin_amdgcn_exp2f(sink2 - m2);
            const float rden = __builtin_amdgcn_rcpf(den);
            f32x4 ot[4];
#pragma unroll
            for (int dt = 0; dt < 4; ++dt) ot[dt] = (f32x4){0.f, 0.f, 0.f, 0.f};
#pragma unroll
            for (int s2 = 0; s2 < 5; ++s2) {
                const f32x4 z4 = (f32x4){0.f, 0.f, 0.f, 0.f};
                const bf16x8 pf = pack8(sc[2 * s2], (s2 < 4) ? sc[(2 * s2 + 1 < 9) ? 2 * s2 + 1 : 8] : z4);
                const int ka = 16 * (kt0 + 2 * s2), kb2 = (s2 < 4) ? ka + 16 : ka;
#pragma unroll
                for (int dt = 0; dt < 4; ++dt) { const LAS unsigned char* vb = L + SW_V + (4 * quad + (l15 >> 2)) * 144 + 32 * dt + 8 * (l15 & 3);
                    const s16x4 lo = ldtr(vb + ka * 144), hi = ldtr(vb + kb2 * 144);
                    const bf16x8 vf = __builtin_shufflevector(lo, hi, 0, 1, 2, 3, 4, 5, 6, 7);
                    ot[dt] = MFMA16(vf, pf, ot[dt]); }
            }
            bf16* op = AO + (size_t)(mb + qi) * D + hq * 64 + 4 * quad;
#pragma unroll
            for (int dt = 0; dt < 4; ++dt) { u32x2 ow; ow.x = pk2(ot[dt][0] * rden, ot[dt][1] * rden); ow.y = pk2(ot[dt][2] * rden, ot[dt][3] * rden); *(u32x2*)(op + 16 * dt) = ow; }
            qc0 = qn0; qc1 = qn1;
        }
    }
    LBAR();
}

#define XB_TMO      128
#define XB_XCNT(j)  (256  + 64 * (j))
#define XB_XSUB(j)  (1280 + 64 * (j))
#define XB_XGEN(j)  (2304 + 64 * (j))
#define XB_TOP      3328
#define XB_TOPGEN   3392
#define XCD_BAR_WORDS 3456
#define XB_SPIN_CAP (1u << 18)

__device__ __forceinline__ unsigned xb_ld(unsigned* p)              { return __hip_atomic_load(p, __ATOMIC_RELAXED, __HIP_MEMORY_SCOPE_AGENT); }
__device__ __forceinline__ unsigned xb_add(unsigned* p, unsigned v) { return __hip_atomic_fetch_add(p, v, __ATOMIC_RELAXED, __HIP_MEMORY_SCOPE_AGENT); }
__device__ __forceinline__ unsigned xb_xcc_id() { return (unsigned)__builtin_amdgcn_s_getreg((3 << 11) | 20) & 0xFu; }
#define XB_SPIN(cond, bar) do { unsigned _sp = 0; while (cond) { __builtin_amdgcn_s_sleep(1); \
    if ((++_sp & 255u) == 0u) { if (xb_ld(&(bar)[XB_TMO])) break; if (_sp > XB_SPIN_CAP) { atomicAdd(&(bar)[XB_TMO], 1u); break; } } } } while (0)

struct XcdBarrier {
    unsigned* bar; unsigned x;
    volatile LAS unsigned* st;
};

__device__ __forceinline__ XcdBarrier xcd_barrier_post(unsigned* bar, volatile LAS unsigned* st) {
    XcdBarrier b; b.bar = bar; b.x = xb_xcc_id(); b.st = st;
    if (threadIdx.x == 0) (void)xb_add(&bar[XB_XCNT(b.x)], 1u);
    return b;
}
__device__ __forceinline__ void xcd_barrier_complete(unsigned* bar, unsigned x, unsigned& nloc, unsigned& nx) {
    const unsigned G = gridDim.x * gridDim.y * gridDim.z;
    unsigned sum, cnt, mine, sp = 0u;
    for (;;) {
        sum = 0u; cnt = 0u; mine = 0u;
#pragma unroll
        for (unsigned j = 0; j < 16; ++j) { const unsigned c = xb_ld(&bar[XB_XCNT(j)]); sum += c; cnt += (c > 0u) ? 1u : 0u; mine = (j == x) ? c : mine; }
        if (sum == G) break;
        __builtin_amdgcn_s_sleep(1);
        if ((++sp & 255u) == 0u) { if (xb_ld(&bar[XB_TMO])) break; if (sp > XB_SPIN_CAP) { atomicAdd(&bar[XB_TMO], 1u); break; } }
    }
    nloc = mine > 0u ? mine : 1u; nx = cnt > 0u ? cnt : 1u;
}

__device__ __forceinline__ void xcd_barrier(const XcdBarrier& b) {
    asm volatile("s_waitcnt vmcnt(0)" ::: "memory");
    __syncthreads();
    if (threadIdx.x == 0) {
        unsigned* bar = b.bar;
        __builtin_amdgcn_s_waitcnt(0);
        unsigned nloc = b.st[0], nx = b.st[1];
        if (nloc == 0u) { xcd_barrier_complete(bar, b.x, nloc, nx); b.st[0] = nloc; b.st[1] = nx; }
        const unsigned old = xb_add(&bar[XB_XSUB(b.x)], 1u);
        const unsigned gen = old / nloc;
        if (old + 1u == (gen + 1u) * nloc) {
            __builtin_amdgcn_fence(__ATOMIC_RELEASE, "agent");
            asm volatile("s_waitcnt vmcnt(0)" ::: "memory");
            const unsigned og = xb_add(&bar[XB_TOP], 1u);
            const unsigned tg = og / nx;
            if (og + 1u == (tg + 1u) * nx) xb_add(&bar[XB_TOPGEN], 1u);
            else XB_SPIN(xb_ld(&bar[XB_TOPGEN]) == tg, bar);
            __builtin_amdgcn_fence(__ATOMIC_ACQUIRE, "agent");
            xb_add(&bar[XB_XGEN(b.x)], 1u);
            asm volatile("s_waitcnt vmcnt(0)" ::: "memory");
        } else {
            XB_SPIN(xb_ld(&bar[XB_XGEN(b.x)]) == gen, bar);
            __builtin_amdgcn_fence(__ATOMIC_ACQUIRE, "agent");
            asm volatile("s_waitcnt vmcnt(0)" ::: "memory");
        }
    }
    __syncthreads();
}

__global__ void __launch_bounds__(NTHREADS, 2) mega_fwd(Params P) {
    extern __shared__ __attribute__((aligned(16))) unsigned char lds_raw[];
    cg::grid_group grid = cg::this_grid();
    Ctx F; F.lds = (LAS unsigned char*)lds_raw;
#define GSYNC() do { XcdBarrier b2_ = bar; unsigned long long bp_ = (unsigned long long)b2_.bar; unsigned bx_ = __builtin_amdgcn_readfirstlane(b2_.x); asm volatile("" : "+s"(bp_), "+s"(bx_)); b2_.bar = (unsigned*)bp_; b2_.x = bx_; xcd_barrier(b2_); } while (0)
#define REFRESH() do { int t_ = threadIdx.x; asm volatile("" : "+v"(t_)); F.tid = t_; F.lane = t_ & 63; F.wave = __builtin_amdgcn_readfirstlane(t_ >> 6); } while (0)
    REFRESH();
    unsigned char* ws = P.ws;
    const int G = gridDim.x, cid = blockIdx.x;
    volatile LAS unsigned* MISC = (volatile LAS unsigned*)(F.lds + 131072 + 320);
    if (threadIdx.x < 32) MISC[threadIdx.x] = 0u;
    __syncthreads();
    if (cid == 0) for (int i = threadIdx.x; i < XCD_BAR_WORDS; i += NTHREADS) __hip_atomic_store((unsigned*)(ws) + 1024 + i, 0u, __ATOMIC_RELAXED, __HIP_MEMORY_SCOPE_AGENT);
    grid.sync();
    XcdBarrier bar = xcd_barrier_post((unsigned*)(ws) + 1024, MISC + 8);
    bf16* A16 = (bf16*)(ws + R0); bf16* U16 = (bf16*)(ws + R2);
    bf16* Y1B = (bf16*)(ws + R1); bf16* Y2B = (bf16*)(ws + R1 + 64 * MiB); bf16* H3B = (bf16*)(ws + R2_H3B);
    float* ST1 = (float*)(ws + 504 * MiB); float* ST2 = (float*)(ws + 508 * MiB);
    LAS float* SX = (LAS float*)(F.lds + 131072 + 1024);

    p0_prologue(F, P);
    GSYNC();
    {
        pg8::Gemm g{A16, (const bf16*)(ws + W_IN_T), M, PROJ_LD, opq(D), D, D}; pg8::StaticOrder S; S.init(M, PROJ_LD, G, cid);
        pg8::EpiBf16 E{U16, PROJ_LD, nullptr, 1 << 30, nullptr};
        pg8::gemm_phase<pg8::EpiBf16, pg8::StaticOrder, true, true>(F.lds, g, S, E, SX);
    }
    GSYNC();
    REFRESH(); gla_scan_pass<false>(F, P);
    fold_finalize(P, cid * NTHREADS + F.tid, G * NTHREADS);
    GSYNC();
    REFRESH(); gla_scan_pass<true>(F, P);
    GSYNC();
#pragma unroll 1
    for (int layer = 0; layer < 2; ++layer) {
        const float* fin = (const float*)(ws + FIN(0)) + (size_t)layer * (64 * 1024 / 4);
        if (layer == 1) {
            {
                pg8::Gemm g{H3B, (const bf16*)(ws + W_QKV_T), M, QKV_LD, opq(D), D, D}; pg8::StaticOrder S; S.init(M, QKV_LD, G, cid);
                pg8::EpiBf16 E{(bf16*)(ws + R2_QKV), QKV_LD, P.in[8], 1 << 30, nullptr};
                pg8::gemm_phase<pg8::EpiBf16, pg8::StaticOrder, true, true>(F.lds, g, S, E, SX);
            }
            GSYNC();
            REFRESH(); swa_phase(F, P);
            GSYNC();
        }
        {
            const bf16* A = layer == 0 ? (const bf16*)(ws + R2) + 2048 : (const bf16*)A16;
            pg8::Gemm g{A, (const bf16*)(ws + (layer == 0 ? W_GOUT_T : W_SOUT_T)), M, D, opq(D), layer == 0 ? PROJ_LD : D, D}; pg8::StaticOrder S; S.init(M, D, G, cid);
            pg8::EpiY<false> E{layer == 0 ? (const void*)A16 : (const void*)H3B, 1, layer == 0 ? nullptr : P.in[11], nullptr, nullptr, nullptr, Y1B, ST1, ALPHA};
            pg8::gemm_phase<pg8::EpiY<false>, pg8::StaticOrder, true, true>(F.lds, g, S, E, SX);
        }
        GSYNC();
        {
            pg8::Gemm g{Y1B, (const bf16*)(ws + W_UP_T + (size_t)layer * W_LSTRIDE), M, FF, opq(D), D, D}; pg8::StaticOrder S; S.init(M, FF, G, cid);
            pg8::EpiUpLN E{ST1, fin, fin + 4096, U16, FF};
            pg8::gemm_phase<pg8::EpiUpLN, pg8::StaticOrder, true, true>(F.lds, g, S, E, SX);
        }
        GSYNC();
        {
            pg8::Gemm g{U16, (const bf16*)(ws + W_DN_T + (size_t)layer * W_LSTRIDE), M, D, opq(FF), FF, FF}; pg8::StaticOrder S; S.init(M, D, G, cid);
            pg8::EpiY<true> E{(const void*)Y1B, 1, nullptr, P.in[14] + layer * D, P.in[15] + layer * D, ST1, Y2B, ST2, ALPHA};
            pg8::gemm_phase<pg8::EpiY<true>, pg8::StaticOrder, true, true>(F.lds, g, S, E, SX);
        }
        GSYNC();
        {
            int kpp = opq(PLE); pg8::Gemm g{layer == 0 ? (const bf16*)P.out : (const bf16*)(ws + PB1_OFF), (const bf16*)(ws + W_PP_T + (size_t)layer * W_LSTRIDE), M, D, kpp, kpp, kpp}; pg8::StaticOrder S; S.init(M, D, G, cid);
            pg8::EpiPP E{(bf16*)(ws + R2_PP), D};
            pg8::gemm_phase<pg8::EpiPP, pg8::StaticOrder, true, true>(F.lds, g, S, E, SX);
        }
        __syncthreads();
        {
            pg8::Gemm g{Y2B, (const bf16*)(ws + W_GATE_T + (size_t)layer * W_LSTRIDE), M, D, opq(D), D, D}; pg8::StaticOrder S; S.init(M, D, G, cid);
            pg8::EpiGateLN E{ST2, Y2B, (const bf16*)(ws + R2_PP), fin + 8192, fin + 9216, P.in[16] + layer * D, P.in[17] + layer * D, P.out, layer == 0 ? H3B : nullptr};
            pg8::gemm_phase<pg8::EpiGateLN, pg8::StaticOrder, true, true>(F.lds, g, S, E, SX);
        }
        if (layer == 0) GSYNC();
    }
}

extern "C" void kernel_launch(void* const* d_in, const int* in_sizes, int n_in, void* d_out, int out_size, void* d_ws, size_t ws_size, hipStream_t stream) {
    static int grid = 0;
    if (grid == 0) {
        if (n_in != 21 || in_sizes[0] != M * D || out_size != M * D || ws_size < WS_END) { fprintf(stderr, "kernel_launch: unexpected shapes (n_in %d, in0 %d, out %d, ws %zu)\n", n_in, n_in > 0 ? in_sizes[0] : -1, out_size, ws_size); grid = -1; return; }
        int dev = 0, cus = 0, per_cu = 0;
        hipGetDevice(&dev); hipDeviceGetAttribute(&cus, hipDeviceAttributeMultiprocessorCount, dev);
        if (hipFuncSetAttribute((const void*)mega_fwd, hipFuncAttributeMaxDynamicSharedMemorySize, LDS_BYTES) != hipSuccess) { fprintf(stderr, "kernel_launch: hipFuncSetAttribute failed\n"); grid = -1; return; }
        if (hipOccupancyMaxActiveBlocksPerMultiprocessor(&per_cu, (const void*)mega_fwd, NTHREADS, LDS_BYTES) != hipSuccess || per_cu < 1) { fprintf(stderr, "kernel_launch: occupancy query says %d\n", per_cu); (void)hipGetLastError(); per_cu = 1; }
        grid = cus * 1;
        if (grid <= 0) grid = 256;
    }
    if (grid < 0) return;
    Params p{};
    for (int i = 0; i < 21; ++i) p.in[i] = (const float*)d_in[i];
    p.out = (float*)d_out; p.ws = (unsigned char*)d_ws;
    void* args[] = {&p};
    hipError_t e = hipLaunchCooperativeKernel((const void*)mega_fwd, dim3(grid), dim3(NTHREADS), args, LDS_BYTES, stream);
    if (e != hipSuccess) fprintf(stderr, "cooperative launch failed: %s (grid %d)\n", hipGetErrorString(e), grid);
}
```

```cpp
#include <hip/hip_runtime.h>
#include <hip/hip_cooperative_groups.h>
#include <cstdio>
#include <cstdint>
namespace cg = cooperative_groups;
namespace pg8 {
#define PG8_LAS __attribute__((address_space(3)))
typedef unsigned short bf16_t;
typedef short bf16x8 __attribute__((ext_vector_type(8)));
typedef float f32x4 __attribute__((ext_vector_type(4)));
typedef unsigned u32x4 __attribute__((ext_vector_type(4)));
constexpr int BM = 256, BK = 64, HALF = 128, HTB = HALF * BK * 2  , STAGE_BYTES = 8 * HTB, NXCD = 8, WGM = 8;

__host__ __device__ __forceinline__ int lds_byte(int r, int c) { const int st = (r >> 4) * 2 + (c >> 5), rr = r & 15, cc = c & 31, ob = rr * 64 + cc * 2; return st * 1024 + (ob ^ (((ob >> 9) & 1) << 5)); }
__host__ __device__ __forceinline__ void stage_rc(int b, int& R, int& C) { const int st = b / 1024, sb = b % 1024, swz = sb ^ (((sb >> 9) & 1) << 5); R = (st >> 1) * 16 + swz / 64; C = (st & 1) * 32 + (swz % 64) / 2; }
__host__ __device__ __forceinline__ int perm32(int rho) { const int n = rho >> 4, i = rho & 15; return 8 * (i >> 2) + 4 * n + (i & 3); }

struct Unit { int pm, pn; };
struct Gemm { const bf16_t* A; const bf16_t* Bt; int M, N, K, lda, ldb; };

struct StaticOrder {
    int nM, nN, nwg, G, c;
    __host__ __device__ void init(int M, int N, int G_, int c_) { nM = M / BM; nN = N / BM; nwg = nM * nN; G = G_; c = c_; }
    __host__ __device__ bool next(int i, Unit& u) const {
        const long L = (long)i * G + c; if (L >= nwg) return false;
        int wgid = (int)L; { const int q = nwg / NXCD, r = nwg % NXCD, xcd = wgid % NXCD, off = wgid / NXCD; wgid = (xcd < r ? xcd * (q + 1) : r * (q + 1) + (xcd - r) * q) + off; }
        const int nig = WGM * nN, gid = wgid / nig, fm = gid * WGM, gsz = (nM - fm) < WGM ? (nM - fm) : WGM;
        u.pm = fm + ((wgid % nig) % gsz); u.pn = (wgid % nig) / gsz; return true;
    }
    __device__ __forceinline__ void a_ready(const Unit&) const {}
    __device__ __forceinline__ void done(const Unit&) const {}
};


__device__ __forceinline__ unsigned cvt_pk_bf16(float lo, float hi) { unsigned r; asm volatile("v_cvt_pk_bf16_f32 %0, %1, %2" : "=v"(r) : "v"(lo), "v"(hi)); return r; }
typedef unsigned u32x2 __attribute__((ext_vector_type(2)));
typedef float f32x2 __attribute__((ext_vector_type(2)));
__device__ __forceinline__ float bf2f(unsigned short b) { return __uint_as_float(((unsigned)b) << 16); }
__device__ __forceinline__ void unpack8(const u32x4 w, float (&v)[8]) {
    v[0] = __uint_as_float(w.x << 16); v[1] = __uint_as_float(w.x & 0xffff0000u); v[2] = __uint_as_float(w.y << 16); v[3] = __uint_as_float(w.y & 0xffff0000u);
    v[4] = __uint_as_float(w.z << 16); v[5] = __uint_as_float(w.z & 0xffff0000u); v[6] = __uint_as_float(w.w << 16); v[7] = __uint_as_float(w.w & 0xffff0000u);
}
constexpr float EPI_LN_EPS = 1e-5f;
__device__ __forceinline__ void stats_pre(const float* ST, int pm, int slot, int tid, PG8_LAS float* sx) {
    if (tid < 256) {
        const f32x4* p = (const f32x4*)(ST + (size_t)(pm * BM + tid) * 32); float s = 0.f, q = 0.f;
#pragma unroll
        for (int i = 0; i < 8; ++i) { const f32x4 v = p[i]; s += v[0] + v[2]; q += v[1] + v[3]; }
        const float mean = s * (1.0f / 1024.0f), var = fmaxf(q * (1.0f / 1024.0f) - mean * mean, 0.f);
        *(PG8_LAS f32x2*)(sx + (slot * 256 + tid) * 2) = (f32x2){mean, 1.0f / sqrtf(var + EPI_LN_EPS)};
    }
}

struct EpiBf16 {
    static constexpr bool PERM = true, AFTER_DRAIN = false;
    bf16_t* O; int ldc; const float* bias; int gk_tile; float* GK;
    __device__ __forceinline__ void pre(const Unit&, int, int, PG8_LAS float*) const {}
    __device__ __forceinline__ void operator()(const f32x4 (&acc)[2][2][4][2], const Unit& u, int wr, int wc, int fr, int fq, int, PG8_LAS float*) const {
        const int row0 = u.pm * BM + wr * 64 + fr;
        if (u.pn >= gk_tile) {
            if (wc == 0 && fq < 2) {
#pragma unroll
                for (int ai = 0; ai < 2; ++ai)
#pragma unroll
                    for (int m = 0; m < 4; ++m) { float* gp = GK + (size_t)(row0 + ai * HALF + m * 16) * 16 + 8 * fq;
                        *(f32x4*)(gp) = acc[ai][0][m][0]; *(f32x4*)(gp + 4) = acc[ai][0][m][1]; }
            }
            return;
        }
        const int col0 = u.pn * BM + wc * 32 + 8 * fq;
#pragma unroll
        for (int bj = 0; bj < 2; ++bj) {
            f32x4 b0 = (f32x4){0.f, 0.f, 0.f, 0.f}, b1 = b0;
            if (bias) { b0 = *(const f32x4*)(bias + col0 + bj * HALF); b1 = *(const f32x4*)(bias + col0 + bj * HALF + 4); }
#pragma unroll
            for (int ai = 0; ai < 2; ++ai)
#pragma unroll
                for (int m = 0; m < 4; ++m) { const f32x4 v0 = acc[ai][bj][m][0] + b0, v1 = acc[ai][bj][m][1] + b1;
                    u32x4 w; w.x = cvt_pk_bf16(v0[0], v0[1]); w.y = cvt_pk_bf16(v0[2], v0[3]); w.z = cvt_pk_bf16(v1[0], v1[1]); w.w = cvt_pk_bf16(v1[2], v1[3]);
                    *(u32x4*)(O + (size_t)(row0 + ai * HALF + m * 16) * ldc + col0 + bj * HALF) = w; } }
    }
};

template <bool LN> struct EpiY {
    static constexpr bool PERM = true, AFTER_DRAIN = false;
    const void* res; int res_bf16; const float* bias; const float* g; const float* b; const float* ST_IN; bf16_t* Y; float* ST; float alpha;
    __device__ __forceinline__ void pre(const Unit& u, int slot, int tid, PG8_LAS float* sx) const { if (LN) stats_pre(ST_IN, u.pm, slot, tid, sx); }
    __device__ __forceinline__ void operator()(const f32x4 (&acc)[2][2][4][2], const Unit& u, int wr, int wc, int fr, int fq, int slot, PG8_LAS float* sx) const {
        const int col0 = u.pn * BM + wc * 32 + 8 * fq, rl0 = wr * 64 + fr; const size_t roff0 = (size_t)(u.pm * BM + rl0) * 1024;
        const bf16_t* R = (const bf16_t*)res;
        float ps[8], pq[8];
#pragma unroll
        for (int r = 0; r < 8; ++r) { ps[r] = 0.f; pq[r] = 0.f; }
#pragma unroll
        for (int bj = 0; bj < 2; ++bj) { const int c = col0 + bj * HALF;
            u32x4 rr[8];
#pragma unroll
            for (int r = 0; r < 8; ++r) rr[r] = *(const u32x4*)(R + roff0 + (size_t)((r >> 2) * HALF + (r & 3) * 16) * 1024 + c);
            f32x4 g0, g1, b0, b1, bb0, bb1;
            if (LN) { g0 = *(const f32x4*)(g + c); g1 = *(const f32x4*)(g + c + 4); b0 = *(const f32x4*)(b + c); b1 = *(const f32x4*)(b + c + 4); }
            if (bias) { bb0 = *(const f32x4*)(bias + c); bb1 = *(const f32x4*)(bias + c + 4); }
#pragma unroll
            for (int r = 0; r < 8; ++r) { const int ai = r >> 2, m = r & 3, rl = rl0 + ai * HALF + m * 16;
                float rv[8]; unpack8(rr[r], rv);
                if (LN) { const f32x2 mr = *(const PG8_LAS f32x2*)(sx + (slot * 256 + rl) * 2);
#pragma unroll
                    for (int i = 0; i < 4; ++i) { rv[i] = (rv[i] - mr[0]) * mr[1] * g0[i] + b0[i]; rv[4 + i] = (rv[4 + i] - mr[0]) * mr[1] * g1[i] + b1[i]; } }
                f32x4 v0 = acc[ai][bj][m][0], v1 = acc[ai][bj][m][1];
                if (bias) { v0 += bb0; v1 += bb1; }
                float y[8];
#pragma unroll
                for (int i = 0; i < 4; ++i) { y[i] = alpha * rv[i] + v0[i]; y[4 + i] = alpha * rv[4 + i] + v1[i]; }
                u32x4 w; w.x = cvt_pk_bf16(y[0], y[1]); w.y = cvt_pk_bf16(y[2], y[3]); w.z = cvt_pk_bf16(y[4], y[5]); w.w = cvt_pk_bf16(y[6], y[7]);
                *(u32x4*)(Y + roff0 + (size_t)(ai * HALF + m * 16) * 1024 + c) = w;
                float yr[8]; unpack8(w, yr);
#pragma unroll
                for (int i = 0; i < 8; ++i) { ps[r] += yr[i]; pq[r] += yr[i] * yr[i]; } }
        }
#pragma unroll
        for (int r = 0; r < 8; ++r) { float a = ps[r], q = pq[r];
            a += __shfl_xor(a, 16); a += __shfl_xor(a, 32); q += __shfl_xor(q, 16); q += __shfl_xor(q, 32);
            if (fq == 0) *(f32x2*)(ST + (size_t)(u.pm * BM + rl0 + (r >> 2) * HALF + (r & 3) * 16) * 32 + (u.pn * 4 + wc) * 2) = (f32x2){a, q}; }
    }
};

struct EpiUpLN {
    static constexpr bool PERM = true, AFTER_DRAIN = false;
    const float* ST_IN; const float* colsum; const float* bw; bf16_t* O; int ldc;
    __device__ __forceinline__ void pre(const Unit& u, int slot, int tid, PG8_LAS float* sx) const { stats_pre(ST_IN, u.pm, slot, tid, sx); }
    __device__ __forceinline__ void operator()(const f32x4 (&acc)[2][2][4][2], const Unit& u, int wr, int wc, int fr, int fq, int slot, PG8_LAS float* sx) const {
        const int col0 = u.pn * BM + wc * 32 + 8 * fq, rl0 = wr * 64 + fr;
#pragma unroll
        for (int bj = 0; bj < 2; ++bj) { const int c = col0 + bj * HALF;
            const f32x4 c0 = *(const f32x4*)(colsum + c), c1 = *(const f32x4*)(colsum + c + 4), w0 = *(const f32x4*)(bw + c), w1 = *(const f32x4*)(bw + c + 4);
#pragma unroll
            for (int r = 0; r < 8; ++r) { const int ai = r >> 2, m = r & 3, rl = rl0 + ai * HALF + m * 16;
                const f32x2 mr = *(const PG8_LAS f32x2*)(sx + (slot * 256 + rl) * 2);
                f32x4 v0 = (acc[ai][bj][m][0] - c0 * mr[0]) * mr[1] + w0, v1 = (acc[ai][bj][m][1] - c1 * mr[0]) * mr[1] + w1;
#pragma unroll
                for (int i = 0; i < 4; ++i) { const float a = fmaxf(v0[i], 0.f), b2 = fmaxf(v1[i], 0.f); v0[i] = a * a; v1[i] = b2 * b2; }
                u32x4 w; w.x = cvt_pk_bf16(v0[0], v0[1]); w.y = cvt_pk_bf16(v0[2], v0[3]); w.z = cvt_pk_bf16(v1[0], v1[1]); w.w = cvt_pk_bf16(v1[2], v1[3]);
                *(u32x4*)(O + (size_t)(u.pm * BM + rl) * ldc + c) = w; } }
    }
};

struct EpiPP {
    static constexpr bool PERM = true, AFTER_DRAIN = false;
    bf16_t* O; int ldc;
    __device__ __forceinline__ void pre(const Unit&, int, int, PG8_LAS float*) const {}
    __device__ __forceinline__ void operator()(const f32x4 (&acc)[2][2][4][2], const Unit& u, int wr, int wc, int fr, int fq, int, PG8_LAS float*) const {
        const int row0 = u.pm * BM + wr * 64 + fr, col0 = u.pn * BM + wc * 32 + 8 * fq;
#pragma unroll
        for (int ai = 0; ai < 2; ++ai)
#pragma unroll
            for (int m = 0; m < 4; ++m) { bf16_t* rowp = O + (size_t)(row0 + ai * HALF + m * 16) * ldc + col0;
#pragma unroll
                for (int bj = 0; bj < 2; ++bj) { const f32x4 v0 = acc[ai][bj][m][0], v1 = acc[ai][bj][m][1];
                    u32x4 w; w.x = cvt_pk_bf16(v0[0], v0[1]); w.y = cvt_pk_bf16(v0[2], v0[3]); w.z = cvt_pk_bf16(v1[0], v1[1]); w.w = cvt_pk_bf16(v1[2], v1[3]);
                    *(u32x4*)(rowp + bj * HALF) = w; } }
    }
};

struct EpiGateLN {
    static constexpr bool PERM = true, AFTER_DRAIN = false;
    const float* ST_IN; const bf16_t* YB; const bf16_t* pp; const float* colsum; const float* bz; const float* g; const float* b; float* out; bf16_t* ob;
    __device__ __forceinline__ void pre(const Unit& u, int slot, int tid, PG8_LAS float* sx) const { stats_pre(ST_IN, u.pm, slot, tid, sx); }
    __device__ __forceinline__ void operator()(const f32x4 (&acc)[2][2][4][2], const Unit& u, int wr, int wc, int fr, int fq, int slot, PG8_LAS float* sx) const {
        const int col0 = u.pn * BM + wc * 32 + 8 * fq, rl0 = wr * 64 + fr; const size_t roff0 = (size_t)(u.pm * BM + rl0) * 1024;
#pragma unroll
        for (int bj = 0; bj < 2; ++bj) { const int c = col0 + bj * HALF;
            f32x4 cs[2], zb[2], gg[2], bb[2];
#pragma unroll
            for (int hh = 0; hh < 2; ++hh) { cs[hh] = *(const f32x4*)(colsum + c + 4 * hh); zb[hh] = *(const f32x4*)(bz + c + 4 * hh); gg[hh] = *(const f32x4*)(g + c + 4 * hh); bb[hh] = *(const f32x4*)(b + c + 4 * hh); }
#pragma unroll
            for (int ai = 0; ai < 2; ++ai) {
                u32x4 yy[4], pw[4];
#pragma unroll
                for (int m = 0; m < 4; ++m) { const size_t o2 = roff0 + (size_t)(ai * HALF + m * 16) * 1024 + c; yy[m] = *(const u32x4*)(YB + o2); pw[m] = *(const u32x4*)(pp + o2); }
#pragma unroll
                for (int m = 0; m < 4; ++m) { const int rl = rl0 + ai * HALF + m * 16; const size_t o2 = roff0 + (size_t)(ai * HALF + m * 16) * 1024 + c;
                    const f32x2 mr = *(const PG8_LAS f32x2*)(sx + (slot * 256 + rl) * 2);
                    float y[8], p[8], o[8]; unpack8(yy[m], y); unpack8(pw[m], p);
#pragma unroll
                    for (int hh = 0; hh < 2; ++hh) { const f32x4 z = (acc[ai][bj][m][hh] - cs[hh] * mr[0]) * mr[1] + zb[hh];
#pragma unroll
                        for (int i = 0; i < 4; ++i) { const float h2 = (y[4 * hh + i] - mr[0]) * mr[1] * gg[hh][i] + bb[hh][i]; o[4 * hh + i] = h2 + p[4 * hh + i] * __builtin_amdgcn_rcpf(1.0f + __expf(-z[i])); } }
                    if (ob) { u32x4 w; w.x = cvt_pk_bf16(o[0], o[1]); w.y = cvt_pk_bf16(o[2], o[3]); w.z = cvt_pk_bf16(o[4], o[5]); w.w = cvt_pk_bf16(o[6], o[7]); *(u32x4*)(ob + o2) = w; }
                    else { *(f32x4*)(out + o2) = (f32x4){o[0], o[1], o[2], o[3]}; *(f32x4*)(out + o2 + 4) = (f32x4){o[4], o[5], o[6], o[7]}; } }
                asm volatile("" ::: "memory");
            } }
    }
};

template <class Epi, class Sched, bool ALIGN_EPI = false, bool SP2 = false>
__device__ __forceinline__ void gemm_phase(PG8_LAS unsigned char* lds, const Gemm g, const Sched& S, const Epi& E, PG8_LAS float* sx) {
    int tid_ = threadIdx.x; asm volatile("" : "+v"(tid_));
    const int tid = tid_, wid = __builtin_amdgcn_readfirstlane(tid >> 6), lane = tid & 63, wr = wid >> 2, wc = wid & 3, fr = lane & 15, fq = lane >> 4;
    const int K = g.K, nt = K / BK;
    unsigned voffA[2], voffB[2];
#pragma unroll
    for (int i = 0; i < 2; ++i) { int R, C; stage_rc(tid * 16 + i * 8192, R, C); const int Rb = Epi::PERM ? ((R & ~31) + perm32(R & 31)) : R;
        voffA[i] = (unsigned)(R * g.lda + C) * 2u; voffB[i] = (unsigned)(Rb * g.ldb + C) * 2u; }
    const size_t kstep = (size_t)(BK * 2);
    const size_t hstepA = (size_t)HALF * g.lda * 2, hstepB = (size_t)HALF * g.ldb * 2;
    const size_t tstepA = 2 * hstepA, tstepB = 2 * hstepB;
    const unsigned ldsw = (unsigned)wid * 1024u;
    const int aoff = lds_byte(wr * 64 + fr, fq * 8), boff = lds_byte(wc * 32 + fr, fq * 8);
#define PG8_SA(b, h) (((b) * 2 + (h)) * HTB)
#define PG8_SB(b, h) ((4 + (b) * 2 + (h)) * HTB)
#define PG8_STAGE(bufoff, gbase, voff) do { _Pragma("unroll") for (int _i = 0; _i < 2; ++_i) \
        __builtin_amdgcn_global_load_lds((const unsigned*)((const char*)(gbase) + (voff)[_i]), (PG8_LAS unsigned*)(lds + (bufoff) + ldsw + _i * 8192), 16, 0, 0); } while (0)
#define PG8_LDA(dst, b, h) do { _Pragma("unroll") for (int m = 0; m < 4; ++m) _Pragma("unroll") for (int k = 0; k < 2; ++k) dst[m][k] = *(const PG8_LAS bf16x8*)(lds + PG8_SA(b, h) + aoff + m * 2048 + k * 1024); } while (0)
#define PG8_LDB(dst, b, h) do { _Pragma("unroll") for (int n = 0; n < 2; ++n) _Pragma("unroll") for (int k = 0; k < 2; ++k) dst[n][k] = *(const PG8_LAS bf16x8*)(lds + PG8_SB(b, h) + boff + n * 2048 + k * 1024); } while (0)
#define PG8_MMA(ai, bj, At, Bt) do { __builtin_amdgcn_s_setprio(1); _Pragma("unroll") for (int m = 0; m < 4; ++m) _Pragma("unroll") for (int n = 0; n < 2; ++n) _Pragma("unroll") for (int k = 0; k < 2; ++k) \
        acc[ai][bj][m][n] = __builtin_amdgcn_mfma_f32_16x16x32_bf16(Bt[n][k], At[m][k], acc[ai][bj][m][n], 0, 0, 0); __builtin_amdgcn_s_setprio(0); } while (0)
#define PG8_WAIT_V(n) asm volatile("s_waitcnt vmcnt(" #n ")" ::: "memory")
#define PG8_WAIT_L(n) asm volatile("s_waitcnt lgkmcnt(" #n ")" ::: "memory")
#define PG8_BAR __builtin_amdgcn_s_barrier()
#define PG8_SCHED __builtin_amdgcn_sched_barrier(0)
    Unit cur, nxt; int ui = 0;
    if (!S.next(0, cur)) return;
    f32x4 acc[2][2][4][2];
#pragma unroll
    for (int a = 0; a < 2; ++a)
#pragma unroll
        for (int b = 0; b < 2; ++b)
#pragma unroll
            for (int m = 0; m < 4; ++m)
#pragma unroll
                for (int n = 0; n < 2; ++n) acc[a][b][m][n] = (f32x4){0.f, 0.f, 0.f, 0.f};
    bf16x8 At[4][2], B0[2][2], B1[2][2];
    const char* cA = (const char*)g.A + (size_t)cur.pm * tstepA; const char* cB = (const char*)g.Bt + (size_t)cur.pn * tstepB;
    S.a_ready(cur); E.pre(cur, 0, tid, sx);
    if constexpr (SP2) {
        PG8_STAGE(PG8_SB(0, 0), cB, voffB); PG8_STAGE(PG8_SB(0, 1), cB + hstepB, voffB); PG8_STAGE(PG8_SA(0, 0), cA, voffA); PG8_STAGE(PG8_SA(0, 1), cA + hstepA, voffA);
        if (wr == 1) PG8_BAR;
        PG8_WAIT_V(2); PG8_BAR;
        PG8_STAGE(PG8_SB(1, 0), cB + kstep, voffB); PG8_STAGE(PG8_SA(1, 0), cA + kstep, voffA); PG8_STAGE(PG8_SB(1, 1), cB + hstepB + kstep, voffB);
        PG8_WAIT_V(6); PG8_BAR;
    } else {
        PG8_STAGE(PG8_SB(0, 0), cB, voffB); PG8_STAGE(PG8_SA(0, 0), cA, voffA); PG8_STAGE(PG8_SB(0, 1), cB + hstepB, voffB); PG8_STAGE(PG8_SA(0, 1), cA + hstepA, voffA);
        if (wr == 1) PG8_BAR;
        PG8_WAIT_V(4); PG8_BAR;
        PG8_STAGE(PG8_SB(1, 0), cB + kstep, voffB); PG8_STAGE(PG8_SA(1, 0), cA + kstep, voffA); PG8_STAGE(PG8_SB(1, 1), cB + hstepB + kstep, voffB);
        PG8_WAIT_V(6); PG8_BAR;
    }
    for (;;) {
        const bool has_next = S.next(ui + 1, nxt);
        const char* nA = has_next ? (const char*)g.A + (size_t)nxt.pm * tstepA : cA; const char* nB = has_next ? (const char*)g.Bt + (size_t)nxt.pn * tstepB : cB;
        for (int t = 0; t < nt; t += 2) {
            const bool last = (t == nt - 2);
            const char* a1 = cA + (size_t)(t + 1) * kstep;
            const char* a2 = last ? nA : cA + (size_t)(t + 2) * kstep; const char* b2 = last ? nB : cB + (size_t)(t + 2) * kstep;
            const char* a3 = a2 + kstep; const char* b3 = b2 + kstep;
            if (last && has_next) { S.a_ready(nxt); E.pre(nxt, (ui + 1) & 1, tid, sx); }
            if constexpr (SP2) {
            PG8_LDB(B0, 0, 0); PG8_LDB(B1, 0, 1); PG8_SCHED; PG8_LDA(At, 0, 0); PG8_STAGE(PG8_SA(1, 1), a1 + hstepA, voffA);
            PG8_WAIT_V(8); PG8_WAIT_L(0); PG8_BAR; PG8_MMA(0, 0, At, B0); PG8_MMA(0, 1, At, B1); PG8_BAR; PG8_SCHED;
            PG8_LDA(At, 0, 1); PG8_STAGE(PG8_SB(0, 0), b2, voffB); PG8_STAGE(PG8_SB(0, 1), b2 + hstepB, voffB); PG8_STAGE(PG8_SA(0, 0), a2, voffA);
            PG8_WAIT_V(8); PG8_WAIT_L(0); PG8_BAR; PG8_MMA(1, 0, At, B0); PG8_MMA(1, 1, At, B1); PG8_BAR; PG8_SCHED;
            PG8_LDB(B0, 1, 0); PG8_LDB(B1, 1, 1); PG8_SCHED; PG8_LDA(At, 1, 0); PG8_STAGE(PG8_SA(0, 1), a2 + hstepA, voffA);
            PG8_WAIT_V(8); PG8_WAIT_L(0); PG8_BAR; PG8_MMA(0, 0, At, B0); PG8_MMA(0, 1, At, B1); PG8_BAR; PG8_SCHED;
            PG8_LDA(At, 1, 1); PG8_STAGE(PG8_SB(1, 0), b3, voffB); PG8_STAGE(PG8_SB(1, 1), b3 + hstepB, voffB); PG8_STAGE(PG8_SA(1, 0), a3, voffA);
            PG8_WAIT_V(8); PG8_WAIT_L(0); PG8_BAR; PG8_MMA(1, 0, At, B0); PG8_MMA(1, 1, At, B1); PG8_BAR; PG8_SCHED;
            } else {
            PG8_LDB(B0, 0, 0); PG8_SCHED; PG8_LDA(At, 0, 0); PG8_STAGE(PG8_SA(1, 1), a1 + hstepA, voffA);
            PG8_WAIT_L(8); PG8_BAR; PG8_WAIT_L(0); PG8_MMA(0, 0, At, B0); PG8_BAR; PG8_SCHED;
            PG8_LDB(B1, 0, 1); PG8_STAGE(PG8_SB(0, 0), b2, voffB);
            PG8_BAR; PG8_WAIT_L(0); PG8_MMA(0, 1, At, B1); PG8_BAR;
            PG8_LDA(At, 0, 1); PG8_STAGE(PG8_SA(0, 0), a2, voffA);
            PG8_BAR; PG8_WAIT_L(0); PG8_MMA(1, 0, At, B0); PG8_BAR; PG8_SCHED;
            PG8_STAGE(PG8_SB(0, 1), b2 + hstepB, voffB);
            PG8_WAIT_V(6); PG8_BAR; PG8_MMA(1, 1, At, B1); PG8_BAR;
            PG8_LDB(B0, 1, 0); PG8_SCHED; PG8_LDA(At, 1, 0); PG8_STAGE(PG8_SA(0, 1), a2 + hstepA, voffA);
            PG8_WAIT_L(8); PG8_BAR; PG8_WAIT_L(0); PG8_MMA(0, 0, At, B0); PG8_BAR; PG8_SCHED;
            PG8_LDB(B1, 1, 1); PG8_STAGE(PG8_SB(1, 0), b3, voffB);
            PG8_BAR; PG8_WAIT_L(0); PG8_MMA(0, 1, At, B1); PG8_BAR;
            PG8_LDA(At, 1, 1); PG8_STAGE(PG8_SA(1, 0), a3, voffA);
            PG8_BAR; PG8_WAIT_L(0); PG8_MMA(1, 0, At, B0); PG8_BAR; PG8_SCHED;
            PG8_STAGE(PG8_SB(1, 1), b3 + hstepB, voffB);
            PG8_WAIT_V(6); PG8_BAR; PG8_MMA(1, 1, At, B1); PG8_BAR;
            }
        }
        if constexpr (ALIGN_EPI) { if (wr == 0) PG8_BAR; }
        if constexpr (!Epi::AFTER_DRAIN) { E(acc, cur, wr, wc, fr, fq, ui & 1, sx); S.done(cur); }
        if (!has_next) break;
#pragma unroll
        for (int a = 0; a < 2; ++a)
#pragma unroll
            for (int b = 0; b < 2; ++b)
#pragma unroll
                for (int m = 0; m < 4; ++m)
#pragma unroll
                    for (int n = 0; n < 2; ++n) acc[a][b][m][n] = (f32x4){0.f, 0.f, 0.f, 0.f};
        cur = nxt; cA = nA; cB = nB; ++ui;
        if constexpr (ALIGN_EPI) { if (wr == 1) PG8_BAR; }
    }
    PG8_WAIT_V(0);
    if constexpr (!ALIGN_EPI) { if (wr == 0) PG8_BAR; }
    PG8_BAR;
    if constexpr (Epi::AFTER_DRAIN) { E.fused(acc, cur, wr, wc, fr, fq, lds, wid, lane); S.done(cur); }
#undef PG8_SA
#undef PG8_SB
#undef PG8_STAGE
#undef PG8_LDA
#undef PG8_LDB
#undef PG8_MMA
#undef PG8_WAIT_V
#undef PG8_WAIT_L
#undef PG8_BAR
#undef PG8_SCHED
}
}

#define LAS __attribute__((address_space(3)))
typedef unsigned short bf16;
typedef unsigned u32x4 __attribute__((ext_vector_type(4)));
typedef unsigned u32x2 __attribute__((ext_vector_type(2)));
typedef float f32x4 __attribute__((ext_vector_type(4)));
typedef short bf16x8 __attribute__((ext_vector_type(8)));
typedef short s16x4 __attribute__((ext_vector_type(4)));

constexpr int NTHREADS = 512, NWAVES = 8;
constexpr int BATCH = 8, SEQ = 4096, D = 1024, M = BATCH * SEQ, FF = 4096, PLE = 256;
constexpr int GLA_COLS = 3088, PROJ_LD = 3072;
constexpr int QKV_LD = 1536;
constexpr float LN_EPS = 1e-5f, RMS_EPS = 1e-5f;
constexpr float ALPHA = 1.4142135623730951f;
constexpr size_t MiB = 1u << 20;
constexpr size_t W_IN_T = 1 * MiB;
constexpr size_t W_GOUT_T = 7 * MiB;
constexpr size_t W_UP_T = 9 * MiB;
constexpr size_t W_DN_T = 17 * MiB;
constexpr size_t W_GATE_T = 25 * MiB;
constexpr size_t W_PP_T = 27 * MiB;
constexpr size_t W_QKV_T = 28 * MiB;
constexpr size_t W_SOUT_T = 31 * MiB;
constexpr size_t W_LSTRIDE = 24 * MiB;
constexpr size_t PB1_OFF = 1 * MiB;
constexpr size_t R0 = 56 * MiB;
constexpr size_t R1 = 120 * MiB;
constexpr size_t R2 = 248 * MiB;
constexpr size_t R2_GK = R2 + 192 * MiB;
constexpr size_t R2_PP = R2 + 16 * MiB;
constexpr size_t R2_H3B = R2 + 80 * MiB;
constexpr size_t R2_QKV = R2 + 144 * MiB;
constexpr size_t R0_BL = R1 + 80 * MiB;
constexpr size_t WS_END = 512 * MiB;
constexpr int LDS_BYTES = 147456;

__device__ __forceinline__ int opq(int v) { asm volatile("" : "+s"(v)); return v; }
struct Params { const float* in[21]; float* out; unsigned char* ws; };
#define LBAR() do { asm volatile("s_waitcnt lgkmcnt(0)" ::: "memory"); __builtin_amdgcn_s_barrier(); asm volatile("" ::: "memory"); } while (0)

struct Ctx { LAS unsigned char* lds; int tid, lane, wave; };

__device__ __forceinline__ float wave_sum(float v) {
#pragma unroll
    for (int o = 1; o < 64; o <<= 1) v += __shfl_xor(v, o);
    return v;
}
__device__ __forceinline__ unsigned pk2(float lo, float hi) { return pg8::cvt_pk_bf16(lo, hi); }
__device__ __forceinline__ float bf2f(unsigned short b) { return __uint_as_float(((unsigned)b) << 16); }
__device__ __forceinline__ bf16x8 pack8(const f32x4 a, const f32x4 b) {
    u32x4 w; w.x = pk2(a[0], a[1]); w.y = pk2(a[2], a[3]); w.z = pk2(b[0], b[1]); w.w = pk2(b[2], b[3]); return __builtin_bit_cast(bf16x8, w);
}
#define MFMA16(a, b, c) __builtin_amdgcn_mfma_f32_16x16x32_bf16((a), (b), (c), 0, 0, 0)
__device__ __forceinline__ bf16x8 lds16(const LAS unsigned char* p) { return *(const LAS bf16x8*)p; }
__device__ __forceinline__ bf16x8 lds8x2(const LAS unsigned char* p0, const LAS unsigned char* p1) {
    const s16x4 lo = *(const LAS s16x4*)p0, hi = *(const LAS s16x4*)p1; return __builtin_shufflevector(lo, hi, 0, 1, 2, 3, 4, 5, 6, 7);
}

template <bool FOLD>
__device__ __forceinline__ void transpose_item(const float* W, int ldw, int nblk, int K, bf16* WT, LAS float* scr, int item, int lane,
                                               const float* gv = nullptr, const float* bv = nullptr, float* csp = nullptr, float* bwp = nullptr) {
    const int kb = item / nblk, nb = item % nblk, k0 = 64 * kb, n0 = 32 * nb;
    { const int r8 = lane >> 3, c4 = lane & 7;
      f32x4 v[8];
#pragma unroll
      for (int it = 0; it < 8; ++it) v[it] = *(const f32x4*)(W + (size_t)(k0 + 8 * it + r8) * ldw + n0 + 4 * c4);
#pragma unroll
      for (int it = 0; it < 8; ++it) { LAS float* d = scr + (8 * it + r8) * 33 + 4 * c4; d[0] = v[it][0]; d[1] = v[it][1]; d[2] = v[it][2]; d[3] = v[it][3]; } }
    asm volatile("s_waitcnt lgkmcnt(0)" ::: "memory");
    const int c = lane & 7;
    float gk[8], bk[8];
    if (FOLD) {
#pragma unroll
        for (int i = 0; i < 8; ++i) { gk[i] = gv[k0 + 8 * c + i]; bk[i] = bv[k0 + 8 * c + i]; }
    }
#pragma unroll
    for (int j = 0; j < 4; ++j) { const int n = (lane >> 3) + 8 * j; const LAS float* sp = scr + (8 * c) * 33 + n;
        float v[8];
#pragma unroll
        for (int i = 0; i < 8; ++i) v[i] = sp[i * 33];
        float bwv = 0.f;
        if (FOLD) {
#pragma unroll
            for (int i = 0; i < 8; ++i) { bwv += bk[i] * v[i]; v[i] *= gk[i]; }
        }
        u32x4 o; o.x = pk2(v[0], v[1]); o.y = pk2(v[2], v[3]); o.z = pk2(v[4], v[5]); o.w = pk2(v[6], v[7]);
        *(u32x4*)(WT + (size_t)(n0 + n) * K + k0 + 8 * c) = o;
        if (FOLD) {
            float r[8]; pg8::unpack8(o, r); float cs = ((r[0] + r[1]) + (r[2] + r[3])) + ((r[4] + r[5]) + (r[6] + r[7]));
            cs += __shfl_xor(cs, 1); cs += __shfl_xor(cs, 2); cs += __shfl_xor(cs, 4);
            bwv += __shfl_xor(bwv, 1); bwv += __shfl_xor(bwv, 2); bwv += __shfl_xor(bwv, 4);
            if (c == 0) { const int N = 32 * nblk; csp[(size_t)kb * N + n0 + n] = cs; bwp[(size_t)kb * N + n0 + n] = bwv; }
        }
    }
    asm volatile("s_waitcnt lgkmcnt(0)" ::: "memory");
}
constexpr size_t VEC = 52 * MiB;
__device__ __host__ constexpr size_t CSP_UP(int l) { return VEC + (size_t)l * 512 * 1024; }
__device__ __host__ constexpr size_t CSP_G(int l) { return VEC + MiB + (size_t)l * 128 * 1024; }
__device__ __host__ constexpr size_t FIN(int l) { return VEC + MiB + 512 * 1024 + (size_t)l * 64 * 1024; }
__device__ __forceinline__ void fold_finalize(const Params& P, int gtid, int gthreads) {
    for (int idx = gtid; idx < 2 * 5120; idx += gthreads) {
        const int l = idx / 5120, r = idx % 5120;
        float* fin = (float*)(P.ws + FIN(l));
        if (r < 4096) { const float* cp = (const float*)(P.ws + CSP_UP(l)); const float* bp = cp + 16 * 4096; float cs = 0.f, bw = 0.f;
#pragma unroll
            for (int kb = 0; kb < 16; ++kb) { cs += cp[kb * 4096 + r]; bw += bp[kb * 4096 + r]; }
            fin[r] = cs; fin[4096 + r] = bw; }
        else { const int n = r - 4096; const float* cp = (const float*)(P.ws + CSP_G(l)); const float* bp = cp + 16 * 1024; float cs = 0.f, bw = 0.f;
#pragma unroll
            for (int kb = 0; kb < 16; ++kb) { cs += cp[kb * 1024 + n]; bw += bp[kb * 1024 + n]; }
            fin[8192 + n] = cs; fin[9216 + n] = bw + P.in[20][l * D + n]; }
    }
}
__device__ __forceinline__ void p0_prologue(const Ctx& F, const Params& P) {
    LAS float* scr = (LAS float*)(F.lds + F.wave * 16384);
    const int gw = blockIdx.x * NWAVES + F.wave, NGW = gridDim.x * NWAVES;
    unsigned char* ws = P.ws;
    constexpr int I_IN = 16 * 96, I_SQ = 16 * 32, I_QKV = 16 * 48, I_UP = 16 * 128, I_DN = 64 * 32, I_PP = 4 * 32;
    constexpr int NITEMS = I_IN + 2 * I_SQ + I_QKV + 2 * I_UP + 2 * I_DN + 2 * I_SQ + 2 * I_PP;
    for (int it = gw; it < NITEMS; it += NGW) {
        int r = it;
        if (r < I_IN) { transpose_item<false>(P.in[2], GLA_COLS, 96, D, (bf16*)(ws + W_IN_T), scr, r, F.lane); continue; } r -= I_IN;
        if (r < I_SQ) { transpose_item<false>(P.in[6], D, 32, D, (bf16*)(ws + W_GOUT_T), scr, r, F.lane); continue; } r -= I_SQ;
        if (r < I_SQ) { transpose_item<false>(P.in[10], D, 32, D, (bf16*)(ws + W_SOUT_T), scr, r, F.lane); continue; } r -= I_SQ;
        if (r < I_QKV) { transpose_item<false>(P.in[7], QKV_LD, 48, D, (bf16*)(ws + W_QKV_T), scr, r, F.lane); continue; } r -= I_QKV;
        if (r < 2 * I_UP) { const int l = r / I_UP; transpose_item<true>(P.in[12] + (size_t)l * D * FF, FF, 128, D, (bf16*)(ws + W_UP_T + (size_t)l * W_LSTRIDE), scr, r % I_UP, F.lane, P.in[14] + l * D, P.in[15] + l * D, (float*)(ws + CSP_UP(l)), (float*)(ws + CSP_UP(l)) + 16 * 4096); continue; } r -= 2 * I_UP;
        if (r < 2 * I_DN) { const int l = r / I_DN; transpose_item<false>(P.in[13] + (size_t)l * D * FF, D, 32, FF, (bf16*)(ws + W_DN_T + (size_t)l * W_LSTRIDE), scr, r % I_DN, F.lane); continue; } r -= 2 * I_DN;
        if (r < 2 * I_SQ) { const int l = r / I_SQ; transpose_item<true>(P.in[19] + (size_t)l * D * D, D, 32, D, (bf16*)(ws + W_GATE_T + (size_t)l * W_LSTRIDE), scr, r % I_SQ, F.lane, P.in[16] + l * D, P.in[17] + l * D, (float*)(ws + CSP_G(l)), (float*)(ws + CSP_G(l)) + 16 * 1024); continue; } r -= 2 * I_SQ;
        { const int l = r / I_PP; transpose_item<false>(P.in[18] + (size_t)l * PLE * D, D, 32, PLE, (bf16*)(ws + W_PP_T + (size_t)l * W_LSTRIDE), scr, r % I_PP, F.lane); }
    }
    const int gtid = blockIdx.x * NTHREADS + F.tid, gthreads = gridDim.x * NTHREADS;
    {
        LAS float* wg = (LAS float*)F.lds;
        __syncthreads();
        for (int i = F.tid; i < 4096; i += NTHREADS) { const int k = i >> 2, c4 = i & 3, pos = (k & 3) * 256 + (k >> 2); *(LAS f32x4*)(wg + pos * 20 + 4 * c4) = *(const f32x4*)(P.in[2] + (size_t)k * GLA_COLS + 3072 + 4 * c4); }
        __syncthreads();
        const float* x = P.in[0]; bf16* xb = (bf16*)(ws + R0); float* GK = (float*)(ws + R2_GK);
        const int lane = F.lane;
#pragma unroll 1
        for (int r0 = gw * 4; r0 < M; r0 += NGW * 4) {
            f32x4 acc[16];
#pragma unroll
            for (int i = 0; i < 16; ++i) acc[i] = (f32x4){0.f, 0.f, 0.f, 0.f};
#pragma unroll 1
            for (int j = 0; j < 4; ++j) {
                float xs[4][4];
#pragma unroll
                for (int rr = 0; rr < 4; ++rr) { const f32x4 v = *(const f32x4*)(x + (size_t)(r0 + rr) * D + 256 * j + 4 * lane);
                    u32x2 o; o.x = pk2(v[0], v[1]); o.y = pk2(v[2], v[3]); *(u32x2*)(xb + (size_t)(r0 + rr) * D + 256 * j + 4 * lane) = o;
                    xs[rr][0] = v[0]; xs[rr][1] = v[1]; xs[rr][2] = v[2]; xs[rr][3] = v[3]; }
#pragma unroll
                for (int i = 0; i < 4; ++i) { const LAS float* wp = wg + (i * 256 + 64 * j + lane) * 20;
                    const f32x4 w0 = *(const LAS f32x4*)(wp), w1 = *(const LAS f32x4*)(wp + 4), w2 = *(const LAS f32x4*)(wp + 8), w3 = *(const LAS f32x4*)(wp + 12);
#pragma unroll
                    for (int rr = 0; rr < 4; ++rr) { const float xv = xs[rr][i]; acc[rr * 4 + 0] += w0 * xv; acc[rr * 4 + 1] += w1 * xv; acc[rr * 4 + 2] += w2 * xv; acc[rr * 4 + 3] += w3 * xv; } }
            }
            float a[64];
#pragma unroll
            for (int i = 0; i < 16; ++i) { a[4 * i] = acc[i][0]; a[4 * i + 1] = acc[i][1]; a[4 * i + 2] = acc[i][2]; a[4 * i + 3] = acc[i][3]; }
#define TR_STEP(n) do { const bool hi_ = (lane & (n)) != 0; _Pragma("unroll") for (int i = 0; i < (n); ++i) { const float send = hi_ ? a[i] : a[i + (n)], keep = hi_ ? a[i + (n)] : a[i]; a[i] = keep + __shfl_xor(send, (n)); } } while (0)
            TR_STEP(32); TR_STEP(16); TR_STEP(8); TR_STEP(4); TR_STEP(2); TR_STEP(1);
#undef TR_STEP
            GK[(size_t)r0 * 16 + lane] = a[0];
        }
    }
}

__device__ __forceinline__ void gla_prep_unit(const Ctx& F, const Params& P, int b, int c, int h, size_t pgrp) {
    LAS float* gk_s = (LAS float*)(F.lds);
    LAS float* part = (LAS float*)(F.lds + 4096);
    const int tid = F.tid, d = tid & 127, g = tid >> 7;
    bf16* PROJ = (bf16*)(P.ws + R2); const float* GK = (const float*)(P.ws + R2_GK);
    float* BL = (float*)(P.ws + R0_BL);
    const float* wup = P.in[3]; const float* bgk = P.in[4];
    const int u = (b * 64 + c) * 4 + h;
    const size_t m0 = (size_t)b * SEQ + (size_t)c * 64;
    if (tid < 256) ((LAS f32x4*)gk_s)[tid] = *(const f32x4*)(GK + m0 * 16 + (size_t)tid * 4);
    bf16* qp = PROJ + (m0 + 16 * g) * PROJ_LD + h * 128 + d; bf16* kp = qp + 512;
    { const f32x4 a = *(const f32x4*)(P.in[1] + pgrp * 8), a2 = *(const f32x4*)(P.in[1] + pgrp * 8 + 4);
      u32x4 o; o.x = pk2(a[0], a[1]); o.y = pk2(a[2], a[3]); o.z = pk2(a2[0], a2[1]); o.w = pk2(a2[2], a2[3]); *(u32x4*)((bf16*)P.out + pgrp * 8) = o; }
    unsigned short qraw[16], kraw[16];
#pragma unroll
    for (int tt = 0; tt < 16; ++tt) { qraw[tt] = qp[(size_t)tt * PROJ_LD]; kraw[tt] = kp[(size_t)tt * PROJ_LD]; }
    float w[16];
#pragma unroll
    for (int r = 0; r < 16; ++r) w[r] = wup[r * 512 + h * 128 + d];
    const float bias = bgk[h * 128 + d];
    LBAR();
    float cs[16]; float run = 0.f;
#pragma unroll
    for (int tt = 0; tt < 16; ++tt) {
        const int t = 16 * g + tt; float z = bias;
#pragma unroll
        for (int r4 = 0; r4 < 4; ++r4) { const f32x4 a = ((const LAS f32x4*)gk_s)[t * 4 + r4]; z += a[0] * w[4 * r4] + a[1] * w[4 * r4 + 1] + a[2] * w[4 * r4 + 2] + a[3] * w[4 * r4 + 3]; }
        const float ls = fminf(z, 0.f) - __logf(1.0f + __expf(-fabsf(z)));
        run += ls * (1.0f / 16.0f); cs[tt] = run;
    }
    part[g * 128 + d] = run;
    LBAR();
    float off = 0.f, tot = 0.f;
#pragma unroll
    for (int gg = 0; gg < 4; ++gg) { const float pv = part[gg * 128 + d]; tot += pv; if (gg < g) off += pv; }
#pragma unroll
    for (int tt = 0; tt < 16; ++tt) {
        const float bc = cs[tt] + off;
        const float qv = bf2f(qraw[tt]), kv = bf2f(kraw[tt]);
        const float e1 = __expf(bc), e2 = __expf(-bc);
        qp[(size_t)tt * PROJ_LD] = (bf16)(pk2(qv * 0.08838834764831845f * e1, 0.f) & 0xffffu);
        kp[(size_t)tt * PROJ_LD] = (bf16)(pk2(kv * e2, 0.f) & 0xffffu);
    }
    if (g == 0) BL[(size_t)u * 128 + d] = tot;
    LBAR();
}

typedef short v4i16_t __attribute__((ext_vector_type(4)));
__device__ __forceinline__ s16x4 ldtr(const LAS unsigned char* p) { return __builtin_bit_cast(s16x4, __builtin_amdgcn_ds_read_tr16_b64_v4i16((LAS v4i16_t*)p)); }
constexpr int GS_Q = 0, GS_K = 17408, GS_V = 34816, GS_ATT = 68608, GS_RS = 77824, GS_RSTD = 79872, GS_BL = 80128;
constexpr size_t R0_SLOC = R1, R0_GSEG = R1 + 40 * MiB;
template <bool FULL>
__device__ __forceinline__ void gla_scan_pass(const Ctx& F, const Params& P) {
    LAS unsigned char* L = F.lds;
    const int tid = F.tid, lane = F.lane, w = F.wave, l15 = lane & 15, quad = lane >> 4;
    bf16* PROJ = (bf16*)(P.ws + R2);
    const float* BL = (const float*)(P.ws + R0_BL);
    float* SLOC = (float*)(P.ws + R0_SLOC); float* GSEG = (float*)(P.ws + R0_GSEG);
    const float* norm_g = P.in[5];
    for (int item = blockIdx.x; item < BATCH * 4 * 8; item += gridDim.x) {
        const int seg = item & 7, bh = item >> 3, b = bh >> 2, h = bh & 3;
        if (!FULL) {
#pragma unroll 1
            for (int cc = 0; cc < 8; ++cc) gla_prep_unit(F, P, b, seg * 8 + cc, h, ((size_t)(item * 8 + cc)) * 512 + tid);
            asm volatile("s_waitcnt vmcnt(0)" ::: "memory"); __builtin_amdgcn_s_barrier();
            __builtin_amdgcn_fence(__ATOMIC_ACQUIRE, "agent"); asm volatile("s_waitcnt vmcnt(0)" ::: "memory");
            __builtin_amdgcn_s_barrier(); asm volatile("" ::: "memory");
            if (seg == 7) continue;
        }
        f32x4 S[8][2];
#pragma unroll
        for (int dt = 0; dt < 8; ++dt) { S[dt][0] = (f32x4){0.f, 0.f, 0.f, 0.f}; S[dt][1] = (f32x4){0.f, 0.f, 0.f, 0.f}; }
        if (FULL) {
#pragma unroll 1
            for (int j = 0; j < seg; ++j) {
                const float* gj = GSEG + (size_t)(bh * 8 + j) * 128 + 4 * quad; const f32x4* sl = (const f32x4*)(SLOC + (size_t)(bh * 8 + j) * 32768) + tid;
#pragma unroll
                for (int dt = 0; dt < 8; ++dt) { const f32x4 gg = *(const f32x4*)(gj + 16 * dt);
                    f32x4 dec; dec[0] = __expf(gg[0]); dec[1] = __expf(gg[1]); dec[2] = __expf(gg[2]); dec[3] = __expf(gg[3]);
                    S[dt][0] = S[dt][0] * dec + sl[(dt * 2 + 0) * 512]; S[dt][1] = S[dt][1] * dec + sl[(dt * 2 + 1) * 512]; }
            }
        }
        float gsum = 0.f;
        u32x4 pq[2], pk[2], pv[4]; float pbl = 0.f;
#define GS_LOADC(cidx) do { const int u_ = (b * 64 + (cidx)) * 4 + h; const size_t m_ = (size_t)b * SEQ + (size_t)(cidx) * 64; int tl_ = tid; asm volatile("" : "+v"(tl_)); \
            _Pragma("unroll") for (int i = 0; i < 2; ++i) { const int idx = tl_ + 512 * i, row = idx >> 4, pc = idx & 15; const bf16* src = PROJ + (m_ + row) * PROJ_LD + h * 128 + pc * 8; \
                if (FULL) pq[i] = *(const u32x4*)(src); pk[i] = *(const u32x4*)(src + 512); } \
            _Pragma("unroll") for (int i = 0; i < 4; ++i) { const int idx = tl_ + 512 * i, row = idx >> 5, pc = idx & 31; pv[i] = *(const u32x4*)(PROJ + (m_ + row) * PROJ_LD + 1024 + h * 256 + pc * 8); } \
            if (tl_ < 128) pbl = BL[(size_t)u_ * 128 + tl_]; } while (0)
        GS_LOADC(seg * 8);
#pragma unroll 1
        for (int cc = 0; cc < 8; ++cc) {
            const int c = seg * 8 + cc;
            const size_t m0 = (size_t)b * SEQ + (size_t)c * 64;
#pragma unroll
            for (int i = 0; i < 2; ++i) { const int idx = tid + 512 * i, row = idx >> 4, pc = idx & 15;
                if (FULL) *(LAS u32x4*)(L + GS_Q + row * 272 + pc * 16) = pq[i];
                *(LAS u32x4*)(L + GS_K + row * 272 + pc * 16) = pk[i]; }
#pragma unroll
            for (int i = 0; i < 4; ++i) { const int idx = tid + 512 * i, row = idx >> 5, pc = idx & 31; *(LAS u32x4*)(L + GS_V + row * 528 + pc * 16) = pv[i]; }
            if (tid < 128) { ((LAS float*)(L + GS_BL))[tid] = pbl; gsum += pbl; }
            LBAR();
            if (cc < 7) GS_LOADC(c + 1);
#define GS_VF(dst) do { _Pragma("unroll") for (int s2 = 0; s2 < 2; ++s2) _Pragma("unroll") for (int et = 0; et < 2; ++et) { \
                const LAS unsigned char* a_ = L + GS_V + (32 * s2 + 8 * quad + (l15 >> 2)) * 528 + (32 * w + 16 * et) * 2 + 8 * (l15 & 3); \
                const s16x4 lo_ = ldtr(a_), hi_ = ldtr(a_ + 4 * 528); dst[s2][et] = __builtin_shufflevector(lo_, hi_, 0, 1, 2, 3, 4, 5, 6, 7); } } while (0)
            f32x4 o[4][2];
            if (FULL) {
                { const int it = w >> 1;
#pragma unroll
                  for (int x = 0; x < 2; ++x) { const int jt = 2 * (w & 1) + x; f32x4 a = (f32x4){0.f, 0.f, 0.f, 0.f};
                      if (jt <= it) {
#pragma unroll
                          for (int ks = 0; ks < 4; ++ks) { const bf16x8 kf = lds16(L + GS_K + (16 * jt + l15) * 272 + ks * 64 + quad * 16), qf = lds16(L + GS_Q + (16 * it + l15) * 272 + ks * 64 + quad * 16);
                              a = MFMA16(kf, qf, a); }
                          const int ii = 16 * it + l15, j0 = 16 * jt + 4 * quad;
#pragma unroll
                          for (int j = 0; j < 4; ++j) if (j0 + j > ii) a[j] = 0.f;
                      }
                      u32x2 ww; ww.x = pk2(a[0], a[1]); ww.y = pk2(a[2], a[3]);
                      *(LAS u32x2*)(L + GS_ATT + (16 * it + l15) * 144 + (16 * jt + 4 * quad) * 2) = ww; } }
                LBAR();
#pragma unroll
                for (int it = 0; it < 4; ++it) { o[it][0] = (f32x4){0.f, 0.f, 0.f, 0.f}; o[it][1] = (f32x4){0.f, 0.f, 0.f, 0.f}; }
#pragma unroll
                for (int s2 = 0; s2 < 4; ++s2) {
                    bf16x8 sf[2]; sf[0] = pack8(S[2 * s2][0], S[2 * s2 + 1][0]); sf[1] = pack8(S[2 * s2][1], S[2 * s2 + 1][1]);
#pragma unroll
                    for (int it = 0; it < 4; ++it) { const LAS unsigned char* qb = L + GS_Q + (16 * it + l15) * 272 + (32 * s2 + 4 * quad) * 2;
                        const bf16x8 qf = lds8x2(qb, qb + 32);
                        o[it][0] = MFMA16(sf[0], qf, o[it][0]); o[it][1] = MFMA16(sf[1], qf, o[it][1]); }
                }
                { bf16x8 vf[2][2]; GS_VF(vf);
#pragma unroll
                  for (int s2 = 0; s2 < 2; ++s2)
#pragma unroll
                    for (int it = 0; it < 4; ++it) { const bf16x8 af = lds16(L + GS_ATT + (16 * it + l15) * 144 + s2 * 64 + quad * 16);
                        o[it][0] = MFMA16(vf[s2][0], af, o[it][0]); o[it][1] = MFMA16(vf[s2][1], af, o[it][1]); } }
            }
            bf16x8 vf[2][2]; GS_VF(vf);
#pragma unroll
            for (int dt = 0; dt < 8; ++dt) {
                const f32x4 bl = *(const LAS f32x4*)(L + GS_BL + (16 * dt + 4 * quad) * 4);
                f32x4 dec; dec[0] = __expf(bl[0]); dec[1] = __expf(bl[1]); dec[2] = __expf(bl[2]); dec[3] = __expf(bl[3]);
#pragma unroll
                for (int s2 = 0; s2 < 2; ++s2) {
                    const LAS unsigned char* ka = L + GS_K + (32 * s2 + 8 * quad + (l15 >> 2)) * 272 + (16 * dt) * 2 + 8 * (l15 & 3);
                    const s16x4 klo = ldtr(ka), khi = ldtr(ka + 4 * 272); const bf16x8 kf = __builtin_shufflevector(klo, khi, 0, 1, 2, 3, 4, 5, 6, 7);
                    S[dt][0] = MFMA16(kf, vf[s2][0], S[dt][0]); S[dt][1] = MFMA16(kf, vf[s2][1], S[dt][1]); }
                S[dt][0] = S[dt][0] * dec; S[dt][1] = S[dt][1] * dec;
            }
            u32x2 rw[4][2];
            if (FULL) {
#pragma unroll
                for (int it = 0; it < 4; ++it)
#pragma unroll
                    for (int et = 0; et < 2; ++et) rw[it][et] = *(const u32x2*)(PROJ + (m0 + 16 * it + l15) * PROJ_LD + 2048 + h * 256 + 32 * w + 16 * et + 4 * quad);
#pragma unroll
                for (int it = 0; it < 4; ++it) { float ss = 0.f;
#pragma unroll
                    for (int et = 0; et < 2; ++et) ss += (o[it][et][0] * o[it][et][0] + o[it][et][1] * o[it][et][1]) + (o[it][et][2] * o[it][et][2] + o[it][et][3] * o[it][et][3]);
                    ss += __shfl_xor(ss, 16); ss += __shfl_xor(ss, 32);
                    if (quad == 0) ((LAS float*)(L + GS_RS))[w * 64 + 16 * it + l15] = ss; }
            }
            LBAR();
            if (FULL) {
                if (tid < 64) { float t = 0.f;
#pragma unroll
                    for (int ww = 0; ww < 8; ++ww) t += ((const LAS float*)(L + GS_RS))[ww * 64 + tid];
                    ((LAS float*)(L + GS_RSTD))[tid] = 1.0f / sqrtf(t * (1.0f / 256.0f) + RMS_EPS); }
                LBAR();
#pragma unroll
                for (int it = 0; it < 4; ++it) { const float rs = ((const LAS float*)(L + GS_RSTD))[16 * it + l15];
#pragma unroll
                    for (int et = 0; et < 2; ++et) { const int e0 = 32 * w + 16 * et + 4 * quad;
                        bf16* wp = PROJ + (m0 + 16 * it + l15) * PROJ_LD + 2048 + h * 256 + e0;
                        const u32x2 r2 = rw[it][et]; const f32x4 gg = *(const f32x4*)(norm_g + e0);
                        float rv[4]; rv[0] = __uint_as_float(r2.x << 16); rv[1] = __uint_as_float(r2.x & 0xffff0000u); rv[2] = __uint_as_float(r2.y << 16); rv[3] = __uint_as_float(r2.y & 0xffff0000u);
                        float ov[4];
#pragma unroll
                        for (int j = 0; j < 4; ++j) ov[j] = o[it][et][j] * rs * gg[j] * (rv[j] * __builtin_amdgcn_rcpf(1.0f + __expf(-rv[j])));
                        u32x2 ow; ow.x = pk2(ov[0], ov[1]); ow.y = pk2(ov[2], ov[3]); *(u32x2*)wp = ow; } }
            }
        }
#undef GS_LOADC
#undef GS_VF
        if (!FULL) {
            f32x4* sl = (f32x4*)(SLOC + (size_t)(bh * 8 + seg) * 32768) + tid;
#pragma unroll
            for (int dt = 0; dt < 8; ++dt) { sl[(dt * 2 + 0) * 512] = S[dt][0]; sl[(dt * 2 + 1) * 512] = S[dt][1]; }
            if (tid < 128) GSEG[(size_t)(bh * 8 + seg) * 128 + tid] = gsum;
        }
        LBAR();
    }
}

constexpr int SW_K = 0, SW_V = 36864;
__device__ __forceinline__ void swa_phase(const Ctx& F, const Params& P) {
    LAS unsigned char* L = F.lds;
    const int tid = F.tid, lane = F.lane, w = F.wave, l15 = lane & 15, quad = lane >> 4;
    const bf16* QKV = (const bf16*)(P.ws + R2_QKV); bf16* AO = (bf16*)(P.ws + R0);
    const float* sinks = P.in[9];
    constexpr int NU = BATCH * 32 * 4;
    u32x4 kv[4], vv[4];
#define SW_LOAD(uu) do { const int kvh_ = (uu) & 3, n_ = ((uu) >> 2) & 31, b_ = (uu) >> 7; const long mb_ = (long)b_ * SEQ + (long)n_ * 128; \
        _Pragma("unroll") for (int i = 0; i < 4; ++i) { const int idx = tid + 512 * i, jj = idx >> 3, pc = idx & 7; \
            kv[i] = (u32x4){0u, 0u, 0u, 0u}; vv[i] = (u32x4){0u, 0u, 0u, 0u}; \
            if (n_ > 0 || jj >= 128) { const bf16* src = QKV + (size_t)(mb_ - 128 + jj) * QKV_LD + 1024 + kvh_ * 64 + pc * 8; kv[i] = *(const u32x4*)(src); vv[i] = *(const u32x4*)(src + 256); } } } while (0)
#define SW_QBASE(uu) (QKV + (size_t)((long)((uu) >> 7) * SEQ + (long)(((uu) >> 2) & 31) * 128 + 64 * (w & 1) + l15) * QKV_LD + (((uu) & 3) * 4 + (w >> 1)) * 64 + quad * 8)
    bf16x8 qc0 = (bf16x8){0, 0, 0, 0, 0, 0, 0, 0}, qc1 = qc0;
    if ((int)blockIdx.x < NU) { SW_LOAD((int)blockIdx.x); const bf16* q0p = SW_QBASE((int)blockIdx.x); qc0 = *(const bf16x8*)(q0p); qc1 = *(const bf16x8*)(q0p + 32); }
    for (int u = blockIdx.x; u < NU; u += gridDim.x) {
        const int kvh = u & 3, n = (u >> 2) & 31, b = u >> 7;
        const long mb = (long)b * SEQ + (long)n * 128;
        const int g = w >> 1, hq = kvh * 4 + g;
        const int un = (u + (int)gridDim.x < NU) ? u + (int)gridDim.x : u;
        const bf16* qbase = SW_QBASE(u);
        const bf16* qnext = SW_QBASE(un);
#pragma unroll
        for (int i = 0; i < 2; ++i) { const size_t pg = (size_t)u * 1024 + tid + 512 * i; const float* src = P.in[1] + (size_t)M * PLE + pg * 8;
            const f32x4 a = *(const f32x4*)(src), a2 = *(const f32x4*)(src + 4);
            u32x4 o; o.x = pk2(a[0], a[1]); o.y = pk2(a[2], a[3]); o.z = pk2(a2[0], a2[1]); o.w = pk2(a2[2], a2[3]); *(u32x4*)((bf16*)(P.ws + PB1_OFF) + pg * 8) = o; }
        LBAR();
#pragma unroll
        for (int i = 0; i < 4; ++i) { const int idx = tid + 512 * i, jj = idx >> 3, pc = idx & 7;
            *(LAS u32x4*)(L + SW_K + jj * 144 + pc * 16) = kv[i]; *(LAS u32x4*)(L + SW_V + jj * 144 + pc * 16) = vv[i]; }
        LBAR();
        if (un != u) SW_LOAD(un);
        const float sink = sinks[hq];
#pragma unroll 1
        for (int qt = 0; qt < 4; ++qt) {
            const int q0 = 64 * (w & 1) + 16 * qt, kt0 = q0 >> 4, qi = q0 + l15;
            const bf16* qn = (qt < 3) ? qbase + (size_t)(16 * (qt + 1)) * QKV_LD : qnext;
            const bf16x8 qn0 = *(const bf16x8*)(qn), qn1 = *(const bf16x8*)(qn + 32);
            f32x4 sc[9];
#pragma unroll
            for (int t = 0; t < 9; ++t) { const LAS unsigned char* kb = L + SW_K + (16 * (kt0 + t) + l15) * 144 + quad * 16;
                f32x4 a = (f32x4){0.f, 0.f, 0.f, 0.f}; a = MFMA16(lds16(kb), qc0, a); a = MFMA16(lds16(kb + 64), qc1, a); sc[t] = a; }
            constexpr float C2 = 0.125f * 1.4426950408889634f;
            const float sink2 = sink * 1.4426950408889634f;
#pragma unroll
            for (int j = 0; j < 4; ++j) { if (!(4 * quad + j > l15)) sc[0][j] = -INFINITY; if (!(4 * quad + j <= l15)) sc[8][j] = -INFINITY; }
            float mraw = -INFINITY;
#pragma unroll
            for (int t = 0; t < 9; ++t)
#pragma unroll
                for (int j = 0; j < 4; ++j) mraw = fmaxf(mraw, sc[t][j]);
            mraw = fmaxf(mraw, __shfl_xor(mraw, 16)); mraw = fmaxf(mraw, __shfl_xor(mraw, 32));
            const float m2 = fmaxf(mraw * C2, sink2);
            float den = 0.f;
#pragma unroll
            for (int t = 0; t < 9; ++t)
#pragma unroll
                for (int j = 0; j < 4; ++j) { const float p = __builtin_amdgcn_exp2f(sc[t][j] * C2 - m2); sc[t][j] = p; den += p; }
            den += __shfl_xor(den, 16); den += __shfl_xor(den, 32);
            den += __builtin_amdgcn_exp2f(sink2 - m2);
            const float rden = __builtin_amdgcn_rcpf(den);
            f32x4 ot[4];
#pragma unroll
            for (int dt = 0; dt < 4; ++dt) ot[dt] = (f32x4){0.f, 0.f, 0.f, 0.f};
#pragma unroll
            for (int s2 = 0; s2 < 5; ++s2) {
                const f32x4 z4 = (f32x4){0.f, 0.f, 0.f, 0.f};
                const bf16x8 pf = pack8(sc[2 * s2], (s2 < 4) ? sc[(2 * s2 + 1 < 9) ? 2 * s2 + 1 : 8] : z4);
                const int ka = 16 * (kt0 + 2 * s2), kb2 = (s2 < 4) ? ka + 16 : ka;
#pragma unroll
                for (int dt = 0; dt < 4; ++dt) { const LAS unsigned char* vb = L + SW_V + (4 * quad + (l15 >> 2)) * 144 + 32 * dt + 8 * (l15 & 3);
                    const s16x4 lo = ldtr(vb + ka * 144), hi = ldtr(vb + kb2 * 144);
                    const bf16x8 vf = __builtin_shufflevector(lo, hi, 0, 1, 2, 3, 4, 5, 6, 7);
                    ot[dt] = MFMA16(vf, pf, ot[dt]); }
            }
            bf16* op = AO + (size_t)(mb + qi) * D + hq * 64 + 4 * quad;
#pragma unroll
            for (int dt = 0; dt < 4; ++dt) { u32x2 ow; ow.x = pk2(ot[dt][0] * rden, ot[dt][1] * rden); ow.y = pk2(ot[dt][2] * rden, ot[dt][3] * rden); *(u32x2*)(op + 16 * dt) = ow; }
            qc0 = qn0; qc1 = qn1;
        }
    }
    LBAR();
#undef SW_LOAD
#undef SW_QBASE
}

#define XB_TMO      128
#define XB_XCNT(j)  (256  + 64 * (j))
#define XB_XSUB(j)  (1280 + 64 * (j))
#define XB_XGEN(j)  (2304 + 64 * (j))
#define XB_TOP      3328
#define XB_TOPGEN   3392
#define XCD_BAR_WORDS 3456
#define XB_SPIN_CAP (1u << 18)

__device__ __forceinline__ unsigned xb_ld(unsigned* p)              { return __hip_atomic_load(p, __ATOMIC_RELAXED, __HIP_MEMORY_SCOPE_AGENT); }
__device__ __forceinline__ unsigned xb_add(unsigned* p, unsigned v) { return __hip_atomic_fetch_add(p, v, __ATOMIC_RELAXED, __HIP_MEMORY_SCOPE_AGENT); }
__device__ __forceinline__ unsigned xb_xcc_id() { return (unsigned)__builtin_amdgcn_s_getreg((3 << 11) | 20) & 0xFu; }
#define XB_SPIN(cond, bar) do { unsigned _sp = 0; while (cond) { __builtin_amdgcn_s_sleep(1); \
    if ((++_sp & 255u) == 0u) { if (xb_ld(&(bar)[XB_TMO])) break; if (_sp > XB_SPIN_CAP) { atomicAdd(&(bar)[XB_TMO], 1u); break; } } } } while (0)

struct XcdBarrier {
    unsigned* bar; unsigned x;
    volatile LAS unsigned* st;
};

__device__ __forceinline__ XcdBarrier xcd_barrier_post(unsigned* bar, volatile LAS unsigned* st) {
    XcdBarrier b; b.bar = bar; b.x = xb_xcc_id(); b.st = st;
    if (threadIdx.x == 0) (void)xb_add(&bar[XB_XCNT(b.x)], 1u);
    return b;
}
__device__ __forceinline__ void xcd_barrier_complete(unsigned* bar, unsigned x, unsigned& nloc, unsigned& nx) {
    const unsigned G = gridDim.x * gridDim.y * gridDim.z;
    unsigned sum, cnt, mine, sp = 0u;
    for (;;) {
        sum = 0u; cnt = 0u; mine = 0u;
#pragma unroll
        for (unsigned j = 0; j < 16; ++j) { const unsigned c = xb_ld(&bar[XB_XCNT(j)]); sum += c; cnt += (c > 0u) ? 1u : 0u; mine = (j == x) ? c : mine; }
        if (sum == G) break;
        __builtin_amdgcn_s_sleep(1);
        if ((++sp & 255u) == 0u) { if (xb_ld(&bar[XB_TMO])) break; if (sp > XB_SPIN_CAP) { atomicAdd(&bar[XB_TMO], 1u); break; } }
    }
    nloc = mine > 0u ? mine : 1u; nx = cnt > 0u ? cnt : 1u;
}

__device__ __forceinline__ void xcd_barrier(const XcdBarrier& b) {
    asm volatile("s_waitcnt vmcnt(0)" ::: "memory");
    __syncthreads();
    if (threadIdx.x == 0) {
        unsigned* bar = b.bar;
        __builtin_amdgcn_s_waitcnt(0);
        unsigned nloc = b.st[0], nx = b.st[1];
        if (nloc == 0u) { xcd_barrier_complete(bar, b.x, nloc, nx); b.st[0] = nloc; b.st[1] = nx; }
        const unsigned old = xb_add(&bar[XB_XSUB(b.x)], 1u);
        const unsigned gen = old / nloc;
        if (old + 1u == (gen + 1u) * nloc) {
            __builtin_amdgcn_fence(__ATOMIC_RELEASE, "agent");
            asm volatile("s_waitcnt vmcnt(0)" ::: "memory");
            const unsigned og = xb_add(&bar[XB_TOP], 1u);
            const unsigned tg = og / nx;
            if (og + 1u == (tg + 1u) * nx) xb_add(&bar[XB_TOPGEN], 1u);
            else XB_SPIN(xb_ld(&bar[XB_TOPGEN]) == tg, bar);
            __builtin_amdgcn_fence(__ATOMIC_ACQUIRE, "agent");
            xb_add(&bar[XB_XGEN(b.x)], 1u);
            asm volatile("s_waitcnt vmcnt(0)" ::: "memory");
        } else {
            XB_SPIN(xb_ld(&bar[XB_XGEN(b.x)]) == gen, bar);
            __builtin_amdgcn_fence(__ATOMIC_ACQUIRE, "agent");
            asm volatile("s_waitcnt vmcnt(0)" ::: "memory");
        }
    }
    __syncthreads();
}

__global__ void __launch_bounds__(NTHREADS, 2) mega_fwd(Params P) {
    extern __shared__ __attribute__((aligned(16))) unsigned char lds_raw[];
    cg::grid_group grid = cg::this_grid();
    Ctx F; F.lds = (LAS unsigned char*)lds_raw;
#define GSYNC() do { XcdBarrier b2_ = bar; unsigned long long bp_ = (unsigned long long)b2_.bar; unsigned bx_ = __builtin_amdgcn_readfirstlane(b2_.x); asm volatile("" : "+s"(bp_), "+s"(bx_)); b2_.bar = (unsigned*)bp_; b2_.x = bx_; xcd_barrier(b2_); } while (0)
#define REFRESH() do { int t_ = threadIdx.x; asm volatile("" : "+v"(t_)); F.tid = t_; F.lane = t_ & 63; F.wave = __builtin_amdgcn_readfirstlane(t_ >> 6); } while (0)
    REFRESH();
    unsigned char* ws = P.ws;
    const int G = gridDim.x, cid = blockIdx.x;
    volatile LAS unsigned* MISC = (volatile LAS unsigned*)(F.lds + 131072 + 320);
    if (threadIdx.x < 32) MISC[threadIdx.x] = 0u;
    __syncthreads();
    if (cid == 0) for (int i = threadIdx.x; i < XCD_BAR_WORDS; i += NTHREADS) __hip_atomic_store((unsigned*)(ws) + 1024 + i, 0u, __ATOMIC_RELAXED, __HIP_MEMORY_SCOPE_AGENT);
    grid.sync();
    XcdBarrier bar = xcd_barrier_post((unsigned*)(ws) + 1024, MISC + 8);
    bf16* A16 = (bf16*)(ws + R0); bf16* U16 = (bf16*)(ws + R2);
    bf16* Y1B = (bf16*)(ws + R1); bf16* Y2B = (bf16*)(ws + R1 + 64 * MiB); bf16* H3B = (bf16*)(ws + R2_H3B);
    float* ST1 = (float*)(ws + 504 * MiB); float* ST2 = (float*)(ws + 508 * MiB);
    LAS float* SX = (LAS float*)(F.lds + 131072 + 1024);

    p0_prologue(F, P);
    GSYNC();
    {
        pg8::Gemm g{A16, (const bf16*)(ws + W_IN_T), M, PROJ_LD, opq(D), D, D}; pg8::StaticOrder S; S.init(M, PROJ_LD, G, cid);
        pg8::EpiBf16 E{U16, PROJ_LD, nullptr, 1 << 30, nullptr};
        pg8::gemm_phase<pg8::EpiBf16, pg8::StaticOrder, true, true>(F.lds, g, S, E, SX);
    }
    GSYNC();
    REFRESH(); gla_scan_pass<false>(F, P);
    fold_finalize(P, cid * NTHREADS + F.tid, G * NTHREADS);
    GSYNC();
    REFRESH(); gla_scan_pass<true>(F, P);
    GSYNC();
#pragma unroll 1
    for (int layer = 0; layer < 2; ++layer) {
        const float* fin = (const float*)(ws + FIN(0)) + (size_t)layer * (64 * 1024 / 4);
        if (layer == 1) {
            {
                pg8::Gemm g{H3B, (const bf16*)(ws + W_QKV_T), M, QKV_LD, opq(D), D, D}; pg8::StaticOrder S; S.init(M, QKV_LD, G, cid);
                pg8::EpiBf16 E{(bf16*)(ws + R2_QKV), QKV_LD, P.in[8], 1 << 30, nullptr};
                pg8::gemm_phase<pg8::EpiBf16, pg8::StaticOrder, true, true>(F.lds, g, S, E, SX);
            }
            GSYNC();
            REFRESH(); swa_phase(F, P);
            GSYNC();
        }
        {
            const bf16* A = layer == 0 ? (const bf16*)(ws + R2) + 2048 : (const bf16*)A16;
            pg8::Gemm g{A, (const bf16*)(ws + (layer == 0 ? W_GOUT_T : W_SOUT_T)), M, D, opq(D), layer == 0 ? PROJ_LD : D, D}; pg8::StaticOrder S; S.init(M, D, G, cid);
            pg8::EpiY<false> E{layer == 0 ? (const void*)A16 : (const void*)H3B, 1, layer == 0 ? nullptr : P.in[11], nullptr, nullptr, nullptr, Y1B, ST1, ALPHA};
            pg8::gemm_phase<pg8::EpiY<false>, pg8::StaticOrder, true, true>(F.lds, g, S, E, SX);
        }
        GSYNC();
        {
            pg8::Gemm g{Y1B, (const bf16*)(ws + W_UP_T + (size_t)layer * W_LSTRIDE), M, FF, opq(D), D, D}; pg8::StaticOrder S; S.init(M, FF, G, cid);
            pg8::EpiUpLN E{ST1, fin, fin + 4096, U16, FF};
            pg8::gemm_phase<pg8::EpiUpLN, pg8::StaticOrder, true, true>(F.lds, g, S, E, SX);
        }
        GSYNC();
        {
            pg8::Gemm g{U16, (const bf16*)(ws + W_DN_T + (size_t)layer * W_LSTRIDE), M, D, opq(FF), FF, FF}; pg8::StaticOrder S; S.init(M, D, G, cid);
            pg8::EpiY<true> E{(const void*)Y1B, 1, nullptr, P.in[14] + layer * D, P.in[15] + layer * D, ST1, Y2B, ST2, ALPHA};
            pg8::gemm_phase<pg8::EpiY<true>, pg8::StaticOrder, true, true>(F.lds, g, S, E, SX);
        }
        GSYNC();
        {
            int kpp = opq(PLE); pg8::Gemm g{layer == 0 ? (const bf16*)P.out : (const bf16*)(ws + PB1_OFF), (const bf16*)(ws + W_PP_T + (size_t)layer * W_LSTRIDE), M, D, kpp, kpp, kpp}; pg8::StaticOrder S; S.init(M, D, G, cid);
            pg8::EpiPP E{(bf16*)(ws + R2_PP), D};
            pg8::gemm_phase<pg8::EpiPP, pg8::StaticOrder, true, true>(F.lds, g, S, E, SX);
        }
        __syncthreads();
        {
            pg8::Gemm g{Y2B, (const bf16*)(ws + W_GATE_T + (size_t)layer * W_LSTRIDE), M, D, opq(D), D, D}; pg8::StaticOrder S; S.init(M, D, G, cid);
            pg8::EpiGateLN E{ST2, Y2B, (const bf16*)(ws + R2_PP), fin + 8192, fin + 9216, P.in[16] + layer * D, P.in[17] + layer * D, P.out, layer == 0 ? H3B : nullptr};
            pg8::gemm_phase<pg8::EpiGateLN, pg8::StaticOrder, true, true>(F.lds, g, S, E, SX);
        }
        if (layer == 0) GSYNC();
    }
}

extern "C" void kernel_launch(void* const* d_in, const int* in_sizes, int n_in, void* d_out, int out_size, void* d_ws, size_t ws_size, hipStream_t stream) {
    static int grid = 0;
    if (grid == 0) {
        if (n_in != 21 || in_sizes[0] != M * D || out_size != M * D || ws_size < WS_END) { fprintf(stderr, "kernel_launch: unexpected shapes (n_in %d, in0 %d, out %d, ws %zu)\n", n_in, n_in > 0 ? in_sizes[0] : -1, out_size, ws_size); grid = -1; return; }
        int dev = 0, cus = 0, per_cu = 0;
        hipGetDevice(&dev); hipDeviceGetAttribute(&cus, hipDeviceAttributeMultiprocessorCount, dev);
        if (hipFuncSetAttribute((const void*)mega_fwd, hipFuncAttributeMaxDynamicSharedMemorySize, LDS_BYTES) != hipSuccess) { fprintf(stderr, "kernel_launch: hipFuncSetAttribute failed\n"); grid = -1; return; }
        if (hipOccupancyMaxActiveBlocksPerMultiprocessor(&per_cu, (const void*)mega_fwd, NTHREADS, LDS_BYTES) != hipSuccess || per_cu < 1) { fprintf(stderr, "kernel_launch: occupancy query says %d\n", per_cu); (void)hipGetLastError(); per_cu = 1; }
        grid = cus * 1;
        if (grid <= 0) grid = 256;
    }
    if (grid < 0) return;
    Params p{};
    for (int i = 0; i < 21; ++i) p.in[i] = (const float*)d_in[i];
    p.out = (float*)d_out; p.ws = (unsigned char*)d_ws;
    void* args[] = {&p};
    hipError_t e = hipLaunchCooperativeKernel((const void*)mega_fwd, dim3(grid), dim3(NTHREADS), args, LDS_BYTES, stream);
    if (e != hipSuccess) fprintf(stderr, "cooperative launch failed: %s (grid %d)\n", hipGetErrorString(e), grid);
}
```

```cpp
#include <hip/hip_runtime.h>
#include <hip/hip_cooperative_groups.h>
#include <cstdio>
#include <cstdint>
namespace cg = cooperative_groups;
namespace pg8 {
#define PG8_LAS __attribute__((address_space(3)))
typedef unsigned short bf16_t;
typedef short bf16x8 __attribute__((ext_vector_type(8)));
typedef float f32x4 __attribute__((ext_vector_type(4)));
typedef unsigned u32x4 __attribute__((ext_vector_type(4)));
constexpr int BM = 256, BK = 64, HALF = 128, HTB = HALF * BK * 2  , STAGE_BYTES = 8 * HTB, NXCD = 8, WGM = 8;

__host__ __device__ __forceinline__ int lds_byte(int r, int c) { const int st = (r >> 4) * 2 + (c >> 5), rr = r & 15, cc = c & 31, ob = rr * 64 + cc * 2; return st * 1024 + (ob ^ (((ob >> 9) & 1) << 5)); }
__host__ __device__ __forceinline__ void stage_rc(int b, int& R, int& C) { const int st = b / 1024, sb = b % 1024, swz = sb ^ (((sb >> 9) & 1) << 5); R = (st >> 1) * 16 + swz / 64; C = (st & 1) * 32 + (swz % 64) / 2; }
__host__ __device__ __forceinline__ int perm32(int rho) { const int n = rho >> 4, i = rho & 15; return 8 * (i >> 2) + 4 * n + (i & 3); }

struct Unit { int pm, pn; };
struct Gemm { const bf16_t* A; const bf16_t* Bt; int M, N, K, lda, ldb; };

struct StaticOrder {
    int nM, nN, nwg, G, c;
    __host__ __device__ void init(int M, int N, int G_, int c_) { nM = M / BM; nN = N / BM; nwg = nM * nN; G = G_; c = c_; }
    __host__ __device__ bool next(int i, Unit& u) const {
        const long L = (long)i * G + c; if (L >= nwg) return false;
        int wgid = (int)L; { const int q = nwg / NXCD, r = nwg % NXCD, xcd = wgid % NXCD, off = wgid / NXCD; wgid = (xcd < r ? xcd * (q + 1) : r * (q + 1) + (xcd - r) * q) + off; }
        const int nig = WGM * nN, gid = wgid / nig, fm = gid * WGM, gsz = (nM - fm) < WGM ? (nM - fm) : WGM;
        u.pm = fm + ((wgid % nig) % gsz); u.pn = (wgid % nig) / gsz; return true;
    }
    __device__ __forceinline__ void a_ready(const Unit&) const {}
    __device__ __forceinline__ void done(const Unit&) const {}
};


__device__ __forceinline__ unsigned cvt_pk_bf16(float lo, float hi) { unsigned r; asm volatile("v_cvt_pk_bf16_f32 %0, %1, %2" : "=v"(r) : "v"(lo), "v"(hi)); return r; }
typedef unsigned u32x2 __attribute__((ext_vector_type(2)));
typedef float f32x2 __attribute__((ext_vector_type(2)));
__device__ __forceinline__ float bf2f(unsigned short b) { return __uint_as_float(((unsigned)b) << 16); }
__device__ __forceinline__ void unpack8(const u32x4 w, float (&v)[8]) {
    v[0] = __uint_as_float(w.x << 16); v[1] = __uint_as_float(w.x & 0xffff0000u); v[2] = __uint_as_float(w.y << 16); v[3] = __uint_as_float(w.y & 0xffff0000u);
    v[4] = __uint_as_float(w.z << 16); v[5] = __uint_as_float(w.z & 0xffff0000u); v[6] = __uint_as_float(w.w << 16); v[7] = __uint_as_float(w.w & 0xffff0000u);
}
constexpr float EPI_LN_EPS = 1e-5f;
__device__ __forceinline__ void stats_pre(const float* ST, int pm, int slot, int tid, PG8_LAS float* sx) {
    if (tid < 256) {
        const f32x4* p = (const f32x4*)(ST + (size_t)(pm * BM + tid) * 32); float s = 0.f, q = 0.f;
#pragma unroll
        for (int i = 0; i < 8; ++i) { const f32x4 v = p[i]; s += v[0] + v[2]; q += v[1] + v[3]; }
        const float mean = s * (1.0f / 1024.0f), var = fmaxf(q * (1.0f / 1024.0f) - mean * mean, 0.f);
        *(PG8_LAS f32x2*)(sx + (slot * 256 + tid) * 2) = (f32x2){mean, 1.0f / sqrtf(var + EPI_LN_EPS)};
    }
}

struct EpiBf16 {
    static constexpr bool PERM = true, AFTER_DRAIN = false;
    bf16_t* O; int ldc; const float* bias; int gk_tile; float* GK;
    __device__ __forceinline__ void pre(const Unit&, int, int, PG8_LAS float*) const {}
    __device__ __forceinline__ void operator()(const f32x4 (&acc)[2][2][4][2], const Unit& u, int wr, int wc, int fr, int fq, int, PG8_LAS float*) const {
        const int row0 = u.pm * BM + wr * 64 + fr;
        if (u.pn >= gk_tile) {
            if (wc == 0 && fq < 2) {
#pragma unroll
                for (int ai = 0; ai < 2; ++ai)
#pragma unroll
                    for (int m = 0; m < 4; ++m) { float* gp = GK + (size_t)(row0 + ai * HALF + m * 16) * 16 + 8 * fq;
                        *(f32x4*)(gp) = acc[ai][0][m][0]; *(f32x4*)(gp + 4) = acc[ai][0][m][1]; }
            }
            return;
        }
        const int col0 = u.pn * BM + wc * 32 + 8 * fq;
#pragma unroll
        for (int bj = 0; bj < 2; ++bj) {
            f32x4 b0 = (f32x4){0.f, 0.f, 0.f, 0.f}, b1 = b0;
            if (bias) { b0 = *(const f32x4*)(bias + col0 + bj * HALF); b1 = *(const f32x4*)(bias + col0 + bj * HALF + 4); }
#pragma unroll
            for (int ai = 0; ai < 2; ++ai)
#pragma unroll
                for (int m = 0; m < 4; ++m) { const f32x4 v0 = acc[ai][bj][m][0] + b0, v1 = acc[ai][bj][m][1] + b1;
                    u32x4 w; w.x = cvt_pk_bf16(v0[0], v0[1]); w.y = cvt_pk_bf16(v0[2], v0[3]); w.z = cvt_pk_bf16(v1[0], v1[1]); w.w = cvt_pk_bf16(v1[2], v1[3]);
                    *(u32x4*)(O + (size_t)(row0 + ai * HALF + m * 16) * ldc + col0 + bj * HALF) = w; } }
    }
};

template <bool LN> struct EpiY {
    static constexpr bool PERM = true, AFTER_DRAIN = false;
    const void* res; int res_bf16; const float* bias; const float* g; const float* b; const float* ST_IN; bf16_t* Y; float* ST; float alpha;
    __device__ __forceinline__ void pre(const Unit& u, int slot, int tid, PG8_LAS float* sx) const { if (LN) stats_pre(ST_IN, u.pm, slot, tid, sx); }
    __device__ __forceinline__ void operator()(const f32x4 (&acc)[2][2][4][2], const Unit& u, int wr, int wc, int fr, int fq, int slot, PG8_LAS float* sx) const {
        const int col0 = u.pn * BM + wc * 32 + 8 * fq, rl0 = wr * 64 + fr; const size_t roff0 = (size_t)(u.pm * BM + rl0) * 1024;
        const bf16_t* R = (const bf16_t*)res;
        float ps[8], pq[8];
#pragma unroll
        for (int r = 0; r < 8; ++r) { ps[r] = 0.f; pq[r] = 0.f; }
#pragma unroll
        for (int bj = 0; bj < 2; ++bj) { const int c = col0 + bj * HALF;
            u32x4 rr[8];
#pragma unroll
            for (int r = 0; r < 8; ++r) rr[r] = *(const u32x4*)(R + roff0 + (size_t)((r >> 2) * HALF + (r & 3) * 16) * 1024 + c);
            f32x4 g0, g1, b0, b1, bb0, bb1;
            if (LN) { g0 = *(const f32x4*)(g + c); g1 = *(const f32x4*)(g + c + 4); b0 = *(const f32x4*)(b + c); b1 = *(const f32x4*)(b + c + 4); }
            if (bias) { bb0 = *(const f32x4*)(bias + c); bb1 = *(const f32x4*)(bias + c + 4); }
#pragma unroll
            for (int r = 0; r < 8; ++r) { const int ai = r >> 2, m = r & 3, rl = rl0 + ai * HALF + m * 16;
                float rv[8]; unpack8(rr[r], rv);
                if (LN) { const f32x2 mr = *(const PG8_LAS f32x2*)(sx + (slot * 256 + rl) * 2);
#pragma unroll
                    for (int i = 0; i < 4; ++i) { rv[i] = (rv[i] - mr[0]) * mr[1] * g0[i] + b0[i]; rv[4 + i] = (rv[4 + i] - mr[0]) * mr[1] * g1[i] + b1[i]; } }
                f32x4 v0 = acc[ai][bj][m][0], v1 = acc[ai][bj][m][1];
                if (bias) { v0 += bb0; v1 += bb1; }
                float y[8];
#pragma unroll
                for (int i = 0; i < 4; ++i) { y[i] = alpha * rv[i] + v0[i]; y[4 + i] = alpha * rv[4 + i] + v1[i]; }
                u32x4 w; w.x = cvt_pk_bf16(y[0], y[1]); w.y = cvt_pk_bf16(y[2], y[3]); w.z = cvt_pk_bf16(y[4], y[5]); w.w = cvt_pk_bf16(y[6], y[7]);
                *(u32x4*)(Y + roff0 + (size_t)(ai * HALF + m * 16) * 1024 + c) = w;
                float yr[8]; unpack8(w, yr);
#pragma unroll
                for (int i = 0; i < 8; ++i) { ps[r] += yr[i]; pq[r] += yr[i] * yr[i]; } }
        }
#pragma unroll
        for (int r = 0; r < 8; ++r) { float a = ps[r], q = pq[r];
            a += __shfl_xor(a, 16); a += __shfl_xor(a, 32); q += __shfl_xor(q, 16); q += __shfl_xor(q, 32);
            if (fq == 0) *(f32x2*)(ST + (size_t)(u.pm * BM + rl0 + (r >> 2) * HALF + (r & 3) * 16) * 32 + (u.pn * 4 + wc) * 2) = (f32x2){a, q}; }
    }
};

struct EpiUpLN {
    static constexpr bool PERM = true, AFTER_DRAIN = false;
    const float* ST_IN; const float* colsum; const float* bw; bf16_t* O; int ldc;
    __device__ __forceinline__ void pre(const Unit& u, int slot, int tid, PG8_LAS float* sx) const { stats_pre(ST_IN, u.pm, slot, tid, sx); }
    __device__ __forceinline__ void operator()(const f32x4 (&acc)[2][2][4][2], const Unit& u, int wr, int wc, int fr, int fq, int slot, PG8_LAS float* sx) const {
        const int col0 = u.pn * BM + wc * 32 + 8 * fq, rl0 = wr * 64 + fr;
#pragma unroll
        for (int bj = 0; bj < 2; ++bj) { const int c = col0 + bj * HALF;
            const f32x4 c0 = *(const f32x4*)(colsum + c), c1 = *(const f32x4*)(colsum + c + 4), w0 = *(const f32x4*)(bw + c), w1 = *(const f32x4*)(bw + c + 4);
#pragma unroll
            for (int r = 0; r < 8; ++r) { const int ai = r >> 2, m = r & 3, rl = rl0 + ai * HALF + m * 16;
                const f32x2 mr = *(const PG8_LAS f32x2*)(sx + (slot * 256 + rl) * 2);
                f32x4 v0 = (acc[ai][bj][m][0] - c0 * mr[0]) * mr[1] + w0, v1 = (acc[ai][bj][m][1] - c1 * mr[0]) * mr[1] + w1;
#pragma unroll
                for (int i = 0; i < 4; ++i) { const float a = fmaxf(v0[i], 0.f), b2 = fmaxf(v1[i], 0.f); v0[i] = a * a; v1[i] = b2 * b2; }
                u32x4 w; w.x = cvt_pk_bf16(v0[0], v0[1]); w.y = cvt_pk_bf16(v0[2], v0[3]); w.z = cvt_pk_bf16(v1[0], v1[1]); w.w = cvt_pk_bf16(v1[2], v1[3]);
                *(u32x4*)(O + (size_t)(u.pm * BM + rl) * ldc + c) = w; } }
    }
};

struct EpiPP {
    static constexpr bool PERM = true, AFTER_DRAIN = false;
    bf16_t* O; int ldc;
    __device__ __forceinline__ void pre(const Unit&, int, int, PG8_LAS float*) const {}
    __device__ __forceinline__ void operator()(const f32x4 (&acc)[2][2][4][2], const Unit& u, int wr, int wc, int fr, int fq, int, PG8_LAS float*) const {
        const int row0 = u.pm * BM + wr * 64 + fr, col0 = u.pn * BM + wc * 32 + 8 * fq;
#pragma unroll
        for (int ai = 0; ai < 2; ++ai)
#pragma unroll
            for (int m = 0; m < 4; ++m) { bf16_t* rowp = O + (size_t)(row0 + ai * HALF + m * 16) * ldc + col0;
#pragma unroll
                for (int bj = 0; bj < 2; ++bj) { const f32x4 v0 = acc[ai][bj][m][0], v1 = acc[ai][bj][m][1];
                    u32x4 w; w.x = cvt_pk_bf16(v0[0], v0[1]); w.y = cvt_pk_bf16(v0[2], v0[3]); w.z = cvt_pk_bf16(v1[0], v1[1]); w.w = cvt_pk_bf16(v1[2], v1[3]);
                    *(u32x4*)(rowp + bj * HALF) = w; } }
    }
};

struct EpiGateLN {
    static constexpr bool PERM = true, AFTER_DRAIN = false;
    const float* ST_IN; const bf16_t* YB; const bf16_t* pp; const float* colsum; const float* bz; const float* g; const float* b; float* out; bf16_t* ob;
    __device__ __forceinline__ void pre(const Unit& u, int slot, int tid, PG8_LAS float* sx) const { stats_pre(ST_IN, u.pm, slot, tid, sx); }
    __device__ __forceinline__ void operator()(const f32x4 (&acc)[2][2][4][2], const Unit& u, int wr, int wc, int fr, int fq, int slot, PG8_LAS float* sx) const {
        const int col0 = u.pn * BM + wc * 32 + 8 * fq, rl0 = wr * 64 + fr; const size_t roff0 = (size_t)(u.pm * BM + rl0) * 1024;
#pragma unroll
        for (int bj = 0; bj < 2; ++bj) { const int c = col0 + bj * HALF;
            f32x4 cs[2], zb[2], gg[2], bb[2];
#pragma unroll
            for (int hh = 0; hh < 2; ++hh) { cs[hh] = *(const f32x4*)(colsum + c + 4 * hh); zb[hh] = *(const f32x4*)(bz + c + 4 * hh); gg[hh] = *(const f32x4*)(g + c + 4 * hh); bb[hh] = *(const f32x4*)(b + c + 4 * hh); }
#pragma unroll
            for (int ai = 0; ai < 2; ++ai) {
                u32x4 yy[4], pw[4];
#pragma unroll
                for (int m = 0; m < 4; ++m) { const size_t o2 = roff0 + (size_t)(ai * HALF + m * 16) * 1024 + c; yy[m] = *(const u32x4*)(YB + o2); pw[m] = *(const u32x4*)(pp + o2); }
#pragma unroll
                for (int m = 0; m < 4; ++m) { const int rl = rl0 + ai * HALF + m * 16; const size_t o2 = roff0 + (size_t)(ai * HALF + m * 16) * 1024 + c;
                    const f32x2 mr = *(const PG8_LAS f32x2*)(sx + (slot * 256 + rl) * 2);
                    float y[8], p[8], o[8]; unpack8(yy[m], y); unpack8(pw[m], p);
#pragma unroll
                    for (int hh = 0; hh < 2; ++hh) { const f32x4 z = (acc[ai][bj][m][hh] - cs[hh] * mr[0]) * mr[1] + zb[hh];
#pragma unroll
                        for (int i = 0; i < 4; ++i) { const float h2 = (y[4 * hh + i] - mr[0]) * mr[1] * gg[hh][i] + bb[hh][i]; o[4 * hh + i] = h2 + p[4 * hh + i] * __builtin_amdgcn_rcpf(1.0f + __expf(-z[i])); } }
                    if (ob) { u32x4 w; w.x = cvt_pk_bf16(o[0], o[1]); w.y = cvt_pk_bf16(o[2], o[3]); w.z = cvt_pk_bf16(o[4], o[5]); w.w = cvt_pk_bf16(o[6], o[7]); *(u32x4*)(ob + o2) = w; }
                    else { *(f32x4*)(out + o2) = (f32x4){o[0], o[1], o[2], o[3]}; *(f32x4*)(out + o2 + 4) = (f32x4){o[4], o[5], o[6], o[7]}; } }
                asm volatile("" ::: "memory");
            } }
    }
};

template <class Epi, class Sched, bool ALIGN_EPI = false, bool SP2 = false>
__device__ __forceinline__ void gemm_phase(PG8_LAS unsigned char* lds, const Gemm g, const Sched& S, const Epi& E, PG8_LAS float* sx) {
    int tid_ = threadIdx.x; asm volatile("" : "+v"(tid_));
    const int tid = tid_, wid = __builtin_amdgcn_readfirstlane(tid >> 6), lane = tid & 63, wr = wid >> 2, wc = wid & 3, fr = lane & 15, fq = lane >> 4;
    const int K = g.K, nt = K / BK;
    unsigned voffA[2], voffB[2];
#pragma unroll
    for (int i = 0; i < 2; ++i) { int R, C; stage_rc(tid * 16 + i * 8192, R, C); const int Rb = Epi::PERM ? ((R & ~31) + perm32(R & 31)) : R;
        voffA[i] = (unsigned)(R * g.lda + C) * 2u; voffB[i] = (unsigned)(Rb * g.ldb + C) * 2u; }
    const size_t kstep = (size_t)(BK * 2);
    const size_t hstepA = (size_t)HALF * g.lda * 2, hstepB = (size_t)HALF * g.ldb * 2;
    const size_t tstepA = 2 * hstepA, tstepB = 2 * hstepB;
    const unsigned ldsw = (unsigned)wid * 1024u;
    const int aoff = lds_byte(wr * 64 + fr, fq * 8), boff = lds_byte(wc * 32 + fr, fq * 8);
#define PG8_SA(b, h) (((b) * 2 + (h)) * HTB)
#define PG8_SB(b, h) ((4 + (b) * 2 + (h)) * HTB)
#define PG8_STAGE(bufoff, gbase, voff) do { _Pragma("unroll") for (int _i = 0; _i < 2; ++_i) \
        __builtin_amdgcn_global_load_lds((const unsigned*)((const char*)(gbase) + (voff)[_i]), (PG8_LAS unsigned*)(lds + (bufoff) + ldsw + _i * 8192), 16, 0, 0); } while (0)
#define PG8_LDA(dst, b, h) do { _Pragma("unroll") for (int m = 0; m < 4; ++m) _Pragma("unroll") for (int k = 0; k < 2; ++k) dst[m][k] = *(const PG8_LAS bf16x8*)(lds + PG8_SA(b, h) + aoff + m * 2048 + k * 1024); } while (0)
#define PG8_LDB(dst, b, h) do { _Pragma("unroll") for (int n = 0; n < 2; ++n) _Pragma("unroll") for (int k = 0; k < 2; ++k) dst[n][k] = *(const PG8_LAS bf16x8*)(lds + PG8_SB(b, h) + boff + n * 2048 + k * 1024); } while (0)
#define PG8_MMA(ai, bj, At, Bt) do { __builtin_amdgcn_s_setprio(1); _Pragma("unroll") for (int m = 0; m < 4; ++m) _Pragma("unroll") for (int n = 0; n < 2; ++n) _Pragma("unroll") for (int k = 0; k < 2; ++k) \
        acc[ai][bj][m][n] = __builtin_amdgcn_mfma_f32_16x16x32_bf16(Bt[n][k], At[m][k], acc[ai][bj][m][n], 0, 0, 0); __builtin_amdgcn_s_setprio(0); } while (0)
#define PG8_WAIT_V(n) asm volatile("s_waitcnt vmcnt(" #n ")" ::: "memory")
#define PG8_WAIT_L(n) asm volatile("s_waitcnt lgkmcnt(" #n ")" ::: "memory")
#define PG8_BAR __builtin_amdgcn_s_barrier()
#define PG8_SCHED __builtin_amdgcn_sched_barrier(0)
    Unit cur, nxt; int ui = 0;
    if (!S.next(0, cur)) return;
    f32x4 acc[2][2][4][2];
#pragma unroll
    for (int a = 0; a < 2; ++a)
#pragma unroll
        for (int b = 0; b < 2; ++b)
#pragma unroll
            for (int m = 0; m < 4; ++m)
#pragma unroll
                for (int n = 0; n < 2; ++n) acc[a][b][m][n] = (f32x4){0.f, 0.f, 0.f, 0.f};
    bf16x8 At[4][2], B0[2][2], B1[2][2];
    const char* cA = (const char*)g.A + (size_t)cur.pm * tstepA; const char* cB = (const char*)g.Bt + (size_t)cur.pn * tstepB;
    S.a_ready(cur); E.pre(cur, 0, tid, sx);
    if constexpr (SP2) {
        PG8_STAGE(PG8_SB(0, 0), cB, voffB); PG8_STAGE(PG8_SB(0, 1), cB + hstepB, voffB); PG8_STAGE(PG8_SA(0, 0), cA, voffA); PG8_STAGE(PG8_SA(0, 1), cA + hstepA, voffA);
        if (wr == 1) PG8_BAR;
        PG8_WAIT_V(2); PG8_BAR;
        PG8_STAGE(PG8_SB(1, 0), cB + kstep, voffB); PG8_STAGE(PG8_SA(1, 0), cA + kstep, voffA); PG8_STAGE(PG8_SB(1, 1), cB + hstepB + kstep, voffB);
        PG8_WAIT_V(6); PG8_BAR;
    } else {
        PG8_STAGE(PG8_SB(0, 0), cB, voffB); PG8_STAGE(PG8_SA(0, 0), cA, voffA); PG8_STAGE(PG8_SB(0, 1), cB + hstepB, voffB); PG8_STAGE(PG8_SA(0, 1), cA + hstepA, voffA);
        if (wr == 1) PG8_BAR;
        PG8_WAIT_V(4); PG8_BAR;
        PG8_STAGE(PG8_SB(1, 0), cB + kstep, voffB); PG8_STAGE(PG8_SA(1, 0), cA + kstep, voffA); PG8_STAGE(PG8_SB(1, 1), cB + hstepB + kstep, voffB);
        PG8_WAIT_V(6); PG8_BAR;
    }
    for (;;) {
        const bool has_next = S.next(ui + 1, nxt);
        const char* nA = has_next ? (const char*)g.A + (size_t)nxt.pm * tstepA : cA; const char* nB = has_next ? (const char*)g.Bt + (size_t)nxt.pn * tstepB : cB;
        for (int t = 0; t < nt; t += 2) {
            const bool last = (t == nt - 2);
            const char* a1 = cA + (size_t)(t + 1) * kstep;
            const char* a2 = last ? nA : cA + (size_t)(t + 2) * kstep; const char* b2 = last ? nB : cB + (size_t)(t + 2) * kstep;
            const char* a3 = a2 + kstep; const char* b3 = b2 + kstep;
            if (last && has_next) { S.a_ready(nxt); E.pre(nxt, (ui + 1) & 1, tid, sx); }
            if constexpr (SP2) {
            PG8_LDB(B0, 0, 0); PG8_LDB(B1, 0, 1); PG8_SCHED; PG8_LDA(At, 0, 0); PG8_STAGE(PG8_SA(1, 1), a1 + hstepA, voffA);
            PG8_WAIT_V(8); PG8_WAIT_L(0); PG8_BAR; PG8_MMA(0, 0, At, B0); PG8_MMA(0, 1, At, B1); PG8_BAR; PG8_SCHED;
            PG8_LDA(At, 0, 1); PG8_STAGE(PG8_SB(0, 0), b2, voffB); PG8_STAGE(PG8_SB(0, 1), b2 + hstepB, voffB); PG8_STAGE(PG8_SA(0, 0), a2, voffA);
            PG8_WAIT_V(8); PG8_WAIT_L(0); PG8_BAR; PG8_MMA(1, 0, At, B0); PG8_MMA(1, 1, At, B1); PG8_BAR; PG8_SCHED;
            PG8_LDB(B0, 1, 0); PG8_LDB(B1, 1, 1); PG8_SCHED; PG8_LDA(At, 1, 0); PG8_STAGE(PG8_SA(0, 1), a2 + hstepA, voffA);
            PG8_WAIT_V(8); PG8_WAIT_L(0); PG8_BAR; PG8_MMA(0, 0, At, B0); PG8_MMA(0, 1, At, B1); PG8_BAR; PG8_SCHED;
            PG8_LDA(At, 1, 1); PG8_STAGE(PG8_SB(1, 0), b3, voffB); PG8_STAGE(PG8_SB(1, 1), b3 + hstepB, voffB); PG8_STAGE(PG8_SA(1, 0), a3, voffA);
            PG8_WAIT_V(8); PG8_WAIT_L(0); PG8_BAR; PG8_MMA(1, 0, At, B0); PG8_MMA(1, 1, At, B1); PG8_BAR; PG8_SCHED;
            } else {
            PG8_LDB(B0, 0, 0); PG8_SCHED; PG8_LDA(At, 0, 0); PG8_STAGE(PG8_SA(1, 1), a1 + hstepA, voffA);
            PG8_WAIT_L(8); PG8_BAR; PG8_WAIT_L(0); PG8_MMA(0, 0, At, B0); PG8_BAR; PG8_SCHED;
            PG8_LDB(B1, 0, 1); PG8_STAGE(PG8_SB(0, 0), b2, voffB);
            PG8_BAR; PG8_WAIT_L(0); PG8_MMA(0, 1, At, B1); PG8_BAR;
            PG8_LDA(At, 0, 1); PG8_STAGE(PG8_SA(0, 0), a2, voffA);
            PG8_BAR; PG8_WAIT_L(0); PG8_MMA(1, 0, At, B0); PG8_BAR; PG8_SCHED;
            PG8_STAGE(PG8_SB(0, 1), b2 + hstepB, voffB);
            PG8_WAIT_V(6); PG8_BAR; PG8_MMA(1, 1, At, B1); PG8_BAR;
            PG8_LDB(B0, 1, 0); PG8_SCHED; PG8_LDA(At, 1, 0); PG8_STAGE(PG8_SA(0, 1), a2 + hstepA, voffA);
            PG8_WAIT_L(8); PG8_BAR; PG8_WAIT_L(0); PG8_MMA(0, 0, At, B0); PG8_BAR; PG8_SCHED;
            PG8_LDB(B1, 1, 1); PG8_STAGE(PG8_SB(1, 0), b3, voffB);
            PG8_BAR; PG8_WAIT_L(0); PG8_MMA(0, 1, At, B1); PG8_BAR;
            PG8_LDA(At, 1, 1); PG8_STAGE(PG8_SA(1, 0), a3, voffA);
            PG8_BAR; PG8_WAIT_L(0); PG8_MMA(1, 0, At, B0); PG8_BAR; PG8_SCHED;
            PG8_STAGE(PG8_SB(1, 1), b3 + hstepB, voffB);
            PG8_WAIT_V(6); PG8_BAR; PG8_MMA(1, 1, At, B1); PG8_BAR;
            }
        }
        if constexpr (ALIGN_EPI) { if (wr == 0) PG8_BAR; }
        if constexpr (!Epi::AFTER_DRAIN) { E(acc, cur, wr, wc, fr, fq, ui & 1, sx); S.done(cur); }
        if (!has_next) break;
#pragma unroll
        for (int a = 0; a < 2; ++a)
#pragma unroll
            for (int b = 0; b < 2; ++b)
#pragma unroll
                for (int m = 0; m < 4; ++m)
#pragma unroll
                    for (int n = 0; n < 2; ++n) acc[a][b][m][n] = (f32x4){0.f, 0.f, 0.f, 0.f};
        cur = nxt; cA = nA; cB = nB; ++ui;
        if constexpr (ALIGN_EPI) { if (wr == 1) PG8_BAR; }
    }
    PG8_WAIT_V(0);
    if constexpr (!ALIGN_EPI) { if (wr == 0) PG8_BAR; }
    PG8_BAR;
    if constexpr (Epi::AFTER_DRAIN) { E.fused(acc, cur, wr, wc, fr, fq, lds, wid, lane); S.done(cur); }
#undef PG8_SA
#undef PG8_SB
#undef PG8_STAGE
#undef PG8_LDA
#undef PG8_LDB
#undef PG8_MMA
#undef PG8_WAIT_V
#undef PG8_WAIT_L
#undef PG8_BAR
#undef PG8_SCHED
}
}

#define LAS __attribute__((address_space(3)))
typedef unsigned short bf16;
typedef unsigned u32x4 __attribute__((ext_vector_type(4)));
typedef unsigned u32x2 __attribute__((ext_vector_type(2)));
typedef float f32x4 __attribute__((ext_vector_type(4)));
typedef short bf16x8 __attribute__((ext_vector_type(8)));
typedef short s16x4 __attribute__((ext_vector_type(4)));

constexpr int NTHREADS = 512, NWAVES = 8;
constexpr int BATCH = 8, SEQ = 4096, D = 1024, M = BATCH * SEQ, FF = 4096, PLE = 256;
constexpr int GLA_COLS = 3088, PROJ_LD = 3072;
constexpr int QKV_LD = 1536;
constexpr float LN_EPS = 1e-5f, RMS_EPS = 1e-5f;
constexpr float ALPHA = 1.4142135623730951f;
constexpr size_t MiB = 1u << 20;
constexpr size_t W_IN_T = 1 * MiB;
constexpr size_t W_GOUT_T = 7 * MiB;
constexpr size_t W_UP_T = 9 * MiB;
constexpr size_t W_DN_T = 17 * MiB;
constexpr size_t W_GATE_T = 25 * MiB;
constexpr size_t W_PP_T = 27 * MiB;
constexpr size_t W_QKV_T = 28 * MiB;
constexpr size_t W_SOUT_T = 31 * MiB;
constexpr size_t W_LSTRIDE = 24 * MiB;
constexpr size_t PB1_OFF = 1 * MiB;
constexpr size_t R0 = 56 * MiB;
constexpr size_t R1 = 120 * MiB;
constexpr size_t R2 = 248 * MiB;
constexpr size_t R2_GK = R2 + 192 * MiB;
constexpr size_t R2_PP = R2 + 16 * MiB;
constexpr size_t R2_H3B = R2 + 80 * MiB;
constexpr size_t R2_QKV = R2 + 144 * MiB;
constexpr size_t R0_BL = R1 + 80 * MiB;
constexpr size_t WS_END = 512 * MiB;
constexpr int LDS_BYTES = 147456;

__device__ __forceinline__ int opq(int v) { asm volatile("" : "+s"(v)); return v; }
struct Params { const float* in[21]; float* out; unsigned char* ws; };
#define LBAR() do { asm volatile("s_waitcnt lgkmcnt(0)" ::: "memory"); __builtin_amdgcn_s_barrier(); asm volatile("" ::: "memory"); } while (0)

struct Ctx { LAS unsigned char* lds; int tid, lane, wave; };

__device__ __forceinline__ float wave_sum(float v) {
#pragma unroll
    for (int o = 1; o < 64; o <<= 1) v += __shfl_xor(v, o);
    return v;
}
__device__ __forceinline__ unsigned pk2(float lo, float hi) { return pg8::cvt_pk_bf16(lo, hi); }
__device__ __forceinline__ float bf2f(unsigned short b) { return __uint_as_float(((unsigned)b) << 16); }
__device__ __forceinline__ bf16x8 pack8(const f32x4 a, const f32x4 b) {
    u32x4 w; w.x = pk2(a[0], a[1]); w.y = pk2(a[2], a[3]); w.z = pk2(b[0], b[1]); w.w = pk2(b[2], b[3]); return __builtin_bit_cast(bf16x8, w);
}
#define MFMA16(a, b, c) __builtin_amdgcn_mfma_f32_16x16x32_bf16((a), (b), (c), 0, 0, 0)
__device__ __forceinline__ bf16x8 lds16(const LAS unsigned char* p) { return *(const LAS bf16x8*)p; }
__device__ __forceinline__ bf16x8 lds8x2(const LAS unsigned char* p0, const LAS unsigned char* p1) {
    const s16x4 lo = *(const LAS s16x4*)p0, hi = *(const LAS s16x4*)p1; return __builtin_shufflevector(lo, hi, 0, 1, 2, 3, 4, 5, 6, 7);
}

template <bool FOLD>
__device__ __forceinline__ void transpose_item(const float* W, int ldw, int nblk, int K, bf16* WT, LAS float* scr, int item, int lane,
                                               const float* gv = nullptr, const float* bv = nullptr, float* csp = nullptr, float* bwp = nullptr) {
    const int kb = item / nblk, nb = item % nblk, k0 = 64 * kb, n0 = 32 * nb;
    { const int r8 = lane >> 3, c4 = lane & 7;
      f32x4 v[8];
#pragma unroll
      for (int it = 0; it < 8; ++it) v[it] = *(const f32x4*)(W + (size_t)(k0 + 8 * it + r8) * ldw + n0 + 4 * c4);
#pragma unroll
      for (int it = 0; it < 8; ++it) { LAS float* d = scr + (8 * it + r8) * 33 + 4 * c4; d[0] = v[it][0]; d[1] = v[it][1]; d[2] = v[it][2]; d[3] = v[it][3]; } }
    asm volatile("s_waitcnt lgkmcnt(0)" ::: "memory");
    const int c = lane & 7;
    float gk[8], bk[8];
    if (FOLD) {
#pragma unroll
        for (int i = 0; i < 8; ++i) { gk[i] = gv[k0 + 8 * c + i]; bk[i] = bv[k0 + 8 * c + i]; }
    }
#pragma unroll
    for (int j = 0; j < 4; ++j) { const int n = (lane >> 3) + 8 * j; const LAS float* sp = scr + (8 * c) * 33 + n;
        float v[8];
#pragma unroll
        for (int i = 0; i < 8; ++i) v[i] = sp[i * 33];
        float bwv = 0.f;
        if (FOLD) {
#pragma unroll
            for (int i = 0; i < 8; ++i) { bwv += bk[i] * v[i]; v[i] *= gk[i]; }
        }
        u32x4 o; o.x = pk2(v[0], v[1]); o.y = pk2(v[2], v[3]); o.z = pk2(v[4], v[5]); o.w = pk2(v[6], v[7]);
        *(u32x4*)(WT + (size_t)(n0 + n) * K + k0 + 8 * c) = o;
        if (FOLD) {
            float r[8]; pg8::unpack8(o, r); float cs = ((r[0] + r[1]) + (r[2] + r[3])) + ((r[4] + r[5]) + (r[6] + r[7]));
            cs += __shfl_xor(cs, 1); cs += __shfl_xor(cs, 2); cs += __shfl_xor(cs, 4);
            bwv += __shfl_xor(bwv, 1); bwv += __shfl_xor(bwv, 2); bwv += __shfl_xor(bwv, 4);
            if (c == 0) { const int N = 32 * nblk; csp[(size_t)kb * N + n0 + n] = cs; bwp[(size_t)kb * N + n0 + n] = bwv; }
        }
    }
    asm volatile("s_waitcnt lgkmcnt(0)" ::: "memory");
}
constexpr size_t VEC = 52 * MiB;
__device__ __host__ constexpr size_t CSP_UP(int l) { return VEC + (size_t)l * 512 * 1024; }
__device__ __host__ constexpr size_t CSP_G(int l) { return VEC + MiB + (size_t)l * 128 * 1024; }
__device__ __host__ constexpr size_t FIN(int l) { return VEC + MiB + 512 * 1024 + (size_t)l * 64 * 1024; }
__device__ __forceinline__ void fold_finalize(const Params& P, int gtid, int gthreads) {
    for (int idx = gtid; idx < 2 * 5120; idx += gthreads) {
        const int l = idx / 5120, r = idx % 5120;
        float* fin = (float*)(P.ws + FIN(l));
        if (r < 4096) { const float* cp = (const float*)(P.ws + CSP_UP(l)); const float* bp = cp + 16 * 4096; float cs = 0.f, bw = 0.f;
#pragma unroll
            for (int kb = 0; kb < 16; ++kb) { cs += cp[kb * 4096 + r]; bw += bp[kb * 4096 + r]; }
            fin[r] = cs; fin[4096 + r] = bw; }
        else { const int n = r - 4096; const float* cp = (const float*)(P.ws + CSP_G(l)); const float* bp = cp + 16 * 1024; float cs = 0.f, bw = 0.f;
#pragma unroll
            for (int kb = 0; kb < 16; ++kb) { cs += cp[kb * 1024 + n]; bw += bp[kb * 1024 + n]; }
            fin[8192 + n] = cs; fin[9216 + n] = bw + P.in[20][l * D + n]; }
    }
}
__device__ __forceinline__ void p0_prologue(const Ctx& F, const Params& P) {
    LAS float* scr = (LAS float*)(F.lds + F.wave * 16384);
    const int gw = blockIdx.x * NWAVES + F.wave, NGW = gridDim.x * NWAVES;
    unsigned char* ws = P.ws;
    constexpr int I_IN = 16 * 96, I_SQ = 16 * 32, I_QKV = 16 * 48, I_UP = 16 * 128, I_DN = 64 * 32, I_PP = 4 * 32;
    constexpr int NITEMS = I_IN + 2 * I_SQ + I_QKV + 2 * I_UP + 2 * I_DN + 2 * I_SQ + 2 * I_PP;
    for (int it = gw; it < NITEMS; it += NGW) {
        int r = it;
        if (r < I_IN) { transpose_item<false>(P.in[2], GLA_COLS, 96, D, (bf16*)(ws + W_IN_T), scr, r, F.lane); continue; } r -= I_IN;
        if (r < I_SQ) { transpose_item<false>(P.in[6], D, 32, D, (bf16*)(ws + W_GOUT_T), scr, r, F.lane); continue; } r -= I_SQ;
        if (r < I_SQ) { transpose_item<false>(P.in[10], D, 32, D, (bf16*)(ws + W_SOUT_T), scr, r, F.lane); continue; } r -= I_SQ;
        if (r < I_QKV) { transpose_item<false>(P.in[7], QKV_LD, 48, D, (bf16*)(ws + W_QKV_T), scr, r, F.lane); continue; } r -= I_QKV;
        if (r < 2 * I_UP) { const int l = r / I_UP; transpose_item<true>(P.in[12] + (size_t)l * D * FF, FF, 128, D, (bf16*)(ws + W_UP_T + (size_t)l * W_LSTRIDE), scr, r % I_UP, F.lane, P.in[14] + l * D, P.in[15] + l * D, (float*)(ws + CSP_UP(l)), (float*)(ws + CSP_UP(l)) + 16 * 4096); continue; } r -= 2 * I_UP;
        if (r < 2 * I_DN) { const int l = r / I_DN; transpose_item<false>(P.in[13] + (size_t)l * D * FF, D, 32, FF, (bf16*)(ws + W_DN_T + (size_t)l * W_LSTRIDE), scr, r % I_DN, F.lane); continue; } r -= 2 * I_DN;
        if (r < 2 * I_SQ) { const int l = r / I_SQ; transpose_item<true>(P.in[19] + (size_t)l * D * D, D, 32, D, (bf16*)(ws + W_GATE_T + (size_t)l * W_LSTRIDE), scr, r % I_SQ, F.lane, P.in[16] + l * D, P.in[17] + l * D, (float*)(ws + CSP_G(l)), (float*)(ws + CSP_G(l)) + 16 * 1024); continue; } r -= 2 * I_SQ;
        { const int l = r / I_PP; transpose_item<false>(P.in[18] + (size_t)l * PLE * D, D, 32, PLE, (bf16*)(ws + W_PP_T + (size_t)l * W_LSTRIDE), scr, r % I_PP, F.lane); }
    }
    const int gtid = blockIdx.x * NTHREADS + F.tid, gthreads = gridDim.x * NTHREADS;
    {
        LAS float* wg = (LAS float*)F.lds;
        __syncthreads();
        for (int i = F.tid; i < 4096; i += NTHREADS) { const int k = i >> 2, c4 = i & 3, pos = (k & 3) * 256 + (k >> 2); *(LAS f32x4*)(wg + pos * 20 + 4 * c4) = *(const f32x4*)(P.in[2] + (size_t)k * GLA_COLS + 3072 + 4 * c4); }
        __syncthreads();
        const float* x = P.in[0]; bf16* xb = (bf16*)(ws + R0); float* GK = (float*)(ws + R2_GK);
        const int lane = F.lane;
#pragma unroll 1
        for (int r0 = gw * 4; r0 < M; r0 += NGW * 4) {
            f32x4 acc[16];
#pragma unroll
            for (int i = 0; i < 16; ++i) acc[i] = (f32x4){0.f, 0.f, 0.f, 0.f};
#pragma unroll 1
            for (int j = 0; j < 4; ++j) {
                float xs[4][4];
#pragma unroll
                for (int rr = 0; rr < 4; ++rr) { const f32x4 v = *(const f32x4*)(x + (size_t)(r0 + rr) * D + 256 * j + 4 * lane);
                    u32x2 o; o.x = pk2(v[0], v[1]); o.y = pk2(v[2], v[3]); *(u32x2*)(xb + (size_t)(r0 + rr) * D + 256 * j + 4 * lane) = o;
                    xs[rr][0] = v[0]; xs[rr][1] = v[1]; xs[rr][2] = v[2]; xs[rr][3] = v[3]; }
#pragma unroll
                for (int i = 0; i < 4; ++i) { const LAS float* wp = wg + (i * 256 + 64 * j + lane) * 20;
                    const f32x4 w0 = *(const LAS f32x4*)(wp), w1 = *(const LAS f32x4*)(wp + 4), w2 = *(const LAS f32x4*)(wp + 8), w3 = *(const LAS f32x4*)(wp + 12);
#pragma unroll
                    for (int rr = 0; rr < 4; ++rr) { const float xv = xs[rr][i]; acc[rr * 4 + 0] += w0 * xv; acc[rr * 4 + 1] += w1 * xv; acc[rr * 4 + 2] += w2 * xv; acc[rr * 4 + 3] += w3 * xv; } }
            }
            float a[64];
#pragma unroll
            for (int i = 0; i < 16; ++i) { a[4 * i] = acc[i][0]; a[4 * i + 1] = acc[i][1]; a[4 * i + 2] = acc[i][2]; a[4 * i + 3] = acc[i][3]; }
#define TR_STEP(n) do { const bool hi_ = (lane & (n)) != 0; _Pragma("unroll") for (int i = 0; i < (n); ++i) { const float send = hi_ ? a[i] : a[i + (n)], keep = hi_ ? a[i + (n)] : a[i]; a[i] = keep + __shfl_xor(send, (n)); } } while (0)
            TR_STEP(32); TR_STEP(16); TR_STEP(8); TR_STEP(4); TR_STEP(2); TR_STEP(1);
#undef TR_STEP
            GK[(size_t)r0 * 16 + lane] = a[0];
        }
    }
}

__device__ __forceinline__ void gla_prep_unit(const Ctx& F, const Params& P, int b, int c, int h, size_t pgrp) {
    LAS float* gk_s = (LAS float*)(F.lds);
    LAS float* part = (LAS float*)(F.lds + 4096);
    const int tid = F.tid, d = tid & 127, g = tid >> 7;
    bf16* PROJ = (bf16*)(P.ws + R2); const float* GK = (const float*)(P.ws + R2_GK);
    float* BL = (float*)(P.ws + R0_BL);
    const float* wup = P.in[3]; const float* bgk = P.in[4];
    const int u = (b * 64 + c) * 4 + h;
    const size_t m0 = (size_t)b * SEQ + (size_t)c * 64;
    if (tid < 256) ((LAS f32x4*)gk_s)[tid] = *(const f32x4*)(GK + m0 * 16 + (size_t)tid * 4);
    bf16* qp = PROJ + (m0 + 16 * g) * PROJ_LD + h * 128 + d; bf16* kp = qp + 512;
    { const f32x4 a = *(const f32x4*)(P.in[1] + pgrp * 8), a2 = *(const f32x4*)(P.in[1] + pgrp * 8 + 4);
      u32x4 o; o.x = pk2(a[0], a[1]); o.y = pk2(a[2], a[3]); o.z = pk2(a2[0], a2[1]); o.w = pk2(a2[2], a2[3]); *(u32x4*)((bf16*)P.out + pgrp * 8) = o; }
    unsigned short qraw[16], kraw[16];
#pragma unroll
    for (int tt = 0; tt < 16; ++tt) { qraw[tt] = qp[(size_t)tt * PROJ_LD]; kraw[tt] = kp[(size_t)tt * PROJ_LD]; }
    float w[16];
#pragma unroll
    for (int r = 0; r < 16; ++r) w[r] = wup[r * 512 + h * 128 + d];
    const float bias = bgk[h * 128 + d];
    LBAR();
    float cs[16]; float run = 0.f;
#pragma unroll
    for (int tt = 0; tt < 16; ++tt) {
        const int t = 16 * g + tt; float z = bias;
#pragma unroll
        for (int r4 = 0; r4 < 4; ++r4) { const f32x4 a = ((const LAS f32x4*)gk_s)[t * 4 + r4]; z += a[0] * w[4 * r4] + a[1] * w[4 * r4 + 1] + a[2] * w[4 * r4 + 2] + a[3] * w[4 * r4 + 3]; }
        const float ls = fminf(z, 0.f) - __logf(1.0f + __expf(-fabsf(z)));
        run += ls * (1.0f / 16.0f); cs[tt] = run;
    }
    part[g * 128 + d] = run;
    LBAR();
    float off = 0.f, tot = 0.f;
#pragma unroll
    for (int gg = 0; gg < 4; ++gg) { const float pv = part[gg * 128 + d]; tot += pv; if (gg < g) off += pv; }
#pragma unroll
    for (int tt = 0; tt < 16; ++tt) {
        const float bc = cs[tt] + off;
        const float qv = bf2f(qraw[tt]), kv = bf2f(kraw[tt]);
        const float e1 = __expf(bc), e2 = __expf(-bc);
        qp[(size_t)tt * PROJ_LD] = (bf16)(pk2(qv * 0.08838834764831845f * e1, 0.f) & 0xffffu);
        kp[(size_t)tt * PROJ_LD] = (bf16)(pk2(kv * e2, 0.f) & 0xffffu);
    }
    if (g == 0) BL[(size_t)u * 128 + d] = tot;
    LBAR();
}

typedef short v4i16_t __attribute__((ext_vector_type(4)));
__device__ __forceinline__ s16x4 ldtr(const LAS unsigned char* p) { return __builtin_bit_cast(s16x4, __builtin_amdgcn_ds_read_tr16_b64_v4i16((LAS v4i16_t*)p)); }
constexpr int GS_Q = 0, GS_K = 17408, GS_V = 34816, GS_ATT = 68608, GS_RS = 77824, GS_RSTD = 79872, GS_BL = 80128;
constexpr size_t R0_SLOC = R1, R0_GSEG = R1 + 40 * MiB;
template <bool FULL>
__device__ __forceinline__ void gla_scan_pass(const Ctx& F, const Params& P) {
    LAS unsigned char* L = F.lds;
    const int tid = F.tid, lane = F.lane, w = F.wave, l15 = lane & 15, quad = lane >> 4;
    bf16* PROJ = (bf16*)(P.ws + R2);
    const float* BL = (const float*)(P.ws + R0_BL);
    float* SLOC = (float*)(P.ws + R0_SLOC); float* GSEG = (float*)(P.ws + R0_GSEG);
    const float* norm_g = P.in[5];
    for (int item = blockIdx.x; item < BATCH * 4 * 8; item += gridDim.x) {
        const int seg = item & 7, bh = item >> 3, b = bh >> 2, h = bh & 3;
        if (!FULL) {
#pragma unroll 1
            for (int cc = 0; cc < 8; ++cc) gla_prep_unit(F, P, b, seg * 8 + cc, h, ((size_t)(item * 8 + cc)) * 512 + tid);
            asm volatile("s_waitcnt vmcnt(0)" ::: "memory"); __builtin_amdgcn_s_barrier();
            __builtin_amdgcn_fence(__ATOMIC_ACQUIRE, "agent"); asm volatile("s_waitcnt vmcnt(0)" ::: "memory");
            __builtin_amdgcn_s_barrier(); asm volatile("" ::: "memory");
            if (seg == 7) continue;
        }
        f32x4 S[8][2];
#pragma unroll
        for (int dt = 0; dt < 8; ++dt) { S[dt][0] = (f32x4){0.f, 0.f, 0.f, 0.f}; S[dt][1] = (f32x4){0.f, 0.f, 0.f, 0.f}; }
        if (FULL) {
#pragma unroll 1
            for (int j = 0; j < seg; ++j) {
                const float* gj = GSEG + (size_t)(bh * 8 + j) * 128 + 4 * quad; const f32x4* sl = (const f32x4*)(SLOC + (size_t)(bh * 8 + j) * 32768) + tid;
#pragma unroll
                for (int dt = 0; dt < 8; ++dt) { const f32x4 gg = *(const f32x4*)(gj + 16 * dt);
                    f32x4 dec; dec[0] = __expf(gg[0]); dec[1] = __expf(gg[1]); dec[2] = __expf(gg[2]); dec[3] = __expf(gg[3]);
                    S[dt][0] = S[dt][0] * dec + sl[(dt * 2 + 0) * 512]; S[dt][1] = S[dt][1] * dec + sl[(dt * 2 + 1) * 512]; }
            }
        }
        float gsum = 0.f;
        u32x4 pq[2], pk[2], pv[4]; float pbl = 0.f;
#define GS_LOADC(cidx) do { const int u_ = (b * 64 + (cidx)) * 4 + h; const size_t m_ = (size_t)b * SEQ + (size_t)(cidx) * 64; int tl_ = tid; asm volatile("" : "+v"(tl_)); \
            _Pragma("unroll") for (int i = 0; i < 2; ++i) { const int idx = tl_ + 512 * i, row = idx >> 4, pc = idx & 15; const bf16* src = PROJ + (m_ + row) * PROJ_LD + h * 128 + pc * 8; \
                if (FULL) pq[i] = *(const u32x4*)(src); pk[i] = *(const u32x4*)(src + 512); } \
            _Pragma("unroll") for (int i = 0; i < 4; ++i) { const int idx = tl_ + 512 * i, row = idx >> 5, pc = idx & 31; pv[i] = *(const u32x4*)(PROJ + (m_ + row) * PROJ_LD + 1024 + h * 256 + pc * 8); } \
            if (tl_ < 128) pbl = BL[(size_t)u_ * 128 + tl_]; } while (0)
        GS_LOADC(seg * 8);
#pragma unroll 1
        for (int cc = 0; cc < 8; ++cc) {
            const int c = seg * 8 + cc;
            const size_t m0 = (size_t)b * SEQ + (size_t)c * 64;
#pragma unroll
            for (int i = 0; i < 2; ++i) { const int idx = tid + 512 * i, row = idx >> 4, pc = idx & 15;
                if (FULL) *(LAS u32x4*)(L + GS_Q + row * 272 + pc * 16) = pq[i];
                *(LAS u32x4*)(L + GS_K + row * 272 + pc * 16) = pk[i]; }
#pragma unroll
            for (int i = 0; i < 4; ++i) { const int idx = tid + 512 * i, row = idx >> 5, pc = idx & 31; *(LAS u32x4*)(L + GS_V + row * 528 + pc * 16) = pv[i]; }
            if (tid < 128) { ((LAS float*)(L + GS_BL))[tid] = pbl; gsum += pbl; }
            LBAR();
            if (cc < 7) GS_LOADC(c + 1);
#define GS_VF(dst) do { _Pragma("unroll") for (int s2 = 0; s2 < 2; ++s2) _Pragma("unroll") for (int et = 0; et < 2; ++et) { \
                const LAS unsigned char* a_ = L + GS_V + (32 * s2 + 8 * quad + (l15 >> 2)) * 528 + (32 * w + 16 * et) * 2 + 8 * (l15 & 3); \
                const s16x4 lo_ = ldtr(a_), hi_ = ldtr(a_ + 4 * 528); dst[s2][et] = __builtin_shufflevector(lo_, hi_, 0, 1, 2, 3, 4, 5, 6, 7); } } while (0)
            f32x4 o[4][2];
            if (FULL) {
                { const int it = w >> 1;
#pragma unroll
                  for (int x = 0; x < 2; ++x) { const int jt = 2 * (w & 1) + x; f32x4 a = (f32x4){0.f, 0.f, 0.f, 0.f};
                      if (jt <= it) {
#pragma unroll
                          for (int ks = 0; ks < 4; ++ks) { const bf16x8 kf = lds16(L + GS_K + (16 * jt + l15) * 272 + ks * 64 + quad * 16), qf = lds16(L + GS_Q + (16 * it + l15) * 272 + ks * 64 + quad * 16);
                              a = MFMA16(kf, qf, a); }
                          const int ii = 16 * it + l15, j0 = 16 * jt + 4 * quad;
#pragma unroll
                          for (int j = 0; j < 4; ++j) if (j0 + j > ii) a[j] = 0.f;
                      }
                      u32x2 ww; ww.x = pk2(a[0], a[1]); ww.y = pk2(a[2], a[3]);
                      *(LAS u32x2*)(L + GS_ATT + (16 * it + l15) * 144 + (16 * jt + 4 * quad) * 2) = ww; } }
                LBAR();
#pragma unroll
                for (int it = 0; it < 4; ++it) { o[it][0] = (f32x4){0.f, 0.f, 0.f, 0.f}; o[it][1] = (f32x4){0.f, 0.f, 0.f, 0.f}; }
#pragma unroll
                for (int s2 = 0; s2 < 4; ++s2) {
                    bf16x8 sf[2]; sf[0] = pack8(S[2 * s2][0], S[2 * s2 + 1][0]); sf[1] = pack8(S[2 * s2][1], S[2 * s2 + 1][1]);
#pragma unroll
                    for (int it = 0; it < 4; ++it) { const LAS unsigned char* qb = L + GS_Q + (16 * it + l15) * 272 + (32 * s2 + 4 * quad) * 2;
                        const bf16x8 qf = lds8x2(qb, qb + 32);
                        o[it][0] = MFMA16(sf[0], qf, o[it][0]); o[it][1] = MFMA16(sf[1], qf, o[it][1]); }
                }
                { bf16x8 vf[2][2]; GS_VF(vf);
#pragma unroll
                  for (int s2 = 0; s2 < 2; ++s2)
#pragma unroll
                    for (int it = 0; it < 4; ++it) { const bf16x8 af = lds16(L + GS_ATT + (16 * it + l15) * 144 + s2 * 64 + quad * 16);
                        o[it][0] = MFMA16(vf[s2][0], af, o[it][0]); o[it][1] = MFMA16(vf[s2][1], af, o[it][1]); } }
            }
            bf16x8 vf[2][2]; GS_VF(vf);
#pragma unroll
            for (int dt = 0; dt < 8; ++dt) {
                const f32x4 bl = *(const LAS f32x4*)(L + GS_BL + (16 * dt + 4 * quad) * 4);
                f32x4 dec; dec[0] = __expf(bl[0]); dec[1] = __expf(bl[1]); dec[2] = __expf(bl[2]); dec[3] = __expf(bl[3]);
#pragma unroll
                for (int s2 = 0; s2 < 2; ++s2) {
                    const LAS unsigned char* ka = L + GS_K + (32 * s2 + 8 * quad + (l15 >> 2)) * 272 + (16 * dt) * 2 + 8 * (l15 & 3);
                    const s16x4 klo = ldtr(ka), khi = ldtr(ka + 4 * 272); const bf16x8 kf = __builtin_shufflevector(klo, khi, 0, 1, 2, 3, 4, 5, 6, 7);
                    S[dt][0] = MFMA16(kf, vf[s2][0], S[dt][0]); S[dt][1] = MFMA16(kf, vf[s2][1], S[dt][1]); }
                S[dt][0] = S[dt][0] * dec; S[dt][1] = S[dt][1] * dec;
            }
            u32x2 rw[4][2];
            if (FULL) {
#pragma unroll
                for (int it = 0; it < 4; ++it)
#pragma unroll
                    for (int et = 0; et < 2; ++et) rw[it][et] = *(const u32x2*)(PROJ + (m0 + 16 * it + l15) * PROJ_LD + 2048 + h * 256 + 32 * w + 16 * et + 4 * quad);
#pragma unroll
                for (int it = 0; it < 4; ++it) { float ss = 0.f;
#pragma unroll
                    for (int et = 0; et < 2; ++et) ss += (o[it][et][0] * o[it][et][0] + o[it][et][1] * o[it][et][1]) + (o[it][et][2] * o[it][et][2] + o[it][et][3] * o[it][et][3]);
                    ss += __shfl_xor(ss, 16); ss += __shfl_xor(ss, 32);
                    if (quad == 0) ((LAS float*)(L + GS_RS))[w * 64 + 16 * it + l15] = ss; }
            }
            LBAR();
            if (FULL) {
                if (tid < 64) { float t = 0.f;
#pragma unroll
                    for (int ww = 0; ww < 8; ++ww) t += ((const LAS float*)(L + GS_RS))[ww * 64 + tid];
                    ((LAS float*)(L + GS_RSTD))[tid] = 1.0f / sqrtf(t * (1.0f / 256.0f) + RMS_EPS); }
                LBAR();
#pragma unroll
                for (int it = 0; it < 4; ++it) { const float rs = ((const LAS float*)(L + GS_RSTD))[16 * it + l15];
#pragma unroll
                    for (int et = 0; et < 2; ++et) { const int e0 = 32 * w + 16 * et + 4 * quad;
                        bf16* wp = PROJ + (m0 + 16 * it + l15) * PROJ_LD + 2048 + h * 256 + e0;
                        const u32x2 r2 = rw[it][et]; const f32x4 gg = *(const f32x4*)(norm_g + e0);
                        float rv[4]; rv[0] = __uint_as_float(r2.x << 16); rv[1] = __uint_as_float(r2.x & 0xffff0000u); rv[2] = __uint_as_float(r2.y << 16); rv[3] = __uint_as_float(r2.y & 0xffff0000u);
                        float ov[4];
#pragma unroll
                        for (int j = 0; j < 4; ++j) ov[j] = o[it][et][j] * rs * gg[j] * (rv[j] * __builtin_amdgcn_rcpf(1.0f + __expf(-rv[j])));
                        u32x2 ow; ow.x = pk2(ov[0], ov[1]); ow.y = pk2(ov[2], ov[3]); *(u32x2*)wp = ow; } }
            }
        }
#undef GS_LOADC
#undef GS_VF
        if (!FULL) {
            f32x4* sl = (f32x4*)(SLOC + (size_t)(bh * 8 + seg) * 32768) + tid;
#pragma unroll
            for (int dt = 0; dt < 8; ++dt) { sl[(dt * 2 + 0) * 512] = S[dt][0]; sl[(dt * 2 + 1) * 512] = S[dt][1]; }
            if (tid < 128) GSEG[(size_t)(bh * 8 + seg) * 128 + tid] = gsum;
        }
        LBAR();
    }
}

__device__ __forceinline__ void gla_pass_a(const Ctx& F, const Params& P) {
    LAS unsigned char* L = F.lds;
    LAS float* gk_s = (LAS float*)(L);
    LAS float* part = (LAS float*)(L + 4096);
    const int tid = F.tid, lane = F.lane, w = F.wave, l15 = lane & 15, quad = lane >> 4, d = tid & 127, g = tid >> 7;
    bf16* PROJ = (bf16*)(P.ws + R2); const float* GK = (const float*)(P.ws + R2_GK);
    float* BL = (float*)(P.ws + R0_BL); float* SLOC = (float*)(P.ws + R0_SLOC); float* GSEG = (float*)(P.ws + R0_GSEG);
    for (int item = blockIdx.x; item < BATCH * 4 * 8; item += gridDim.x) {
        const int seg = item & 7, bh = item >> 3, b = bh >> 2, h = bh & 3;
        float wv[16];
#pragma unroll
        for (int r = 0; r < 16; ++r) wv[r] = P.in[3][r * 512 + h * 128 + d];
        const float bias = P.in[4][h * 128 + d];
        f32x4 S[8][2];
#pragma unroll
        for (int dt = 0; dt < 8; ++dt) { S[dt][0] = (f32x4){0.f, 0.f, 0.f, 0.f}; S[dt][1] = (f32x4){0.f, 0.f, 0.f, 0.f}; }
        float gsum = 0.f;
        u32x4 pv[4]; f32x4 gkn = (f32x4){0.f, 0.f, 0.f, 0.f};
#define PA_LOAD(cidx) do { const size_t m_ = (size_t)b * SEQ + (size_t)(cidx) * 64; int tl_ = tid; asm volatile("" : "+v"(tl_)); \
            _Pragma("unroll") for (int i = 0; i < 4; ++i) { const int idx = tl_ + 512 * i, row = idx >> 5, pc = idx & 31; pv[i] = *(const u32x4*)(PROJ + (m_ + row) * PROJ_LD + 1024 + h * 256 + pc * 8); } \
            if (tl_ < 256) gkn = *(const f32x4*)(GK + m_ * 16 + (size_t)tl_ * 4); } while (0)
        PA_LOAD(seg * 8);
#pragma unroll 1
        for (int cc = 0; cc < 8; ++cc) {
            const int c = seg * 8 + cc, u = (b * 64 + c) * 4 + h;
            const size_t m0 = (size_t)b * SEQ + (size_t)c * 64;
            if (tid < 256) ((LAS f32x4*)gk_s)[tid] = gkn;
#pragma unroll
            for (int i = 0; i < 4; ++i) { const int idx = tid + 512 * i, row = idx >> 5, pc = idx & 31; *(LAS u32x4*)(L + GS_V + row * 528 + pc * 16) = pv[i]; }
            bf16* qp = PROJ + (m0 + 16 * g) * PROJ_LD + h * 128 + d; bf16* kp = qp + 512;
            unsigned qk[16];
            { const bf16* rp = qp;
#pragma unroll
              for (int tt = 0; tt < 16; ++tt) { qk[tt] = (unsigned)rp[0] | ((unsigned)rp[512] << 16); rp += PROJ_LD; asm volatile("" : "+v"(rp)); } }
            { const size_t pgrp = ((size_t)(item * 8 + cc)) * 512 + tid;
              const f32x4 a = *(const f32x4*)(P.in[1] + pgrp * 8), a2 = *(const f32x4*)(P.in[1] + pgrp * 8 + 4);
              u32x4 o; o.x = pk2(a[0], a[1]); o.y = pk2(a[2], a[3]); o.z = pk2(a2[0], a2[1]); o.w = pk2(a2[2], a2[3]); *(u32x4*)((bf16*)P.out + pgrp * 8) = o; }
            LBAR();
            float cs[16]; float run = 0.f;
#pragma unroll
            for (int tt = 0; tt < 16; ++tt) {
                const int t = 16 * g + tt; float z = bias;
#pragma unroll
                for (int r4 = 0; r4 < 4; ++r4) { const f32x4 a = ((const LAS f32x4*)gk_s)[t * 4 + r4]; z += a[0] * wv[4 * r4] + a[1] * wv[4 * r4 + 1] + a[2] * wv[4 * r4 + 2] + a[3] * wv[4 * r4 + 3]; }
                const float ls = fminf(z, 0.f) - __logf(1.0f + __expf(-fabsf(z)));
                run += ls * (1.0f / 16.0f); cs[tt] = run;
                if ((tt & 1) == 1) asm volatile("" ::: "memory");
            }
            part[g * 128 + d] = run;
            LBAR();
            if (cc < 7) PA_LOAD(c + 1);
            float off = 0.f, tot = 0.f;
#pragma unroll
            for (int gg = 0; gg < 4; ++gg) { const float pvv = part[gg * 128 + d]; tot += pvv; if (gg < g) off += pvv; }
            bf16* wq = qp;
#pragma unroll
            for (int tt = 0; tt < 16; ++tt) {
                const float bc = cs[tt] + off;
                const float qv = __uint_as_float(qk[tt] << 16), kv = __uint_as_float(qk[tt] & 0xffff0000u);
                const float e1 = __expf(bc), e2 = __expf(-bc);
                wq[0] = (bf16)(pk2(qv * 0.08838834764831845f * e1, 0.f) & 0xffffu);
                const bf16 kt = (bf16)(pk2(kv * e2, 0.f) & 0xffffu);
                wq[512] = kt; wq += PROJ_LD; asm volatile("" : "+v"(wq));
                *(LAS bf16*)(L + GS_K + (16 * g + tt) * 272 + d * 2) = kt;
            }
            if (g == 0) { BL[(size_t)u * 128 + d] = tot; ((LAS float*)(L + GS_BL))[d] = tot; gsum += tot; }
            LBAR();
            if (seg < 7) {
                bf16x8 vf[2][2];
#pragma unroll
                for (int s2 = 0; s2 < 2; ++s2)
#pragma unroll
                    for (int et = 0; et < 2; ++et) { const LAS unsigned char* a_ = L + GS_V + (32 * s2 + 8 * quad + (l15 >> 2)) * 528 + (32 * w + 16 * et) * 2 + 8 * (l15 & 3);
                        const s16x4 lo_ = ldtr(a_), hi_ = ldtr(a_ + 4 * 528); vf[s2][et] = __builtin_shufflevector(lo_, hi_, 0, 1, 2, 3, 4, 5, 6, 7); }
#pragma unroll
                for (int dt = 0; dt < 8; ++dt) {
                    const f32x4 bl = *(const LAS f32x4*)(L + GS_BL + (16 * dt + 4 * quad) * 4);
                    f32x4 dec; dec[0] = __expf(bl[0]); dec[1] = __expf(bl[1]); dec[2] = __expf(bl[2]); dec[3] = __expf(bl[3]);
#pragma unroll
                    for (int s2 = 0; s2 < 2; ++s2) {
                        const LAS unsigned char* ka = L + GS_K + (32 * s2 + 8 * quad + (l15 >> 2)) * 272 + (16 * dt) * 2 + 8 * (l15 & 3);
                        const s16x4 klo = ldtr(ka), khi = ldtr(ka + 4 * 272); const bf16x8 kf = __builtin_shufflevector(klo, khi, 0, 1, 2, 3, 4, 5, 6, 7);
                        S[dt][0] = MFMA16(kf, vf[s2][0], S[dt][0]); S[dt][1] = MFMA16(kf, vf[s2][1], S[dt][1]); }
                    S[dt][0] = S[dt][0] * dec; S[dt][1] = S[dt][1] * dec;
                }
            }
            LBAR();
        }
#undef PA_LOAD
        if (seg < 7) {
            f32x4* sl = (f32x4*)(SLOC + (size_t)(bh * 8 + seg) * 32768) + tid;
#pragma unroll
            for (int dt = 0; dt < 8; ++dt) { sl[(dt * 2 + 0) * 512] = S[dt][0]; sl[(dt * 2 + 1) * 512] = S[dt][1]; }
            if (tid < 128) GSEG[(size_t)(bh * 8 + seg) * 128 + tid] = gsum;
        }
    }
}

constexpr int SW_K = 0, SW_V = 36864;
__device__ __forceinline__ void swa_phase(const Ctx& F, const Params& P) {
    LAS unsigned char* L = F.lds;
    const int tid = F.tid, lane = F.lane, w = F.wave, l15 = lane & 15, quad = lane >> 4;
    const bf16* QKV = (const bf16*)(P.ws + R2_QKV); bf16* AO = (bf16*)(P.ws + R0);
    const float* sinks = P.in[9];
    constexpr int NU = BATCH * 32 * 4;
    u32x4 kv[4], vv[4];
#define SW_LOAD(uu) do { const int kvh_ = (uu) & 3, n_ = ((uu) >> 2) & 31, b_ = (uu) >> 7; const long mb_ = (long)b_ * SEQ + (long)n_ * 128; \
        _Pragma("unroll") for (int i = 0; i < 4; ++i) { const int idx = tid + 512 * i, jj = idx >> 3, pc = idx & 7; \
            kv[i] = (u32x4){0u, 0u, 0u, 0u}; vv[i] = (u32x4){0u, 0u, 0u, 0u}; \
            if (n_ > 0 || jj >= 128) { const bf16* src = QKV + (size_t)(mb_ - 128 + jj) * QKV_LD + 1024 + kvh_ * 64 + pc * 8; kv[i] = *(const u32x4*)(src); vv[i] = *(const u32x4*)(src + 256); } } } while (0)
#define SW_QBASE(uu) (QKV + (size_t)((long)((uu) >> 7) * SEQ + (long)(((uu) >> 2) & 31) * 128 + 64 * (w & 1) + l15) * QKV_LD + (((uu) & 3) * 4 + (w >> 1)) * 64 + quad * 8)
    bf16x8 qc0 = (bf16x8){0, 0, 0, 0, 0, 0, 0, 0}, qc1 = qc0;
    if ((int)blockIdx.x < NU) { SW_LOAD((int)blockIdx.x); const bf16* q0p = SW_QBASE((int)blockIdx.x); qc0 = *(const bf16x8*)(q0p); qc1 = *(const bf16x8*)(q0p + 32); }
    for (int u = blockIdx.x; u < NU; u += gridDim.x) {
        const int kvh = u & 3, n = (u >> 2) & 31, b = u >> 7;
        const long mb = (long)b * SEQ + (long)n * 128;
        const int g = w >> 1, hq = kvh * 4 + g;
        const int un = (u + (int)gridDim.x < NU) ? u + (int)gridDim.x : u;
        const bf16* qbase = SW_QBASE(u);
        const bf16* qnext = SW_QBASE(un);
#pragma unroll
        for (int i = 0; i < 2; ++i) { const size_t pg = (size_t)u * 1024 + tid + 512 * i; const float* src = P.in[1] + (size_t)M * PLE + pg * 8;
            const f32x4 a = *(const f32x4*)(src), a2 = *(const f32x4*)(src + 4);
            u32x4 o; o.x = pk2(a[0], a[1]); o.y = pk2(a[2], a[3]); o.z = pk2(a2[0], a2[1]); o.w = pk2(a2[2], a2[3]); *(u32x4*)((bf16*)(P.ws + PB1_OFF) + pg * 8) = o; }
        LBAR();
#pragma unroll
        for (int i = 0; i < 4; ++i) { const int idx = tid + 512 * i, jj = idx >> 3, pc = idx & 7;
            *(LAS u32x4*)(L + SW_K + jj * 144 + pc * 16) = kv[i]; *(LAS u32x4*)(L + SW_V + jj * 144 + pc * 16) = vv[i]; }
        LBAR();
        if (un != u) SW_LOAD(un);
        const float sink = sinks[hq];
#pragma unroll 1
        for (int qt = 0; qt < 4; ++qt) {
            const int q0 = 64 * (w & 1) + 16 * qt, kt0 = q0 >> 4, qi = q0 + l15;
            const bf16* qn = (qt < 3) ? qbase + (size_t)(16 * (qt + 1)) * QKV_LD : qnext;
            const bf16x8 qn0 = *(const bf16x8*)(qn), qn1 = *(const bf16x8*)(qn + 32);
            f32x4 sc[9];
#pragma unroll
            for (int t = 0; t < 9; ++t) { const LAS unsigned char* kb = L + SW_K + (16 * (kt0 + t) + l15) * 144 + quad * 16;
                f32x4 a = (f32x4){0.f, 0.f, 0.f, 0.f}; a = MFMA16(lds16(kb), qc0, a); a = MFMA16(lds16(kb + 64), qc1, a); sc[t] = a; }
            constexpr float C2 = 0.125f * 1.4426950408889634f;
            const float sink2 = sink * 1.4426950408889634f;
#pragma unroll
            for (int j = 0; j < 4; ++j) { if (!(4 * quad + j > l15)) sc[0][j] = -INFINITY; if (!(4 * quad + j <= l15)) sc[8][j] = -INFINITY; }
            float mraw = -INFINITY;
#pragma unroll
            for (int t = 0; t < 9; ++t)
#pragma unroll
                for (int j = 0; j < 4; ++j) mraw = fmaxf(mraw, sc[t][j]);
            mraw = fmaxf(mraw, __shfl_xor(mraw, 16)); mraw = fmaxf(mraw, __shfl_xor(mraw, 32));
            const float m2 = fmaxf(mraw * C2, sink2);
            float den = 0.f;
#pragma unroll
            for (int t = 0; t < 9; ++t)
#pragma unroll
                for (int j = 0; j < 4; ++j) { const float p = __builtin_amdgcn_exp2f(sc[t][j] * C2 - m2); sc[t][j] = p; den += p; }
            den += __shfl_xor(den, 16); den += __shfl_xor(den, 32);
            den += __builtin_amdgcn_exp2f(sink2 - m2);
            const float rden = __builtin_amdgcn_rcpf(den);
            f32x4 ot[4];
#pragma unroll
            for (int dt = 0; dt < 4; ++dt) ot[dt] = (f32x4){0.f, 0.f, 0.f, 0.f};
#pragma unroll
            for (int s2 = 0; s2 < 5; ++s2) {
                const f32x4 z4 = (f32x4){0.f, 0.f, 0.f, 0.f};
                const bf16x8 pf = pack8(sc[2 * s2], (s2 < 4) ? sc[(2 * s2 + 1 < 9) ? 2 * s2 + 1 : 8] : z4);
                const int ka = 16 * (kt0 + 2 * s2), kb2 = (s2 < 4) ? ka + 16 : ka;
#pragma unroll
                for (int dt = 0; dt < 4; ++dt) { const LAS unsigned char* vb = L + SW_V + (4 * quad + (l15 >> 2)) * 144 + 32 * dt + 8 * (l15 & 3);
                    const s16x4 lo = ldtr(vb + ka * 144), hi = ldtr(vb + kb2 * 144);
                    const bf16x8 vf = __builtin_shufflevector(lo, hi, 0, 1, 2, 3, 4, 5, 6, 7);
                    ot[dt] = MFMA16(vf, pf, ot[dt]); }
            }
            bf16* op = AO + (size_t)(mb + qi) * D + hq * 64 + 4 * quad;
#pragma unroll
            for (int dt = 0; dt < 4; ++dt) { u32x2 ow; ow.x = pk2(ot[dt][0] * rden, ot[dt][1] * rden); ow.y = pk2(ot[dt][2] * rden, ot[dt][3] * rden); *(u32x2*)(op + 16 * dt) = ow; }
            qc0 = qn0; qc1 = qn1;
        }
    }
    LBAR();
#undef SW_LOAD
#undef SW_QBASE
}

#define XB_TMO      128
#define XB_XCNT(j)  (256  + 64 * (j))
#define XB_XSUB(j)  (1280 + 64 * (j))
#define XB_XGEN(j)  (2304 + 64 * (j))
#define XB_TOP      3328
#define XB_TOPGEN   3392
#define XCD_BAR_WORDS 3456
#define XB_SPIN_CAP (1u << 18)

__device__ __forceinline__ unsigned xb_ld(unsigned* p)              { return __hip_atomic_load(p, __ATOMIC_RELAXED, __HIP_MEMORY_SCOPE_AGENT); }
__device__ __forceinline__ unsigned xb_add(unsigned* p, unsigned v) { return __hip_atomic_fetch_add(p, v, __ATOMIC_RELAXED, __HIP_MEMORY_SCOPE_AGENT); }
__device__ __forceinline__ unsigned xb_xcc_id() { return (unsigned)__builtin_amdgcn_s_getreg((3 << 11) | 20) & 0xFu; }
#define XB_SPIN(cond, bar) do { unsigned _sp = 0; while (cond) { __builtin_amdgcn_s_sleep(1); \
    if ((++_sp & 255u) == 0u) { if (xb_ld(&(bar)[XB_TMO])) break; if (_sp > XB_SPIN_CAP) { atomicAdd(&(bar)[XB_TMO], 1u); break; } } } } while (0)

struct XcdBarrier {
    unsigned* bar; unsigned x;
    volatile LAS unsigned* st;
};

__device__ __forceinline__ XcdBarrier xcd_barrier_post(unsigned* bar, volatile LAS unsigned* st) {
    XcdBarrier b; b.bar = bar; b.x = xb_xcc_id(); b.st = st;
    if (threadIdx.x == 0) (void)xb_add(&bar[XB_XCNT(b.x)], 1u);
    return b;
}
__device__ __forceinline__ void xcd_barrier_complete(unsigned* bar, unsigned x, unsigned& nloc, unsigned& nx) {
    const unsigned G = gridDim.x * gridDim.y * gridDim.z;
    unsigned sum, cnt, mine, sp = 0u;
    for (;;) {
        sum = 0u; cnt = 0u; mine = 0u;
#pragma unroll
        for (unsigned j = 0; j < 16; ++j) { const unsigned c = xb_ld(&bar[XB_XCNT(j)]); sum += c; cnt += (c > 0u) ? 1u : 0u; mine = (j == x) ? c : mine; }
        if (sum == G) break;
        __builtin_amdgcn_s_sleep(1);
        if ((++sp & 255u) == 0u) { if (xb_ld(&bar[XB_TMO])) break; if (sp > XB_SPIN_CAP) { atomicAdd(&bar[XB_TMO], 1u); break; } }
    }
    nloc = mine > 0u ? mine : 1u; nx = cnt > 0u ? cnt : 1u;
}

__device__ __forceinline__ void xcd_barrier(const XcdBarrier& b) {
    asm volatile("s_waitcnt vmcnt(0)" ::: "memory");
    __syncthreads();
    if (threadIdx.x == 0) {
        unsigned* bar = b.bar;
        __builtin_amdgcn_s_waitcnt(0);
        unsigned nloc = b.st[0], nx = b.st[1];
        if (nloc == 0u) { xcd_barrier_complete(bar, b.x, nloc, nx); b.st[0] = nloc; b.st[1] = nx; }
        const unsigned old = xb_add(&bar[XB_XSUB(b.x)], 1u);
        const unsigned gen = old / nloc;
        if (old + 1u == (gen + 1u) * nloc) {
            __builtin_amdgcn_fence(__ATOMIC_RELEASE, "agent");
            asm volatile("s_waitcnt vmcnt(0)" ::: "memory");
            const unsigned og = xb_add(&bar[XB_TOP], 1u);
            const unsigned tg = og / nx;
            if (og + 1u == (tg + 1u) * nx) xb_add(&bar[XB_TOPGEN], 1u);
            else XB_SPIN(xb_ld(&bar[XB_TOPGEN]) == tg, bar);
            __builtin_amdgcn_fence(__ATOMIC_ACQUIRE, "agent");
            xb_add(&bar[XB_XGEN(b.x)], 1u);
            asm volatile("s_waitcnt vmcnt(0)" ::: "memory");
        } else {
            XB_SPIN(xb_ld(&bar[XB_XGEN(b.x)]) == gen, bar);
            __builtin_amdgcn_fence(__ATOMIC_ACQUIRE, "agent");
            asm volatile("s_waitcnt vmcnt(0)" ::: "memory");
        }
    }
    __syncthreads();
}

__global__ void __launch_bounds__(NTHREADS, 2) mega_fwd(Params P) {
    extern __shared__ __attribute__((aligned(16))) unsigned char lds_raw[];
    cg::grid_group grid = cg::this_grid();
    Ctx F; F.lds = (LAS unsigned char*)lds_raw;
#define GSYNC() do { XcdBarrier b2_ = bar; unsigned long long bp_ = (unsigned long long)b2_.bar; unsigned bx_ = __builtin_amdgcn_readfirstlane(b2_.x); asm volatile("" : "+s"(bp_), "+s"(bx_)); b2_.bar = (unsigned*)bp_; b2_.x = bx_; xcd_barrier(b2_); } while (0)
#define REFRESH() do { int t_ = threadIdx.x; asm volatile("" : "+v"(t_)); F.tid = t_; F.lane = t_ & 63; F.wave = __builtin_amdgcn_readfirstlane(t_ >> 6); } while (0)
    REFRESH();
    unsigned char* ws = P.ws;
    const int G = gridDim.x, cid = blockIdx.x;
    volatile LAS unsigned* MISC = (volatile LAS unsigned*)(F.lds + 131072 + 320);
    if (threadIdx.x < 32) MISC[threadIdx.x] = 0u;
    __syncthreads();
    if (cid == 0) for (int i = threadIdx.x; i < XCD_BAR_WORDS; i += NTHREADS) __hip_atomic_store((unsigned*)(ws) + 1024 + i, 0u, __ATOMIC_RELAXED, __HIP_MEMORY_SCOPE_AGENT);
    grid.sync();
    XcdBarrier bar = xcd_barrier_post((unsigned*)(ws) + 1024, MISC + 8);
    bf16* A16 = (bf16*)(ws + R0); bf16* U16 = (bf16*)(ws + R2);
    bf16* Y1B = (bf16*)(ws + R1); bf16* Y2B = (bf16*)(ws + R1 + 64 * MiB); bf16* H3B = (bf16*)(ws + R2_H3B);
    float* ST1 = (float*)(ws + 504 * MiB); float* ST2 = (float*)(ws + 508 * MiB);
    LAS float* SX = (LAS float*)(F.lds + 131072 + 1024);

    p0_prologue(F, P);
    GSYNC();
    {
        pg8::Gemm g{A16, (const bf16*)(ws + W_IN_T), M, PROJ_LD, opq(D), D, D}; pg8::StaticOrder S; S.init(M, PROJ_LD, G, cid);
        pg8::EpiBf16 E{U16, PROJ_LD, nullptr, 1 << 30, nullptr};
        pg8::gemm_phase<pg8::EpiBf16, pg8::StaticOrder, true, true>(F.lds, g, S, E, SX);
    }
    GSYNC();
    REFRESH(); gla_pass_a(F, P);
    fold_finalize(P, cid * NTHREADS + F.tid, G * NTHREADS);
    GSYNC();
    REFRESH(); gla_scan_pass<true>(F, P);
    GSYNC();
#pragma unroll 1
    for (int layer = 0; layer < 2; ++layer) {
        const float* fin = (const float*)(ws + FIN(0)) + (size_t)layer * (64 * 1024 / 4);
        if (layer == 1) {
            {
                pg8::Gemm g{H3B, (const bf16*)(ws + W_QKV_T), M, QKV_LD, opq(D), D, D}; pg8::StaticOrder S; S.init(M, QKV_LD, G, cid);
                pg8::EpiBf16 E{(bf16*)(ws + R2_QKV), QKV_LD, P.in[8], 1 << 30, nullptr};
                pg8::gemm_phase<pg8::EpiBf16, pg8::StaticOrder, true, true>(F.lds, g, S, E, SX);
            }
            GSYNC();
            REFRESH(); swa_phase(F, P);
            GSYNC();
        }
        {
            const bf16* A = layer == 0 ? (const bf16*)(ws + R2) + 2048 : (const bf16*)A16;
            pg8::Gemm g{A, (const bf16*)(ws + (layer == 0 ? W_GOUT_T : W_SOUT_T)), M, D, opq(D), layer == 0 ? PROJ_LD : D, D}; pg8::StaticOrder S; S.init(M, D, G, cid);
            pg8::EpiY<false> E{layer == 0 ? (const void*)A16 : (const void*)H3B, 1, layer == 0 ? nullptr : P.in[11], nullptr, nullptr, nullptr, Y1B, ST1, ALPHA};
            pg8::gemm_phase<pg8::EpiY<false>, pg8::StaticOrder, true, true>(F.lds, g, S, E, SX);
        }
        GSYNC();
        {
            pg8::Gemm g{Y1B, (const bf16*)(ws + W_UP_T + (size_t)layer * W_LSTRIDE), M, FF, opq(D), D, D}; pg8::StaticOrder S; S.init(M, FF, G, cid);
            pg8::EpiUpLN E{ST1, fin, fin + 4096, U16, FF};
            pg8::gemm_phase<pg8::EpiUpLN, pg8::StaticOrder, true, true>(F.lds, g, S, E, SX);
        }
        GSYNC();
        {
            pg8::Gemm g{U16, (const bf16*)(ws + W_DN_T + (size_t)layer * W_LSTRIDE), M, D, opq(FF), FF, FF}; pg8::StaticOrder S; S.init(M, D, G, cid);
            pg8::EpiY<true> E{(const void*)Y1B, 1, nullptr, P.in[14] + layer * D, P.in[15] + layer * D, ST1, Y2B, ST2, ALPHA};
            pg8::gemm_phase<pg8::EpiY<true>, pg8::StaticOrder, true, true>(F.lds, g, S, E, SX);
        }
        GSYNC();
        {
            int kpp = opq(PLE); pg8::Gemm g{layer == 0 ? (const bf16*)P.out : (const bf16*)(ws + PB1_OFF), (const bf16*)(ws + W_PP_T + (size_t)layer * W_LSTRIDE), M, D, kpp, kpp, kpp}; pg8::StaticOrder S; S.init(M, D, G, cid);
            pg8::EpiPP E{(bf16*)(ws + R2_PP), D};
            pg8::gemm_phase<pg8::EpiPP, pg8::StaticOrder, true, true>(F.lds, g, S, E, SX);
        }
        __syncthreads();
        {
            pg8::Gemm g{Y2B, (const bf16*)(ws + W_GATE_T + (size_t)layer * W_LSTRIDE), M, D, opq(D), D, D}; pg8::StaticOrder S; S.init(M, D, G, cid);
            pg8::EpiGateLN E{ST2, Y2B, (const bf16*)(ws + R2_PP), fin + 8192, fin + 9216, P.in[16] + layer * D, P.in[17] + layer * D, P.out, layer == 0 ? H3B : nullptr};
            pg8::gemm_phase<pg8::EpiGateLN, pg8::StaticOrder, true, true>(F.lds, g, S, E, SX);
        }
        if (layer == 0) GSYNC();
    }
}

extern "C" void kernel_launch(void* const* d_in, const int* in_sizes, int n_in, void* d_out, int out_size, void* d_ws, size_t ws_size, hipStream_t stream) {
    static int grid = 0;
    if (grid == 0) {
        if (n_in != 21 || in_sizes[0] != M * D || out_size != M * D || ws_size < WS_END) { fprintf(stderr, "kernel_launch: unexpected shapes (n_in %d, in0 %d, out %d, ws %zu)\n", n_in, n_in > 0 ? in_sizes[0] : -1, out_size, ws_size); grid = -1; return; }
        int dev = 0, cus = 0, per_cu = 0;
        hipGetDevice(&dev); hipDeviceGetAttribute(&cus, hipDeviceAttributeMultiprocessorCount, dev);
        if (hipFuncSetAttribute((const void*)mega_fwd, hipFuncAttributeMaxDynamicSharedMemorySize, LDS_BYTES) != hipSuccess) { fprintf(stderr, "kernel_launch: hipFuncSetAttribute failed\n"); grid = -1; return; }
        if (hipOccupancyMaxActiveBlocksPerMultiprocessor(&per_cu, (const void*)mega_fwd, NTHREADS, LDS_BYTES) != hipSuccess || per_cu < 1) { fprintf(stderr, "kernel_launch: occupancy query says %d\n", per_cu); (void)hipGetLastError(); per_cu = 1; }
        grid = cus * 1;
        if (grid <= 0) grid = 256;
    }
    if (grid < 0) return;
    Params p{};
    for (int i = 0; i < 21; ++i) p.in[i] = (const float*)d_in[i];
    p.out = (float*)d_out; p.ws = (unsigned char*)d_ws;
    void* args[] = {&p};
    hipError_t e = hipLaunchCooperativeKernel((const void*)mega_fwd, dim3(grid), dim3(NTHREADS), args, LDS_BYTES, stream);
    if (e != hipSuccess) fprintf(stderr, "cooperative launch failed: %s (grid %d)\n", hipGetErrorString(e), grid);
}
```

```cpp
#include <hip/hip_runtime.h>
#include <hip/hip_cooperative_groups.h>
#include <cstdio>
#include <cstdint>
namespace cg = cooperative_groups;
namespace pg8 {
#define PG8_LAS __attribute__((address_space(3)))
typedef unsigned short bf16_t;
typedef short bf16x8 __attribute__((ext_vector_type(8)));
typedef float f32x4 __attribute__((ext_vector_type(4)));
typedef unsigned u32x4 __attribute__((ext_vector_type(4)));
constexpr int BM = 256, BK = 64, HALF = 128, HTB = HALF * BK * 2  , STAGE_BYTES = 8 * HTB, NXCD = 8, WGM = 8;

__host__ __device__ __forceinline__ int lds_byte(int r, int c) { const int st = (r >> 4) * 2 + (c >> 5), rr = r & 15, cc = c & 31, ob = rr * 64 + cc * 2; return st * 1024 + (ob ^ (((ob >> 9) & 1) << 5)); }
__host__ __device__ __forceinline__ void stage_rc(int b, int& R, int& C) { const int st = b / 1024, sb = b % 1024, swz = sb ^ (((sb >> 9) & 1) << 5); R = (st >> 1) * 16 + swz / 64; C = (st & 1) * 32 + (swz % 64) / 2; }
__host__ __device__ __forceinline__ int perm32(int rho) { const int n = rho >> 4, i = rho & 15; return 8 * (i >> 2) + 4 * n + (i & 3); }

struct Unit { int pm, pn; };
struct Gemm { const bf16_t* A; const bf16_t* Bt; int M, N, K, lda, ldb; };

struct StaticOrder {
    int nM, nN, nwg, G, c;
    __host__ __device__ void init(int M, int N, int G_, int c_) { nM = M / BM; nN = N / BM; nwg = nM * nN; G = G_; c = c_; }
    __host__ __device__ bool next(int i, Unit& u) const {
        const long L = (long)i * G + c; if (L >= nwg) return false;
        int wgid = (int)L; { const int q = nwg / NXCD, r = nwg % NXCD, xcd = wgid % NXCD, off = wgid / NXCD; wgid = (xcd < r ? xcd * (q + 1) : r * (q + 1) + (xcd - r) * q) + off; }
        const int nig = WGM * nN, gid = wgid / nig, fm = gid * WGM, gsz = (nM - fm) < WGM ? (nM - fm) : WGM;
        u.pm = fm + ((wgid % nig) % gsz); u.pn = (wgid % nig) / gsz; return true;
    }
    __device__ __forceinline__ void a_ready(const Unit&) const {}
    __device__ __forceinline__ void done(const Unit&) const {}
};


__device__ __forceinline__ unsigned cvt_pk_bf16(float lo, float hi) { unsigned r; asm volatile("v_cvt_pk_bf16_f32 %0, %1, %2" : "=v"(r) : "v"(lo), "v"(hi)); return r; }
typedef unsigned u32x2 __attribute__((ext_vector_type(2)));
typedef float f32x2 __attribute__((ext_vector_type(2)));
__device__ __forceinline__ float bf2f(unsigned short b) { return __uint_as_float(((unsigned)b) << 16); }
__device__ __forceinline__ void unpack8(const u32x4 w, float (&v)[8]) {
    v[0] = __uint_as_float(w.x << 16); v[1] = __uint_as_float(w.x & 0xffff0000u); v[2] = __uint_as_float(w.y << 16); v[3] = __uint_as_float(w.y & 0xffff0000u);
    v[4] = __uint_as_float(w.z << 16); v[5] = __uint_as_float(w.z & 0xffff0000u); v[6] = __uint_as_float(w.w << 16); v[7] = __uint_as_float(w.w & 0xffff0000u);
}
constexpr float EPI_LN_EPS = 1e-5f;
__device__ __forceinline__ void stats_pre(const float* ST, int pm, int slot, int tid, PG8_LAS float* sx) {
    if (tid < 256) {
        const f32x4* p = (const f32x4*)(ST + (size_t)(pm * BM + tid) * 32); float s = 0.f, q = 0.f;
#pragma unroll
        for (int i = 0; i < 8; ++i) { const f32x4 v = p[i]; s += v[0] + v[2]; q += v[1] + v[3]; }
        const float mean = s * (1.0f / 1024.0f), var = fmaxf(q * (1.0f / 1024.0f) - mean * mean, 0.f);
        *(PG8_LAS f32x2*)(sx + (slot * 256 + tid) * 2) = (f32x2){mean, 1.0f / sqrtf(var + EPI_LN_EPS)};
    }
}

struct EpiBf16 {
    static constexpr bool PERM = true, AFTER_DRAIN = false;
    bf16_t* O; int ldc; const float* bias; int gk_tile; float* GK;
    __device__ __forceinline__ void pre(const Unit&, int, int, PG8_LAS float*) const {}
    __device__ __forceinline__ void operator()(const f32x4 (&acc)[2][2][4][2], const Unit& u, int wr, int wc, int fr, int fq, int, PG8_LAS float*) const {
        const int row0 = u.pm * BM + wr * 64 + fr;
        if (u.pn >= gk_tile) {
            if (wc == 0 && fq < 2) {
#pragma unroll
                for (int ai = 0; ai < 2; ++ai)
#pragma unroll
                    for (int m = 0; m < 4; ++m) { float* gp = GK + (size_t)(row0 + ai * HALF + m * 16) * 16 + 8 * fq;
                        *(f32x4*)(gp) = acc[ai][0][m][0]; *(f32x4*)(gp + 4) = acc[ai][0][m][1]; }
            }
            return;
        }
        const int col0 = u.pn * BM + wc * 32 + 8 * fq;
#pragma unroll
        for (int bj = 0; bj < 2; ++bj) {
            f32x4 b0 = (f32x4){0.f, 0.f, 0.f, 0.f}, b1 = b0;
            if (bias) { b0 = *(const f32x4*)(bias + col0 + bj * HALF); b1 = *(const f32x4*)(bias + col0 + bj * HALF + 4); }
#pragma unroll
            for (int ai = 0; ai < 2; ++ai)
#pragma unroll
                for (int m = 0; m < 4; ++m) { const f32x4 v0 = acc[ai][bj][m][0] + b0, v1 = acc[ai][bj][m][1] + b1;
                    u32x4 w; w.x = cvt_pk_bf16(v0[0], v0[1]); w.y = cvt_pk_bf16(v0[2], v0[3]); w.z = cvt_pk_bf16(v1[0], v1[1]); w.w = cvt_pk_bf16(v1[2], v1[3]);
                    *(u32x4*)(O + (size_t)(row0 + ai * HALF + m * 16) * ldc + col0 + bj * HALF) = w; } }
    }
};

template <bool LN> struct EpiY {
    static constexpr bool PERM = true, AFTER_DRAIN = false;
    const void* res; int res_bf16; const float* bias; const float* g; const float* b; const float* ST_IN; bf16_t* Y; float* ST; float alpha;
    __device__ __forceinline__ void pre(const Unit& u, int slot, int tid, PG8_LAS float* sx) const { if (LN) stats_pre(ST_IN, u.pm, slot, tid, sx); }
    __device__ __forceinline__ void operator()(const f32x4 (&acc)[2][2][4][2], const Unit& u, int wr, int wc, int fr, int fq, int slot, PG8_LAS float* sx) const {
        const int col0 = u.pn * BM + wc * 32 + 8 * fq, rl0 = wr * 64 + fr; const size_t roff0 = (size_t)(u.pm * BM + rl0) * 1024;
        const bf16_t* R = (const bf16_t*)res;
        float ps[8], pq[8];
#pragma unroll
        for (int r = 0; r < 8; ++r) { ps[r] = 0.f; pq[r] = 0.f; }
#pragma unroll
        for (int bj = 0; bj < 2; ++bj) { const int c = col0 + bj * HALF;
            u32x4 rr[8];
#pragma unroll
            for (int r = 0; r < 8; ++r) rr[r] = *(const u32x4*)(R + roff0 + (size_t)((r >> 2) * HALF + (r & 3) * 16) * 1024 + c);
            f32x4 g0, g1, b0, b1, bb0, bb1;
            if (LN) { g0 = *(const f32x4*)(g + c); g1 = *(const f32x4*)(g + c + 4); b0 = *(const f32x4*)(b + c); b1 = *(const f32x4*)(b + c + 4); }
            if (bias) { bb0 = *(const f32x4*)(bias + c); bb1 = *(const f32x4*)(bias + c + 4); }
#pragma unroll
            for (int r = 0; r < 8; ++r) { const int ai = r >> 2, m = r & 3, rl = rl0 + ai * HALF + m * 16;
                float rv[8]; unpack8(rr[r], rv);
                if (LN) { const f32x2 mr = *(const PG8_LAS f32x2*)(sx + (slot * 256 + rl) * 2);
#pragma unroll
                    for (int i = 0; i < 4; ++i) { rv[i] = (rv[i] - mr[0]) * mr[1] * g0[i] + b0[i]; rv[4 + i] = (rv[4 + i] - mr[0]) * mr[1] * g1[i] + b1[i]; } }
                f32x4 v0 = acc[ai][bj][m][0], v1 = acc[ai][bj][m][1];
                if (bias) { v0 += bb0; v1 += bb1; }
                float y[8];
#pragma unroll
                for (int i = 0; i < 4; ++i) { y[i] = alpha * rv[i] + v0[i]; y[4 + i] = alpha * rv[4 + i] + v1[i]; }
                u32x4 w; w.x = cvt_pk_bf16(y[0], y[1]); w.y = cvt_pk_bf16(y[2], y[3]); w.z = cvt_pk_bf16(y[4], y[5]); w.w = cvt_pk_bf16(y[6], y[7]);
                *(u32x4*)(Y + roff0 + (size_t)(ai * HALF + m * 16) * 1024 + c) = w;
                float yr[8]; unpack8(w, yr);
#pragma unroll
                for (int i = 0; i < 8; ++i) { ps[r] += yr[i]; pq[r] += yr[i] * yr[i]; } }
        }
#pragma unroll
        for (int r = 0; r < 8; ++r) { float a = ps[r], q = pq[r];
            a += __shfl_xor(a, 16); a += __shfl_xor(a, 32); q += __shfl_xor(q, 16); q += __shfl_xor(q, 32);
            if (fq == 0) *(f32x2*)(ST + (size_t)(u.pm * BM + rl0 + (r >> 2) * HALF + (r & 3) * 16) * 32 + (u.pn * 4 + wc) * 2) = (f32x2){a, q}; }
    }
};

struct EpiUpLN {
    static constexpr bool PERM = true, AFTER_DRAIN = false;
    const float* ST_IN; const float* colsum; const float* bw; bf16_t* O; int ldc;
    __device__ __forceinline__ void pre(const Unit& u, int slot, int tid, PG8_LAS float* sx) const { stats_pre(ST_IN, u.pm, slot, tid, sx); }
    __device__ __forceinline__ void operator()(const f32x4 (&acc)[2][2][4][2], const Unit& u, int wr, int wc, int fr, int fq, int slot, PG8_LAS float* sx) const {
        const int col0 = u.pn * BM + wc * 32 + 8 * fq, rl0 = wr * 64 + fr;
#pragma unroll
        for (int bj = 0; bj < 2; ++bj) { const int c = col0 + bj * HALF;
            const f32x4 c0 = *(const f32x4*)(colsum + c), c1 = *(const f32x4*)(colsum + c + 4), w0 = *(const f32x4*)(bw + c), w1 = *(const f32x4*)(bw + c + 4);
#pragma unroll
            for (int r = 0; r < 8; ++r) { const int ai = r >> 2, m = r & 3, rl = rl0 + ai * HALF + m * 16;
                const f32x2 mr = *(const PG8_LAS f32x2*)(sx + (slot * 256 + rl) * 2);
                f32x4 v0 = (acc[ai][bj][m][0] - c0 * mr[0]) * mr[1] + w0, v1 = (acc[ai][bj][m][1] - c1 * mr[0]) * mr[1] + w1;
#pragma unroll
                for (int i = 0; i < 4; ++i) { const float a = fmaxf(v0[i], 0.f), b2 = fmaxf(v1[i], 0.f); v0[i] = a * a; v1[i] = b2 * b2; }
                u32x4 w; w.x = cvt_pk_bf16(v0[0], v0[1]); w.y = cvt_pk_bf16(v0[2], v0[3]); w.z = cvt_pk_bf16(v1[0], v1[1]); w.w = cvt_pk_bf16(v1[2], v1[3]);
                *(u32x4*)(O + (size_t)(u.pm * BM + rl) * ldc + c) = w; } }
    }
};

struct EpiPP {
    static constexpr bool PERM = true, AFTER_DRAIN = false;
    bf16_t* O; int ldc;
    __device__ __forceinline__ void pre(const Unit&, int, int, PG8_LAS float*) const {}
    __device__ __forceinline__ void operator()(const f32x4 (&acc)[2][2][4][2], const Unit& u, int wr, int wc, int fr, int fq, int, PG8_LAS float*) const {
        const int row0 = u.pm * BM + wr * 64 + fr, col0 = u.pn * BM + wc * 32 + 8 * fq;
#pragma unroll
        for (int ai = 0; ai < 2; ++ai)
#pragma unroll
            for (int m = 0; m < 4; ++m) { bf16_t* rowp = O + (size_t)(row0 + ai * HALF + m * 16) * ldc + col0;
#pragma unroll
                for (int bj = 0; bj < 2; ++bj) { const f32x4 v0 = acc[ai][bj][m][0], v1 = acc[ai][bj][m][1];
                    u32x4 w; w.x = cvt_pk_bf16(v0[0], v0[1]); w.y = cvt_pk_bf16(v0[2], v0[3]); w.z = cvt_pk_bf16(v1[0], v1[1]); w.w = cvt_pk_bf16(v1[2], v1[3]);
                    *(u32x4*)(rowp + bj * HALF) = w; } }
    }
};

struct EpiGateLN {
    static constexpr bool PERM = true, AFTER_DRAIN = false;
    const float* ST_IN; const bf16_t* YB; const bf16_t* pp; const float* colsum; const float* bz; const float* g; const float* b; float* out; bf16_t* ob;
    __device__ __forceinline__ void pre(const Unit& u, int slot, int tid, PG8_LAS float* sx) const { stats_pre(ST_IN, u.pm, slot, tid, sx); }
    __device__ __forceinline__ void operator()(const f32x4 (&acc)[2][2][4][2], const Unit& u, int wr, int wc, int fr, int fq, int slot, PG8_LAS float* sx) const {
        const int col0 = u.pn * BM + wc * 32 + 8 * fq, rl0 = wr * 64 + fr; const size_t roff0 = (size_t)(u.pm * BM + rl0) * 1024;
#pragma unroll
        for (int bj = 0; bj < 2; ++bj) { const int c = col0 + bj * HALF;
            f32x4 cs[2], zb[2], gg[2], bb[2];
#pragma unroll
            for (int hh = 0; hh < 2; ++hh) { cs[hh] = *(const f32x4*)(colsum + c + 4 * hh); zb[hh] = *(const f32x4*)(bz + c + 4 * hh); gg[hh] = *(const f32x4*)(g + c + 4 * hh); bb[hh] = *(const f32x4*)(b + c + 4 * hh); }
#pragma unroll
            for (int ai = 0; ai < 2; ++ai) {
                u32x4 yy[4], pw[4];
#pragma unroll
                for (int m = 0; m < 4; ++m) { const size_t o2 = roff0 + (size_t)(ai * HALF + m * 16) * 1024 + c; yy[m] = *(const u32x4*)(YB + o2); pw[m] = *(const u32x4*)(pp + o2); }
#pragma unroll
                for (int m = 0; m < 4; ++m) { const int rl = rl0 + ai * HALF + m * 16; const size_t o2 = roff0 + (size_t)(ai * HALF + m * 16) * 1024 + c;
                    const f32x2 mr = *(const PG8_LAS f32x2*)(sx + (slot * 256 + rl) * 2);
                    float y[8], p[8], o[8]; unpack8(yy[m], y); unpack8(pw[m], p);
#pragma unroll
                    for (int hh = 0; hh < 2; ++hh) { const f32x4 z = (acc[ai][bj][m][hh] - cs[hh] * mr[0]) * mr[1] + zb[hh];
#pragma unroll
                        for (int i = 0; i < 4; ++i) { const float h2 = (y[4 * hh + i] - mr[0]) * mr[1] * gg[hh][i] + bb[hh][i]; o[4 * hh + i] = h2 + p[4 * hh + i] * __builtin_amdgcn_rcpf(1.0f + __expf(-z[i])); } }
                    if (ob) { u32x4 w; w.x = cvt_pk_bf16(o[0], o[1]); w.y = cvt_pk_bf16(o[2], o[3]); w.z = cvt_pk_bf16(o[4], o[5]); w.w = cvt_pk_bf16(o[6], o[7]); *(u32x4*)(ob + o2) = w; }
                    else { *(f32x4*)(out + o2) = (f32x4){o[0], o[1], o[2], o[3]}; *(f32x4*)(out + o2 + 4) = (f32x4){o[4], o[5], o[6], o[7]}; } }
                asm volatile("" ::: "memory");
            } }
    }
};

template <class Epi, class Sched, bool ALIGN_EPI = false, bool SP2 = false>
__device__ __forceinline__ void gemm_phase(PG8_LAS unsigned char* lds, const Gemm g, const Sched& S, const Epi& E, PG8_LAS float* sx) {
    int tid_ = threadIdx.x; asm volatile("" : "+v"(tid_));
    const int tid = tid_, wid = __builtin_amdgcn_readfirstlane(tid >> 6), lane = tid & 63, wr = wid >> 2, wc = wid & 3, fr = lane & 15, fq = lane >> 4;
    const int K = g.K, nt = K / BK;
    unsigned voffA[2], voffB[2];
#pragma unroll
    for (int i = 0; i < 2; ++i) { int R, C; stage_rc(tid * 16 + i * 8192, R, C); const int Rb = Epi::PERM ? ((R & ~31) + perm32(R & 31)) : R;
        voffA[i] = (unsigned)(R * g.lda + C) * 2u; voffB[i] = (unsigned)(Rb * g.ldb + C) * 2u; }
    const size_t kstep = (size_t)(BK * 2);
    const size_t hstepA = (size_t)HALF * g.lda * 2, hstepB = (size_t)HALF * g.ldb * 2;
    const size_t tstepA = 2 * hstepA, tstepB = 2 * hstepB;
    const unsigned ldsw = (unsigned)wid * 1024u;
    const int aoff = lds_byte(wr * 64 + fr, fq * 8), boff = lds_byte(wc * 32 + fr, fq * 8);
#define PG8_SA(b, h) (((b) * 2 + (h)) * HTB)
#define PG8_SB(b, h) ((4 + (b) * 2 + (h)) * HTB)
#define PG8_STAGE(bufoff, gbase, voff) do { _Pragma("unroll") for (int _i = 0; _i < 2; ++_i) \
        __builtin_amdgcn_global_load_lds((const unsigned*)((const char*)(gbase) + (voff)[_i]), (PG8_LAS unsigned*)(lds + (bufoff) + ldsw + _i * 8192), 16, 0, 0); } while (0)
#define PG8_LDA(dst, b, h) do { _Pragma("unroll") for (int m = 0; m < 4; ++m) _Pragma("unroll") for (int k = 0; k < 2; ++k) dst[m][k] = *(const PG8_LAS bf16x8*)(lds + PG8_SA(b, h) + aoff + m * 2048 + k * 1024); } while (0)
#define PG8_LDB(dst, b, h) do { _Pragma("unroll") for (int n = 0; n < 2; ++n) _Pragma("unroll") for (int k = 0; k < 2; ++k) dst[n][k] = *(const PG8_LAS bf16x8*)(lds + PG8_SB(b, h) + boff + n * 2048 + k * 1024); } while (0)
#define PG8_MMA(ai, bj, At, Bt) do { __builtin_amdgcn_s_setprio(1); _Pragma("unroll") for (int m = 0; m < 4; ++m) _Pragma("unroll") for (int n = 0; n < 2; ++n) _Pragma("unroll") for (int k = 0; k < 2; ++k) \
        acc[ai][bj][m][n] = __builtin_amdgcn_mfma_f32_16x16x32_bf16(Bt[n][k], At[m][k], acc[ai][bj][m][n], 0, 0, 0); __builtin_amdgcn_s_setprio(0); } while (0)
#define PG8_WAIT_V(n) asm volatile("s_waitcnt vmcnt(" #n ")" ::: "memory")
#define PG8_WAIT_L(n) asm volatile("s_waitcnt lgkmcnt(" #n ")" ::: "memory")
#define PG8_BAR __builtin_amdgcn_s_barrier()
#define PG8_SCHED __builtin_amdgcn_sched_barrier(0)
    Unit cur, nxt; int ui = 0;
    if (!S.next(0, cur)) return;
    f32x4 acc[2][2][4][2];
#pragma unroll
    for (int a = 0; a < 2; ++a)
#pragma unroll
        for (int b = 0; b < 2; ++b)
#pragma unroll
            for (int m = 0; m < 4; ++m)
#pragma unroll
                for (int n = 0; n < 2; ++n) acc[a][b][m][n] = (f32x4){0.f, 0.f, 0.f, 0.f};
    bf16x8 At[4][2], B0[2][2], B1[2][2];
    const char* cA = (const char*)g.A + (size_t)cur.pm * tstepA; const char* cB = (const char*)g.Bt + (size_t)cur.pn * tstepB;
    S.a_ready(cur); E.pre(cur, 0, tid, sx);
    if constexpr (SP2) {
        PG8_STAGE(PG8_SB(0, 0), cB, voffB); PG8_STAGE(PG8_SB(0, 1), cB + hstepB, voffB); PG8_STAGE(PG8_SA(0, 0), cA, voffA); PG8_STAGE(PG8_SA(0, 1), cA + hstepA, voffA);
        if (wr == 1) PG8_BAR;
        PG8_WAIT_V(2); PG8_BAR;
        PG8_STAGE(PG8_SB(1, 0), cB + kstep, voffB); PG8_STAGE(PG8_SA(1, 0), cA + kstep, voffA); PG8_STAGE(PG8_SB(1, 1), cB + hstepB + kstep, voffB);
        PG8_WAIT_V(6); PG8_BAR;
    } else {
        PG8_STAGE(PG8_SB(0, 0), cB, voffB); PG8_STAGE(PG8_SA(0, 0), cA, voffA); PG8_STAGE(PG8_SB(0, 1), cB + hstepB, voffB); PG8_STAGE(PG8_SA(0, 1), cA + hstepA, voffA);
        if (wr == 1) PG8_BAR;
        PG8_WAIT_V(4); PG8_BAR;
        PG8_STAGE(PG8_SB(1, 0), cB + kstep, voffB); PG8_STAGE(PG8_SA(1, 0), cA + kstep, voffA); PG8_STAGE(PG8_SB(1, 1), cB + hstepB + kstep, voffB);
        PG8_WAIT_V(6); PG8_BAR;
    }
    for (;;) {
        const bool has_next = S.next(ui + 1, nxt);
        const char* nA = has_next ? (const char*)g.A + (size_t)nxt.pm * tstepA : cA; const char* nB = has_next ? (const char*)g.Bt + (size_t)nxt.pn * tstepB : cB;
        for (int t = 0; t < nt; t += 2) {
            const bool last = (t == nt - 2);
            const char* a1 = cA + (size_t)(t + 1) * kstep;
            const char* a2 = last ? nA : cA + (size_t)(t + 2) * kstep; const char* b2 = last ? nB : cB + (size_t)(t + 2) * kstep;
            const char* a3 = a2 + kstep; const char* b3 = b2 + kstep;
            if (last && has_next) { S.a_ready(nxt); E.pre(nxt, (ui + 1) & 1, tid, sx); }
            if constexpr (SP2) {
            PG8_LDB(B0, 0, 0); PG8_LDB(B1, 0, 1); PG8_SCHED; PG8_LDA(At, 0, 0); PG8_STAGE(PG8_SA(1, 1), a1 + hstepA, voffA);
            PG8_WAIT_V(8); PG8_WAIT_L(0); PG8_BAR; PG8_MMA(0, 0, At, B0); PG8_MMA(0, 1, At, B1); PG8_BAR; PG8_SCHED;
            PG8_LDA(At, 0, 1); PG8_STAGE(PG8_SB(0, 0), b2, voffB); PG8_STAGE(PG8_SB(0, 1), b2 + hstepB, voffB); PG8_STAGE(PG8_SA(0, 0), a2, voffA);
            PG8_WAIT_V(8); PG8_WAIT_L(0); PG8_BAR; PG8_MMA(1, 0, At, B0); PG8_MMA(1, 1, At, B1); PG8_BAR; PG8_SCHED;
            PG8_LDB(B0, 1, 0); PG8_LDB(B1, 1, 1); PG8_SCHED; PG8_LDA(At, 1, 0); PG8_STAGE(PG8_SA(0, 1), a2 + hstepA, voffA);
            PG8_WAIT_V(8); PG8_WAIT_L(0); PG8_BAR; PG8_MMA(0, 0, At, B0); PG8_MMA(0, 1, At, B1); PG8_BAR; PG8_SCHED;
            PG8_LDA(At, 1, 1); PG8_STAGE(PG8_SB(1, 0), b3, voffB); PG8_STAGE(PG8_SB(1, 1), b3 + hstepB, voffB); PG8_STAGE(PG8_SA(1, 0), a3, voffA);
            PG8_WAIT_V(8); PG8_WAIT_L(0); PG8_BAR; PG8_MMA(1, 0, At, B0); PG8_MMA(1, 1, At, B1); PG8_BAR; PG8_SCHED;
            } else {
            PG8_LDB(B0, 0, 0); PG8_SCHED; PG8_LDA(At, 0, 0); PG8_STAGE(PG8_SA(1, 1), a1 + hstepA, voffA);
            PG8_WAIT_L(8); PG8_BAR; PG8_WAIT_L(0); PG8_MMA(0, 0, At, B0); PG8_BAR; PG8_SCHED;
            PG8_LDB(B1, 0, 1); PG8_STAGE(PG8_SB(0, 0), b2, voffB);
            PG8_BAR; PG8_WAIT_L(0); PG8_MMA(0, 1, At, B1); PG8_BAR;
            PG8_LDA(At, 0, 1); PG8_STAGE(PG8_SA(0, 0), a2, voffA);
            PG8_BAR; PG8_WAIT_L(0); PG8_MMA(1, 0, At, B0); PG8_BAR; PG8_SCHED;
            PG8_STAGE(PG8_SB(0, 1), b2 + hstepB, voffB);
            PG8_WAIT_V(6); PG8_BAR; PG8_MMA(1, 1, At, B1); PG8_BAR;
            PG8_LDB(B0, 1, 0); PG8_SCHED; PG8_LDA(At, 1, 0); PG8_STAGE(PG8_SA(0, 1), a2 + hstepA, voffA);
            PG8_WAIT_L(8); PG8_BAR; PG8_WAIT_L(0); PG8_MMA(0, 0, At, B0); PG8_BAR; PG8_SCHED;
            PG8_LDB(B1, 1, 1); PG8_STAGE(PG8_SB(1, 0), b3, voffB);
            PG8_BAR; PG8_WAIT_L(0); PG8_MMA(0, 1, At, B1); PG8_BAR;
            PG8_LDA(At, 1, 1); PG8_STAGE(PG8_SA(1, 0), a3, voffA);
            PG8_BAR; PG8_WAIT_L(0); PG8_MMA(1, 0, At, B0); PG8_BAR; PG8_SCHED;
            PG8_STAGE(PG8_SB(1, 1), b3 + hstepB, voffB);
            PG8_WAIT_V(6); PG8_BAR; PG8_MMA(1, 1, At, B1); PG8_BAR;
            }
        }
        if constexpr (ALIGN_EPI) { if (wr == 0) PG8_BAR; }
        if constexpr (!Epi::AFTER_DRAIN) { E(acc, cur, wr, wc, fr, fq, ui & 1, sx); S.done(cur); }
        if (!has_next) break;
#pragma unroll
        for (int a = 0; a < 2; ++a)
#pragma unroll
            for (int b = 0; b < 2; ++b)
#pragma unroll
                for (int m = 0; m < 4; ++m)
#pragma unroll
                    for (int n = 0; n < 2; ++n) acc[a][b][m][n] = (f32x4){0.f, 0.f, 0.f, 0.f};
        cur = nxt; cA = nA; cB = nB; ++ui;
        if constexpr (ALIGN_EPI) { if (wr == 1) PG8_BAR; }
    }
    PG8_WAIT_V(0);
    if constexpr (!ALIGN_EPI) { if (wr == 0) PG8_BAR; }
    PG8_BAR;
    if constexpr (Epi::AFTER_DRAIN) { E.fused(acc, cur, wr, wc, fr, fq, lds, wid, lane); S.done(cur); }
#undef PG8_SA
#undef PG8_SB
#undef PG8_STAGE
#undef PG8_LDA
#undef PG8_LDB
#undef PG8_MMA
#undef PG8_WAIT_V
#undef PG8_WAIT_L
#undef PG8_BAR
#undef PG8_SCHED
}
}

#define LAS __attribute__((address_space(3)))
typedef unsigned short bf16;
typedef unsigned u32x4 __attribute__((ext_vector_type(4)));
typedef unsigned u32x2 __attribute__((ext_vector_type(2)));
typedef float f32x4 __attribute__((ext_vector_type(4)));
typedef short bf16x8 __attribute__((ext_vector_type(8)));
typedef short s16x4 __attribute__((ext_vector_type(4)));

constexpr int NTHREADS = 512, NWAVES = 8;
constexpr int BATCH = 8, SEQ = 4096, D = 1024, M = BATCH * SEQ, FF = 4096, PLE = 256;
constexpr int GLA_COLS = 3088, PROJ_LD = 3072;
constexpr int QKV_LD = 1536;
constexpr float LN_EPS = 1e-5f, RMS_EPS = 1e-5f;
constexpr float ALPHA = 1.4142135623730951f;
constexpr size_t MiB = 1u << 20;
constexpr size_t W_IN_T = 1 * MiB;
constexpr size_t W_GOUT_T = 7 * MiB;
constexpr size_t W_UP_T = 9 * MiB;
constexpr size_t W_DN_T = 17 * MiB;
constexpr size_t W_GATE_T = 25 * MiB;
constexpr size_t W_PP_T = 27 * MiB;
constexpr size_t W_QKV_T = 28 * MiB;
constexpr size_t W_SOUT_T = 31 * MiB;
constexpr size_t W_LSTRIDE = 24 * MiB;
constexpr size_t PB1_OFF = 1 * MiB;
constexpr size_t R0 = 56 * MiB;
constexpr size_t R1 = 120 * MiB;
constexpr size_t R2 = 248 * MiB;
constexpr size_t R2_GK = R2 + 192 * MiB;
constexpr size_t R2_PP = R2 + 16 * MiB;
constexpr size_t R2_H3B = R2 + 80 * MiB;
constexpr size_t R2_QKV = R2 + 144 * MiB;
constexpr size_t R0_BL = R1 + 80 * MiB;
constexpr size_t WS_END = 512 * MiB;
constexpr int LDS_BYTES = 147456;

__device__ __forceinline__ int opq(int v) { asm volatile("" : "+s"(v)); return v; }
struct Params { const float* in[21]; float* out; unsigned char* ws; };
#define LBAR() do { asm volatile("s_waitcnt lgkmcnt(0)" ::: "memory"); __builtin_amdgcn_s_barrier(); asm volatile("" ::: "memory"); } while (0)

struct Ctx { LAS unsigned char* lds; int tid, lane, wave; };

__device__ __forceinline__ float wave_sum(float v) {
#pragma unroll
    for (int o = 1; o < 64; o <<= 1) v += __shfl_xor(v, o);
    return v;
}
__device__ __forceinline__ unsigned pk2(float lo, float hi) { return pg8::cvt_pk_bf16(lo, hi); }
__device__ __forceinline__ float bf2f(unsigned short b) { return __uint_as_float(((unsigned)b) << 16); }
__device__ __forceinline__ bf16x8 pack8(const f32x4 a, const f32x4 b) {
    u32x4 w; w.x = pk2(a[0], a[1]); w.y = pk2(a[2], a[3]); w.z = pk2(b[0], b[1]); w.w = pk2(b[2], b[3]); return __builtin_bit_cast(bf16x8, w);
}
#define MFMA16(a, b, c) __builtin_amdgcn_mfma_f32_16x16x32_bf16((a), (b), (c), 0, 0, 0)
__device__ __forceinline__ bf16x8 lds16(const LAS unsigned char* p) { return *(const LAS bf16x8*)p; }
__device__ __forceinline__ bf16x8 lds8x2(const LAS unsigned char* p0, const LAS unsigned char* p1) {
    const s16x4 lo = *(const LAS s16x4*)p0, hi = *(const LAS s16x4*)p1; return __builtin_shufflevector(lo, hi, 0, 1, 2, 3, 4, 5, 6, 7);
}

template <bool FOLD>
__device__ __forceinline__ void transpose_item(const float* W, int ldw, int nblk, int K, bf16* WT, LAS float* scr, int item, int lane,
                                               const float* gv = nullptr, const float* bv = nullptr, float* csp = nullptr, float* bwp = nullptr) {
    const int kb = item / nblk, nb = item % nblk, k0 = 64 * kb, n0 = 32 * nb;
    { const int r8 = lane >> 3, c4 = lane & 7;
      f32x4 v[8];
#pragma unroll
      for (int it = 0; it < 8; ++it) v[it] = *(const f32x4*)(W + (size_t)(k0 + 8 * it + r8) * ldw + n0 + 4 * c4);
#pragma unroll
      for (int it = 0; it < 8; ++it) { LAS float* d = scr + (8 * it + r8) * 33 + 4 * c4; d[0] = v[it][0]; d[1] = v[it][1]; d[2] = v[it][2]; d[3] = v[it][3]; } }
    asm volatile("s_waitcnt lgkmcnt(0)" ::: "memory");
    const int c = lane & 7;
    float gk[8], bk[8];
    if (FOLD) {
#pragma unroll
        for (int i = 0; i < 8; ++i) { gk[i] = gv[k0 + 8 * c + i]; bk[i] = bv[k0 + 8 * c + i]; }
    }
#pragma unroll
    for (int j = 0; j < 4; ++j) { const int n = (lane >> 3) + 8 * j; const LAS float* sp = scr + (8 * c) * 33 + n;
        float v[8];
#pragma unroll
        for (int i = 0; i < 8; ++i) v[i] = sp[i * 33];
        float bwv = 0.f;
        if (FOLD) {
#pragma unroll
            for (int i = 0; i < 8; ++i) { bwv += bk[i] * v[i]; v[i] *= gk[i]; }
        }
        u32x4 o; o.x = pk2(v[0], v[1]); o.y = pk2(v[2], v[3]); o.z = pk2(v[4], v[5]); o.w = pk2(v[6], v[7]);
        *(u32x4*)(WT + (size_t)(n0 + n) * K + k0 + 8 * c) = o;
        if (FOLD) {
            float r[8]; pg8::unpack8(o, r); float cs = ((r[0] + r[1]) + (r[2] + r[3])) + ((r[4] + r[5]) + (r[6] + r[7]));
            cs += __shfl_xor(cs, 1); cs += __shfl_xor(cs, 2); cs += __shfl_xor(cs, 4);
            bwv += __shfl_xor(bwv, 1); bwv += __shfl_xor(bwv, 2); bwv += __shfl_xor(bwv, 4);
            if (c == 0) { const int N = 32 * nblk; csp[(size_t)kb * N + n0 + n] = cs; bwp[(size_t)kb * N + n0 + n] = bwv; }
        }
    }
    asm volatile("s_waitcnt lgkmcnt(0)" ::: "memory");
}
constexpr size_t VEC = 52 * MiB;
__device__ __host__ constexpr size_t CSP_UP(int l) { return VEC + (size_t)l * 512 * 1024; }
__device__ __host__ constexpr size_t CSP_G(int l) { return VEC + MiB + (size_t)l * 128 * 1024; }
__device__ __host__ constexpr size_t FIN(int l) { return VEC + MiB + 512 * 1024 + (size_t)l * 64 * 1024; }
__device__ __forceinline__ void fold_finalize(const Params& P, int gtid, int gthreads) {
    for (int idx = gtid; idx < 2 * 5120; idx += gthreads) {
        const int l = idx / 5120, r = idx % 5120;
        float* fin = (float*)(P.ws + FIN(l));
        if (r < 4096) { const float* cp = (const float*)(P.ws + CSP_UP(l)); const float* bp = cp + 16 * 4096; float cs = 0.f, bw = 0.f;
#pragma unroll
            for (int kb = 0; kb < 16; ++kb) { cs += cp[kb * 4096 + r]; bw += bp[kb * 4096 + r]; }
            fin[r] = cs; fin[4096 + r] = bw; }
        else { const int n = r - 4096; const float* cp = (const float*)(P.ws + CSP_G(l)); const float* bp = cp + 16 * 1024; float cs = 0.f, bw = 0.f;
#pragma unroll
            for (int kb = 0; kb < 16; ++kb) { cs += cp[kb * 1024 + n]; bw += bp[kb * 1024 + n]; }
            fin[8192 + n] = cs; fin[9216 + n] = bw + P.in[20][l * D + n]; }
    }
}
__device__ __forceinline__ void p0_prologue(const Ctx& F, const Params& P) {
    LAS float* scr = (LAS float*)(F.lds + F.wave * 16384);
    const int gw = blockIdx.x * NWAVES + F.wave, NGW = gridDim.x * NWAVES;
    unsigned char* ws = P.ws;
    constexpr int I_IN = 16 * 96, I_SQ = 16 * 32, I_QKV = 16 * 48, I_UP = 16 * 128, I_DN = 64 * 32, I_PP = 4 * 32;
    constexpr int NITEMS = I_IN + 2 * I_SQ + I_QKV + 2 * I_UP + 2 * I_DN + 2 * I_SQ + 2 * I_PP;
    for (int it = gw; it < NITEMS; it += NGW) {
        int r = it;
        if (r < I_IN) { transpose_item<false>(P.in[2], GLA_COLS, 96, D, (bf16*)(ws + W_IN_T), scr, r, F.lane); continue; } r -= I_IN;
        if (r < I_SQ) { transpose_item<false>(P.in[6], D, 32, D, (bf16*)(ws + W_GOUT_T), scr, r, F.lane); continue; } r -= I_SQ;
        if (r < I_SQ) { transpose_item<false>(P.in[10], D, 32, D, (bf16*)(ws + W_SOUT_T), scr, r, F.lane); continue; } r -= I_SQ;
        if (r < I_QKV) { transpose_item<false>(P.in[7], QKV_LD, 48, D, (bf16*)(ws + W_QKV_T), scr, r, F.lane); continue; } r -= I_QKV;
        if (r < 2 * I_UP) { const int l = r / I_UP; transpose_item<true>(P.in[12] + (size_t)l * D * FF, FF, 128, D, (bf16*)(ws + W_UP_T + (size_t)l * W_LSTRIDE), scr, r % I_UP, F.lane, P.in[14] + l * D, P.in[15] + l * D, (float*)(ws + CSP_UP(l)), (float*)(ws + CSP_UP(l)) + 16 * 4096); continue; } r -= 2 * I_UP;
        if (r < 2 * I_DN) { const int l = r / I_DN; transpose_item<false>(P.in[13] + (size_t)l * D * FF, D, 32, FF, (bf16*)(ws + W_DN_T + (size_t)l * W_LSTRIDE), scr, r % I_DN, F.lane); continue; } r -= 2 * I_DN;
        if (r < 2 * I_SQ) { const int l = r / I_SQ; transpose_item<true>(P.in[19] + (size_t)l * D * D, D, 32, D, (bf16*)(ws + W_GATE_T + (size_t)l * W_LSTRIDE), scr, r % I_SQ, F.lane, P.in[16] + l * D, P.in[17] + l * D, (float*)(ws + CSP_G(l)), (float*)(ws + CSP_G(l)) + 16 * 1024); continue; } r -= 2 * I_SQ;
        { const int l = r / I_PP; transpose_item<false>(P.in[18] + (size_t)l * PLE * D, D, 32, PLE, (bf16*)(ws + W_PP_T + (size_t)l * W_LSTRIDE), scr, r % I_PP, F.lane); }
    }
    const int gtid = blockIdx.x * NTHREADS + F.tid, gthreads = gridDim.x * NTHREADS;
    {
        LAS float* wg = (LAS float*)F.lds;
        __syncthreads();
        for (int i = F.tid; i < 4096; i += NTHREADS) { const int k = i >> 2, c4 = i & 3, pos = (k & 3) * 256 + (k >> 2); *(LAS f32x4*)(wg + pos * 20 + 4 * c4) = *(const f32x4*)(P.in[2] + (size_t)k * GLA_COLS + 3072 + 4 * c4); }
        __syncthreads();
        const float* x = P.in[0]; bf16* xb = (bf16*)(ws + R0); float* GK = (float*)(ws + R2_GK);
        const int lane = F.lane;
#pragma unroll 1
        for (int r0 = gw * 4; r0 < M; r0 += NGW * 4) {
            f32x4 acc[16];
#pragma unroll
            for (int i = 0; i < 16; ++i) acc[i] = (f32x4){0.f, 0.f, 0.f, 0.f};
#pragma unroll 1
            for (int j = 0; j < 4; ++j) {
                float xs[4][4];
#pragma unroll
                for (int rr = 0; rr < 4; ++rr) { const f32x4 v = *(const f32x4*)(x + (size_t)(r0 + rr) * D + 256 * j + 4 * lane);
                    u32x2 o; o.x = pk2(v[0], v[1]); o.y = pk2(v[2], v[3]); *(u32x2*)(xb + (size_t)(r0 + rr) * D + 256 * j + 4 * lane) = o;
                    xs[rr][0] = v[0]; xs[rr][1] = v[1]; xs[rr][2] = v[2]; xs[rr][3] = v[3]; }
#pragma unroll
                for (int i = 0; i < 4; ++i) { const LAS float* wp = wg + (i * 256 + 64 * j + lane) * 20;
                    const f32x4 w0 = *(const LAS f32x4*)(wp), w1 = *(const LAS f32x4*)(wp + 4), w2 = *(const LAS f32x4*)(wp + 8), w3 = *(const LAS f32x4*)(wp + 12);
#pragma unroll
                    for (int rr = 0; rr < 4; ++rr) { const float xv = xs[rr][i]; acc[rr * 4 + 0] += w0 * xv; acc[rr * 4 + 1] += w1 * xv; acc[rr * 4 + 2] += w2 * xv; acc[rr * 4 + 3] += w3 * xv; } }
            }
            float a[64];
#pragma unroll
            for (int i = 0; i < 16; ++i) { a[4 * i] = acc[i][0]; a[4 * i + 1] = acc[i][1]; a[4 * i + 2] = acc[i][2]; a[4 * i + 3] = acc[i][3]; }
#define TR_STEP(n) do { const bool hi_ = (lane & (n)) != 0; _Pragma("unroll") for (int i = 0; i < (n); ++i) { const float send = hi_ ? a[i] : a[i + (n)], keep = hi_ ? a[i + (n)] : a[i]; a[i] = keep + __shfl_xor(send, (n)); } } while (0)
            TR_STEP(32); TR_STEP(16); TR_STEP(8); TR_STEP(4); TR_STEP(2); TR_STEP(1);
#undef TR_STEP
            GK[(size_t)r0 * 16 + lane] = a[0];
        }
    }
}

__device__ __forceinline__ void gla_prep_unit(const Ctx& F, const Params& P, int b, int c, int h, size_t pgrp) {
    LAS float* gk_s = (LAS float*)(F.lds);
    LAS float* part = (LAS float*)(F.lds + 4096);
    const int tid = F.tid, d = tid & 127, g = tid >> 7;
    bf16* PROJ = (bf16*)(P.ws + R2); const float* GK = (const float*)(P.ws + R2_GK);
    float* BL = (float*)(P.ws + R0_BL);
    const float* wup = P.in[3]; const float* bgk = P.in[4];
    const int u = (b * 64 + c) * 4 + h;
    const size_t m0 = (size_t)b * SEQ + (size_t)c * 64;
    if (tid < 256) ((LAS f32x4*)gk_s)[tid] = *(const f32x4*)(GK + m0 * 16 + (size_t)tid * 4);
    bf16* qp = PROJ + (m0 + 16 * g) * PROJ_LD + h * 128 + d; bf16* kp = qp + 512;
    { const f32x4 a = *(const f32x4*)(P.in[1] + pgrp * 8), a2 = *(const f32x4*)(P.in[1] + pgrp * 8 + 4);
      u32x4 o; o.x = pk2(a[0], a[1]); o.y = pk2(a[2], a[3]); o.z = pk2(a2[0], a2[1]); o.w = pk2(a2[2], a2[3]); *(u32x4*)((bf16*)P.out + pgrp * 8) = o; }
    unsigned short qraw[16], kraw[16];
#pragma unroll
    for (int tt = 0; tt < 16; ++tt) { qraw[tt] = qp[(size_t)tt * PROJ_LD]; kraw[tt] = kp[(size_t)tt * PROJ_LD]; }
    float w[16];
#pragma unroll
    for (int r = 0; r < 16; ++r) w[r] = wup[r * 512 + h * 128 + d];
    const float bias = bgk[h * 128 + d];
    LBAR();
    float cs[16]; float run = 0.f;
#pragma unroll
    for (int tt = 0; tt < 16; ++tt) {
        const int t = 16 * g + tt; float z = bias;
#pragma unroll
        for (int r4 = 0; r4 < 4; ++r4) { const f32x4 a = ((const LAS f32x4*)gk_s)[t * 4 + r4]; z += a[0] * w[4 * r4] + a[1] * w[4 * r4 + 1] + a[2] * w[4 * r4 + 2] + a[3] * w[4 * r4 + 3]; }
        const float ls = fminf(z, 0.f) - __logf(1.0f + __expf(-fabsf(z)));
        run += ls * (1.0f / 16.0f); cs[tt] = run;
    }
    part[g * 128 + d] = run;
    LBAR();
    float off = 0.f, tot = 0.f;
#pragma unroll
    for (int gg = 0; gg < 4; ++gg) { const float pv = part[gg * 128 + d]; tot += pv; if (gg < g) off += pv; }
#pragma unroll
    for (int tt = 0; tt < 16; ++tt) {
        const float bc = cs[tt] + off;
        const float qv = bf2f(qraw[tt]), kv = bf2f(kraw[tt]);
        const float e1 = __expf(bc), e2 = __expf(-bc);
        qp[(size_t)tt * PROJ_LD] = (bf16)(pk2(qv * 0.08838834764831845f * e1, 0.f) & 0xffffu);
        kp[(size_t)tt * PROJ_LD] = (bf16)(pk2(kv * e2, 0.f) & 0xffffu);
    }
    if (g == 0) BL[(size_t)u * 128 + d] = tot;
    LBAR();
}

typedef short v4i16_t __attribute__((ext_vector_type(4)));
__device__ __forceinline__ s16x4 ldtr(const LAS unsigned char* p) { return __builtin_bit_cast(s16x4, __builtin_amdgcn_ds_read_tr16_b64_v4i16((LAS v4i16_t*)p)); }
constexpr int GS_Q = 0, GS_K = 17408, GS_V = 34816, GS_ATT = 68608, GS_RS = 77824, GS_RSTD = 79872, GS_BL = 80128;
constexpr size_t R0_SLOC = R1, R0_GSEG = R1 + 40 * MiB;
template <bool FULL>
__device__ __forceinline__ void gla_scan_pass(const Ctx& F, const Params& P) {
    LAS unsigned char* L = F.lds;
    const int tid = F.tid, lane = F.lane, w = F.wave, l15 = lane & 15, quad = lane >> 4;
    bf16* PROJ = (bf16*)(P.ws + R2);
    const float* BL = (const float*)(P.ws + R0_BL);
    float* SLOC = (float*)(P.ws + R0_SLOC); float* GSEG = (float*)(P.ws + R0_GSEG);
    const float* norm_g = P.in[5];
    for (int item = blockIdx.x; item < BATCH * 4 * 8; item += gridDim.x) {
        const int seg = item & 7, bh = item >> 3, b = bh >> 2, h = bh & 3;
        if (!FULL) {
#pragma unroll 1
            for (int cc = 0; cc < 8; ++cc) gla_prep_unit(F, P, b, seg * 8 + cc, h, ((size_t)(item * 8 + cc)) * 512 + tid);
            asm volatile("s_waitcnt vmcnt(0)" ::: "memory"); __builtin_amdgcn_s_barrier();
            __builtin_amdgcn_fence(__ATOMIC_ACQUIRE, "agent"); asm volatile("s_waitcnt vmcnt(0)" ::: "memory");
            __builtin_amdgcn_s_barrier(); asm volatile("" ::: "memory");
            if (seg == 7) continue;
        }
        f32x4 S[8][2];
#pragma unroll
        for (int dt = 0; dt < 8; ++dt) { S[dt][0] = (f32x4){0.f, 0.f, 0.f, 0.f}; S[dt][1] = (f32x4){0.f, 0.f, 0.f, 0.f}; }
        if (FULL) {
#pragma unroll 1
            for (int j = 0; j < seg; ++j) {
                const float* gj = GSEG + (size_t)(bh * 8 + j) * 128 + 4 * quad; const f32x4* sl = (const f32x4*)(SLOC + (size_t)(bh * 8 + j) * 32768) + tid;
#pragma unroll
                for (int dt = 0; dt < 8; ++dt) { const f32x4 gg = *(const f32x4*)(gj + 16 * dt);
                    f32x4 dec; dec[0] = __expf(gg[0]); dec[1] = __expf(gg[1]); dec[2] = __expf(gg[2]); dec[3] = __expf(gg[3]);
                    S[dt][0] = S[dt][0] * dec + sl[(dt * 2 + 0) * 512]; S[dt][1] = S[dt][1] * dec + sl[(dt * 2 + 1) * 512]; }
            }
        }
        float gsum = 0.f;
        u32x4 pq[2], pk[2], pv[4]; float pbl = 0.f;
#define GS_LOADC(cidx) do { const int u_ = (b * 64 + (cidx)) * 4 + h; const size_t m_ = (size_t)b * SEQ + (size_t)(cidx) * 64; int tl_ = tid; asm volatile("" : "+v"(tl_)); \
            _Pragma("unroll") for (int i = 0; i < 2; ++i) { const int idx = tl_ + 512 * i, row = idx >> 4, pc = idx & 15; const bf16* src = PROJ + (m_ + row) * PROJ_LD + h * 128 + pc * 8; \
                if (FULL) pq[i] = *(const u32x4*)(src); pk[i] = *(const u32x4*)(src + 512); } \
            _Pragma("unroll") for (int i = 0; i < 4; ++i) { const int idx = tl_ + 512 * i, row = idx >> 5, pc = idx & 31; pv[i] = *(const u32x4*)(PROJ + (m_ + row) * PROJ_LD + 1024 + h * 256 + pc * 8); } \
            if (tl_ < 128) pbl = BL[(size_t)u_ * 128 + tl_]; } while (0)
        GS_LOADC(seg * 8);
#pragma unroll 1
        for (int cc = 0; cc < 8; ++cc) {
            const int c = seg * 8 + cc;
            const size_t m0 = (size_t)b * SEQ + (size_t)c * 64;
#pragma unroll
            for (int i = 0; i < 2; ++i) { const int idx = tid + 512 * i, row = idx >> 4, pc = idx & 15;
                if (FULL) *(LAS u32x4*)(L + GS_Q + row * 272 + pc * 16) = pq[i];
                *(LAS u32x4*)(L + GS_K + row * 272 + pc * 16) = pk[i]; }
#pragma unroll
            for (int i = 0; i < 4; ++i) { const int idx = tid + 512 * i, row = idx >> 5, pc = idx & 31; *(LAS u32x4*)(L + GS_V + row * 528 + pc * 16) = pv[i]; }
            if (tid < 128) { ((LAS float*)(L + GS_BL))[tid] = pbl; gsum += pbl; }
            LBAR();
            if (cc < 7) GS_LOADC(c + 1);
            u32x2 rw[4][2];
            if (FULL) { const bf16* rp = PROJ + (m0 + l15) * PROJ_LD + 2048 + h * 256 + 32 * w + 4 * quad;
#pragma unroll
                for (int it = 0; it < 4; ++it) { rw[it][0] = *(const u32x2*)(rp); rw[it][1] = *(const u32x2*)(rp + 16); rp += 16 * PROJ_LD; asm volatile("" : "+v"(rp)); } }
#define GS_VF(dst) do { _Pragma("unroll") for (int s2 = 0; s2 < 2; ++s2) _Pragma("unroll") for (int et = 0; et < 2; ++et) { \
                const LAS unsigned char* a_ = L + GS_V + (32 * s2 + 8 * quad + (l15 >> 2)) * 528 + (32 * w + 16 * et) * 2 + 8 * (l15 & 3); \
                const s16x4 lo_ = ldtr(a_), hi_ = ldtr(a_ + 4 * 528); dst[s2][et] = __builtin_shufflevector(lo_, hi_, 0, 1, 2, 3, 4, 5, 6, 7); } } while (0)
            f32x4 o[4][2];
            if (FULL) {
                { const int it = w >> 1;
#pragma unroll
                  for (int x = 0; x < 2; ++x) { const int jt = 2 * (w & 1) + x; f32x4 a = (f32x4){0.f, 0.f, 0.f, 0.f};
                      if (jt <= it) {
#pragma unroll
                          for (int ks = 0; ks < 4; ++ks) { const bf16x8 kf = lds16(L + GS_K + (16 * jt + l15) * 272 + ks * 64 + quad * 16), qf = lds16(L + GS_Q + (16 * it + l15) * 272 + ks * 64 + quad * 16);
                              a = MFMA16(kf, qf, a); }
                          const int ii = 16 * it + l15, j0 = 16 * jt + 4 * quad;
#pragma unroll
                          for (int j = 0; j < 4; ++j) if (j0 + j > ii) a[j] = 0.f;
                      }
                      u32x2 ww; ww.x = pk2(a[0], a[1]); ww.y = pk2(a[2], a[3]);
                      *(LAS u32x2*)(L + GS_ATT + (16 * it + l15) * 144 + (16 * jt + 4 * quad) * 2) = ww; } }
                LBAR();
#pragma unroll
                for (int it = 0; it < 4; ++it) { o[it][0] = (f32x4){0.f, 0.f, 0.f, 0.f}; o[it][1] = (f32x4){0.f, 0.f, 0.f, 0.f}; }
#pragma unroll
                for (int s2 = 0; s2 < 4; ++s2) {
                    bf16x8 sf[2]; sf[0] = pack8(S[2 * s2][0], S[2 * s2 + 1][0]); sf[1] = pack8(S[2 * s2][1], S[2 * s2 + 1][1]);
#pragma unroll
                    for (int it = 0; it < 4; ++it) { const LAS unsigned char* qb = L + GS_Q + (16 * it + l15) * 272 + (32 * s2 + 4 * quad) * 2;
                        const bf16x8 qf = lds8x2(qb, qb + 32);
                        o[it][0] = MFMA16(sf[0], qf, o[it][0]); o[it][1] = MFMA16(sf[1], qf, o[it][1]); }
                }
                { bf16x8 vf[2][2]; GS_VF(vf);
#pragma unroll
                  for (int s2 = 0; s2 < 2; ++s2)
#pragma unroll
                    for (int it = 0; it < 4; ++it) { const bf16x8 af = lds16(L + GS_ATT + (16 * it + l15) * 144 + s2 * 64 + quad * 16);
                        o[it][0] = MFMA16(vf[s2][0], af, o[it][0]); o[it][1] = MFMA16(vf[s2][1], af, o[it][1]); } }
            }
            bf16x8 vf[2][2]; GS_VF(vf);
#pragma unroll
            for (int dt = 0; dt < 8; ++dt) {
                const f32x4 bl = *(const LAS f32x4*)(L + GS_BL + (16 * dt + 4 * quad) * 4);
                f32x4 dec; dec[0] = __expf(bl[0]); dec[1] = __expf(bl[1]); dec[2] = __expf(bl[2]); dec[3] = __expf(bl[3]);
#pragma unroll
                for (int s2 = 0; s2 < 2; ++s2) {
                    const LAS unsigned char* ka = L + GS_K + (32 * s2 + 8 * quad + (l15 >> 2)) * 272 + (16 * dt) * 2 + 8 * (l15 & 3);
                    const s16x4 klo = ldtr(ka), khi = ldtr(ka + 4 * 272); const bf16x8 kf = __builtin_shufflevector(klo, khi, 0, 1, 2, 3, 4, 5, 6, 7);
                    S[dt][0] = MFMA16(kf, vf[s2][0], S[dt][0]); S[dt][1] = MFMA16(kf, vf[s2][1], S[dt][1]); }
                S[dt][0] = S[dt][0] * dec; S[dt][1] = S[dt][1] * dec;
            }
            if (FULL) {
#pragma unroll
                for (int it = 0; it < 4; ++it) { float ss = 0.f;
#pragma unroll
                    for (int et = 0; et < 2; ++et) ss += (o[it][et][0] * o[it][et][0] + o[it][et][1] * o[it][et][1]) + (o[it][et][2] * o[it][et][2] + o[it][et][3] * o[it][et][3]);
                    ss += __shfl_xor(ss, 16); ss += __shfl_xor(ss, 32);
                    if (quad == 0) ((LAS float*)(L + GS_RS))[w * 64 + 16 * it + l15] = ss; }
            }
            LBAR();
            if (FULL) {
                if (tid < 64) { float t = 0.f;
#pragma unroll
                    for (int ww = 0; ww < 8; ++ww) t += ((const LAS float*)(L + GS_RS))[ww * 64 + tid];
                    ((LAS float*)(L + GS_RSTD))[tid] = 1.0f / sqrtf(t * (1.0f / 256.0f) + RMS_EPS); }
                LBAR();
#pragma unroll
                for (int it = 0; it < 4; ++it) { const float rs = ((const LAS float*)(L + GS_RSTD))[16 * it + l15];
#pragma unroll
                    for (int et = 0; et < 2; ++et) { const int e0 = 32 * w + 16 * et + 4 * quad;
                        bf16* wp = PROJ + (m0 + 16 * it + l15) * PROJ_LD + 2048 + h * 256 + e0;
                        const u32x2 r2 = rw[it][et]; const f32x4 gg = *(const f32x4*)(norm_g + e0);
                        float rv[4]; rv[0] = __uint_as_float(r2.x << 16); rv[1] = __uint_as_float(r2.x & 0xffff0000u); rv[2] = __uint_as_float(r2.y << 16); rv[3] = __uint_as_float(r2.y & 0xffff0000u);
                        float ov[4];
#pragma unroll
                        for (int j = 0; j < 4; ++j) ov[j] = o[it][et][j] * rs * gg[j] * (rv[j] * __builtin_amdgcn_rcpf(1.0f + __expf(-rv[j])));
                        u32x2 ow; ow.x = pk2(ov[0], ov[1]); ow.y = pk2(ov[2], ov[3]); *(u32x2*)wp = ow; } }
            }
        }
#undef GS_LOADC
#undef GS_VF
        if (!FULL) {
            f32x4* sl = (f32x4*)(SLOC + (size_t)(bh * 8 + seg) * 32768) + tid;
#pragma unroll
            for (int dt = 0; dt < 8; ++dt) { sl[(dt * 2 + 0) * 512] = S[dt][0]; sl[(dt * 2 + 1) * 512] = S[dt][1]; }
            if (tid < 128) GSEG[(size_t)(bh * 8 + seg) * 128 + tid] = gsum;
        }
        LBAR();
    }
}

__device__ __forceinline__ void gla_pass_a(const Ctx& F, const Params& P) {
    LAS unsigned char* L = F.lds;
    LAS float* gk_s = (LAS float*)(L);
    LAS float* part = (LAS float*)(L + 4096);
    const int tid = F.tid, lane = F.lane, w = F.wave, l15 = lane & 15, quad = lane >> 4, d = tid & 127, g = tid >> 7;
    bf16* PROJ = (bf16*)(P.ws + R2); const float* GK = (const float*)(P.ws + R2_GK);
    float* BL = (float*)(P.ws + R0_BL); float* SLOC = (float*)(P.ws + R0_SLOC); float* GSEG = (float*)(P.ws + R0_GSEG);
    for (int item = blockIdx.x; item < BATCH * 4 * 8; item += gridDim.x) {
        const int seg = item & 7, bh = item >> 3, b = bh >> 2, h = bh & 3;
        float wv[16];
#pragma unroll
        for (int r = 0; r < 16; ++r) wv[r] = P.in[3][r * 512 + h * 128 + d];
        const float bias = P.in[4][h * 128 + d];
        f32x4 S[8][2];
#pragma unroll
        for (int dt = 0; dt < 8; ++dt) { S[dt][0] = (f32x4){0.f, 0.f, 0.f, 0.f}; S[dt][1] = (f32x4){0.f, 0.f, 0.f, 0.f}; }
        float gsum = 0.f;
        u32x4 pv[4]; f32x4 gkn = (f32x4){0.f, 0.f, 0.f, 0.f};
#define PA_LOAD(cidx) do { const size_t m_ = (size_t)b * SEQ + (size_t)(cidx) * 64; int tl_ = tid; asm volatile("" : "+v"(tl_)); \
            _Pragma("unroll") for (int i = 0; i < 4; ++i) { const int idx = tl_ + 512 * i, row = idx >> 5, pc = idx & 31; pv[i] = *(const u32x4*)(PROJ + (m_ + row) * PROJ_LD + 1024 + h * 256 + pc * 8); } \
            if (tl_ < 256) gkn = *(const f32x4*)(GK + m_ * 16 + (size_t)tl_ * 4); } while (0)
        PA_LOAD(seg * 8);
#pragma unroll 1
        for (int cc = 0; cc < 8; ++cc) {
            const int c = seg * 8 + cc, u = (b * 64 + c) * 4 + h;
            const size_t m0 = (size_t)b * SEQ + (size_t)c * 64;
            if (tid < 256) ((LAS f32x4*)gk_s)[tid] = gkn;
#pragma unroll
            for (int i = 0; i < 4; ++i) { const int idx = tid + 512 * i, row = idx >> 5, pc = idx & 31; *(LAS u32x4*)(L + GS_V + row * 528 + pc * 16) = pv[i]; }
            bf16* qp = PROJ + (m0 + 16 * g) * PROJ_LD + h * 128 + d; bf16* kp = qp + 512;
            unsigned qk[16];
            { const bf16* rp = qp;
#pragma unroll
              for (int tt = 0; tt < 16; ++tt) { qk[tt] = (unsigned)rp[0] | ((unsigned)rp[512] << 16); rp += PROJ_LD; asm volatile("" : "+v"(rp)); } }
            { const size_t pgrp = ((size_t)(item * 8 + cc)) * 512 + tid;
              const f32x4 a = *(const f32x4*)(P.in[1] + pgrp * 8), a2 = *(const f32x4*)(P.in[1] + pgrp * 8 + 4);
              u32x4 o; o.x = pk2(a[0], a[1]); o.y = pk2(a[2], a[3]); o.z = pk2(a2[0], a2[1]); o.w = pk2(a2[2], a2[3]); *(u32x4*)((bf16*)P.out + pgrp * 8) = o; }
            LBAR();
            float cs[16]; float run = 0.f;
#pragma unroll
            for (int tt = 0; tt < 16; ++tt) {
                const int t = 16 * g + tt; float z = bias;
#pragma unroll
                for (int r4 = 0; r4 < 4; ++r4) { const f32x4 a = ((const LAS f32x4*)gk_s)[t * 4 + r4]; z += a[0] * wv[4 * r4] + a[1] * wv[4 * r4 + 1] + a[2] * wv[4 * r4 + 2] + a[3] * wv[4 * r4 + 3]; }
                const float ls = fminf(z, 0.f) - __logf(1.0f + __expf(-fabsf(z)));
                run += ls * (1.0f / 16.0f); cs[tt] = run;
                if ((tt & 1) == 1) asm volatile("" ::: "memory");
            }
            part[g * 128 + d] = run;
            LBAR();
            if (cc < 7) PA_LOAD(c + 1);
            float off = 0.f, tot = 0.f;
#pragma unroll
            for (int gg = 0; gg < 4; ++gg) { const float pvv = part[gg * 128 + d]; tot += pvv; if (gg < g) off += pvv; }
            bf16* wq = qp;
#pragma unroll
            for (int tt = 0; tt < 16; ++tt) {
                const float bc = cs[tt] + off;
                const float qv = __uint_as_float(qk[tt] << 16), kv = __uint_as_float(qk[tt] & 0xffff0000u);
                const float e1 = __expf(bc), e2 = __expf(-bc);
                wq[0] = (bf16)(pk2(qv * 0.08838834764831845f * e1, 0.f) & 0xffffu);
                const bf16 kt = (bf16)(pk2(kv * e2, 0.f) & 0xffffu);
                wq[512] = kt; wq += PROJ_LD; asm volatile("" : "+v"(wq));
                *(LAS bf16*)(L + GS_K + (16 * g + tt) * 272 + d * 2) = kt;
            }
            if (g == 0) { BL[(size_t)u * 128 + d] = tot; ((LAS float*)(L + GS_BL))[d] = tot; gsum += tot; }
            LBAR();
            if (seg < 7) {
                bf16x8 vf[2][2];
#pragma unroll
                for (int s2 = 0; s2 < 2; ++s2)
#pragma unroll
                    for (int et = 0; et < 2; ++et) { const LAS unsigned char* a_ = L + GS_V + (32 * s2 + 8 * quad + (l15 >> 2)) * 528 + (32 * w + 16 * et) * 2 + 8 * (l15 & 3);
                        const s16x4 lo_ = ldtr(a_), hi_ = ldtr(a_ + 4 * 528); vf[s2][et] = __builtin_shufflevector(lo_, hi_, 0, 1, 2, 3, 4, 5, 6, 7); }
#pragma unroll
                for (int dt = 0; dt < 8; ++dt) {
                    const f32x4 bl = *(const LAS f32x4*)(L + GS_BL + (16 * dt + 4 * quad) * 4);
                    f32x4 dec; dec[0] = __expf(bl[0]); dec[1] = __expf(bl[1]); dec[2] = __expf(bl[2]); dec[3] = __expf(bl[3]);
#pragma unroll
                    for (int s2 = 0; s2 < 2; ++s2) {
                        const LAS unsigned char* ka = L + GS_K + (32 * s2 + 8 * quad + (l15 >> 2)) * 272 + (16 * dt) * 2 + 8 * (l15 & 3);
                        const s16x4 klo = ldtr(ka), khi = ldtr(ka + 4 * 272); const bf16x8 kf = __builtin_shufflevector(klo, khi, 0, 1, 2, 3, 4, 5, 6, 7);
                        S[dt][0] = MFMA16(kf, vf[s2][0], S[dt][0]); S[dt][1] = MFMA16(kf, vf[s2][1], S[dt][1]); }
                    S[dt][0] = S[dt][0] * dec; S[dt][1] = S[dt][1] * dec;
                }
            }
            LBAR();
        }
#undef PA_LOAD
        if (seg < 7) {
            f32x4* sl = (f32x4*)(SLOC + (size_t)(bh * 8 + seg) * 32768) + tid;
#pragma unroll
            for (int dt = 0; dt < 8; ++dt) { sl[(dt * 2 + 0) * 512] = S[dt][0]; sl[(dt * 2 + 1) * 512] = S[dt][1]; }
            if (tid < 128) GSEG[(size_t)(bh * 8 + seg) * 128 + tid] = gsum;
        }
    }
}

constexpr int SW_K = 0, SW_V = 36864;
__device__ __forceinline__ void swa_phase(const Ctx& F, const Params& P) {
    LAS unsigned char* L = F.lds;
    const int tid = F.tid, lane = F.lane, w = F.wave, l15 = lane & 15, quad = lane >> 4;
    const bf16* QKV = (const bf16*)(P.ws + R2_QKV); bf16* AO = (bf16*)(P.ws + R0);
    const float* sinks = P.in[9];
    constexpr int NU = BATCH * 32 * 4;
    u32x4 kv[4], vv[4];
#define SW_LOAD(uu) do { const int kvh_ = (uu) & 3, n_ = ((uu) >> 2) & 31, b_ = (uu) >> 7; const long mb_ = (long)b_ * SEQ + (long)n_ * 128; \
        _Pragma("unroll") for (int i = 0; i < 4; ++i) { const int idx = tid + 512 * i, jj = idx >> 3, pc = idx & 7; \
            kv[i] = (u32x4){0u, 0u, 0u, 0u}; vv[i] = (u32x4){0u, 0u, 0u, 0u}; \
            if (n_ > 0 || jj >= 128) { const bf16* src = QKV + (size_t)(mb_ - 128 + jj) * QKV_LD + 1024 + kvh_ * 64 + pc * 8; kv[i] = *(const u32x4*)(src); vv[i] = *(const u32x4*)(src + 256); } } } while (0)
#define SW_QBASE(uu) (QKV + (size_t)((long)((uu) >> 7) * SEQ + (long)(((uu) >> 2) & 31) * 128 + 64 * (w & 1) + l15) * QKV_LD + (((uu) & 3) * 4 + (w >> 1)) * 64 + quad * 8)
    bf16x8 qc0 = (bf16x8){0, 0, 0, 0, 0, 0, 0, 0}, qc1 = qc0;
    if ((int)blockIdx.x < NU) { SW_LOAD((int)blockIdx.x); const bf16* q0p = SW_QBASE((int)blockIdx.x); qc0 = *(const bf16x8*)(q0p); qc1 = *(const bf16x8*)(q0p + 32); }
    for (int u = blockIdx.x; u < NU; u += gridDim.x) {
        const int kvh = u & 3, n = (u >> 2) & 31, b = u >> 7;
        const long mb = (long)b * SEQ + (long)n * 128;
        const int g = w >> 1, hq = kvh * 4 + g;
        const int un = (u + (int)gridDim.x < NU) ? u + (int)gridDim.x : u;
        const bf16* qbase = SW_QBASE(u);
        const bf16* qnext = SW_QBASE(un);
#pragma unroll
        for (int i = 0; i < 2; ++i) { const size_t pg = (size_t)u * 1024 + tid + 512 * i; const float* src = P.in[1] + (size_t)M * PLE + pg * 8;
            const f32x4 a = *(const f32x4*)(src), a2 = *(const f32x4*)(src + 4);
            u32x4 o; o.x = pk2(a[0], a[1]); o.y = pk2(a[2], a[3]); o.z = pk2(a2[0], a2[1]); o.w = pk2(a2[2], a2[3]); *(u32x4*)((bf16*)(P.ws + PB1_OFF) + pg * 8) = o; }
        LBAR();
#pragma unroll
        for (int i = 0; i < 4; ++i) { const int idx = tid + 512 * i, jj = idx >> 3, pc = idx & 7;
            *(LAS u32x4*)(L + SW_K + jj * 144 + pc * 16) = kv[i]; *(LAS u32x4*)(L + SW_V + jj * 144 + pc * 16) = vv[i]; }
        LBAR();
        if (un != u) SW_LOAD(un);
        const float sink = sinks[hq];
#pragma unroll 1
        for (int qt = 0; qt < 4; ++qt) {
            const int q0 = 64 * (w & 1) + 16 * qt, kt0 = q0 >> 4, qi = q0 + l15;
            const bf16* qn = (qt < 3) ? qbase + (size_t)(16 * (qt + 1)) * QKV_LD : qnext;
            const bf16x8 qn0 = *(const bf16x8*)(qn), qn1 = *(const bf16x8*)(qn + 32);
            f32x4 sc[9];
#pragma unroll
            for (int t = 0; t < 9; ++t) { const LAS unsigned char* kb = L + SW_K + (16 * (kt0 + t) + l15) * 144 + quad * 16;
                f32x4 a = (f32x4){0.f, 0.f, 0.f, 0.f}; a = MFMA16(lds16(kb), qc0, a); a = MFMA16(lds16(kb + 64), qc1, a); sc[t] = a; }
            constexpr float C2 = 0.125f * 1.4426950408889634f;
            const float sink2 = sink * 1.4426950408889634f;
#pragma unroll
            for (int j = 0; j < 4; ++j) { if (!(4 * quad + j > l15)) sc[0][j] = -INFINITY; if (!(4 * quad + j <= l15)) sc[8][j] = -INFINITY; }
            float mraw = -INFINITY;
#pragma unroll
            for (int t = 0; t < 9; ++t)
#pragma unroll
                for (int j = 0; j < 4; ++j) mraw = fmaxf(mraw, sc[t][j]);
            mraw = fmaxf(mraw, __shfl_xor(mraw, 16)); mraw = fmaxf(mraw, __shfl_xor(mraw, 32));
            const float m2 = fmaxf(mraw * C2, sink2);
            float den = 0.f;
#pragma unroll
            for (int t = 0; t < 9; ++t)
#pragma unroll
                for (int j = 0; j < 4; ++j) { const float p = __builtin_amdgcn_exp2f(sc[t][j] * C2 - m2); sc[t][j] = p; den += p; }
            den += __shfl_xor(den, 16); den += __shfl_xor(den, 32);
            den += __builtin_amdgcn_exp2f(sink2 - m2);
            const float rden = __builtin_amdgcn_rcpf(den);
            f32x4 ot[4];
#pragma unroll
            for (int dt = 0; dt < 4; ++dt) ot[dt] = (f32x4){0.f, 0.f, 0.f, 0.f};
#pragma unroll
            for (int s2 = 0; s2 < 5; ++s2) {
                const f32x4 z4 = (f32x4){0.f, 0.f, 0.f, 0.f};
                const bf16x8 pf = pack8(sc[2 * s2], (s2 < 4) ? sc[(2 * s2 + 1 < 9) ? 2 * s2 + 1 : 8] : z4);
                const int ka = 16 * (kt0 + 2 * s2), kb2 = (s2 < 4) ? ka + 16 : ka;
#pragma unroll
                for (int dt = 0; dt < 4; ++dt) { const LAS unsigned char* vb = L + SW_V + (4 * quad + (l15 >> 2)) * 144 + 32 * dt + 8 * (l15 & 3);
                    const s16x4 lo = ldtr(vb + ka * 144), hi = ldtr(vb + kb2 * 144);
                    const bf16x8 vf = __builtin_shufflevector(lo, hi, 0, 1, 2, 3, 4, 5, 6, 7);
                    ot[dt] = MFMA16(vf, pf, ot[dt]); }
            }
            bf16* op = AO + (size_t)(mb + qi) * D + hq * 64 + 4 * quad;
#pragma unroll
            for (int dt = 0; dt < 4; ++dt) { u32x2 ow; ow.x = pk2(ot[dt][0] * rden, ot[dt][1] * rden); ow.y = pk2(ot[dt][2] * rden, ot[dt][3] * rden); *(u32x2*)(op + 16 * dt) = ow; }
            qc0 = qn0; qc1 = qn1;
        }
    }
    LBAR();
#undef SW_LOAD
#undef SW_QBASE
}

#define XB_TMO      128
#define XB_XCNT(j)  (256  + 64 * (j))
#define XB_XSUB(j)  (1280 + 64 * (j))
#define XB_XGEN(j)  (2304 + 64 * (j))
#define XB_TOP      3328
#define XB_TOPGEN   3392
#define XCD_BAR_WORDS 3456
#define XB_SPIN_CAP (1u << 18)

__device__ __forceinline__ unsigned xb_ld(unsigned* p)              { return __hip_atomic_load(p, __ATOMIC_RELAXED, __HIP_MEMORY_SCOPE_AGENT); }
__device__ __forceinline__ unsigned xb_add(unsigned* p, unsigned v) { return __hip_atomic_fetch_add(p, v, __ATOMIC_RELAXED, __HIP_MEMORY_SCOPE_AGENT); }
__device__ __forceinline__ unsigned xb_xcc_id() { return (unsigned)__builtin_amdgcn_s_getreg((3 << 11) | 20) & 0xFu; }
#define XB_SPIN(cond, bar) do { unsigned _sp = 0; while (cond) { __builtin_amdgcn_s_sleep(1); \
    if ((++_sp & 255u) == 0u) { if (xb_ld(&(bar)[XB_TMO])) break; if (_sp > XB_SPIN_CAP) { atomicAdd(&(bar)[XB_TMO], 1u); break; } } } } while (0)

struct XcdBarrier {
    unsigned* bar; unsigned x;
    volatile LAS unsigned* st;
};

__device__ __forceinline__ XcdBarrier xcd_barrier_post(unsigned* bar, volatile LAS unsigned* st) {
    XcdBarrier b; b.bar = bar; b.x = xb_xcc_id(); b.st = st;
    if (threadIdx.x == 0) (void)xb_add(&bar[XB_XCNT(b.x)], 1u);
    return b;
}
__device__ __forceinline__ void xcd_barrier_complete(unsigned* bar, unsigned x, unsigned& nloc, unsigned& nx) {
    const unsigned G = gridDim.x * gridDim.y * gridDim.z;
    unsigned sum, cnt, mine, sp = 0u;
    for (;;) {
        sum = 0u; cnt = 0u; mine = 0u;
#pragma unroll
        for (unsigned j = 0; j < 16; ++j) { const unsigned c = xb_ld(&bar[XB_XCNT(j)]); sum += c; cnt += (c > 0u) ? 1u : 0u; mine = (j == x) ? c : mine; }
        if (sum == G) break;
        __builtin_amdgcn_s_sleep(1);
        if ((++sp & 255u) == 0u) { if (xb_ld(&bar[XB_TMO])) break; if (sp > XB_SPIN_CAP) { atomicAdd(&bar[XB_TMO], 1u); break; } }
    }
    nloc = mine > 0u ? mine : 1u; nx = cnt > 0u ? cnt : 1u;
}

__device__ __forceinline__ void xcd_barrier(const XcdBarrier& b) {
    asm volatile("s_waitcnt vmcnt(0)" ::: "memory");
    __syncthreads();
    if (threadIdx.x == 0) {
        unsigned* bar = b.bar;
        __builtin_amdgcn_s_waitcnt(0);
        unsigned nloc = b.st[0], nx = b.st[1];
        if (nloc == 0u) { xcd_barrier_complete(bar, b.x, nloc, nx); b.st[0] = nloc; b.st[1] = nx; }
        const unsigned old = xb_add(&bar[XB_XSUB(b.x)], 1u);
        const unsigned gen = old / nloc;
        if (old + 1u == (gen + 1u) * nloc) {
            __builtin_amdgcn_fence(__ATOMIC_RELEASE, "agent");
            asm volatile("s_waitcnt vmcnt(0)" ::: "memory");
            const unsigned og = xb_add(&bar[XB_TOP], 1u);
            const unsigned tg = og / nx;
            if (og + 1u == (tg + 1u) * nx) xb_add(&bar[XB_TOPGEN], 1u);
            else XB_SPIN(xb_ld(&bar[XB_TOPGEN]) == tg, bar);
            __builtin_amdgcn_fence(__ATOMIC_ACQUIRE, "agent");
            xb_add(&bar[XB_XGEN(b.x)], 1u);
            asm volatile("s_waitcnt vmcnt(0)" ::: "memory");
        } else {
            XB_SPIN(xb_ld(&bar[XB_XGEN(b.x)]) == gen, bar);
            __builtin_amdgcn_fence(__ATOMIC_ACQUIRE, "agent");
            asm volatile("s_waitcnt vmcnt(0)" ::: "memory");
        }
    }
    __syncthreads();
}

__global__ void __launch_bounds__(NTHREADS, 2) mega_fwd(Params P) {
    extern __shared__ __attribute__((aligned(16))) unsigned char lds_raw[];
    cg::grid_group grid = cg::this_grid();
    Ctx F; F.lds = (LAS unsigned char*)lds_raw;
#define GSYNC() do { XcdBarrier b2_ = bar; unsigned long long bp_ = (unsigned long long)b2_.bar; unsigned bx_ = __builtin_amdgcn_readfirstlane(b2_.x); asm volatile("" : "+s"(bp_), "+s"(bx_)); b2_.bar = (unsigned*)bp_; b2_.x = bx_; xcd_barrier(b2_); } while (0)
#define REFRESH() do { int t_ = threadIdx.x; asm volatile("" : "+v"(t_)); F.tid = t_; F.lane = t_ & 63; F.wave = __builtin_amdgcn_readfirstlane(t_ >> 6); } while (0)
    REFRESH();
    unsigned char* ws = P.ws;
    const int G = gridDim.x, cid = blockIdx.x;
    volatile LAS unsigned* MISC = (volatile LAS unsigned*)(F.lds + 131072 + 320);
    if (threadIdx.x < 32) MISC[threadIdx.x] = 0u;
    __syncthreads();
    if (cid == 0) for (int i = threadIdx.x; i < XCD_BAR_WORDS; i += NTHREADS) __hip_atomic_store((unsigned*)(ws) + 1024 + i, 0u, __ATOMIC_RELAXED, __HIP_MEMORY_SCOPE_AGENT);
    grid.sync();
    XcdBarrier bar = xcd_barrier_post((unsigned*)(ws) + 1024, MISC + 8);
    bf16* A16 = (bf16*)(ws + R0); bf16* U16 = (bf16*)(ws + R2);
    bf16* Y1B = (bf16*)(ws + R1); bf16* Y2B = (bf16*)(ws + R1 + 64 * MiB); bf16* H3B = (bf16*)(ws + R2_H3B);
    float* ST1 = (float*)(ws + 504 * MiB); float* ST2 = (float*)(ws + 508 * MiB);
    LAS float* SX = (LAS float*)(F.lds + 131072 + 1024);

    p0_prologue(F, P);
    GSYNC();
    {
        pg8::Gemm g{A16, (const bf16*)(ws + W_IN_T), M, PROJ_LD, opq(D), D, D}; pg8::StaticOrder S; S.init(M, PROJ_LD, G, cid);
        pg8::EpiBf16 E{U16, PROJ_LD, nullptr, 1 << 30, nullptr};
        pg8::gemm_phase<pg8::EpiBf16, pg8::StaticOrder, true, true>(F.lds, g, S, E, SX);
    }
    GSYNC();
    REFRESH(); gla_pass_a(F, P);
    fold_finalize(P, cid * NTHREADS + F.tid, G * NTHREADS);
    GSYNC();
    REFRESH(); gla_scan_pass<true>(F, P);
    GSYNC();
#pragma unroll 1
    for (int layer = 0; layer < 2; ++layer) {
        const float* fin = (const float*)(ws + FIN(0)) + (size_t)layer * (64 * 1024 / 4);
        if (layer == 1) {
            {
                pg8::Gemm g{H3B, (const bf16*)(ws + W_QKV_T), M, QKV_LD, opq(D), D, D}; pg8::StaticOrder S; S.init(M, QKV_LD, G, cid);
                pg8::EpiBf16 E{(bf16*)(ws + R2_QKV), QKV_LD, P.in[8], 1 << 30, nullptr};
                pg8::gemm_phase<pg8::EpiBf16, pg8::StaticOrder, true, true>(F.lds, g, S, E, SX);
            }
            GSYNC();
            REFRESH(); swa_phase(F, P);
            GSYNC();
        }
        {
            const bf16* A = layer == 0 ? (const bf16*)(ws + R2) + 2048 : (const bf16*)A16;
            pg8::Gemm g{A, (const bf16*)(ws + (layer == 0 ? W_GOUT_T : W_SOUT_T)), M, D, opq(D), layer == 0 ? PROJ_LD : D, D}; pg8::StaticOrder S; S.init(M, D, G, cid);
            pg8::EpiY<false> E{layer == 0 ? (const void*)A16 : (const void*)H3B, 1, layer == 0 ? nullptr : P.in[11], nullptr, nullptr, nullptr, Y1B, ST1, ALPHA};
            pg8::gemm_phase<pg8::EpiY<false>, pg8::StaticOrder, true, true>(F.lds, g, S, E, SX);
        }
        GSYNC();
        {
            pg8::Gemm g{Y1B, (const bf16*)(ws + W_UP_T + (size_t)layer * W_LSTRIDE), M, FF, opq(D), D, D}; pg8::StaticOrder S; S.init(M, FF, G, cid);
            pg8::EpiUpLN E{ST1, fin, fin + 4096, U16, FF};
            pg8::gemm_phase<pg8::EpiUpLN, pg8::StaticOrder, true, true>(F.lds, g, S, E, SX);
        }
        GSYNC();
        {
            pg8::Gemm g{U16, (const bf16*)(ws + W_DN_T + (size_t)layer * W_LSTRIDE), M, D, opq(FF), FF, FF}; pg8::StaticOrder S; S.init(M, D, G, cid);
            pg8::EpiY<true> E{(const void*)Y1B, 1, nullptr, P.in[14] + layer * D, P.in[15] + layer * D, ST1, Y2B, ST2, ALPHA};
            pg8::gemm_phase<pg8::EpiY<true>, pg8::StaticOrder, true, true>(F.lds, g, S, E, SX);
        }
        GSYNC();
        {
            int kpp = opq(PLE); pg8::Gemm g{layer == 0 ? (const bf16*)P.out : (const bf16*)(ws + PB1_OFF), (const bf16*)(ws + W_PP_T + (size_t)layer * W_LSTRIDE), M, D, kpp, kpp, kpp}; pg8::StaticOrder S; S.init(M, D, G, cid);
            pg8::EpiPP E{(bf16*)(ws + R2_PP), D};
            pg8::gemm_phase<pg8::EpiPP, pg8::StaticOrder, true, true>(F.lds, g, S, E, SX);
        }
        __syncthreads();
        {
            pg8::Gemm g{Y2B, (const bf16*)(ws + W_GATE_T + (size_t)layer * W_LSTRIDE), M, D, opq(D), D, D}; pg8::StaticOrder S; S.init(M, D, G, cid);
            pg8::EpiGateLN E{ST2, Y2B, (const bf16*)(ws + R2_PP), fin + 8192, fin + 9216, P.in[16] + layer * D, P.in[17] + layer * D, P.out, layer == 0 ? H3B : nullptr};
            pg8::gemm_phase<pg8::EpiGateLN, pg8::StaticOrder, true, true>(F.lds, g, S, E, SX);
        }
        if (layer == 0) GSYNC();
    }
}

extern "C" void kernel_launch(void* const* d_in, const int* in_sizes, int n_in, void* d_out, int out_size, void* d_ws, size_t ws_size, hipStream_t stream) {
    static int grid = 0;
    if (grid == 0) {
        if (n_in != 21 || in_sizes[0] != M * D || out_size != M * D || ws_size < WS_END) { fprintf(stderr, "kernel_launch: unexpected shapes (n_in %d, in0 %d, out %d, ws %zu)\n", n_in, n_in > 0 ? in_sizes[0] : -1, out_size, ws_size); grid = -1; return; }
        int dev = 0, cus = 0, per_cu = 0;
        hipGetDevice(&dev); hipDeviceGetAttribute(&cus, hipDeviceAttributeMultiprocessorCount, dev);
        if (hipFuncSetAttribute((const void*)mega_fwd, hipFuncAttributeMaxDynamicSharedMemorySize, LDS_BYTES) != hipSuccess) { fprintf(stderr, "kernel_launch: hipFuncSetAttribute failed\n"); grid = -1; return; }
        if (hipOccupancyMaxActiveBlocksPerMultiprocessor(&per_cu, (const void*)mega_fwd, NTHREADS, LDS_BYTES) != hipSuccess || per_cu < 1) { fprintf(stderr, "kernel_launch: occupancy query says %d\n", per_cu); (void)hipGetLastError(); per_cu = 1; }
        grid = cus * 1;
        if (grid <= 0) grid = 256;
    }
    if (grid < 0) return;
    Params p{};
    for (int i = 0; i < 21; ++i) p.in[i] = (const float*)d_in[i];
    p.out = (float*)d_out; p.ws = (unsigned char*)d_ws;
    void* args[] = {&p};
    hipError_t e = hipLaunchCooperativeKernel((const void*)mega_fwd, dim3(grid), dim3(NTHREADS), args, LDS_BYTES, stream);
    if (e != hipSuccess) fprintf(stderr, "cooperative launch failed: %s (grid %d)\n", hipGetErrorString(e), grid);
}
```

```cpp
#include <hip/hip_runtime.h>
#include <hip/hip_cooperative_groups.h>
#include <cstdio>
#include <cstdint>
namespace cg = cooperative_groups;
namespace pg8 {
#define PG8_LAS __attribute__((address_space(3)))
typedef unsigned short bf16_t;
typedef short bf16x8 __attribute__((ext_vector_type(8)));
typedef float f32x4 __attribute__((ext_vector_type(4)));
typedef unsigned u32x4 __attribute__((ext_vector_type(4)));
constexpr int BM = 256, BK = 64, HALF = 128, HTB = HALF * BK * 2  , STAGE_BYTES = 8 * HTB, NXCD = 8, WGM = 8;

__host__ __device__ __forceinline__ int lds_byte(int r, int c) { const int st = (r >> 4) * 2 + (c >> 5), rr = r & 15, cc = c & 31, ob = rr * 64 + cc * 2; return st * 1024 + (ob ^ (((ob >> 9) & 1) << 5)); }
__host__ __device__ __forceinline__ void stage_rc(int b, int& R, int& C) { const int st = b / 1024, sb = b % 1024, swz = sb ^ (((sb >> 9) & 1) << 5); R = (st >> 1) * 16 + swz / 64; C = (st & 1) * 32 + (swz % 64) / 2; }
__host__ __device__ __forceinline__ int perm32(int rho) { const int n = rho >> 4, i = rho & 15; return 8 * (i >> 2) + 4 * n + (i & 3); }

struct Unit { int pm, pn; };
struct Gemm { const bf16_t* A; const bf16_t* Bt; int M, N, K, lda, ldb; };

struct StaticOrder {
    int nM, nN, nwg, G, c;
    __host__ __device__ void init(int M, int N, int G_, int c_) { nM = M / BM; nN = N / BM; nwg = nM * nN; G = G_; c = c_; }
    __host__ __device__ bool next(int i, Unit& u) const {
        const long L = (long)i * G + c; if (L >= nwg) return false;
        int wgid = (int)L; { const int q = nwg / NXCD, r = nwg % NXCD, xcd = wgid % NXCD, off = wgid / NXCD; wgid = (xcd < r ? xcd * (q + 1) : r * (q + 1) + (xcd - r) * q) + off; }
        const int nig = WGM * nN, gid = wgid / nig, fm = gid * WGM, gsz = (nM - fm) < WGM ? (nM - fm) : WGM;
        u.pm = fm + ((wgid % nig) % gsz); u.pn = (wgid % nig) / gsz; return true;
    }
    __device__ __forceinline__ void a_ready(const Unit&) const {}
    __device__ __forceinline__ void done(const Unit&) const {}
};


__device__ __forceinline__ unsigned cvt_pk_bf16(float lo, float hi) { unsigned r; asm volatile("v_cvt_pk_bf16_f32 %0, %1, %2" : "=v"(r) : "v"(lo), "v"(hi)); return r; }
typedef unsigned u32x2 __attribute__((ext_vector_type(2)));
typedef float f32x2 __attribute__((ext_vector_type(2)));
__device__ __forceinline__ float bf2f(unsigned short b) { return __uint_as_float(((unsigned)b) << 16); }
__device__ __forceinline__ void unpack8(const u32x4 w, float (&v)[8]) {
    v[0] = __uint_as_float(w.x << 16); v[1] = __uint_as_float(w.x & 0xffff0000u); v[2] = __uint_as_float(w.y << 16); v[3] = __uint_as_float(w.y & 0xffff0000u);
    v[4] = __uint_as_float(w.z << 16); v[5] = __uint_as_float(w.z & 0xffff0000u); v[6] = __uint_as_float(w.w << 16); v[7] = __uint_as_float(w.w & 0xffff0000u);
}
constexpr float EPI_LN_EPS = 1e-5f;
__device__ __forceinline__ void stats_pre(const float* ST, int pm, int slot, int tid, PG8_LAS float* sx) {
    if (tid < 256) {
        const f32x4* p = (const f32x4*)(ST + (size_t)(pm * BM + tid) * 32); float s = 0.f, q = 0.f;
#pragma unroll
        for (int i = 0; i < 8; ++i) { const f32x4 v = p[i]; s += v[0] + v[2]; q += v[1] + v[3]; }
        const float mean = s * (1.0f / 1024.0f), var = fmaxf(q * (1.0f / 1024.0f) - mean * mean, 0.f);
        *(PG8_LAS f32x2*)(sx + (slot * 256 + tid) * 2) = (f32x2){mean, 1.0f / sqrtf(var + EPI_LN_EPS)};
    }
}

struct EpiBf16 {
    static constexpr bool PERM = true, AFTER_DRAIN = false;
    bf16_t* O; int ldc; const float* bias; int gk_tile; float* GK;
    __device__ __forceinline__ void pre(const Unit&, int, int, PG8_LAS float*) const {}
    __device__ __forceinline__ void operator()(const f32x4 (&acc)[2][2][4][2], const Unit& u, int wr, int wc, int fr, int fq, int, PG8_LAS float*) const {
        const int row0 = u.pm * BM + wr * 64 + fr;
        if (u.pn >= gk_tile) {
            if (wc == 0 && fq < 2) {
#pragma unroll
                for (int ai = 0; ai < 2; ++ai)
#pragma unroll
                    for (int m = 0; m < 4; ++m) { float* gp = GK + (size_t)(row0 + ai * HALF + m * 16) * 16 + 8 * fq;
                        *(f32x4*)(gp) = acc[ai][0][m][0]; *(f32x4*)(gp + 4) = acc[ai][0][m][1]; }
            }
            return;
        }
        const int col0 = u.pn * BM + wc * 32 + 8 * fq;
#pragma unroll
        for (int bj = 0; bj < 2; ++bj) {
            f32x4 b0 = (f32x4){0.f, 0.f, 0.f, 0.f}, b1 = b0;
            if (bias) { b0 = *(const f32x4*)(bias + col0 + bj * HALF); b1 = *(const f32x4*)(bias + col0 + bj * HALF + 4); }
#pragma unroll
            for (int ai = 0; ai < 2; ++ai)
#pragma unroll
                for (int m = 0; m < 4; ++m) { const f32x4 v0 = acc[ai][bj][m][0] + b0, v1 = acc[ai][bj][m][1] + b1;
                    u32x4 w; w.x = cvt_pk_bf16(v0[0], v0[1]); w.y = cvt_pk_bf16(v0[2], v0[3]); w.z = cvt_pk_bf16(v1[0], v1[1]); w.w = cvt_pk_bf16(v1[2], v1[3]);
                    *(u32x4*)(O + (size_t)(row0 + ai * HALF + m * 16) * ldc + col0 + bj * HALF) = w; } }
    }
};

template <bool LN> struct EpiY {
    static constexpr bool PERM = true, AFTER_DRAIN = false;
    const void* res; int res_bf16; const float* bias; const float* g; const float* b; const float* ST_IN; bf16_t* Y; float* ST; float alpha;
    __device__ __forceinline__ void pre(const Unit& u, int slot, int tid, PG8_LAS float* sx) const { if (LN) stats_pre(ST_IN, u.pm, slot, tid, sx); }
    __device__ __forceinline__ void operator()(const f32x4 (&acc)[2][2][4][2], const Unit& u, int wr, int wc, int fr, int fq, int slot, PG8_LAS float* sx) const {
        const int col0 = u.pn * BM + wc * 32 + 8 * fq, rl0 = wr * 64 + fr; const size_t roff0 = (size_t)(u.pm * BM + rl0) * 1024;
        const bf16_t* R = (const bf16_t*)res;
        float ps[8], pq[8];
#pragma unroll
        for (int r = 0; r < 8; ++r) { ps[r] = 0.f; pq[r] = 0.f; }
#pragma unroll
        for (int bj = 0; bj < 2; ++bj) { const int c = col0 + bj * HALF;
            u32x4 rr[8];
#pragma unroll
            for (int r = 0; r < 8; ++r) rr[r] = *(const u32x4*)(R + roff0 + (size_t)((r >> 2) * HALF + (r & 3) * 16) * 1024 + c);
            f32x4 g0, g1, b0, b1, bb0, bb1;
            if (LN) { g0 = *(const f32x4*)(g + c); g1 = *(const f32x4*)(g + c + 4); b0 = *(const f32x4*)(b + c); b1 = *(const f32x4*)(b + c + 4); }
            if (bias) { bb0 = *(const f32x4*)(bias + c); bb1 = *(const f32x4*)(bias + c + 4); }
#pragma unroll
            for (int r = 0; r < 8; ++r) { const int ai = r >> 2, m = r & 3, rl = rl0 + ai * HALF + m * 16;
                float rv[8]; unpack8(rr[r], rv);
                if (LN) { const f32x2 mr = *(const PG8_LAS f32x2*)(sx + (slot * 256 + rl) * 2);
#pragma unroll
                    for (int i = 0; i < 4; ++i) { rv[i] = (rv[i] - mr[0]) * mr[1] * g0[i] + b0[i]; rv[4 + i] = (rv[4 + i] - mr[0]) * mr[1] * g1[i] + b1[i]; } }
                f32x4 v0 = acc[ai][bj][m][0], v1 = acc[ai][bj][m][1];
                if (bias) { v0 += bb0; v1 += bb1; }
                float y[8];
#pragma unroll
                for (int i = 0; i < 4; ++i) { y[i] = alpha * rv[i] + v0[i]; y[4 + i] = alpha * rv[4 + i] + v1[i]; }
                u32x4 w; w.x = cvt_pk_bf16(y[0], y[1]); w.y = cvt_pk_bf16(y[2], y[3]); w.z = cvt_pk_bf16(y[4], y[5]); w.w = cvt_pk_bf16(y[6], y[7]);
                *(u32x4*)(Y + roff0 + (size_t)(ai * HALF + m * 16) * 1024 + c) = w;
                float yr[8]; unpack8(w, yr);
#pragma unroll
                for (int i = 0; i < 8; ++i) { ps[r] += yr[i]; pq[r] += yr[i] * yr[i]; } }
        }
#pragma unroll
        for (int r = 0; r < 8; ++r) { float a = ps[r], q = pq[r];
            a += __shfl_xor(a, 16); a += __shfl_xor(a, 32); q += __shfl_xor(q, 16); q += __shfl_xor(q, 32);
            if (fq == 0) *(f32x2*)(ST + (size_t)(u.pm * BM + rl0 + (r >> 2) * HALF + (r & 3) * 16) * 32 + (u.pn * 4 + wc) * 2) = (f32x2){a, q}; }
    }
};

struct EpiUpLN {
    static constexpr bool PERM = true, AFTER_DRAIN = false;
    const float* ST_IN; const float* colsum; const float* bw; bf16_t* O; int ldc;
    __device__ __forceinline__ void pre(const Unit& u, int slot, int tid, PG8_LAS float* sx) const { stats_pre(ST_IN, u.pm, slot, tid, sx); }
    __device__ __forceinline__ void operator()(const f32x4 (&acc)[2][2][4][2], const Unit& u, int wr, int wc, int fr, int fq, int slot, PG8_LAS float* sx) const {
        const int col0 = u.pn * BM + wc * 32 + 8 * fq, rl0 = wr * 64 + fr;
#pragma unroll
        for (int bj = 0; bj < 2; ++bj) { const int c = col0 + bj * HALF;
            const f32x4 c0 = *(const f32x4*)(colsum + c), c1 = *(const f32x4*)(colsum + c + 4), w0 = *(const f32x4*)(bw + c), w1 = *(const f32x4*)(bw + c + 4);
#pragma unroll
            for (int r = 0; r < 8; ++r) { const int ai = r >> 2, m = r & 3, rl = rl0 + ai * HALF + m * 16;
                const f32x2 mr = *(const PG8_LAS f32x2*)(sx + (slot * 256 + rl) * 2);
                f32x4 v0 = (acc[ai][bj][m][0] - c0 * mr[0]) * mr[1] + w0, v1 = (acc[ai][bj][m][1] - c1 * mr[0]) * mr[1] + w1;
#pragma unroll
                for (int i = 0; i < 4; ++i) { const float a = fmaxf(v0[i], 0.f), b2 = fmaxf(v1[i], 0.f); v0[i] = a * a; v1[i] = b2 * b2; }
                u32x4 w; w.x = cvt_pk_bf16(v0[0], v0[1]); w.y = cvt_pk_bf16(v0[2], v0[3]); w.z = cvt_pk_bf16(v1[0], v1[1]); w.w = cvt_pk_bf16(v1[2], v1[3]);
                *(u32x4*)(O + (size_t)(u.pm * BM + rl) * ldc + c) = w; } }
    }
};

struct EpiPP {
    static constexpr bool PERM = true, AFTER_DRAIN = false;
    bf16_t* O; int ldc;
    __device__ __forceinline__ void pre(const Unit&, int, int, PG8_LAS float*) const {}
    __device__ __forceinline__ void operator()(const f32x4 (&acc)[2][2][4][2], const Unit& u, int wr, int wc, int fr, int fq, int, PG8_LAS float*) const {
        const int row0 = u.pm * BM + wr * 64 + fr, col0 = u.pn * BM + wc * 32 + 8 * fq;
#pragma unroll
        for (int ai = 0; ai < 2; ++ai)
#pragma unroll
            for (int m = 0; m < 4; ++m) { bf16_t* rowp = O + (size_t)(row0 + ai * HALF + m * 16) * ldc + col0;
#pragma unroll
                for (int bj = 0; bj < 2; ++bj) { const f32x4 v0 = acc[ai][bj][m][0], v1 = acc[ai][bj][m][1];
                    u32x4 w; w.x = cvt_pk_bf16(v0[0], v0[1]); w.y = cvt_pk_bf16(v0[2], v0[3]); w.z = cvt_pk_bf16(v1[0], v1[1]); w.w = cvt_pk_bf16(v1[2], v1[3]);
                    *(u32x4*)(rowp + bj * HALF) = w; } }
    }
};

struct EpiGateLN {
    static constexpr bool PERM = true, AFTER_DRAIN = false;
    const float* ST_IN; const bf16_t* YB; const bf16_t* pp; const float* colsum; const float* bz; const float* g; const float* b; float* out; bf16_t* ob;
    __device__ __forceinline__ void pre(const Unit& u, int slot, int tid, PG8_LAS float* sx) const { stats_pre(ST_IN, u.pm, slot, tid, sx); }
    __device__ __forceinline__ void operator()(const f32x4 (&acc)[2][2][4][2], const Unit& u, int wr, int wc, int fr, int fq, int slot, PG8_LAS float* sx) const {
        const int col0 = u.pn * BM + wc * 32 + 8 * fq, rl0 = wr * 64 + fr; const size_t roff0 = (size_t)(u.pm * BM + rl0) * 1024;
#pragma unroll
        for (int bj = 0; bj < 2; ++bj) { const int c = col0 + bj * HALF;
            f32x4 cs[2], zb[2], gg[2], bb[2];
#pragma unroll
            for (int hh = 0; hh < 2; ++hh) { cs[hh] = *(const f32x4*)(colsum + c + 4 * hh); zb[hh] = *(const f32x4*)(bz + c + 4 * hh); gg[hh] = *(const f32x4*)(g + c + 4 * hh); bb[hh] = *(const f32x4*)(b + c + 4 * hh); }
#pragma unroll
            for (int ai = 0; ai < 2; ++ai) {
                u32x4 yy[4], pw[4];
#pragma unroll
                for (int m = 0; m < 4; ++m) { const size_t o2 = roff0 + (size_t)(ai * HALF + m * 16) * 1024 + c; yy[m] = *(const u32x4*)(YB + o2); pw[m] = *(const u32x4*)(pp + o2); }
#pragma unroll
                for (int m = 0; m < 4; ++m) { const int rl = rl0 + ai * HALF + m * 16; const size_t o2 = roff0 + (size_t)(ai * HALF + m * 16) * 1024 + c;
                    const f32x2 mr = *(const PG8_LAS f32x2*)(sx + (slot * 256 + rl) * 2);
                    float y[8], p[8], o[8]; unpack8(yy[m], y); unpack8(pw[m], p);
#pragma unroll
                    for (int hh = 0; hh < 2; ++hh) { const f32x4 z = (acc[ai][bj][m][hh] - cs[hh] * mr[0]) * mr[1] + zb[hh];
#pragma unroll
                        for (int i = 0; i < 4; ++i) { const float h2 = (y[4 * hh + i] - mr[0]) * mr[1] * gg[hh][i] + bb[hh][i]; o[4 * hh + i] = h2 + p[4 * hh + i] * __builtin_amdgcn_rcpf(1.0f + __expf(-z[i])); } }
                    if (ob) { u32x4 w; w.x = cvt_pk_bf16(o[0], o[1]); w.y = cvt_pk_bf16(o[2], o[3]); w.z = cvt_pk_bf16(o[4], o[5]); w.w = cvt_pk_bf16(o[6], o[7]); *(u32x4*)(ob + o2) = w; }
                    else { *(f32x4*)(out + o2) = (f32x4){o[0], o[1], o[2], o[3]}; *(f32x4*)(out + o2 + 4) = (f32x4){o[4], o[5], o[6], o[7]}; } }
                asm volatile("" ::: "memory");
            } }
    }
};

template <class Epi, class Sched, bool ALIGN_EPI = false, bool SP2 = false>
__device__ __forceinline__ void gemm_phase(PG8_LAS unsigned char* lds, const Gemm g, const Sched& S, const Epi& E, PG8_LAS float* sx) {
    int tid_ = threadIdx.x; asm volatile("" : "+v"(tid_));
    const int tid = tid_, wid = __builtin_amdgcn_readfirstlane(tid >> 6), lane = tid & 63, wr = wid >> 2, wc = wid & 3, fr = lane & 15, fq = lane >> 4;
    const int K = g.K, nt = K / BK;
    unsigned voffA[2], voffB[2];
#pragma unroll
    for (int i = 0; i < 2; ++i) { int R, C; stage_rc(tid * 16 + i * 8192, R, C); const int Rb = Epi::PERM ? ((R & ~31) + perm32(R & 31)) : R;
        voffA[i] = (unsigned)(R * g.lda + C) * 2u; voffB[i] = (unsigned)(Rb * g.ldb + C) * 2u; }
    const size_t kstep = (size_t)(BK * 2);
    const size_t hstepA = (size_t)HALF * g.lda * 2, hstepB = (size_t)HALF * g.ldb * 2;
    const size_t tstepA = 2 * hstepA, tstepB = 2 * hstepB;
    const unsigned ldsw = (unsigned)wid * 1024u;
    const int aoff = lds_byte(wr * 64 + fr, fq * 8), boff = lds_byte(wc * 32 + fr, fq * 8);
#define PG8_SA(b, h) (((b) * 2 + (h)) * HTB)
#define PG8_SB(b, h) ((4 + (b) * 2 + (h)) * HTB)
#define PG8_STAGE(bufoff, gbase, voff) do { _Pragma("unroll") for (int _i = 0; _i < 2; ++_i) \
        __builtin_amdgcn_global_load_lds((const unsigned*)((const char*)(gbase) + (voff)[_i]), (PG8_LAS unsigned*)(lds + (bufoff) + ldsw + _i * 8192), 16, 0, 0); } while (0)
#define PG8_LDA(dst, b, h) do { _Pragma("unroll") for (int m = 0; m < 4; ++m) _Pragma("unroll") for (int k = 0; k < 2; ++k) dst[m][k] = *(const PG8_LAS bf16x8*)(lds + PG8_SA(b, h) + aoff + m * 2048 + k * 1024); } while (0)
#define PG8_LDB(dst, b, h) do { _Pragma("unroll") for (int n = 0; n < 2; ++n) _Pragma("unroll") for (int k = 0; k < 2; ++k) dst[n][k] = *(const PG8_LAS bf16x8*)(lds + PG8_SB(b, h) + boff + n * 2048 + k * 1024); } while (0)
#define PG8_MMA(ai, bj, At, Bt) do { __builtin_amdgcn_s_setprio(1); _Pragma("unroll") for (int m = 0; m < 4; ++m) _Pragma("unroll") for (int n = 0; n < 2; ++n) _Pragma("unroll") for (int k = 0; k < 2; ++k) \
        acc[ai][bj][m][n] = __builtin_amdgcn_mfma_f32_16x16x32_bf16(Bt[n][k], At[m][k], acc[ai][bj][m][n], 0, 0, 0); __builtin_amdgcn_s_setprio(0); } while (0)
#define PG8_WAIT_V(n) asm volatile("s_waitcnt vmcnt(" #n ")" ::: "memory")
#define PG8_WAIT_L(n) asm volatile("s_waitcnt lgkmcnt(" #n ")" ::: "memory")
#define PG8_BAR __builtin_amdgcn_s_barrier()
#define PG8_SCHED __builtin_amdgcn_sched_barrier(0)
    Unit cur, nxt; int ui = 0;
    if (!S.next(0, cur)) return;
    f32x4 acc[2][2][4][2];
#pragma unroll
    for (int a = 0; a < 2; ++a)
#pragma unroll
        for (int b = 0; b < 2; ++b)
#pragma unroll
            for (int m = 0; m < 4; ++m)
#pragma unroll
                for (int n = 0; n < 2; ++n) acc[a][b][m][n] = (f32x4){0.f, 0.f, 0.f, 0.f};
    bf16x8 At[4][2], B0[2][2], B1[2][2];
    const char* cA = (const char*)g.A + (size_t)cur.pm * tstepA; const char* cB = (const char*)g.Bt + (size_t)cur.pn * tstepB;
    S.a_ready(cur); E.pre(cur, 0, tid, sx);
    if constexpr (SP2) {
        PG8_STAGE(PG8_SB(0, 0), cB, voffB); PG8_STAGE(PG8_SB(0, 1), cB + hstepB, voffB); PG8_STAGE(PG8_SA(0, 0), cA, voffA); PG8_STAGE(PG8_SA(0, 1), cA + hstepA, voffA);
        if (wr == 1) PG8_BAR;
        PG8_WAIT_V(2); PG8_BAR;
        PG8_STAGE(PG8_SB(1, 0), cB + kstep, voffB); PG8_STAGE(PG8_SA(1, 0), cA + kstep, voffA); PG8_STAGE(PG8_SB(1, 1), cB + hstepB + kstep, voffB);
        PG8_WAIT_V(6); PG8_BAR;
    } else {
        PG8_STAGE(PG8_SB(0, 0), cB, voffB); PG8_STAGE(PG8_SA(0, 0), cA, voffA); PG8_STAGE(PG8_SB(0, 1), cB + hstepB, voffB); PG8_STAGE(PG8_SA(0, 1), cA + hstepA, voffA);
        if (wr == 1) PG8_BAR;
        PG8_WAIT_V(4); PG8_BAR;
        PG8_STAGE(PG8_SB(1, 0), cB + kstep, voffB); PG8_STAGE(PG8_SA(1, 0), cA + kstep, voffA); PG8_STAGE(PG8_SB(1, 1), cB + hstepB + kstep, voffB);
        PG8_WAIT_V(6); PG8_BAR;
    }
    for (;;) {
        const bool has_next = S.next(ui + 1, nxt);
        const char* nA = has_next ? (const char*)g.A + (size_t)nxt.pm * tstepA : cA; const char* nB = has_next ? (const char*)g.Bt + (size_t)nxt.pn * tstepB : cB;
        for (int t = 0; t < nt; t += 2) {
            const bool last = (t == nt - 2);
            const char* a1 = cA + (size_t)(t + 1) * kstep;
            const char* a2 = last ? nA : cA + (size_t)(t + 2) * kstep; const char* b2 = last ? nB : cB + (size_t)(t + 2) * kstep;
            const char* a3 = a2 + kstep; const char* b3 = b2 + kstep;
            if (last && has_next) { S.a_ready(nxt); E.pre(nxt, (ui + 1) & 1, tid, sx); }
            if constexpr (SP2) {
            PG8_LDB(B0, 0, 0); PG8_LDB(B1, 0, 1); PG8_SCHED; PG8_LDA(At, 0, 0); PG8_STAGE(PG8_SA(1, 1), a1 + hstepA, voffA);
            PG8_WAIT_V(8); PG8_WAIT_L(0); PG8_BAR; PG8_MMA(0, 0, At, B0); PG8_MMA(0, 1, At, B1); PG8_BAR; PG8_SCHED;
            PG8_LDA(At, 0, 1); PG8_STAGE(PG8_SB(0, 0), b2, voffB); PG8_STAGE(PG8_SB(0, 1), b2 + hstepB, voffB); PG8_STAGE(PG8_SA(0, 0), a2, voffA);
            PG8_WAIT_V(8); PG8_WAIT_L(0); PG8_BAR; PG8_MMA(1, 0, At, B0); PG8_MMA(1, 1, At, B1); PG8_BAR; PG8_SCHED;
            PG8_LDB(B0, 1, 0); PG8_LDB(B1, 1, 1); PG8_SCHED; PG8_LDA(At, 1, 0); PG8_STAGE(PG8_SA(0, 1), a2 + hstepA, voffA);
            PG8_WAIT_V(8); PG8_WAIT_L(0); PG8_BAR; PG8_MMA(0, 0, At, B0); PG8_MMA(0, 1, At, B1); PG8_BAR; PG8_SCHED;
            PG8_LDA(At, 1, 1); PG8_STAGE(PG8_SB(1, 0), b3, voffB); PG8_STAGE(PG8_SB(1, 1), b3 + hstepB, voffB); PG8_STAGE(PG8_SA(1, 0), a3, voffA);
            PG8_WAIT_V(8); PG8_WAIT_L(0); PG8_BAR; PG8_MMA(1, 0, At, B0); PG8_MMA(1, 1, At, B1); PG8_BAR; PG8_SCHED;
            } else {
            PG8_LDB(B0, 0, 0); PG8_SCHED; PG8_LDA(At, 0, 0); PG8_STAGE(PG8_SA(1, 1), a1 + hstepA, voffA);
            PG8_WAIT_L(8); PG8_BAR; PG8_WAIT_L(0); PG8_MMA(0, 0, At, B0); PG8_BAR; PG8_SCHED;
            PG8_LDB(B1, 0, 1); PG8_STAGE(PG8_SB(0, 0), b2, voffB);
            PG8_BAR; PG8_WAIT_L(0); PG8_MMA(0, 1, At, B1); PG8_BAR;
            PG8_LDA(At, 0, 1); PG8_STAGE(PG8_SA(0, 0), a2, voffA);
            PG8_BAR; PG8_WAIT_L(0); PG8_MMA(1, 0, At, B0); PG8_BAR; PG8_SCHED;
            PG8_STAGE(PG8_SB(0, 1), b2 + hstepB, voffB);
            PG8_WAIT_V(6); PG8_BAR; PG8_MMA(1, 1, At, B1); PG8_BAR;
            PG8_LDB(B0, 1, 0); PG8_SCHED; PG8_LDA(At, 1, 0); PG8_STAGE(PG8_SA(0, 1), a2 + hstepA, voffA);
            PG8_WAIT_L(8); PG8_BAR; PG8_WAIT_L(0); PG8_MMA(0, 0, At, B0); PG8_BAR; PG8_SCHED;
            PG8_LDB(B1, 1, 1); PG8_STAGE(PG8_SB(1, 0), b3, voffB);
            PG8_BAR; PG8_WAIT_L(0); PG8_MMA(0, 1, At, B1); PG8_BAR;
            PG8_LDA(At, 1, 1); PG8_STAGE(PG8_SA(1, 0), a3, voffA);
            PG8_BAR; PG8_WAIT_L(0); PG8_MMA(1, 0, At, B0); PG8_BAR; PG8_SCHED;
            PG8_STAGE(PG8_SB(1, 1), b3 + hstepB, voffB);
            PG8_WAIT_V(6); PG8_BAR; PG8_MMA(1, 1, At, B1); PG8_BAR;
            }
        }
        if constexpr (ALIGN_EPI) { if (wr == 0) PG8_BAR; }
        if constexpr (!Epi::AFTER_DRAIN) { E(acc, cur, wr, wc, fr, fq, ui & 1, sx); S.done(cur); }
        if (!has_next) break;
#pragma unroll
        for (int a = 0; a < 2; ++a)
#pragma unroll
            for (int b = 0; b < 2; ++b)
#pragma unroll
                for (int m = 0; m < 4; ++m)
#pragma unroll
                    for (int n = 0; n < 2; ++n) acc[a][b][m][n] = (f32x4){0.f, 0.f, 0.f, 0.f};
        cur = nxt; cA = nA; cB = nB; ++ui;
        if constexpr (ALIGN_EPI) { if (wr == 1) PG8_BAR; }
    }
    PG8_WAIT_V(0);
    if constexpr (!ALIGN_EPI) { if (wr == 0) PG8_BAR; }
    PG8_BAR;
    if constexpr (Epi::AFTER_DRAIN) { E.fused(acc, cur, wr, wc, fr, fq, lds, wid, lane); S.done(cur); }
#undef PG8_SA
#undef PG8_SB
#undef PG8_STAGE
#undef PG8_LDA
#undef PG8_LDB
#undef PG8_MMA
#undef PG8_WAIT_V
#undef PG8_WAIT_L
#undef PG8_BAR
#undef PG8_SCHED
}
}

#define LAS __attribute__((address_space(3)))
typedef unsigned short bf16;
typedef unsigned u32x4 __attribute__((ext_vector_type(4)));
typedef unsigned u32x2 __attribute__((ext_vector_type(2)));
typedef float f32x4 __attribute__((ext_vector_type(4)));
typedef short bf16x8 __attribute__((ext_vector_type(8)));
typedef short s16x4 __attribute__((ext_vector_type(4)));

constexpr int NTHREADS = 512, NWAVES = 8;
constexpr int BATCH = 8, SEQ = 4096, D = 1024, M = BATCH * SEQ, FF = 4096, PLE = 256;
constexpr int GLA_COLS = 3088, PROJ_LD = 3072;
constexpr int QKV_LD = 1536;
constexpr float LN_EPS = 1e-5f, RMS_EPS = 1e-5f;
constexpr float ALPHA = 1.4142135623730951f;
constexpr size_t MiB = 1u << 20;
constexpr size_t W_IN_T = 1 * MiB;
constexpr size_t W_GOUT_T = 7 * MiB;
constexpr size_t W_UP_T = 9 * MiB;
constexpr size_t W_DN_T = 17 * MiB;
constexpr size_t W_GATE_T = 25 * MiB;
constexpr size_t W_PP_T = 27 * MiB;
constexpr size_t W_QKV_T = 28 * MiB;
constexpr size_t W_SOUT_T = 31 * MiB;
constexpr size_t W_LSTRIDE = 24 * MiB;
constexpr size_t PB1_OFF = 1 * MiB;
constexpr size_t R0 = 56 * MiB;
constexpr size_t R1 = 120 * MiB;
constexpr size_t R2 = 248 * MiB;
constexpr size_t R2_GK = R2 + 192 * MiB;
constexpr size_t R2_PP = R2 + 16 * MiB;
constexpr size_t R2_H3B = R2 + 80 * MiB;
constexpr size_t R2_QKV = R2 + 144 * MiB;
constexpr size_t R0_BL = R1 + 80 * MiB;
constexpr size_t WS_END = 512 * MiB;
constexpr int LDS_BYTES = 147456;

__device__ __forceinline__ int opq(int v) { asm volatile("" : "+s"(v)); return v; }
struct Params { const float* in[21]; float* out; unsigned char* ws; };
#define LBAR() do { asm volatile("s_waitcnt lgkmcnt(0)" ::: "memory"); __builtin_amdgcn_s_barrier(); asm volatile("" ::: "memory"); } while (0)

struct Ctx { LAS unsigned char* lds; int tid, lane, wave; };

__device__ __forceinline__ float wave_sum(float v) {
#pragma unroll
    for (int o = 1; o < 64; o <<= 1) v += __shfl_xor(v, o);
    return v;
}
__device__ __forceinline__ unsigned pk2(float lo, float hi) { return pg8::cvt_pk_bf16(lo, hi); }
__device__ __forceinline__ float bf2f(unsigned short b) { return __uint_as_float(((unsigned)b) << 16); }
__device__ __forceinline__ bf16x8 pack8(const f32x4 a, const f32x4 b) {
    u32x4 w; w.x = pk2(a[0], a[1]); w.y = pk2(a[2], a[3]); w.z = pk2(b[0], b[1]); w.w = pk2(b[2], b[3]); return __builtin_bit_cast(bf16x8, w);
}
#define MFMA16(a, b, c) __builtin_amdgcn_mfma_f32_16x16x32_bf16((a), (b), (c), 0, 0, 0)
__device__ __forceinline__ bf16x8 lds16(const LAS unsigned char* p) { return *(const LAS bf16x8*)p; }
__device__ __forceinline__ bf16x8 lds8x2(const LAS unsigned char* p0, const LAS unsigned char* p1) {
    const s16x4 lo = *(const LAS s16x4*)p0, hi = *(const LAS s16x4*)p1; return __builtin_shufflevector(lo, hi, 0, 1, 2, 3, 4, 5, 6, 7);
}

template <bool FOLD>
__device__ __forceinline__ void transpose_item(const float* W, int ldw, int nblk, int K, bf16* WT, LAS float* scr, int item, int lane,
                                               const float* gv = nullptr, const float* bv = nullptr, float* csp = nullptr, float* bwp = nullptr) {
    const int kb = item / nblk, nb = item % nblk, k0 = 64 * kb, n0 = 32 * nb;
    { const int r8 = lane >> 3, c4 = lane & 7;
      f32x4 v[8];
#pragma unroll
      for (int it = 0; it < 8; ++it) v[it] = *(const f32x4*)(W + (size_t)(k0 + 8 * it + r8) * ldw + n0 + 4 * c4);
#pragma unroll
      for (int it = 0; it < 8; ++it) { LAS float* d = scr + (8 * it + r8) * 33 + 4 * c4; d[0] = v[it][0]; d[1] = v[it][1]; d[2] = v[it][2]; d[3] = v[it][3]; } }
    asm volatile("s_waitcnt lgkmcnt(0)" ::: "memory");
    const int c = lane & 7;
    float gk[8], bk[8];
    if (FOLD) {
#pragma unroll
        for (int i = 0; i < 8; ++i) { gk[i] = gv[k0 + 8 * c + i]; bk[i] = bv[k0 + 8 * c + i]; }
    }
#pragma unroll
    for (int j = 0; j < 4; ++j) { const int n = (lane >> 3) + 8 * j; const LAS float* sp = scr + (8 * c) * 33 + n;
        float v[8];
#pragma unroll
        for (int i = 0; i < 8; ++i) v[i] = sp[i * 33];
        float bwv = 0.f;
        if (FOLD) {
#pragma unroll
            for (int i = 0; i < 8; ++i) { bwv += bk[i] * v[i]; v[i] *= gk[i]; }
        }
        u32x4 o; o.x = pk2(v[0], v[1]); o.y = pk2(v[2], v[3]); o.z = pk2(v[4], v[5]); o.w = pk2(v[6], v[7]);
        *(u32x4*)(WT + (size_t)(n0 + n) * K + k0 + 8 * c) = o;
        if (FOLD) {
            float r[8]; pg8::unpack8(o, r); float cs = ((r[0] + r[1]) + (r[2] + r[3])) + ((r[4] + r[5]) + (r[6] + r[7]));
            cs += __shfl_xor(cs, 1); cs += __shfl_xor(cs, 2); cs += __shfl_xor(cs, 4);
            bwv += __shfl_xor(bwv, 1); bwv += __shfl_xor(bwv, 2); bwv += __shfl_xor(bwv, 4);
            if (c == 0) { const int N = 32 * nblk; csp[(size_t)kb * N + n0 + n] = cs; bwp[(size_t)kb * N + n0 + n] = bwv; }
        }
    }
    asm volatile("s_waitcnt lgkmcnt(0)" ::: "memory");
}
constexpr size_t VEC = 52 * MiB;
__device__ __host__ constexpr size_t CSP_UP(int l) { return VEC + (size_t)l * 512 * 1024; }
__device__ __host__ constexpr size_t CSP_G(int l) { return VEC + MiB + (size_t)l * 128 * 1024; }
__device__ __host__ constexpr size_t FIN(int l) { return VEC + MiB + 512 * 1024 + (size_t)l * 64 * 1024; }
__device__ __forceinline__ void fold_finalize(const Params& P, int gtid, int gthreads) {
    for (int idx = gtid; idx < 2 * 5120; idx += gthreads) {
        const int l = idx / 5120, r = idx % 5120;
        float* fin = (float*)(P.ws + FIN(l));
        if (r < 4096) { const float* cp = (const float*)(P.ws + CSP_UP(l)); const float* bp = cp + 16 * 4096; float cs = 0.f, bw = 0.f;
#pragma unroll
            for (int kb = 0; kb < 16; ++kb) { cs += cp[kb * 4096 + r]; bw += bp[kb * 4096 + r]; }
            fin[r] = cs; fin[4096 + r] = bw; }
        else { const int n = r - 4096; const float* cp = (const float*)(P.ws + CSP_G(l)); const float* bp = cp + 16 * 1024; float cs = 0.f, bw = 0.f;
#pragma unroll
            for (int kb = 0; kb < 16; ++kb) { cs += cp[kb * 1024 + n]; bw += bp[kb * 1024 + n]; }
            fin[8192 + n] = cs; fin[9216 + n] = bw + P.in[20][l * D + n]; }
    }
}
__device__ __forceinline__ void p0_prologue(const Ctx& F, const Params& P) {
    LAS float* scr = (LAS float*)(F.lds + F.wave * 16384);
    const int gw = blockIdx.x * NWAVES + F.wave, NGW = gridDim.x * NWAVES;
    unsigned char* ws = P.ws;
    constexpr int I_IN = 16 * 96, I_SQ = 16 * 32, I_QKV = 16 * 48, I_UP = 16 * 128, I_DN = 64 * 32, I_PP = 4 * 32;
    constexpr int NITEMS = I_IN + 2 * I_SQ + I_QKV + 2 * I_UP + 2 * I_DN + 2 * I_SQ + 2 * I_PP;
    for (int it = gw; it < NITEMS; it += NGW) {
        int r = it;
        if (r < I_IN) { transpose_item<false>(P.in[2], GLA_COLS, 96, D, (bf16*)(ws + W_IN_T), scr, r, F.lane); continue; } r -= I_IN;
        if (r < I_SQ) { transpose_item<false>(P.in[6], D, 32, D, (bf16*)(ws + W_GOUT_T), scr, r, F.lane); continue; } r -= I_SQ;
        if (r < I_SQ) { transpose_item<false>(P.in[10], D, 32, D, (bf16*)(ws + W_SOUT_T), scr, r, F.lane); continue; } r -= I_SQ;
        if (r < I_QKV) { transpose_item<false>(P.in[7], QKV_LD, 48, D, (bf16*)(ws + W_QKV_T), scr, r, F.lane); continue; } r -= I_QKV;
        if (r < 2 * I_UP) { const int l = r / I_UP; transpose_item<true>(P.in[12] + (size_t)l * D * FF, FF, 128, D, (bf16*)(ws + W_UP_T + (size_t)l * W_LSTRIDE), scr, r % I_UP, F.lane, P.in[14] + l * D, P.in[15] + l * D, (float*)(ws + CSP_UP(l)), (float*)(ws + CSP_UP(l)) + 16 * 4096); continue; } r -= 2 * I_UP;
        if (r < 2 * I_DN) { const int l = r / I_DN; transpose_item<false>(P.in[13] + (size_t)l * D * FF, D, 32, FF, (bf16*)(ws + W_DN_T + (size_t)l * W_LSTRIDE), scr, r % I_DN, F.lane); continue; } r -= 2 * I_DN;
        if (r < 2 * I_SQ) { const int l = r / I_SQ; transpose_item<true>(P.in[19] + (size_t)l * D * D, D, 32, D, (bf16*)(ws + W_GATE_T + (size_t)l * W_LSTRIDE), scr, r % I_SQ, F.lane, P.in[16] + l * D, P.in[17] + l * D, (float*)(ws + CSP_G(l)), (float*)(ws + CSP_G(l)) + 16 * 1024); continue; } r -= 2 * I_SQ;
        { const int l = r / I_PP; transpose_item<false>(P.in[18] + (size_t)l * PLE * D, D, 32, PLE, (bf16*)(ws + W_PP_T + (size_t)l * W_LSTRIDE), scr, r % I_PP, F.lane); }
    }
    const int gtid = blockIdx.x * NTHREADS + F.tid, gthreads = gridDim.x * NTHREADS;
    {
        LAS float* wg = (LAS float*)F.lds;
        __syncthreads();
        for (int i = F.tid; i < 4096; i += NTHREADS) { const int k = i >> 2, c4 = i & 3, pos = (k & 3) * 256 + (k >> 2); *(LAS f32x4*)(wg + pos * 20 + 4 * c4) = *(const f32x4*)(P.in[2] + (size_t)k * GLA_COLS + 3072 + 4 * c4); }
        __syncthreads();
        const float* x = P.in[0]; bf16* xb = (bf16*)(ws + R0); float* GK = (float*)(ws + R2_GK);
        const int lane = F.lane;
#pragma unroll 1
        for (int r0 = gw * 4; r0 < M; r0 += NGW * 4) {
            f32x4 acc[16];
#pragma unroll
            for (int i = 0; i < 16; ++i) acc[i] = (f32x4){0.f, 0.f, 0.f, 0.f};
#pragma unroll 1
            for (int j = 0; j < 4; ++j) {
                float xs[4][4];
#pragma unroll
                for (int rr = 0; rr < 4; ++rr) { const f32x4 v = *(const f32x4*)(x + (size_t)(r0 + rr) * D + 256 * j + 4 * lane);
                    u32x2 o; o.x = pk2(v[0], v[1]); o.y = pk2(v[2], v[3]); *(u32x2*)(xb + (size_t)(r0 + rr) * D + 256 * j + 4 * lane) = o;
                    xs[rr][0] = v[0]; xs[rr][1] = v[1]; xs[rr][2] = v[2]; xs[rr][3] = v[3]; }
#pragma unroll
                for (int i = 0; i < 4; ++i) { const LAS float* wp = wg + (i * 256 + 64 * j + lane) * 20;
                    const f32x4 w0 = *(const LAS f32x4*)(wp), w1 = *(const LAS f32x4*)(wp + 4), w2 = *(const LAS f32x4*)(wp + 8), w3 = *(const LAS f32x4*)(wp + 12);
#pragma unroll
                    for (int rr = 0; rr < 4; ++rr) { const float xv = xs[rr][i]; acc[rr * 4 + 0] += w0 * xv; acc[rr * 4 + 1] += w1 * xv; acc[rr * 4 + 2] += w2 * xv; acc[rr * 4 + 3] += w3 * xv; } }
            }
            float a[64];
#pragma unroll
            for (int i = 0; i < 16; ++i) { a[4 * i] = acc[i][0]; a[4 * i + 1] = acc[i][1]; a[4 * i + 2] = acc[i][2]; a[4 * i + 3] = acc[i][3]; }
#define TR_STEP(n) do { const bool hi_ = (lane & (n)) != 0; _Pragma("unroll") for (int i = 0; i < (n); ++i) { const float send = hi_ ? a[i] : a[i + (n)], keep = hi_ ? a[i + (n)] : a[i]; a[i] = keep + __shfl_xor(send, (n)); } } while (0)
            TR_STEP(32); TR_STEP(16); TR_STEP(8); TR_STEP(4); TR_STEP(2); TR_STEP(1);
#undef TR_STEP
            GK[(size_t)r0 * 16 + lane] = a[0];
        }
    }
}

typedef short v4i16_t __attribute__((ext_vector_type(4)));
__device__ __forceinline__ s16x4 ldtr(const LAS unsigned char* p) { return __builtin_bit_cast(s16x4, __builtin_amdgcn_ds_read_tr16_b64_v4i16((LAS v4i16_t*)p)); }
constexpr int GS_Q = 0, GS_K = 17408, GS_V = 34816, GS_ATT = 68608, GS_RS = 77824, GS_RSTD = 79872, GS_BL = 80128;
constexpr size_t R0_SLOC = R1, R0_GSEG = R1 + 40 * MiB;
template <bool FULL>
__device__ __forceinline__ void gla_scan_pass(const Ctx& F, const Params& P) {
    LAS unsigned char* L = F.lds;
    const int tid = F.tid, lane = F.lane, w = F.wave, l15 = lane & 15, quad = lane >> 4;
    bf16* PROJ = (bf16*)(P.ws + R2);
    const float* BL = (const float*)(P.ws + R0_BL);
    float* SLOC = (float*)(P.ws + R0_SLOC); float* GSEG = (float*)(P.ws + R0_GSEG);
    const float* norm_g = P.in[5];
    for (int item = blockIdx.x; item < BATCH * 4 * 8; item += gridDim.x) {
        const int seg = item & 7, bh = item >> 3, b = bh >> 2, h = bh & 3;
        if (!FULL && seg == 7) continue;
        f32x4 S[8][2];
#pragma unroll
        for (int dt = 0; dt < 8; ++dt) { S[dt][0] = (f32x4){0.f, 0.f, 0.f, 0.f}; S[dt][1] = (f32x4){0.f, 0.f, 0.f, 0.f}; }
        if (FULL) {
#pragma unroll 1
            for (int j = 0; j < seg; ++j) {
                const float* gj = GSEG + (size_t)(bh * 8 + j) * 128 + 4 * quad; const f32x4* sl = (const f32x4*)(SLOC + (size_t)(bh * 8 + j) * 32768) + tid;
#pragma unroll
                for (int dt = 0; dt < 8; ++dt) { const f32x4 gg = *(const f32x4*)(gj + 16 * dt);
                    f32x4 dec; dec[0] = __expf(gg[0]); dec[1] = __expf(gg[1]); dec[2] = __expf(gg[2]); dec[3] = __expf(gg[3]);
                    S[dt][0] = S[dt][0] * dec + sl[(dt * 2 + 0) * 512]; S[dt][1] = S[dt][1] * dec + sl[(dt * 2 + 1) * 512]; }
            }
        }
        float gsum = 0.f;
        u32x4 pq[2], pk[2], pv[4]; float pbl = 0.f;
#define GS_LOADC(cidx) do { const int u_ = (b * 64 + (cidx)) * 4 + h; const size_t m_ = (size_t)b * SEQ + (size_t)(cidx) * 64; int tl_ = tid; asm volatile("" : "+v"(tl_)); \
            _Pragma("unroll") for (int i = 0; i < 2; ++i) { const int idx = tl_ + 512 * i, row = idx >> 4, pc = idx & 15; const bf16* src = PROJ + (m_ + row) * PROJ_LD + h * 128 + pc * 8; \
                if (FULL) pq[i] = *(const u32x4*)(src); pk[i] = *(const u32x4*)(src + 512); } \
            _Pragma("unroll") for (int i = 0; i < 4; ++i) { const int idx = tl_ + 512 * i, row = idx >> 5, pc = idx & 31; pv[i] = *(const u32x4*)(PROJ + (m_ + row) * PROJ_LD + 1024 + h * 256 + pc * 8); } \
            if (tl_ < 128) pbl = BL[(size_t)u_ * 128 + tl_]; } while (0)
        GS_LOADC(seg * 8);
#pragma unroll 1
        for (int cc = 0; cc < 8; ++cc) {
            const int c = seg * 8 + cc;
            const size_t m0 = (size_t)b * SEQ + (size_t)c * 64;
#pragma unroll
            for (int i = 0; i < 2; ++i) { const int idx = tid + 512 * i, row = idx >> 4, pc = idx & 15;
                if (FULL) *(LAS u32x4*)(L + GS_Q + row * 272 + pc * 16) = pq[i];
                *(LAS u32x4*)(L + GS_K + row * 272 + pc * 16) = pk[i]; }
#pragma unroll
            for (int i = 0; i < 4; ++i) { const int idx = tid + 512 * i, row = idx >> 5, pc = idx & 31; *(LAS u32x4*)(L + GS_V + row * 528 + pc * 16) = pv[i]; }
            if (tid < 128) { ((LAS float*)(L + GS_BL))[tid] = pbl; gsum += pbl; }
            LBAR();
            if (cc < 7) GS_LOADC(c + 1);
            u32x2 rw[4][2];
            if (FULL) { const bf16* rp = PROJ + (m0 + l15) * PROJ_LD + 2048 + h * 256 + 32 * w + 4 * quad;
#pragma unroll
                for (int it = 0; it < 4; ++it) { rw[it][0] = *(const u32x2*)(rp); rw[it][1] = *(const u32x2*)(rp + 16); rp += 16 * PROJ_LD; asm volatile("" : "+v"(rp)); } }
#define GS_VF(dst) do { _Pragma("unroll") for (int s2 = 0; s2 < 2; ++s2) _Pragma("unroll") for (int et = 0; et < 2; ++et) { \
                const LAS unsigned char* a_ = L + GS_V + (32 * s2 + 8 * quad + (l15 >> 2)) * 528 + (32 * w + 16 * et) * 2 + 8 * (l15 & 3); \
                const s16x4 lo_ = ldtr(a_), hi_ = ldtr(a_ + 4 * 528); dst[s2][et] = __builtin_shufflevector(lo_, hi_, 0, 1, 2, 3, 4, 5, 6, 7); } } while (0)
            f32x4 o[4][2];
            if (FULL) {
                { const int it = w >> 1;
#pragma unroll
                  for (int x = 0; x < 2; ++x) { const int jt = 2 * (w & 1) + x; f32x4 a = (f32x4){0.f, 0.f, 0.f, 0.f};
                      if (jt <= it) {
#pragma unroll
                          for (int ks = 0; ks < 4; ++ks) { const bf16x8 kf = lds16(L + GS_K + (16 * jt + l15) * 272 + ks * 64 + quad * 16), qf = lds16(L + GS_Q + (16 * it + l15) * 272 + ks * 64 + quad * 16);
                              a = MFMA16(kf, qf, a); }
                          const int ii = 16 * it + l15, j0 = 16 * jt + 4 * quad;
#pragma unroll
                          for (int j = 0; j < 4; ++j) if (j0 + j > ii) a[j] = 0.f;
                      }
                      u32x2 ww; ww.x = pk2(a[0], a[1]); ww.y = pk2(a[2], a[3]);
                      *(LAS u32x2*)(L + GS_ATT + (16 * it + l15) * 144 + (16 * jt + 4 * quad) * 2) = ww; } }
                LBAR();
#pragma unroll
                for (int it = 0; it < 4; ++it) { o[it][0] = (f32x4){0.f, 0.f, 0.f, 0.f}; o[it][1] = (f32x4){0.f, 0.f, 0.f, 0.f}; }
#pragma unroll
                for (int s2 = 0; s2 < 4; ++s2) {
                    bf16x8 sf[2]; sf[0] = pack8(S[2 * s2][0], S[2 * s2 + 1][0]); sf[1] = pack8(S[2 * s2][1], S[2 * s2 + 1][1]);
#pragma unroll
                    for (int it = 0; it < 4; ++it) { const LAS unsigned char* qb = L + GS_Q + (16 * it + l15) * 272 + (32 * s2 + 4 * quad) * 2;
                        const bf16x8 qf = lds8x2(qb, qb + 32);
                        o[it][0] = MFMA16(sf[0], qf, o[it][0]); o[it][1] = MFMA16(sf[1], qf, o[it][1]); }
                }
                { bf16x8 vf[2][2]; GS_VF(vf);
#pragma unroll
                  for (int s2 = 0; s2 < 2; ++s2)
#pragma unroll
                    for (int it = 0; it < 4; ++it) { const bf16x8 af = lds16(L + GS_ATT + (16 * it + l15) * 144 + s2 * 64 + quad * 16);
                        o[it][0] = MFMA16(vf[s2][0], af, o[it][0]); o[it][1] = MFMA16(vf[s2][1], af, o[it][1]); } }
            }
            bf16x8 vf[2][2]; GS_VF(vf);
#pragma unroll
            for (int dt = 0; dt < 8; ++dt) {
                const f32x4 bl = *(const LAS f32x4*)(L + GS_BL + (16 * dt + 4 * quad) * 4);
                f32x4 dec; dec[0] = __expf(bl[0]); dec[1] = __expf(bl[1]); dec[2] = __expf(bl[2]); dec[3] = __expf(bl[3]);
#pragma unroll
                for (int s2 = 0; s2 < 2; ++s2) {
                    const LAS unsigned char* ka = L + GS_K + (32 * s2 + 8 * quad + (l15 >> 2)) * 272 + (16 * dt) * 2 + 8 * (l15 & 3);
                    const s16x4 klo = ldtr(ka), khi = ldtr(ka + 4 * 272); const bf16x8 kf = __builtin_shufflevector(klo, khi, 0, 1, 2, 3, 4, 5, 6, 7);
                    S[dt][0] = MFMA16(kf, vf[s2][0], S[dt][0]); S[dt][1] = MFMA16(kf, vf[s2][1], S[dt][1]); }
                S[dt][0] = S[dt][0] * dec; S[dt][1] = S[dt][1] * dec;
            }
            if (FULL) {
#pragma unroll
                for (int it = 0; it < 4; ++it) { float ss = 0.f;
#pragma unroll
                    for (int et = 0; et < 2; ++et) ss += (o[it][et][0] * o[it][et][0] + o[it][et][1] * o[it][et][1]) + (o[it][et][2] * o[it][et][2] + o[it][et][3] * o[it][et][3]);
                    ss += __shfl_xor(ss, 16); ss += __shfl_xor(ss, 32);
                    if (quad == 0) ((LAS float*)(L + GS_RS))[w * 64 + 16 * it + l15] = ss; }
            }
            LBAR();
            if (FULL) {
                if (tid < 64) { float t = 0.f;
#pragma unroll
                    for (int ww = 0; ww < 8; ++ww) t += ((const LAS float*)(L + GS_RS))[ww * 64 + tid];
                    ((LAS float*)(L + GS_RSTD))[tid] = 1.0f / sqrtf(t * (1.0f / 256.0f) + RMS_EPS); }
                LBAR();
#pragma unroll
                for (int it = 0; it < 4; ++it) { const float rs = ((const LAS float*)(L + GS_RSTD))[16 * it + l15];
#pragma unroll
                    for (int et = 0; et < 2; ++et) { const int e0 = 32 * w + 16 * et + 4 * quad;
                        bf16* wp = PROJ + (m0 + 16 * it + l15) * PROJ_LD + 2048 + h * 256 + e0;
                        const u32x2 r2 = rw[it][et]; const f32x4 gg = *(const f32x4*)(norm_g + e0);
                        float rv[4]; rv[0] = __uint_as_float(r2.x << 16); rv[1] = __uint_as_float(r2.x & 0xffff0000u); rv[2] = __uint_as_float(r2.y << 16); rv[3] = __uint_as_float(r2.y & 0xffff0000u);
                        float ov[4];
#pragma unroll
                        for (int j = 0; j < 4; ++j) ov[j] = o[it][et][j] * rs * gg[j] * (rv[j] * __builtin_amdgcn_rcpf(1.0f + __expf(-rv[j])));
                        u32x2 ow; ow.x = pk2(ov[0], ov[1]); ow.y = pk2(ov[2], ov[3]); *(u32x2*)wp = ow; } }
            }
        }
#undef GS_LOADC
#undef GS_VF
        if (!FULL) {
            f32x4* sl = (f32x4*)(SLOC + (size_t)(bh * 8 + seg) * 32768) + tid;
#pragma unroll
            for (int dt = 0; dt < 8; ++dt) { sl[(dt * 2 + 0) * 512] = S[dt][0]; sl[(dt * 2 + 1) * 512] = S[dt][1]; }
            if (tid < 128) GSEG[(size_t)(bh * 8 + seg) * 128 + tid] = gsum;
        }
        LBAR();
    }
}

__device__ __forceinline__ void gla_pass_a(const Ctx& F, const Params& P) {
    LAS unsigned char* L = F.lds;
    LAS float* gk_s = (LAS float*)(L);
    LAS float* part = (LAS float*)(L + 4096);
    const int tid = F.tid, lane = F.lane, w = F.wave, l15 = lane & 15, quad = lane >> 4, d = tid & 127, g = tid >> 7;
    bf16* PROJ = (bf16*)(P.ws + R2); const float* GK = (const float*)(P.ws + R2_GK);
    float* BL = (float*)(P.ws + R0_BL); float* SLOC = (float*)(P.ws + R0_SLOC); float* GSEG = (float*)(P.ws + R0_GSEG);
    for (int item = blockIdx.x; item < BATCH * 4 * 8; item += gridDim.x) {
        const int seg = item & 7, bh = item >> 3, b = bh >> 2, h = bh & 3;
        float wv[16];
#pragma unroll
        for (int r = 0; r < 16; ++r) wv[r] = P.in[3][r * 512 + h * 128 + d];
        const float bias = P.in[4][h * 128 + d];
        f32x4 S[8][2];
#pragma unroll
        for (int dt = 0; dt < 8; ++dt) { S[dt][0] = (f32x4){0.f, 0.f, 0.f, 0.f}; S[dt][1] = (f32x4){0.f, 0.f, 0.f, 0.f}; }
        float gsum = 0.f;
        u32x4 pv[4]; f32x4 gkn = (f32x4){0.f, 0.f, 0.f, 0.f};
#define PA_LOAD(cidx) do { const size_t m_ = (size_t)b * SEQ + (size_t)(cidx) * 64; int tl_ = tid; asm volatile("" : "+v"(tl_)); \
            _Pragma("unroll") for (int i = 0; i < 4; ++i) { const int idx = tl_ + 512 * i, row = idx >> 5, pc = idx & 31; pv[i] = *(const u32x4*)(PROJ + (m_ + row) * PROJ_LD + 1024 + h * 256 + pc * 8); } \
            if (tl_ < 256) gkn = *(const f32x4*)(GK + m_ * 16 + (size_t)tl_ * 4); } while (0)
        PA_LOAD(seg * 8);
#pragma unroll 1
        for (int cc = 0; cc < 8; ++cc) {
            const int c = seg * 8 + cc, u = (b * 64 + c) * 4 + h;
            const size_t m0 = (size_t)b * SEQ + (size_t)c * 64;
            if (tid < 256) ((LAS f32x4*)gk_s)[tid] = gkn;
#pragma unroll
            for (int i = 0; i < 4; ++i) { const int idx = tid + 512 * i, row = idx >> 5, pc = idx & 31; *(LAS u32x4*)(L + GS_V + row * 528 + pc * 16) = pv[i]; }
            bf16* qp = PROJ + (m0 + 16 * g) * PROJ_LD + h * 128 + d; bf16* kp = qp + 512;
            unsigned qk[16];
            { const bf16* rp = qp;
#pragma unroll
              for (int tt = 0; tt < 16; ++tt) { qk[tt] = (unsigned)rp[0] | ((unsigned)rp[512] << 16); rp += PROJ_LD; asm volatile("" : "+v"(rp)); } }
            { const size_t pgrp = ((size_t)(item * 8 + cc)) * 512 + tid;
              const f32x4 a = *(const f32x4*)(P.in[1] + pgrp * 8), a2 = *(const f32x4*)(P.in[1] + pgrp * 8 + 4);
              u32x4 o; o.x = pk2(a[0], a[1]); o.y = pk2(a[2], a[3]); o.z = pk2(a2[0], a2[1]); o.w = pk2(a2[2], a2[3]); *(u32x4*)((bf16*)P.out + pgrp * 8) = o; }
            LBAR();
            float cs[16]; float run = 0.f;
#pragma unroll
            for (int tt = 0; tt < 16; ++tt) {
                const int t = 16 * g + tt; float z = bias;
#pragma unroll
                for (int r4 = 0; r4 < 4; ++r4) { const f32x4 a = ((const LAS f32x4*)gk_s)[t * 4 + r4]; z += a[0] * wv[4 * r4] + a[1] * wv[4 * r4 + 1] + a[2] * wv[4 * r4 + 2] + a[3] * wv[4 * r4 + 3]; }
                const float ls = fminf(z, 0.f) - __logf(1.0f + __expf(-fabsf(z)));
                run += ls * (1.0f / 16.0f); cs[tt] = run;
                if ((tt & 1) == 1) asm volatile("" ::: "memory");
            }
            part[g * 128 + d] = run;
            LBAR();
            if (cc < 7) PA_LOAD(c + 1);
            float off = 0.f, tot = 0.f;
#pragma unroll
            for (int gg = 0; gg < 4; ++gg) { const float pvv = part[gg * 128 + d]; tot += pvv; if (gg < g) off += pvv; }
            bf16* wq = qp;
#pragma unroll
            for (int tt = 0; tt < 16; ++tt) {
                const float bc = cs[tt] + off;
                const float qv = __uint_as_float(qk[tt] << 16), kv = __uint_as_float(qk[tt] & 0xffff0000u);
                const float e1 = __expf(bc), e2 = __expf(-bc);
                wq[0] = (bf16)(pk2(qv * 0.08838834764831845f * e1, 0.f) & 0xffffu);
                const bf16 kt = (bf16)(pk2(kv * e2, 0.f) & 0xffffu);
                wq[512] = kt; wq += PROJ_LD; asm volatile("" : "+v"(wq));
                *(LAS bf16*)(L + GS_K + (16 * g + tt) * 272 + d * 2) = kt;
            }
            if (g == 0) { BL[(size_t)u * 128 + d] = tot; ((LAS float*)(L + GS_BL))[d] = tot; gsum += tot; }
            LBAR();
            if (seg < 7) {
                bf16x8 vf[2][2];
#pragma unroll
                for (int s2 = 0; s2 < 2; ++s2)
#pragma unroll
                    for (int et = 0; et < 2; ++et) { const LAS unsigned char* a_ = L + GS_V + (32 * s2 + 8 * quad + (l15 >> 2)) * 528 + (32 * w + 16 * et) * 2 + 8 * (l15 & 3);
                        const s16x4 lo_ = ldtr(a_), hi_ = ldtr(a_ + 4 * 528); vf[s2][et] = __builtin_shufflevector(lo_, hi_, 0, 1, 2, 3, 4, 5, 6, 7); }
#pragma unroll
                for (int dt = 0; dt < 8; ++dt) {
                    const f32x4 bl = *(const LAS f32x4*)(L + GS_BL + (16 * dt + 4 * quad) * 4);
                    f32x4 dec; dec[0] = __expf(bl[0]); dec[1] = __expf(bl[1]); dec[2] = __expf(bl[2]); dec[3] = __expf(bl[3]);
#pragma unroll
                    for (int s2 = 0; s2 < 2; ++s2) {
                        const LAS unsigned char* ka = L + GS_K + (32 * s2 + 8 * quad + (l15 >> 2)) * 272 + (16 * dt) * 2 + 8 * (l15 & 3);
                        const s16x4 klo = ldtr(ka), khi = ldtr(ka + 4 * 272); const bf16x8 kf = __builtin_shufflevector(klo, khi, 0, 1, 2, 3, 4, 5, 6, 7);
                        S[dt][0] = MFMA16(kf, vf[s2][0], S[dt][0]); S[dt][1] = MFMA16(kf, vf[s2][1], S[dt][1]); }
                    S[dt][0] = S[dt][0] * dec; S[dt][1] = S[dt][1] * dec;
                }
            }
            LBAR();
        }
#undef PA_LOAD
        if (seg < 7) {
            f32x4* sl = (f32x4*)(SLOC + (size_t)(bh * 8 + seg) * 32768) + tid;
#pragma unroll
            for (int dt = 0; dt < 8; ++dt) { sl[(dt * 2 + 0) * 512] = S[dt][0]; sl[(dt * 2 + 1) * 512] = S[dt][1]; }
            if (tid < 128) GSEG[(size_t)(bh * 8 + seg) * 128 + tid] = gsum;
        }
    }
}

constexpr int SW_K = 0, SW_V = 36864;
__device__ __forceinline__ void swa_phase(const Ctx& F, const Params& P) {
    LAS unsigned char* L = F.lds;
    const int tid = F.tid, lane = F.lane, w = F.wave, l15 = lane & 15, quad = lane >> 4;
    const bf16* QKV = (const bf16*)(P.ws + R2_QKV); bf16* AO = (bf16*)(P.ws + R0);
    const float* sinks = P.in[9];
    constexpr int NU = BATCH * 32 * 4;
    u32x4 kv[4], vv[4];
#define SW_LOAD(uu) do { const int kvh_ = (uu) & 3, n_ = ((uu) >> 2) & 31, b_ = (uu) >> 7; const long mb_ = (long)b_ * SEQ + (long)n_ * 128; \
        _Pragma("unroll") for (int i = 0; i < 4; ++i) { const int idx = tid + 512 * i, jj = idx >> 3, pc = idx & 7; \
            kv[i] = (u32x4){0u, 0u, 0u, 0u}; vv[i] = (u32x4){0u, 0u, 0u, 0u}; \
            if (n_ > 0 || jj >= 128) { const bf16* src = QKV + (size_t)(mb_ - 128 + jj) * QKV_LD + 1024 + kvh_ * 64 + pc * 8; kv[i] = *(const u32x4*)(src); vv[i] = *(const u32x4*)(src + 256); } } } while (0)
#define SW_QBASE(uu) (QKV + (size_t)((long)((uu) >> 7) * SEQ + (long)(((uu) >> 2) & 31) * 128 + 64 * (w & 1) + l15) * QKV_LD + (((uu) & 3) * 4 + (w >> 1)) * 64 + quad * 8)
    bf16x8 qc0 = (bf16x8){0, 0, 0, 0, 0, 0, 0, 0}, qc1 = qc0;
    if ((int)blockIdx.x < NU) { SW_LOAD((int)blockIdx.x); const bf16* q0p = SW_QBASE((int)blockIdx.x); qc0 = *(const bf16x8*)(q0p); qc1 = *(const bf16x8*)(q0p + 32); }
    for (int u = blockIdx.x; u < NU; u += gridDim.x) {
        const int kvh = u & 3, n = (u >> 2) & 31, b = u >> 7;
        const long mb = (long)b * SEQ + (long)n * 128;
        const int g = w >> 1, hq = kvh * 4 + g;
        const int un = (u + (int)gridDim.x < NU) ? u + (int)gridDim.x : u;
        const bf16* qbase = SW_QBASE(u);
        const bf16* qnext = SW_QBASE(un);
#pragma unroll
        for (int i = 0; i < 2; ++i) { const size_t pg = (size_t)u * 1024 + tid + 512 * i; const float* src = P.in[1] + (size_t)M * PLE + pg * 8;
            const f32x4 a = *(const f32x4*)(src), a2 = *(const f32x4*)(src + 4);
            u32x4 o; o.x = pk2(a[0], a[1]); o.y = pk2(a[2], a[3]); o.z = pk2(a2[0], a2[1]); o.w = pk2(a2[2], a2[3]); *(u32x4*)((bf16*)(P.ws + PB1_OFF) + pg * 8) = o; }
        LBAR();
#pragma unroll
        for (int i = 0; i < 4; ++i) { const int idx = tid + 512 * i, jj = idx >> 3, pc = idx & 7;
            *(LAS u32x4*)(L + SW_K + jj * 144 + pc * 16) = kv[i]; *(LAS u32x4*)(L + SW_V + jj * 144 + pc * 16) = vv[i]; }
        LBAR();
        if (un != u) SW_LOAD(un);
        const float sink = sinks[hq];
#pragma unroll 1
        for (int qt = 0; qt < 4; ++qt) {
            const int q0 = 64 * (w & 1) + 16 * qt, kt0 = q0 >> 4, qi = q0 + l15;
            const bf16* qn = (qt < 3) ? qbase + (size_t)(16 * (qt + 1)) * QKV_LD : qnext;
            const bf16x8 qn0 = *(const bf16x8*)(qn), qn1 = *(const bf16x8*)(qn + 32);
            f32x4 sc[9];
#pragma unroll
            for (int t = 0; t < 9; ++t) { const LAS unsigned char* kb = L + SW_K + (16 * (kt0 + t) + l15) * 144 + quad * 16;
                f32x4 a = (f32x4){0.f, 0.f, 0.f, 0.f}; a = MFMA16(lds16(kb), qc0, a); a = MFMA16(lds16(kb + 64), qc1, a); sc[t] = a; }
            constexpr float C2 = 0.125f * 1.4426950408889634f;
            const float sink2 = sink * 1.4426950408889634f;
#pragma unroll
            for (int j = 0; j < 4; ++j) { if (!(4 * quad + j > l15)) sc[0][j] = -INFINITY; if (!(4 * quad + j <= l15)) sc[8][j] = -INFINITY; }
            float mraw = -INFINITY;
#pragma unroll
            for (int t = 0; t < 9; ++t)
#pragma unroll
                for (int j = 0; j < 4; ++j) mraw = fmaxf(mraw, sc[t][j]);
            mraw = fmaxf(mraw, __shfl_xor(mraw, 16)); mraw = fmaxf(mraw, __shfl_xor(mraw, 32));
            const float m2 = fmaxf(mraw * C2, sink2);
            float den = 0.f;
#pragma unroll
            for (int t = 0; t < 9; ++t)
#pragma unroll
                for (int j = 0; j < 4; ++j) { const float p = __builtin_amdgcn_exp2f(sc[t][j] * C2 - m2); sc[t][j] = p; den += p; }
            den += __shfl_xor(den, 16); den += __shfl_xor(den, 32);
            den += __builtin_amdgcn_exp2f(sink2 - m2);
            const float rden = __builtin_amdgcn_rcpf(den);
            f32x4 ot[4];
#pragma unroll
            for (int dt = 0; dt < 4; ++dt) ot[dt] = (f32x4){0.f, 0.f, 0.f, 0.f};
#pragma unroll
            for (int s2 = 0; s2 < 5; ++s2) {
                const f32x4 z4 = (f32x4){0.f, 0.f, 0.f, 0.f};
                const bf16x8 pf = pack8(sc[2 * s2], (s2 < 4) ? sc[(2 * s2 + 1 < 9) ? 2 * s2 + 1 : 8] : z4);
                const int ka = 16 * (kt0 + 2 * s2), kb2 = (s2 < 4) ? ka + 16 : ka;
#pragma unroll
                for (int dt = 0; dt < 4; ++dt) { const LAS unsigned char* vb = L + SW_V + (4 * quad + (l15 >> 2)) * 144 + 32 * dt + 8 * (l15 & 3);
                    const s16x4 lo = ldtr(vb + ka * 144), hi = ldtr(vb + kb2 * 144);
                    const bf16x8 vf = __builtin_shufflevector(lo, hi, 0, 1, 2, 3, 4, 5, 6, 7);
                    ot[dt] = MFMA16(vf, pf, ot[dt]); }
            }
            bf16* op = AO + (size_t)(mb + qi) * D + hq * 64 + 4 * quad;
#pragma unroll
            for (int dt = 0; dt < 4; ++dt) { u32x2 ow; ow.x = pk2(ot[dt][0] * rden, ot[dt][1] * rden); ow.y = pk2(ot[dt][2] * rden, ot[dt][3] * rden); *(u32x2*)(op + 16 * dt) = ow; }
            qc0 = qn0; qc1 = qn1;
        }
    }
    LBAR();
#undef SW_LOAD
#undef SW_QBASE
}

#define XB_TMO      128
#define XB_XCNT(j)  (256  + 64 * (j))
#define XB_XSUB(j)  (1280 + 64 * (j))
#define XB_XGEN(j)  (2304 + 64 * (j))
#define XB_TOP      3328
#define XB_TOPGEN   3392
#define XCD_BAR_WORDS 3456
#define XB_SPIN_CAP (1u << 18)

__device__ __forceinline__ unsigned xb_ld(unsigned* p)              { return __hip_atomic_load(p, __ATOMIC_RELAXED, __HIP_MEMORY_SCOPE_AGENT); }
__device__ __forceinline__ unsigned xb_add(unsigned* p, unsigned v) { return __hip_atomic_fetch_add(p, v, __ATOMIC_RELAXED, __HIP_MEMORY_SCOPE_AGENT); }
__device__ __forceinline__ unsigned xb_xcc_id() { return (unsigned)__builtin_amdgcn_s_getreg((3 << 11) | 20) & 0xFu; }
#define XB_SPIN(cond, bar) do { unsigned _sp = 0; while (cond) { __builtin_amdgcn_s_sleep(1); \
    if ((++_sp & 255u) == 0u) { if (xb_ld(&(bar)[XB_TMO])) break; if (_sp > XB_SPIN_CAP) { atomicAdd(&(bar)[XB_TMO], 1u); break; } } } } while (0)

struct XcdBarrier {
    unsigned* bar; unsigned x;
    volatile LAS unsigned* st;
};

__device__ __forceinline__ XcdBarrier xcd_barrier_post(unsigned* bar, volatile LAS unsigned* st) {
    XcdBarrier b; b.bar = bar; b.x = xb_xcc_id(); b.st = st;
    if (threadIdx.x == 0) (void)xb_add(&bar[XB_XCNT(b.x)], 1u);
    return b;
}
__device__ __forceinline__ void xcd_barrier_complete(unsigned* bar, unsigned x, unsigned& nloc, unsigned& nx) {
    const unsigned G = gridDim.x * gridDim.y * gridDim.z;
    unsigned sum, cnt, mine, sp = 0u;
    for (;;) {
        sum = 0u; cnt = 0u; mine = 0u;
#pragma unroll
        for (unsigned j = 0; j < 16; ++j) { const unsigned c = xb_ld(&bar[XB_XCNT(j)]); sum += c; cnt += (c > 0u) ? 1u : 0u; mine = (j == x) ? c : mine; }
        if (sum == G) break;
        __builtin_amdgcn_s_sleep(1);
        if ((++sp & 255u) == 0u) { if (xb_ld(&bar[XB_TMO])) break; if (sp > XB_SPIN_CAP) { atomicAdd(&bar[XB_TMO], 1u); break; } }
    }
    nloc = mine > 0u ? mine : 1u; nx = cnt > 0u ? cnt : 1u;
}

__device__ __forceinline__ void xcd_barrier(const XcdBarrier& b) {
    asm volatile("s_waitcnt vmcnt(0)" ::: "memory");
    __syncthreads();
    if (threadIdx.x == 0) {
        unsigned* bar = b.bar;
        __builtin_amdgcn_s_waitcnt(0);
        unsigned nloc = b.st[0], nx = b.st[1];
        if (nloc == 0u) { xcd_barrier_complete(bar, b.x, nloc, nx); b.st[0] = nloc; b.st[1] = nx; }
        const unsigned old = xb_add(&bar[XB_XSUB(b.x)], 1u);
        const unsigned gen = old / nloc;
        if (old + 1u == (gen + 1u) * nloc) {
            __builtin_amdgcn_fence(__ATOMIC_RELEASE, "agent");
            asm volatile("s_waitcnt vmcnt(0)" ::: "memory");
            const unsigned og = xb_add(&bar[XB_TOP], 1u);
            const unsigned tg = og / nx;
            if (og + 1u == (tg + 1u) * nx) xb_add(&bar[XB_TOPGEN], 1u);
            else XB_SPIN(xb_ld(&bar[XB_TOPGEN]) == tg, bar);
            __builtin_amdgcn_fence(__ATOMIC_ACQUIRE, "agent");
            xb_add(&bar[XB_XGEN(b.x)], 1u);
            asm volatile("s_waitcnt vmcnt(0)" ::: "memory");
        } else {
            XB_SPIN(xb_ld(&bar[XB_XGEN(b.x)]) == gen, bar);
            __builtin_amdgcn_fence(__ATOMIC_ACQUIRE, "agent");
            asm volatile("s_waitcnt vmcnt(0)" ::: "memory");
        }
    }
    __syncthreads();
}

__global__ void __launch_bounds__(NTHREADS, 2) mega_fwd(Params P) {
    extern __shared__ __attribute__((aligned(16))) unsigned char lds_raw[];
    cg::grid_group grid = cg::this_grid();
    Ctx F; F.lds = (LAS unsigned char*)lds_raw;
#define GSYNC() do { XcdBarrier b2_ = bar; unsigned long long bp_ = (unsigned long long)b2_.bar; unsigned bx_ = __builtin_amdgcn_readfirstlane(b2_.x); asm volatile("" : "+s"(bp_), "+s"(bx_)); b2_.bar = (unsigned*)bp_; b2_.x = bx_; xcd_barrier(b2_); } while (0)
#define REFRESH() do { int t_ = threadIdx.x; asm volatile("" : "+v"(t_)); F.tid = t_; F.lane = t_ & 63; F.wave = __builtin_amdgcn_readfirstlane(t_ >> 6); } while (0)
    REFRESH();
    unsigned char* ws = P.ws;
    const int G = gridDim.x, cid = blockIdx.x;
    volatile LAS unsigned* MISC = (volatile LAS unsigned*)(F.lds + 131072 + 320);
    if (threadIdx.x < 32) MISC[threadIdx.x] = 0u;
    __syncthreads();
    if (cid == 0) for (int i = threadIdx.x; i < XCD_BAR_WORDS; i += NTHREADS) __hip_atomic_store((unsigned*)(ws) + 1024 + i, 0u, __ATOMIC_RELAXED, __HIP_MEMORY_SCOPE_AGENT);
    grid.sync();
    XcdBarrier bar = xcd_barrier_post((unsigned*)(ws) + 1024, MISC + 8);
    bf16* A16 = (bf16*)(ws + R0); bf16* U16 = (bf16*)(ws + R2);
    bf16* Y1B = (bf16*)(ws + R1); bf16* Y2B = (bf16*)(ws + R1 + 64 * MiB); bf16* H3B = (bf16*)(ws + R2_H3B);
    float* ST1 = (float*)(ws + 504 * MiB); float* ST2 = (float*)(ws + 508 * MiB);
    LAS float* SX = (LAS float*)(F.lds + 131072 + 1024);

    p0_prologue(F, P);
    GSYNC();
    {
        pg8::Gemm g{A16, (const bf16*)(ws + W_IN_T), M, PROJ_LD, opq(D), D, D}; pg8::StaticOrder S; S.init(M, PROJ_LD, G, cid);
        pg8::EpiBf16 E{U16, PROJ_LD, nullptr, 1 << 30, nullptr};
        pg8::gemm_phase<pg8::EpiBf16, pg8::StaticOrder, true, true>(F.lds, g, S, E, SX);
    }
    GSYNC();
    REFRESH(); gla_pass_a(F, P);
    fold_finalize(P, cid * NTHREADS + F.tid, G * NTHREADS);
    GSYNC();
    REFRESH(); gla_scan_pass<true>(F, P);
    GSYNC();
#pragma unroll 1
    for (int layer = 0; layer < 2; ++layer) {
        const float* fin = (const float*)(ws + FIN(0)) + (size_t)layer * (64 * 1024 / 4);
        if (layer == 1) {
            {
                pg8::Gemm g{H3B, (const bf16*)(ws + W_QKV_T), M, QKV_LD, opq(D), D, D}; pg8::StaticOrder S; S.init(M, QKV_LD, G, cid);
                pg8::EpiBf16 E{(bf16*)(ws + R2_QKV), QKV_LD, P.in[8], 1 << 30, nullptr};
                pg8::gemm_phase<pg8::EpiBf16, pg8::StaticOrder, true, true>(F.lds, g, S, E, SX);
            }
            GSYNC();
            REFRESH(); swa_phase(F, P);
            GSYNC();
        }
        {
            const bf16* A = layer == 0 ? (const bf16*)(ws + R2) + 2048 : (const bf16*)A16;
            pg8::Gemm g{A, (const bf16*)(ws + (layer == 0 ? W_GOUT_T : W_SOUT_T)), M, D, opq(D), layer == 0 ? PROJ_LD : D, D}; pg8::StaticOrder S; S.init(M, D, G, cid);
            pg8::EpiY<false> E{layer == 0 ? (const void*)A16 : (const void*)H3B, 1, layer == 0 ? nullptr : P.in[11], nullptr, nullptr, nullptr, Y1B, ST1, ALPHA};
            pg8::gemm_phase<pg8::EpiY<false>, pg8::StaticOrder, true, true>(F.lds, g, S, E, SX);
        }
        GSYNC();
        {
            pg8::Gemm g{Y1B, (const bf16*)(ws + W_UP_T + (size_t)layer * W_LSTRIDE), M, FF, opq(D), D, D}; pg8::StaticOrder S; S.init(M, FF, G, cid);
            pg8::EpiUpLN E{ST1, fin, fin + 4096, U16, FF};
            pg8::gemm_phase<pg8::EpiUpLN, pg8::StaticOrder, true, true>(F.lds, g, S, E, SX);
        }
        GSYNC();
        {
            pg8::Gemm g{U16, (const bf16*)(ws + W_DN_T + (size_t)layer * W_LSTRIDE), M, D, opq(FF), FF, FF}; pg8::StaticOrder S; S.init(M, D, G, cid);
            pg8::EpiY<true> E{(const void*)Y1B, 1, nullptr, P.in[14] + layer * D, P.in[15] + layer * D, ST1, Y2B, ST2, ALPHA};
            pg8::gemm_phase<pg8::EpiY<true>, pg8::StaticOrder, true, true>(F.lds, g, S, E, SX);
        }
        GSYNC();
        {
            int kpp = opq(PLE); pg8::Gemm g{layer == 0 ? (const bf16*)P.out : (const bf16*)(ws + PB1_OFF), (const bf16*)(ws + W_PP_T + (size_t)layer * W_LSTRIDE), M, D, kpp, kpp, kpp}; pg8::StaticOrder S; S.init(M, D, G, cid);
            pg8::EpiPP E{(bf16*)(ws + R2_PP), D};
            pg8::gemm_phase<pg8::EpiPP, pg8::StaticOrder, true, true>(F.lds, g, S, E, SX);
        }
        __syncthreads();
        {
            pg8::Gemm g{Y2B, (const bf16*)(ws + W_GATE_T + (size_t)layer * W_LSTRIDE), M, D, opq(D), D, D}; pg8::StaticOrder S; S.init(M, D, G, cid);
            pg8::EpiGateLN E{ST2, Y2B, (const bf16*)(ws + R2_PP), fin + 8192, fin + 9216, P.in[16] + layer * D, P.in[17] + layer * D, P.out, layer == 0 ? H3B : nullptr};
            pg8::gemm_phase<pg8::EpiGateLN, pg8::StaticOrder, true, true>(F.lds, g, S, E, SX);
        }
        if (layer == 0) GSYNC();
    }
}

extern "C" void kernel_launch(void* const* d_in, const int* in_sizes, int n_in, void* d_out, int out_size, void* d_ws, size_t ws_size, hipStream_t stream) {
    static int grid = 0;
    if (grid == 0) {
        if (n_in != 21 || in_sizes[0] != M * D || out_size != M * D || ws_size < WS_END) { fprintf(stderr, "kernel_launch: unexpected shapes (n_in %d, in0 %d, out %d, ws %zu)\n", n_in, n_in > 0 ? in_sizes[0] : -1, out_size, ws_size); grid = -1; return; }
        int dev = 0, cus = 0, per_cu = 0;
        hipGetDevice(&dev); hipDeviceGetAttribute(&cus, hipDeviceAttributeMultiprocessorCount, dev);
        if (hipFuncSetAttribute((const void*)mega_fwd, hipFuncAttributeMaxDynamicSharedMemorySize, LDS_BYTES) != hipSuccess) { fprintf(stderr, "kernel_launch: hipFuncSetAttribute failed\n"); grid = -1; return; }
        if (hipOccupancyMaxActiveBlocksPerMultiprocessor(&per_cu, (const void*)mega_fwd, NTHREADS, LDS_BYTES) != hipSuccess || per_cu < 1) { fprintf(stderr, "kernel_launch: occupancy query says %d\n", per_cu); (void)hipGetLastError(); per_cu = 1; }
        grid = cus * 1;
        if (grid <= 0) grid = 256;
    }
    if (grid < 0) return;
    Params p{};
    for (int i = 0; i < 21; ++i) p.in[i] = (const float*)d_in[i];
    p.out = (float*)d_out; p.ws = (unsigned char*)d_ws;
    void* args[] = {&p};
    hipError_t e = hipLaunchCooperativeKernel((const void*)mega_fwd, dim3(grid), dim3(NTHREADS), args, LDS_BYTES, stream);
    if (e != hipSuccess) fprintf(stderr, "cooperative launch failed: %s (grid %d)\n", hipGetErrorString(e), grid);
}
```

```cpp
#include <hip/hip_runtime.h>
#include <hip/hip_cooperative_groups.h>
#include <cstdio>
#include <cstdint>
namespace cg = cooperative_groups;
namespace pg8 {
#define PG8_LAS __attribute__((address_space(3)))
typedef unsigned short bf16_t;
typedef short bf16x8 __attribute__((ext_vector_type(8)));
typedef float f32x4 __attribute__((ext_vector_type(4)));
typedef unsigned u32x4 __attribute__((ext_vector_type(4)));
constexpr int BM = 256, BK = 64, HALF = 128, HTB = HALF * BK * 2  , STAGE_BYTES = 8 * HTB, NXCD = 8, WGM = 8;

__host__ __device__ __forceinline__ int lds_byte(int r, int c) { const int st = (r >> 4) * 2 + (c >> 5), rr = r & 15, cc = c & 31, ob = rr * 64 + cc * 2; return st * 1024 + (ob ^ (((ob >> 9) & 1) << 5)); }
__host__ __device__ __forceinline__ void stage_rc(int b, int& R, int& C) { const int st = b / 1024, sb = b % 1024, swz = sb ^ (((sb >> 9) & 1) << 5); R = (st >> 1) * 16 + swz / 64; C = (st & 1) * 32 + (swz % 64) / 2; }
__host__ __device__ __forceinline__ int perm32(int rho) { const int n = rho >> 4, i = rho & 15; return 8 * (i >> 2) + 4 * n + (i & 3); }

struct Unit { int pm, pn; };
struct Gemm { const bf16_t* A; const bf16_t* Bt; int M, N, K, lda, ldb; };

struct StaticOrder {
    int nM, nN, nwg, G, c;
    __host__ __device__ void init(int M, int N, int G_, int c_) { nM = M / BM; nN = N / BM; nwg = nM * nN; G = G_; c = c_; }
    __host__ __device__ bool next(int i, Unit& u) const {
        const long L = (long)i * G + c; if (L >= nwg) return false;
        int wgid = (int)L; { const int q = nwg / NXCD, r = nwg % NXCD, xcd = wgid % NXCD, off = wgid / NXCD; wgid = (xcd < r ? xcd * (q + 1) : r * (q + 1) + (xcd - r) * q) + off; }
        const int nig = WGM * nN, gid = wgid / nig, fm = gid * WGM, gsz = (nM - fm) < WGM ? (nM - fm) : WGM;
        u.pm = fm + ((wgid % nig) % gsz); u.pn = (wgid % nig) / gsz; return true;
    }
    __device__ __forceinline__ void a_ready(const Unit&) const {}
    __device__ __forceinline__ void done(const Unit&) const {}
};


__device__ __forceinline__ unsigned cvt_pk_bf16(float lo, float hi) { unsigned r; asm volatile("v_cvt_pk_bf16_f32 %0, %1, %2" : "=v"(r) : "v"(lo), "v"(hi)); return r; }
typedef unsigned u32x2 __attribute__((ext_vector_type(2)));
typedef float f32x2 __attribute__((ext_vector_type(2)));
__device__ __forceinline__ float bf2f(unsigned short b) { return __uint_as_float(((unsigned)b) << 16); }
__device__ __forceinline__ void unpack8(const u32x4 w, float (&v)[8]) {
    v[0] = __uint_as_float(w.x << 16); v[1] = __uint_as_float(w.x & 0xffff0000u); v[2] = __uint_as_float(w.y << 16); v[3] = __uint_as_float(w.y & 0xffff0000u);
    v[4] = __uint_as_float(w.z << 16); v[5] = __uint_as_float(w.z & 0xffff0000u); v[6] = __uint_as_float(w.w << 16); v[7] = __uint_as_float(w.w & 0xffff0000u);
}
constexpr float EPI_LN_EPS = 1e-5f;
__device__ __forceinline__ void stats_pre(const float* ST, int pm, int slot, int tid, PG8_LAS float* sx) {
    if (tid < 256) {
        const f32x4* p = (const f32x4*)(ST + (size_t)(pm * BM + tid) * 32); float s = 0.f, q = 0.f;
#pragma unroll
        for (int i = 0; i < 8; ++i) { const f32x4 v = p[i]; s += v[0] + v[2]; q += v[1] + v[3]; }
        const float mean = s * (1.0f / 1024.0f), var = fmaxf(q * (1.0f / 1024.0f) - mean * mean, 0.f);
        *(PG8_LAS f32x2*)(sx + (slot * 256 + tid) * 2) = (f32x2){mean, 1.0f / sqrtf(var + EPI_LN_EPS)};
    }
}

struct EpiBf16 {
    static constexpr bool PERM = true, AFTER_DRAIN = false;
    bf16_t* O; int ldc; const float* bias; int gk_tile; float* GK;
    __device__ __forceinline__ void pre(const Unit&, int, int, PG8_LAS float*) const {}
    __device__ __forceinline__ void operator()(const f32x4 (&acc)[2][2][4][2], const Unit& u, int wr, int wc, int fr, int fq, int, PG8_LAS float*) const {
        const int row0 = u.pm * BM + wr * 64 + fr;
        if (u.pn >= gk_tile) {
            if (wc == 0 && fq < 2) {
#pragma unroll
                for (int ai = 0; ai < 2; ++ai)
#pragma unroll
                    for (int m = 0; m < 4; ++m) { float* gp = GK + (size_t)(row0 + ai * HALF + m * 16) * 16 + 8 * fq;
                        *(f32x4*)(gp) = acc[ai][0][m][0]; *(f32x4*)(gp + 4) = acc[ai][0][m][1]; }
            }
            return;
        }
        const int col0 = u.pn * BM + wc * 32 + 8 * fq;
#pragma unroll
        for (int bj = 0; bj < 2; ++bj) {
            f32x4 b0 = (f32x4){0.f, 0.f, 0.f, 0.f}, b1 = b0;
            if (bias) { b0 = *(const f32x4*)(bias + col0 + bj * HALF); b1 = *(const f32x4*)(bias + col0 + bj * HALF + 4); }
#pragma unroll
            for (int ai = 0; ai < 2; ++ai)
#pragma unroll
                for (int m = 0; m < 4; ++m) { const f32x4 v0 = acc[ai][bj][m][0] + b0, v1 = acc[ai][bj][m][1] + b1;
                    u32x4 w; w.x = cvt_pk_bf16(v0[0], v0[1]); w.y = cvt_pk_bf16(v0[2], v0[3]); w.z = cvt_pk_bf16(v1[0], v1[1]); w.w = cvt_pk_bf16(v1[2], v1[3]);
                    *(u32x4*)(O + (size_t)(row0 + ai * HALF + m * 16) * ldc + col0 + bj * HALF) = w; } }
    }
};

template <bool LN> struct EpiY {
    static constexpr bool PERM = true, AFTER_DRAIN = false;
    const void* res; int res_bf16; const float* bias; const float* g; const float* b; const float* ST_IN; bf16_t* Y; float* ST; float alpha;
    __device__ __forceinline__ void pre(const Unit& u, int slot, int tid, PG8_LAS float* sx) const { if (LN) stats_pre(ST_IN, u.pm, slot, tid, sx); }
    __device__ __forceinline__ void operator()(const f32x4 (&acc)[2][2][4][2], const Unit& u, int wr, int wc, int fr, int fq, int slot, PG8_LAS float* sx) const {
        const int col0 = u.pn * BM + wc * 32 + 8 * fq, rl0 = wr * 64 + fr; const size_t roff0 = (size_t)(u.pm * BM + rl0) * 1024;
        const bf16_t* R = (const bf16_t*)res;
        float ps[8], pq[8];
#pragma unroll
        for (int r = 0; r < 8; ++r) { ps[r] = 0.f; pq[r] = 0.f; }
#pragma unroll
        for (int bj = 0; bj < 2; ++bj) { const int c = col0 + bj * HALF;
            u32x4 rr[8];
#pragma unroll
            for (int r = 0; r < 8; ++r) rr[r] = *(const u32x4*)(R + roff0 + (size_t)((r >> 2) * HALF + (r & 3) * 16) * 1024 + c);
            f32x4 g0, g1, b0, b1, bb0, bb1;
            if (LN) { g0 = *(const f32x4*)(g + c); g1 = *(const f32x4*)(g + c + 4); b0 = *(const f32x4*)(b + c); b1 = *(const f32x4*)(b + c + 4); }
            if (bias) { bb0 = *(const f32x4*)(bias + c); bb1 = *(const f32x4*)(bias + c + 4); }
#pragma unroll
            for (int r = 0; r < 8; ++r) { const int ai = r >> 2, m = r & 3, rl = rl0 + ai * HALF + m * 16;
                float rv[8]; unpack8(rr[r], rv);
                if (LN) { const f32x2 mr = *(const PG8_LAS f32x2*)(sx + (slot * 256 + rl) * 2);
#pragma unroll
                    for (int i = 0; i < 4; ++i) { rv[i] = (rv[i] - mr[0]) * mr[1] * g0[i] + b0[i]; rv[4 + i] = (rv[4 + i] - mr[0]) * mr[1] * g1[i] + b1[i]; } }
                f32x4 v0 = acc[ai][bj][m][0], v1 = acc[ai][bj][m][1];
                if (bias) { v0 += bb0; v1 += bb1; }
                float y[8];
#pragma unroll
                for (int i = 0; i < 4; ++i) { y[i] = alpha * rv[i] + v0[i]; y[4 + i] = alpha * rv[4 + i] + v1[i]; }
                u32x4 w; w.x = cvt_pk_bf16(y[0], y[1]); w.y = cvt_pk_bf16(y[2], y[3]); w.z = cvt_pk_bf16(y[4], y[5]); w.w = cvt_pk_bf16(y[6], y[7]);
                *(u32x4*)(Y + roff0 + (size_t)(ai * HALF + m * 16) * 1024 + c) = w;
                float yr[8]; unpack8(w, yr);
#pragma unroll
                for (int i = 0; i < 8; ++i) { ps[r] += yr[i]; pq[r] += yr[i] * yr[i]; } }
        }
#pragma unroll
        for (int r = 0; r < 8; ++r) { float a = ps[r], q = pq[r];
            a += __shfl_xor(a, 16); a += __shfl_xor(a, 32); q += __shfl_xor(q, 16); q += __shfl_xor(q, 32);
            if (fq == 0) *(f32x2*)(ST + (size_t)(u.pm * BM + rl0 + (r >> 2) * HALF + (r & 3) * 16) * 32 + (u.pn * 4 + wc) * 2) = (f32x2){a, q}; }
    }
};

struct EpiUpLN {
    static constexpr bool PERM = true, AFTER_DRAIN = false;
    const float* ST_IN; const float* colsum; const float* bw; bf16_t* O; int ldc;
    __device__ __forceinline__ void pre(const Unit& u, int slot, int tid, PG8_LAS float* sx) const { stats_pre(ST_IN, u.pm, slot, tid, sx); }
    __device__ __forceinline__ void operator()(const f32x4 (&acc)[2][2][4][2], const Unit& u, int wr, int wc, int fr, int fq, int slot, PG8_LAS float* sx) const {
        const int col0 = u.pn * BM + wc * 32 + 8 * fq, rl0 = wr * 64 + fr;
#pragma unroll
        for (int bj = 0; bj < 2; ++bj) { const int c = col0 + bj * HALF;
            const f32x4 c0 = *(const f32x4*)(colsum + c), c1 = *(const f32x4*)(colsum + c + 4), w0 = *(const f32x4*)(bw + c), w1 = *(const f32x4*)(bw + c + 4);
#pragma unroll
            for (int r = 0; r < 8; ++r) { const int ai = r >> 2, m = r & 3, rl = rl0 + ai * HALF + m * 16;
                const f32x2 mr = *(const PG8_LAS f32x2*)(sx + (slot * 256 + rl) * 2);
                f32x4 v0 = (acc[ai][bj][m][0] - c0 * mr[0]) * mr[1] + w0, v1 = (acc[ai][bj][m][1] - c1 * mr[0]) * mr[1] + w1;
#pragma unroll
                for (int i = 0; i < 4; ++i) { const float a = fmaxf(v0[i], 0.f), b2 = fmaxf(v1[i], 0.f); v0[i] = a * a; v1[i] = b2 * b2; }
                u32x4 w; w.x = cvt_pk_bf16(v0[0], v0[1]); w.y = cvt_pk_bf16(v0[2], v0[3]); w.z = cvt_pk_bf16(v1[0], v1[1]); w.w = cvt_pk_bf16(v1[2], v1[3]);
                *(u32x4*)(O + (size_t)(u.pm * BM + rl) * ldc + c) = w; } }
    }
};

struct EpiPP {
    static constexpr bool PERM = true, AFTER_DRAIN = false;
    bf16_t* O; int ldc;
    __device__ __forceinline__ void pre(const Unit&, int, int, PG8_LAS float*) const {}
    __device__ __forceinline__ void operator()(const f32x4 (&acc)[2][2][4][2], const Unit& u, int wr, int wc, int fr, int fq, int, PG8_LAS float*) const {
        const int row0 = u.pm * BM + wr * 64 + fr, col0 = u.pn * BM + wc * 32 + 8 * fq;
#pragma unroll
        for (int ai = 0; ai < 2; ++ai)
#pragma unroll
            for (int m = 0; m < 4; ++m) { bf16_t* rowp = O + (size_t)(row0 + ai * HALF + m * 16) * ldc + col0;
#pragma unroll
                for (int bj = 0; bj < 2; ++bj) { const f32x4 v0 = acc[ai][bj][m][0], v1 = acc[ai][bj][m][1];
                    u32x4 w; w.x = cvt_pk_bf16(v0[0], v0[1]); w.y = cvt_pk_bf16(v0[2], v0[3]); w.z = cvt_pk_bf16(v1[0], v1[1]); w.w = cvt_pk_bf16(v1[2], v1[3]);
                    *(u32x4*)(rowp + bj * HALF) = w; } }
    }
};

struct EpiGateLN {
    static constexpr bool PERM = true, AFTER_DRAIN = false;
    const float* ST_IN; const bf16_t* YB; const bf16_t* pp; const float* colsum; const float* bz; const float* g; const float* b; float* out; bf16_t* ob;
    __device__ __forceinline__ void pre(const Unit& u, int slot, int tid, PG8_LAS float* sx) const { stats_pre(ST_IN, u.pm, slot, tid, sx); }
    __device__ __forceinline__ void operator()(const f32x4 (&acc)[2][2][4][2], const Unit& u, int wr, int wc, int fr, int fq, int slot, PG8_LAS float* sx) const {
        const int col0 = u.pn * BM + wc * 32 + 8 * fq, rl0 = wr * 64 + fr; const size_t roff0 = (size_t)(u.pm * BM + rl0) * 1024;
#pragma unroll
        for (int bj = 0; bj < 2; ++bj) { const int c = col0 + bj * HALF;
            f32x4 cs[2], zb[2], gg[2], bb[2];
#pragma unroll
            for (int hh = 0; hh < 2; ++hh) { cs[hh] = *(const f32x4*)(colsum + c + 4 * hh); zb[hh] = *(const f32x4*)(bz + c + 4 * hh); gg[hh] = *(const f32x4*)(g + c + 4 * hh); bb[hh] = *(const f32x4*)(b + c + 4 * hh); }
#pragma unroll
            for (int ai = 0; ai < 2; ++ai) {
                u32x4 yy[4], pw[4];
#pragma unroll
                for (int m = 0; m < 4; ++m) { const size_t o2 = roff0 + (size_t)(ai * HALF + m * 16) * 1024 + c; yy[m] = *(const u32x4*)(YB + o2); pw[m] = *(const u32x4*)(pp + o2); }
#pragma unroll
                for (int m = 0; m < 4; ++m) { const int rl = rl0 + ai * HALF + m * 16; const size_t o2 = roff0 + (size_t)(ai * HALF + m * 16) * 1024 + c;
                    const f32x2 mr = *(const PG8_LAS f32x2*)(sx + (slot * 256 + rl) * 2);
                    float y[8], p[8], o[8]; unpack8(yy[m], y); unpack8(pw[m], p);
#pragma unroll
                    for (int hh = 0; hh < 2; ++hh) { const f32x4 z = (acc[ai][bj][m][hh] - cs[hh] * mr[0]) * mr[1] + zb[hh];
#pragma unroll
                        for (int i = 0; i < 4; ++i) { const float h2 = (y[4 * hh + i] - mr[0]) * mr[1] * gg[hh][i] + bb[hh][i]; o[4 * hh + i] = h2 + p[4 * hh + i] * __builtin_amdgcn_rcpf(1.0f + __expf(-z[i])); } }
                    if (ob) { u32x4 w; w.x = cvt_pk_bf16(o[0], o[1]); w.y = cvt_pk_bf16(o[2], o[3]); w.z = cvt_pk_bf16(o[4], o[5]); w.w = cvt_pk_bf16(o[6], o[7]); *(u32x4*)(ob + o2) = w; }
                    else { *(f32x4*)(out + o2) = (f32x4){o[0], o[1], o[2], o[3]}; *(f32x4*)(out + o2 + 4) = (f32x4){o[4], o[5], o[6], o[7]}; } }
                asm volatile("" ::: "memory");
            } }
    }
};

template <class Epi, class Sched, bool ALIGN_EPI = false, bool SP2 = false>
__device__ __forceinline__ void gemm_phase(PG8_LAS unsigned char* lds, const Gemm g, const Sched& S, const Epi& E, PG8_LAS float* sx) {
    int tid_ = threadIdx.x; asm volatile("" : "+v"(tid_));
    const int tid = tid_, wid = __builtin_amdgcn_readfirstlane(tid >> 6), lane = tid & 63, wr = wid >> 2, wc = wid & 3, fr = lane & 15, fq = lane >> 4;
    const int K = g.K, nt = K / BK;
    unsigned voffA[2], voffB[2];
#pragma unroll
    for (int i = 0; i < 2; ++i) { int R, C; stage_rc(tid * 16 + i * 8192, R, C); const int Rb = Epi::PERM ? ((R & ~31) + perm32(R & 31)) : R;
        voffA[i] = (unsigned)(R * g.lda + C) * 2u; voffB[i] = (unsigned)(Rb * g.ldb + C) * 2u; }
    const size_t kstep = (size_t)(BK * 2);
    const size_t hstepA = (size_t)HALF * g.lda * 2, hstepB = (size_t)HALF * g.ldb * 2;
    const size_t tstepA = 2 * hstepA, tstepB = 2 * hstepB;
    const unsigned ldsw = (unsigned)wid * 1024u;
    const int aoff = lds_byte(wr * 64 + fr, fq * 8), boff = lds_byte(wc * 32 + fr, fq * 8);
#define PG8_SA(b, h) (((b) * 2 + (h)) * HTB)
#define PG8_SB(b, h) ((4 + (b) * 2 + (h)) * HTB)
#define PG8_STAGE(bufoff, gbase, voff) do { _Pragma("unroll") for (int _i = 0; _i < 2; ++_i) \
        __builtin_amdgcn_global_load_lds((const unsigned*)((const char*)(gbase) + (voff)[_i]), (PG8_LAS unsigned*)(lds + (bufoff) + ldsw + _i * 8192), 16, 0, 0); } while (0)
#define PG8_LDA(dst, b, h) do { _Pragma("unroll") for (int m = 0; m < 4; ++m) _Pragma("unroll") for (int k = 0; k < 2; ++k) dst[m][k] = *(const PG8_LAS bf16x8*)(lds + PG8_SA(b, h) + aoff + m * 2048 + k * 1024); } while (0)
#define PG8_LDB(dst, b, h) do { _Pragma("unroll") for (int n = 0; n < 2; ++n) _Pragma("unroll") for (int k = 0; k < 2; ++k) dst[n][k] = *(const PG8_LAS bf16x8*)(lds + PG8_SB(b, h) + boff + n * 2048 + k * 1024); } while (0)
#define PG8_MMA(ai, bj, At, Bt) do { __builtin_amdgcn_s_setprio(1); _Pragma("unroll") for (int m = 0; m < 4; ++m) _Pragma("unroll") for (int n = 0; n < 2; ++n) _Pragma("unroll") for (int k = 0; k < 2; ++k) \
        acc[ai][bj][m][n] = __builtin_amdgcn_mfma_f32_16x16x32_bf16(Bt[n][k], At[m][k], acc[ai][bj][m][n], 0, 0, 0); __builtin_amdgcn_s_setprio(0); } while (0)
#define PG8_WAIT_V(n) asm volatile("s_waitcnt vmcnt(" #n ")" ::: "memory")
#define PG8_WAIT_L(n) asm volatile("s_waitcnt lgkmcnt(" #n ")" ::: "memory")
#define PG8_BAR __builtin_amdgcn_s_barrier()
#define PG8_SCHED __builtin_amdgcn_sched_barrier(0)
    Unit cur, nxt; int ui = 0;
    if (!S.next(0, cur)) return;
    f32x4 acc[2][2][4][2];
#pragma unroll
    for (int a = 0; a < 2; ++a)
#pragma unroll
        for (int b = 0; b < 2; ++b)
#pragma unroll
            for (int m = 0; m < 4; ++m)
#pragma unroll
                for (int n = 0; n < 2; ++n) acc[a][b][m][n] = (f32x4){0.f, 0.f, 0.f, 0.f};
    bf16x8 At[4][2], B0[2][2], B1[2][2];
    const char* cA = (const char*)g.A + (size_t)cur.pm * tstepA; const char* cB = (const char*)g.Bt + (size_t)cur.pn * tstepB;
    S.a_ready(cur); E.pre(cur, 0, tid, sx);
    if constexpr (SP2) {
        PG8_STAGE(PG8_SB(0, 0), cB, voffB); PG8_STAGE(PG8_SB(0, 1), cB + hstepB, voffB); PG8_STAGE(PG8_SA(0, 0), cA, voffA); PG8_STAGE(PG8_SA(0, 1), cA + hstepA, voffA);
        if (wr == 1) PG8_BAR;
        PG8_WAIT_V(2); PG8_BAR;
        PG8_STAGE(PG8_SB(1, 0), cB + kstep, voffB); PG8_STAGE(PG8_SA(1, 0), cA + kstep, voffA); PG8_STAGE(PG8_SB(1, 1), cB + hstepB + kstep, voffB);
        PG8_WAIT_V(6); PG8_BAR;
    } else {
        PG8_STAGE(PG8_SB(0, 0), cB, voffB); PG8_STAGE(PG8_SA(0, 0), cA, voffA); PG8_STAGE(PG8_SB(0, 1), cB + hstepB, voffB); PG8_STAGE(PG8_SA(0, 1), cA + hstepA, voffA);
        if (wr == 1) PG8_BAR;
        PG8_WAIT_V(4); PG8_BAR;
        PG8_STAGE(PG8_SB(1, 0), cB + kstep, voffB); PG8_STAGE(PG8_SA(1, 0), cA + kstep, voffA); PG8_STAGE(PG8_SB(1, 1), cB + hstepB + kstep, voffB);
        PG8_WAIT_V(6); PG8_BAR;
    }
    for (;;) {
        const bool has_next = S.next(ui + 1, nxt);
        const char* nA = has_next ? (const char*)g.A + (size_t)nxt.pm * tstepA : cA; const char* nB = has_next ? (const char*)g.Bt + (size_t)nxt.pn * tstepB : cB;
        for (int t = 0; t < nt; t += 2) {
            const bool last = (t == nt - 2);
            const char* a1 = cA + (size_t)(t + 1) * kstep;
            const char* a2 = last ? nA : cA + (size_t)(t + 2) * kstep; const char* b2 = last ? nB : cB + (size_t)(t + 2) * kstep;
            const char* a3 = a2 + kstep; const char* b3 = b2 + kstep;
            if (last && has_next) { S.a_ready(nxt); E.pre(nxt, (ui + 1) & 1, tid, sx); }
            if constexpr (SP2) {
            PG8_LDB(B0, 0, 0); PG8_LDB(B1, 0, 1); PG8_SCHED; PG8_LDA(At, 0, 0); PG8_STAGE(PG8_SA(1, 1), a1 + hstepA, voffA);
            PG8_WAIT_V(8); PG8_WAIT_L(0); PG8_BAR; PG8_MMA(0, 0, At, B0); PG8_MMA(0, 1, At, B1); PG8_BAR; PG8_SCHED;
            PG8_LDA(At, 0, 1); PG8_STAGE(PG8_SB(0, 0), b2, voffB); PG8_STAGE(PG8_SB(0, 1), b2 + hstepB, voffB); PG8_STAGE(PG8_SA(0, 0), a2, voffA);
            PG8_WAIT_V(8); PG8_WAIT_L(0); PG8_BAR; PG8_MMA(1, 0, At, B0); PG8_MMA(1, 1, At, B1); PG8_BAR; PG8_SCHED;
            PG8_LDB(B0, 1, 0); PG8_LDB(B1, 1, 1); PG8_SCHED; PG8_LDA(At, 1, 0); PG8_STAGE(PG8_SA(0, 1), a2 + hstepA, voffA);
            PG8_WAIT_V(8); PG8_WAIT_L(0); PG8_BAR; PG8_MMA(0, 0, At, B0); PG8_MMA(0, 1, At, B1); PG8_BAR; PG8_SCHED;
            PG8_LDA(At, 1, 1); PG8_STAGE(PG8_SB(1, 0), b3, voffB); PG8_STAGE(PG8_SB(1, 1), b3 + hstepB, voffB); PG8_STAGE(PG8_SA(1, 0), a3, voffA);
            PG8_WAIT_V(8); PG8_WAIT_L(0); PG8_BAR; PG8_MMA(1, 0, At, B0); PG8_MMA(1, 1, At, B1); PG8_BAR; PG8_SCHED;
            } else {
            PG8_LDB(B0, 0, 0); PG8_SCHED; PG8_LDA(At, 0, 0); PG8_STAGE(PG8_SA(1, 1), a1 + hstepA, voffA);
            PG8_WAIT_L(8); PG8_BAR; PG8_WAIT_L(0); PG8_MMA(0, 0, At, B0); PG8_BAR; PG8_SCHED;
            PG8_LDB(B1, 0, 1); PG8_STAGE(PG8_SB(0, 0), b2, voffB);
            PG8_BAR; PG8_WAIT_L(0); PG8_MMA(0, 1, At, B1); PG8_BAR;
            PG8_LDA(At, 0, 1); PG8_STAGE(PG8_SA(0, 0), a2, voffA);
            PG8_BAR; PG8_WAIT_L(0); PG8_MMA(1, 0, At, B0); PG8_BAR; PG8_SCHED;
            PG8_STAGE(PG8_SB(0, 1), b2 + hstepB, voffB);
            PG8_WAIT_V(6); PG8_BAR; PG8_MMA(1, 1, At, B1); PG8_BAR;
            PG8_LDB(B0, 1, 0); PG8_SCHED; PG8_LDA(At, 1, 0); PG8_STAGE(PG8_SA(0, 1), a2 + hstepA, voffA);
            PG8_WAIT_L(8); PG8_BAR; PG8_WAIT_L(0); PG8_MMA(0, 0, At, B0); PG8_BAR; PG8_SCHED;
            PG8_LDB(B1, 1, 1); PG8_STAGE(PG8_SB(1, 0), b3, voffB);
            PG8_BAR; PG8_WAIT_L(0); PG8_MMA(0, 1, At, B1); PG8_BAR;
            PG8_LDA(At, 1, 1); PG8_STAGE(PG8_SA(1, 0), a3, voffA);
            PG8_BAR; PG8_WAIT_L(0); PG8_MMA(1, 0, At, B0); PG8_BAR; PG8_SCHED;
            PG8_STAGE(PG8_SB(1, 1), b3 + hstepB, voffB);
            PG8_WAIT_V(6); PG8_BAR; PG8_MMA(1, 1, At, B1); PG8_BAR;
            }
        }
        if constexpr (ALIGN_EPI) { if (wr == 0) PG8_BAR; }
        if constexpr (!Epi::AFTER_DRAIN) { E(acc, cur, wr, wc, fr, fq, ui & 1, sx); S.done(cur); }
        if (!has_next) break;
#pragma unroll
        for (int a = 0; a < 2; ++a)
#pragma unroll
            for (int b = 0; b < 2; ++b)
#pragma unroll
                for (int m = 0; m < 4; ++m)
#pragma unroll
                    for (int n = 0; n < 2; ++n) acc[a][b][m][n] = (f32x4){0.f, 0.f, 0.f, 0.f};
        cur = nxt; cA = nA; cB = nB; ++ui;
        if constexpr (ALIGN_EPI) { if (wr == 1) PG8_BAR; }
    }
    PG8_WAIT_V(0);
    if constexpr (!ALIGN_EPI) { if (wr == 0) PG8_BAR; }
    PG8_BAR;
    if constexpr (Epi::AFTER_DRAIN) { E.fused(acc, cur, wr, wc, fr, fq, lds, wid, lane); S.done(cur); }
#undef PG8_SA
#undef PG8_SB
#undef PG8_STAGE
#undef PG8_LDA
#undef PG8_LDB
#undef PG8_MMA
#undef PG8_WAIT_V
#undef PG8_WAIT_L
#undef PG8_BAR
#undef PG8_SCHED
}
}

#define LAS __attribute__((address_space(3)))
typedef unsigned short bf16;
typedef unsigned u32x4 __attribute__((ext_vector_type(4)));
typedef unsigned u32x2 __attribute__((ext_vector_type(2)));
typedef float f32x4 __attribute__((ext_vector_type(4)));
typedef short bf16x8 __attribute__((ext_vector_type(8)));
typedef short s16x4 __attribute__((ext_vector_type(4)));

constexpr int NTHREADS = 512, NWAVES = 8;
constexpr int BATCH = 8, SEQ = 4096, D = 1024, M = BATCH * SEQ, FF = 4096, PLE = 256;
constexpr int GLA_COLS = 3088, PROJ_LD = 3072;
constexpr int QKV_LD = 1536;
constexpr float LN_EPS = 1e-5f, RMS_EPS = 1e-5f;
constexpr float ALPHA = 1.4142135623730951f;
constexpr size_t MiB = 1u << 20;
constexpr size_t W_IN_T = 1 * MiB;
constexpr size_t W_GOUT_T = 7 * MiB;
constexpr size_t W_UP_T = 9 * MiB;
constexpr size_t W_DN_T = 17 * MiB;
constexpr size_t W_GATE_T = 25 * MiB;
constexpr size_t W_PP_T = 27 * MiB;
constexpr size_t W_QKV_T = 28 * MiB;
constexpr size_t W_SOUT_T = 31 * MiB;
constexpr size_t W_LSTRIDE = 24 * MiB;
constexpr size_t PB1_OFF = 1 * MiB;
constexpr size_t R0 = 56 * MiB;
constexpr size_t R1 = 120 * MiB;
constexpr size_t R2 = 248 * MiB;
constexpr size_t R2_GK = R2 + 192 * MiB;
constexpr size_t R2_PP = R2 + 16 * MiB;
constexpr size_t R2_H3B = R2 + 80 * MiB;
constexpr size_t R2_QKV = R2 + 144 * MiB;
constexpr size_t R0_BL = R1 + 80 * MiB;
constexpr size_t WS_END = 512 * MiB;
constexpr int LDS_BYTES = 147456;

__device__ __forceinline__ int opq(int v) { asm volatile("" : "+s"(v)); return v; }
struct Params { const float* in[21]; float* out; unsigned char* ws; };
#define LBAR() do { asm volatile("s_waitcnt lgkmcnt(0)" ::: "memory"); __builtin_amdgcn_s_barrier(); asm volatile("" ::: "memory"); } while (0)

struct Ctx { LAS unsigned char* lds; int tid, lane, wave; };

__device__ __forceinline__ float wave_sum(float v) {
#pragma unroll
    for (int o = 1; o < 64; o <<= 1) v += __shfl_xor(v, o);
    return v;
}
__device__ __forceinline__ unsigned pk2(float lo, float hi) { return pg8::cvt_pk_bf16(lo, hi); }
__device__ __forceinline__ float bf2f(unsigned short b) { return __uint_as_float(((unsigned)b) << 16); }
__device__ __forceinline__ bf16x8 pack8(const f32x4 a, const f32x4 b) {
    u32x4 w; w.x = pk2(a[0], a[1]); w.y = pk2(a[2], a[3]); w.z = pk2(b[0], b[1]); w.w = pk2(b[2], b[3]); return __builtin_bit_cast(bf16x8, w);
}
#define MFMA16(a, b, c) __builtin_amdgcn_mfma_f32_16x16x32_bf16((a), (b), (c), 0, 0, 0)
__device__ __forceinline__ bf16x8 lds16(const LAS unsigned char* p) { return *(const LAS bf16x8*)p; }
__device__ __forceinline__ bf16x8 lds8x2(const LAS unsigned char* p0, const LAS unsigned char* p1) {
    const s16x4 lo = *(const LAS s16x4*)p0, hi = *(const LAS s16x4*)p1; return __builtin_shufflevector(lo, hi, 0, 1, 2, 3, 4, 5, 6, 7);
}

template <bool FOLD>
__device__ __forceinline__ void transpose_item(const float* W, int ldw, int nblk, int K, bf16* WT, LAS float* scr, int item, int lane,
                                               const float* gv = nullptr, const float* bv = nullptr, float* csp = nullptr, float* bwp = nullptr) {
    const int kb = item / nblk, nb = item % nblk, k0 = 64 * kb, n0 = 32 * nb;
    { const int r8 = lane >> 3, c4 = lane & 7;
      f32x4 v[8];
#pragma unroll
      for (int it = 0; it < 8; ++it) v[it] = __builtin_nontemporal_load((const f32x4*)(W + (size_t)(k0 + 8 * it + r8) * ldw + n0 + 4 * c4));
#pragma unroll
      for (int it = 0; it < 8; ++it) { LAS float* d = scr + (8 * it + r8) * 33 + 4 * c4; d[0] = v[it][0]; d[1] = v[it][1]; d[2] = v[it][2]; d[3] = v[it][3]; } }
    asm volatile("s_waitcnt lgkmcnt(0)" ::: "memory");
    const int c = lane & 7;
    float gk[8], bk[8];
    if (FOLD) {
#pragma unroll
        for (int i = 0; i < 8; ++i) { gk[i] = gv[k0 + 8 * c + i]; bk[i] = bv[k0 + 8 * c + i]; }
    }
#pragma unroll
    for (int j = 0; j < 4; ++j) { const int n = (lane >> 3) + 8 * j; const LAS float* sp = scr + (8 * c) * 33 + n;
        float v[8];
#pragma unroll
        for (int i = 0; i < 8; ++i) v[i] = sp[i * 33];
        float bwv = 0.f;
        if (FOLD) {
#pragma unroll
            for (int i = 0; i < 8; ++i) { bwv += bk[i] * v[i]; v[i] *= gk[i]; }
        }
        u32x4 o; o.x = pk2(v[0], v[1]); o.y = pk2(v[2], v[3]); o.z = pk2(v[4], v[5]); o.w = pk2(v[6], v[7]);
        *(u32x4*)(WT + (size_t)(n0 + n) * K + k0 + 8 * c) = o;
        if (FOLD) {
            float r[8]; pg8::unpack8(o, r); float cs = ((r[0] + r[1]) + (r[2] + r[3])) + ((r[4] + r[5]) + (r[6] + r[7]));
            cs += __shfl_xor(cs, 1); cs += __shfl_xor(cs, 2); cs += __shfl_xor(cs, 4);
            bwv += __shfl_xor(bwv, 1); bwv += __shfl_xor(bwv, 2); bwv += __shfl_xor(bwv, 4);
            if (c == 0) { const int N = 32 * nblk; csp[(size_t)kb * N + n0 + n] = cs; bwp[(size_t)kb * N + n0 + n] = bwv; }
        }
    }
    asm volatile("s_waitcnt lgkmcnt(0)" ::: "memory");
}
constexpr size_t VEC = 52 * MiB;
__device__ __host__ constexpr size_t CSP_UP(int l) { return VEC + (size_t)l * 512 * 1024; }
__device__ __host__ constexpr size_t CSP_G(int l) { return VEC + MiB + (size_t)l * 128 * 1024; }
__device__ __host__ constexpr size_t FIN(int l) { return VEC + MiB + 512 * 1024 + (size_t)l * 64 * 1024; }
__device__ __forceinline__ void fold_finalize(const Params& P, int gtid, int gthreads) {
    for (int idx = gtid; idx < 2 * 5120; idx += gthreads) {
        const int l = idx / 5120, r = idx % 5120;
        float* fin = (float*)(P.ws + FIN(l));
        if (r < 4096) { const float* cp = (const float*)(P.ws + CSP_UP(l)); const float* bp = cp + 16 * 4096; float cs = 0.f, bw = 0.f;
#pragma unroll
            for (int kb = 0; kb < 16; ++kb) { cs += cp[kb * 4096 + r]; bw += bp[kb * 4096 + r]; }
            fin[r] = cs; fin[4096 + r] = bw; }
        else { const int n = r - 4096; const float* cp = (const float*)(P.ws + CSP_G(l)); const float* bp = cp + 16 * 1024; float cs = 0.f, bw = 0.f;
#pragma unroll
            for (int kb = 0; kb < 16; ++kb) { cs += cp[kb * 1024 + n]; bw += bp[kb * 1024 + n]; }
            fin[8192 + n] = cs; fin[9216 + n] = bw + P.in[20][l * D + n]; }
    }
}
__device__ __forceinline__ void p0_prologue(const Ctx& F, const Params& P) {
    LAS float* scr = (LAS float*)(F.lds + F.wave * 16384);
    const int gw = blockIdx.x * NWAVES + F.wave, NGW = gridDim.x * NWAVES;
    unsigned char* ws = P.ws;
    constexpr int I_IN = 16 * 96, I_SQ = 16 * 32, I_QKV = 16 * 48, I_UP = 16 * 128, I_DN = 64 * 32, I_PP = 4 * 32;
    constexpr int NITEMS = I_IN + 2 * I_SQ + I_QKV + 2 * I_UP + 2 * I_DN + 2 * I_SQ + 2 * I_PP;
    for (int it = gw; it < NITEMS; it += NGW) {
        int r = it;
        if (r < I_IN) { transpose_item<false>(P.in[2], GLA_COLS, 96, D, (bf16*)(ws + W_IN_T), scr, r, F.lane); continue; } r -= I_IN;
        if (r < I_SQ) { transpose_item<false>(P.in[6], D, 32, D, (bf16*)(ws + W_GOUT_T), scr, r, F.lane); continue; } r -= I_SQ;
        if (r < I_SQ) { transpose_item<false>(P.in[10], D, 32, D, (bf16*)(ws + W_SOUT_T), scr, r, F.lane); continue; } r -= I_SQ;
        if (r < I_QKV) { transpose_item<false>(P.in[7], QKV_LD, 48, D, (bf16*)(ws + W_QKV_T), scr, r, F.lane); continue; } r -= I_QKV;
        if (r < 2 * I_UP) { const int l = r / I_UP; transpose_item<true>(P.in[12] + (size_t)l * D * FF, FF, 128, D, (bf16*)(ws + W_UP_T + (size_t)l * W_LSTRIDE), scr, r % I_UP, F.lane, P.in[14] + l * D, P.in[15] + l * D, (float*)(ws + CSP_UP(l)), (float*)(ws + CSP_UP(l)) + 16 * 4096); continue; } r -= 2 * I_UP;
        if (r < 2 * I_DN) { const int l = r / I_DN; transpose_item<false>(P.in[13] + (size_t)l * D * FF, D, 32, FF, (bf16*)(ws + W_DN_T + (size_t)l * W_LSTRIDE), scr, r % I_DN, F.lane); continue; } r -= 2 * I_DN;
        if (r < 2 * I_SQ) { const int l = r / I_SQ; transpose_item<true>(P.in[19] + (size_t)l * D * D, D, 32, D, (bf16*)(ws + W_GATE_T + (size_t)l * W_LSTRIDE), scr, r % I_SQ, F.lane, P.in[16] + l * D, P.in[17] + l * D, (float*)(ws + CSP_G(l)), (float*)(ws + CSP_G(l)) + 16 * 1024); continue; } r -= 2 * I_SQ;
        { const int l = r / I_PP; transpose_item<false>(P.in[18] + (size_t)l * PLE * D, D, 32, PLE, (bf16*)(ws + W_PP_T + (size_t)l * W_LSTRIDE), scr, r % I_PP, F.lane); }
    }
    const int gtid = blockIdx.x * NTHREADS + F.tid, gthreads = gridDim.x * NTHREADS;
    {
        LAS float* wg = (LAS float*)F.lds;
        __syncthreads();
        for (int i = F.tid; i < 4096; i += NTHREADS) { const int k = i >> 2, c4 = i & 3, pos = (k & 3) * 256 + (k >> 2); *(LAS f32x4*)(wg + pos * 20 + 4 * c4) = *(const f32x4*)(P.in[2] + (size_t)k * GLA_COLS + 3072 + 4 * c4); }
        __syncthreads();
        const float* x = P.in[0]; bf16* xb = (bf16*)(ws + R0); float* GK = (float*)(ws + R2_GK);
        const int lane = F.lane;
#pragma unroll 1
        for (int r0 = gw * 4; r0 < M; r0 += NGW * 4) {
            f32x4 acc[16];
#pragma unroll
            for (int i = 0; i < 16; ++i) acc[i] = (f32x4){0.f, 0.f, 0.f, 0.f};
#pragma unroll 1
            for (int j = 0; j < 4; ++j) {
                float xs[4][4];
#pragma unroll
                for (int rr = 0; rr < 4; ++rr) { const f32x4 v = __builtin_nontemporal_load((const f32x4*)(x + (size_t)(r0 + rr) * D + 256 * j + 4 * lane));
                    u32x2 o; o.x = pk2(v[0], v[1]); o.y = pk2(v[2], v[3]); *(u32x2*)(xb + (size_t)(r0 + rr) * D + 256 * j + 4 * lane) = o;
                    xs[rr][0] = v[0]; xs[rr][1] = v[1]; xs[rr][2] = v[2]; xs[rr][3] = v[3]; }
#pragma unroll
                for (int i = 0; i < 4; ++i) { const LAS float* wp = wg + (i * 256 + 64 * j + lane) * 20;
                    const f32x4 w0 = *(const LAS f32x4*)(wp), w1 = *(const LAS f32x4*)(wp + 4), w2 = *(const LAS f32x4*)(wp + 8), w3 = *(const LAS f32x4*)(wp + 12);
#pragma unroll
                    for (int rr = 0; rr < 4; ++rr) { const float xv = xs[rr][i]; acc[rr * 4 + 0] += w0 * xv; acc[rr * 4 + 1] += w1 * xv; acc[rr * 4 + 2] += w2 * xv; acc[rr * 4 + 3] += w3 * xv; } }
            }
            float a[64];
#pragma unroll
            for (int i = 0; i < 16; ++i) { a[4 * i] = acc[i][0]; a[4 * i + 1] = acc[i][1]; a[4 * i + 2] = acc[i][2]; a[4 * i + 3] = acc[i][3]; }
#define TR_STEP(n) do { const bool hi_ = (lane & (n)) != 0; _Pragma("unroll") for (int i = 0; i < (n); ++i) { const float send = hi_ ? a[i] : a[i + (n)], keep = hi_ ? a[i + (n)] : a[i]; a[i] = keep + __shfl_xor(send, (n)); } } while (0)
            TR_STEP(32); TR_STEP(16); TR_STEP(8); TR_STEP(4); TR_STEP(2); TR_STEP(1);
#undef TR_STEP
            GK[(size_t)r0 * 16 + lane] = a[0];
        }
    }
}

typedef short v4i16_t __attribute__((ext_vector_type(4)));
__device__ __forceinline__ s16x4 ldtr(const LAS unsigned char* p) { return __builtin_bit_cast(s16x4, __builtin_amdgcn_ds_read_tr16_b64_v4i16((LAS v4i16_t*)p)); }
constexpr int GS_Q = 0, GS_K = 17408, GS_V = 34816, GS_ATT = 68608, GS_RS = 77824, GS_RSTD = 79872, GS_BL = 80128;
constexpr size_t R0_SLOC = R1, R0_GSEG = R1 + 40 * MiB;
template <bool FULL>
__device__ __forceinline__ void gla_scan_pass(const Ctx& F, const Params& P) {
    LAS unsigned char* L = F.lds;
    const int tid = F.tid, lane = F.lane, w = F.wave, l15 = lane & 15, quad = lane >> 4;
    bf16* PROJ = (bf16*)(P.ws + R2);
    const float* BL = (const float*)(P.ws + R0_BL);
    float* SLOC = (float*)(P.ws + R0_SLOC); float* GSEG = (float*)(P.ws + R0_GSEG);
    const float* norm_g = P.in[5];
    for (int item = blockIdx.x; item < BATCH * 4 * 8; item += gridDim.x) {
        const int seg = item & 7, bh = item >> 3, b = bh >> 2, h = bh & 3;
        if (!FULL && seg == 7) continue;
        f32x4 S[8][2];
#pragma unroll
        for (int dt = 0; dt < 8; ++dt) { S[dt][0] = (f32x4){0.f, 0.f, 0.f, 0.f}; S[dt][1] = (f32x4){0.f, 0.f, 0.f, 0.f}; }
        if (FULL) {
#pragma unroll 1
            for (int j = 0; j < seg; ++j) {
                const float* gj = GSEG + (size_t)(bh * 8 + j) * 128 + 4 * quad; const f32x4* sl = (const f32x4*)(SLOC + (size_t)(bh * 8 + j) * 32768) + tid;
#pragma unroll
                for (int dt = 0; dt < 8; ++dt) { const f32x4 gg = *(const f32x4*)(gj + 16 * dt);
                    f32x4 dec; dec[0] = __expf(gg[0]); dec[1] = __expf(gg[1]); dec[2] = __expf(gg[2]); dec[3] = __expf(gg[3]);
                    S[dt][0] = S[dt][0] * dec + sl[(dt * 2 + 0) * 512]; S[dt][1] = S[dt][1] * dec + sl[(dt * 2 + 1) * 512]; }
            }
        }
        float gsum = 0.f;
        u32x4 pq[2], pk[2], pv[4]; float pbl = 0.f;
#define GS_LOADC(cidx) do { const int u_ = (b * 64 + (cidx)) * 4 + h; const size_t m_ = (size_t)b * SEQ + (size_t)(cidx) * 64; int tl_ = tid; asm volatile("" : "+v"(tl_)); \
            _Pragma("unroll") for (int i = 0; i < 2; ++i) { const int idx = tl_ + 512 * i, row = idx >> 4, pc = idx & 15; const bf16* src = PROJ + (m_ + row) * PROJ_LD + h * 128 + pc * 8; \
                if (FULL) pq[i] = *(const u32x4*)(src); pk[i] = *(const u32x4*)(src + 512); } \
            _Pragma("unroll") for (int i = 0; i < 4; ++i) { const int idx = tl_ + 512 * i, row = idx >> 5, pc = idx & 31; pv[i] = *(const u32x4*)(PROJ + (m_ + row) * PROJ_LD + 1024 + h * 256 + pc * 8); } \
            if (tl_ < 128) pbl = BL[(size_t)u_ * 128 + tl_]; } while (0)
        GS_LOADC(seg * 8);
#pragma unroll 1
        for (int cc = 0; cc < 8; ++cc) {
            const int c = seg * 8 + cc;
            const size_t m0 = (size_t)b * SEQ + (size_t)c * 64;
#pragma unroll
            for (int i = 0; i < 2; ++i) { const int idx = tid + 512 * i, row = idx >> 4, pc = idx & 15;
                if (FULL) *(LAS u32x4*)(L + GS_Q + row * 272 + pc * 16) = pq[i];
                *(LAS u32x4*)(L + GS_K + row * 272 + pc * 16) = pk[i]; }
#pragma unroll
            for (int i = 0; i < 4; ++i) { const int idx = tid + 512 * i, row = idx >> 5, pc = idx & 31; *(LAS u32x4*)(L + GS_V + row * 528 + pc * 16) = pv[i]; }
            if (tid < 128) { ((LAS float*)(L + GS_BL))[tid] = pbl; gsum += pbl; }
            LBAR();
            if (cc < 7) GS_LOADC(c + 1);
            u32x2 rw[4][2];
            if (FULL) { const bf16* rp = PROJ + (m0 + l15) * PROJ_LD + 2048 + h * 256 + 32 * w + 4 * quad;
#pragma unroll
                for (int it = 0; it < 4; ++it) { rw[it][0] = *(const u32x2*)(rp); rw[it][1] = *(const u32x2*)(rp + 16); rp += 16 * PROJ_LD; asm volatile("" : "+v"(rp)); } }
#define GS_VF(dst) do { _Pragma("unroll") for (int s2 = 0; s2 < 2; ++s2) _Pragma("unroll") for (int et = 0; et < 2; ++et) { \
                const LAS unsigned char* a_ = L + GS_V + (32 * s2 + 8 * quad + (l15 >> 2)) * 528 + (32 * w + 16 * et) * 2 + 8 * (l15 & 3); \
                const s16x4 lo_ = ldtr(a_), hi_ = ldtr(a_ + 4 * 528); dst[s2][et] = __builtin_shufflevector(lo_, hi_, 0, 1, 2, 3, 4, 5, 6, 7); } } while (0)
            f32x4 o[4][2];
            if (FULL) {
                { const int it = w >> 1;
#pragma unroll
                  for (int x = 0; x < 2; ++x) { const int jt = 2 * (w & 1) + x; f32x4 a = (f32x4){0.f, 0.f, 0.f, 0.f};
                      if (jt <= it) {
#pragma unroll
                          for (int ks = 0; ks < 4; ++ks) { const bf16x8 kf = lds16(L + GS_K + (16 * jt + l15) * 272 + ks * 64 + quad * 16), qf = lds16(L + GS_Q + (16 * it + l15) * 272 + ks * 64 + quad * 16);
                              a = MFMA16(kf, qf, a); }
                          const int ii = 16 * it + l15, j0 = 16 * jt + 4 * quad;
#pragma unroll
                          for (int j = 0; j < 4; ++j) if (j0 + j > ii) a[j] = 0.f;
                      }
                      u32x2 ww; ww.x = pk2(a[0], a[1]); ww.y = pk2(a[2], a[3]);
                      *(LAS u32x2*)(L + GS_ATT + (16 * it + l15) * 144 + (16 * jt + 4 * quad) * 2) = ww; } }
                LBAR();
#pragma unroll
                for (int it = 0; it < 4; ++it) { o[it][0] = (f32x4){0.f, 0.f, 0.f, 0.f}; o[it][1] = (f32x4){0.f, 0.f, 0.f, 0.f}; }
#pragma unroll
                for (int s2 = 0; s2 < 4; ++s2) {
                    bf16x8 sf[2]; sf[0] = pack8(S[2 * s2][0], S[2 * s2 + 1][0]); sf[1] = pack8(S[2 * s2][1], S[2 * s2 + 1][1]);
#pragma unroll
                    for (int it = 0; it < 4; ++it) { const LAS unsigned char* qb = L + GS_Q + (16 * it + l15) * 272 + (32 * s2 + 4 * quad) * 2;
                        const bf16x8 qf = lds8x2(qb, qb + 32);
                        o[it][0] = MFMA16(sf[0], qf, o[it][0]); o[it][1] = MFMA16(sf[1], qf, o[it][1]); }
                }
                { bf16x8 vf[2][2]; GS_VF(vf);
#pragma unroll
                  for (int s2 = 0; s2 < 2; ++s2)
#pragma unroll
                    for (int it = 0; it < 4; ++it) { const bf16x8 af = lds16(L + GS_ATT + (16 * it + l15) * 144 + s2 * 64 + quad * 16);
                        o[it][0] = MFMA16(vf[s2][0], af, o[it][0]); o[it][1] = MFMA16(vf[s2][1], af, o[it][1]); } }
            }
            bf16x8 vf[2][2]; GS_VF(vf);
#pragma unroll
            for (int dt = 0; dt < 8; ++dt) {
                const f32x4 bl = *(const LAS f32x4*)(L + GS_BL + (16 * dt + 4 * quad) * 4);
                f32x4 dec; dec[0] = __expf(bl[0]); dec[1] = __expf(bl[1]); dec[2] = __expf(bl[2]); dec[3] = __expf(bl[3]);
#pragma unroll
                for (int s2 = 0; s2 < 2; ++s2) {
                    const LAS unsigned char* ka = L + GS_K + (32 * s2 + 8 * quad + (l15 >> 2)) * 272 + (16 * dt) * 2 + 8 * (l15 & 3);
                    const s16x4 klo = ldtr(ka), khi = ldtr(ka + 4 * 272); const bf16x8 kf = __builtin_shufflevector(klo, khi, 0, 1, 2, 3, 4, 5, 6, 7);
                    S[dt][0] = MFMA16(kf, vf[s2][0], S[dt][0]); S[dt][1] = MFMA16(kf, vf[s2][1], S[dt][1]); }
                S[dt][0] = S[dt][0] * dec; S[dt][1] = S[dt][1] * dec;
            }
            if (FULL) {
#pragma unroll
                for (int it = 0; it < 4; ++it) { float ss = 0.f;
#pragma unroll
                    for (int et = 0; et < 2; ++et) ss += (o[it][et][0] * o[it][et][0] + o[it][et][1] * o[it][et][1]) + (o[it][et][2] * o[it][et][2] + o[it][et][3] * o[it][et][3]);
                    ss += __shfl_xor(ss, 16); ss += __shfl_xor(ss, 32);
                    if (quad == 0) ((LAS float*)(L + GS_RS))[w * 64 + 16 * it + l15] = ss; }
            }
            LBAR();
            if (FULL) {
                if (tid < 64) { float t = 0.f;
#pragma unroll
                    for (int ww = 0; ww < 8; ++ww) t += ((const LAS float*)(L + GS_RS))[ww * 64 + tid];
                    ((LAS float*)(L + GS_RSTD))[tid] = 1.0f / sqrtf(t * (1.0f / 256.0f) + RMS_EPS); }
                LBAR();
#pragma unroll
                for (int it = 0; it < 4; ++it) { const float rs = ((const LAS float*)(L + GS_RSTD))[16 * it + l15];
#pragma unroll
                    for (int et = 0; et < 2; ++et) { const int e0 = 32 * w + 16 * et + 4 * quad;
                        bf16* wp = PROJ + (m0 + 16 * it + l15) * PROJ_LD + 2048 + h * 256 + e0;
                        const u32x2 r2 = rw[it][et]; const f32x4 gg = *(const f32x4*)(norm_g + e0);
                        float rv[4]; rv[0] = __uint_as_float(r2.x << 16); rv[1] = __uint_as_float(r2.x & 0xffff0000u); rv[2] = __uint_as_float(r2.y << 16); rv[3] = __uint_as_float(r2.y & 0xffff0000u);
                        float ov[4];
#pragma unroll
                        for (int j = 0; j < 4; ++j) ov[j] = o[it][et][j] * rs * gg[j] * (rv[j] * __builtin_amdgcn_rcpf(1.0f + __expf(-rv[j])));
                        u32x2 ow; ow.x = pk2(ov[0], ov[1]); ow.y = pk2(ov[2], ov[3]); *(u32x2*)wp = ow; } }
            }
        }
#undef GS_LOADC
#undef GS_VF
        if (!FULL) {
            f32x4* sl = (f32x4*)(SLOC + (size_t)(bh * 8 + seg) * 32768) + tid;
#pragma unroll
            for (int dt = 0; dt < 8; ++dt) { sl[(dt * 2 + 0) * 512] = S[dt][0]; sl[(dt * 2 + 1) * 512] = S[dt][1]; }
            if (tid < 128) GSEG[(size_t)(bh * 8 + seg) * 128 + tid] = gsum;
        }
        LBAR();
    }
}

__device__ __forceinline__ void gla_pass_a(const Ctx& F, const Params& P) {
    LAS unsigned char* L = F.lds;
    LAS float* gk_s = (LAS float*)(L);
    LAS float* part = (LAS float*)(L + 4096);
    const int tid = F.tid, lane = F.lane, w = F.wave, l15 = lane & 15, quad = lane >> 4, d = tid & 127, g = tid >> 7;
    bf16* PROJ = (bf16*)(P.ws + R2); const float* GK = (const float*)(P.ws + R2_GK);
    float* BL = (float*)(P.ws + R0_BL); float* SLOC = (float*)(P.ws + R0_SLOC); float* GSEG = (float*)(P.ws + R0_GSEG);
    for (int item = blockIdx.x; item < BATCH * 4 * 8; item += gridDim.x) {
        const int seg = item & 7, bh = item >> 3, b = bh >> 2, h = bh & 3;
        float wv[16];
#pragma unroll
        for (int r = 0; r < 16; ++r) wv[r] = P.in[3][r * 512 + h * 128 + d];
        const float bias = P.in[4][h * 128 + d];
        f32x4 S[8][2];
#pragma unroll
        for (int dt = 0; dt < 8; ++dt) { S[dt][0] = (f32x4){0.f, 0.f, 0.f, 0.f}; S[dt][1] = (f32x4){0.f, 0.f, 0.f, 0.f}; }
        float gsum = 0.f;
        u32x4 pv[4]; f32x4 gkn = (f32x4){0.f, 0.f, 0.f, 0.f};
#define PA_LOAD(cidx) do { const size_t m_ = (size_t)b * SEQ + (size_t)(cidx) * 64; int tl_ = tid; asm volatile("" : "+v"(tl_)); \
            _Pragma("unroll") for (int i = 0; i < 4; ++i) { const int idx = tl_ + 512 * i, row = idx >> 5, pc = idx & 31; pv[i] = *(const u32x4*)(PROJ + (m_ + row) * PROJ_LD + 1024 + h * 256 + pc * 8); } \
            if (tl_ < 256) gkn = *(const f32x4*)(GK + m_ * 16 + (size_t)tl_ * 4); } while (0)
        PA_LOAD(seg * 8);
#pragma unroll 1
        for (int cc = 0; cc < 8; ++cc) {
            const int c = seg * 8 + cc, u = (b * 64 + c) * 4 + h;
            const size_t m0 = (size_t)b * SEQ + (size_t)c * 64;
            if (tid < 256) ((LAS f32x4*)gk_s)[tid] = gkn;
#pragma unroll
            for (int i = 0; i < 4; ++i) { const int idx = tid + 512 * i, row = idx >> 5, pc = idx & 31; *(LAS u32x4*)(L + GS_V + row * 528 + pc * 16) = pv[i]; }
            bf16* qp = PROJ + (m0 + 16 * g) * PROJ_LD + h * 128 + d; bf16* kp = qp + 512;
            unsigned qk[16];
            { const bf16* rp = qp;
#pragma unroll
              for (int tt = 0; tt < 16; ++tt) { qk[tt] = (unsigned)rp[0] | ((unsigned)rp[512] << 16); rp += PROJ_LD; asm volatile("" : "+v"(rp)); } }
            { const size_t pgrp = ((size_t)(item * 8 + cc)) * 512 + tid;
              const f32x4 a = __builtin_nontemporal_load((const f32x4*)(P.in[1] + pgrp * 8)), a2 = __builtin_nontemporal_load((const f32x4*)(P.in[1] + pgrp * 8 + 4));
              u32x4 o; o.x = pk2(a[0], a[1]); o.y = pk2(a[2], a[3]); o.z = pk2(a2[0], a2[1]); o.w = pk2(a2[2], a2[3]); *(u32x4*)((bf16*)P.out + pgrp * 8) = o; }
            LBAR();
            float cs[16]; float run = 0.f;
#pragma unroll
            for (int tt = 0; tt < 16; ++tt) {
                const int t = 16 * g + tt; float z = bias;
#pragma unroll
                for (int r4 = 0; r4 < 4; ++r4) { const f32x4 a = ((const LAS f32x4*)gk_s)[t * 4 + r4]; z += a[0] * wv[4 * r4] + a[1] * wv[4 * r4 + 1] + a[2] * wv[4 * r4 + 2] + a[3] * wv[4 * r4 + 3]; }
                const float ls = fminf(z, 0.f) - __logf(1.0f + __expf(-fabsf(z)));
                run += ls * (1.0f / 16.0f); cs[tt] = run;
                if ((tt & 1) == 1) asm volatile("" ::: "memory");
            }
            part[g * 128 + d] = run;
            LBAR();
            if (cc < 7) PA_LOAD(c + 1);
            float off = 0.f, tot = 0.f;
#pragma unroll
            for (int gg = 0; gg < 4; ++gg) { const float pvv = part[gg * 128 + d]; tot += pvv; if (gg < g) off += pvv; }
            bf16* wq = qp;
#pragma unroll
            for (int tt = 0; tt < 16; ++tt) {
                const float bc = cs[tt] + off;
                const float qv = __uint_as_float(qk[tt] << 16), kv = __uint_as_float(qk[tt] & 0xffff0000u);
                const float e1 = __expf(bc), e2 = __expf(-bc);
                wq[0] = (bf16)(pk2(qv * 0.08838834764831845f * e1, 0.f) & 0xffffu);
                const bf16 kt = (bf16)(pk2(kv * e2, 0.f) & 0xffffu);
                wq[512] = kt; wq += PROJ_LD; asm volatile("" : "+v"(wq));
                *(LAS bf16*)(L + GS_K + (16 * g + tt) * 272 + d * 2) = kt;
            }
            if (g == 0) { BL[(size_t)u * 128 + d] = tot; ((LAS float*)(L + GS_BL))[d] = tot; gsum += tot; }
            LBAR();
            if (seg < 7) {
                bf16x8 vf[2][2];
#pragma unroll
                for (int s2 = 0; s2 < 2; ++s2)
#pragma unroll
                    for (int et = 0; et < 2; ++et) { const LAS unsigned char* a_ = L + GS_V + (32 * s2 + 8 * quad + (l15 >> 2)) * 528 + (32 * w + 16 * et) * 2 + 8 * (l15 & 3);
                        const s16x4 lo_ = ldtr(a_), hi_ = ldtr(a_ + 4 * 528); vf[s2][et] = __builtin_shufflevector(lo_, hi_, 0, 1, 2, 3, 4, 5, 6, 7); }
#pragma unroll
                for (int dt = 0; dt < 8; ++dt) {
                    const f32x4 bl = *(const LAS f32x4*)(L + GS_BL + (16 * dt + 4 * quad) * 4);
                    f32x4 dec; dec[0] = __expf(bl[0]); dec[1] = __expf(bl[1]); dec[2] = __expf(bl[2]); dec[3] = __expf(bl[3]);
#pragma unroll
                    for (int s2 = 0; s2 < 2; ++s2) {
                        const LAS unsigned char* ka = L + GS_K + (32 * s2 + 8 * quad + (l15 >> 2)) * 272 + (16 * dt) * 2 + 8 * (l15 & 3);
                        const s16x4 klo = ldtr(ka), khi = ldtr(ka + 4 * 272); const bf16x8 kf = __builtin_shufflevector(klo, khi, 0, 1, 2, 3, 4, 5, 6, 7);
                        S[dt][0] = MFMA16(kf, vf[s2][0], S[dt][0]); S[dt][1] = MFMA16(kf, vf[s2][1], S[dt][1]); }
                    S[dt][0] = S[dt][0] * dec; S[dt][1] = S[dt][1] * dec;
                }
            }
            LBAR();
        }
#undef PA_LOAD
        if (seg < 7) {
            f32x4* sl = (f32x4*)(SLOC + (size_t)(bh * 8 + seg) * 32768) + tid;
#pragma unroll
            for (int dt = 0; dt < 8; ++dt) { sl[(dt * 2 + 0) * 512] = S[dt][0]; sl[(dt * 2 + 1) * 512] = S[dt][1]; }
            if (tid < 128) GSEG[(size_t)(bh * 8 + seg) * 128 + tid] = gsum;
        }
    }
}

constexpr int SW_K = 0, SW_V = 36864;
__device__ __forceinline__ void swa_phase(const Ctx& F, const Params& P) {
    LAS unsigned char* L = F.lds;
    const int tid = F.tid, lane = F.lane, w = F.wave, l15 = lane & 15, quad = lane >> 4;
    const bf16* QKV = (const bf16*)(P.ws + R2_QKV); bf16* AO = (bf16*)(P.ws + R0);
    const float* sinks = P.in[9];
    constexpr int NU = BATCH * 32 * 4;
    u32x4 kv[4], vv[4];
#define SW_LOAD(uu) do { const int kvh_ = (uu) & 3, n_ = ((uu) >> 2) & 31, b_ = (uu) >> 7; const long mb_ = (long)b_ * SEQ + (long)n_ * 128; \
        _Pragma("unroll") for (int i = 0; i < 4; ++i) { const int idx = tid + 512 * i, jj = idx >> 3, pc = idx & 7; \
            kv[i] = (u32x4){0u, 0u, 0u, 0u}; vv[i] = (u32x4){0u, 0u, 0u, 0u}; \
            if (n_ > 0 || jj >= 128) { const bf16* src = QKV + (size_t)(mb_ - 128 + jj) * QKV_LD + 1024 + kvh_ * 64 + pc * 8; kv[i] = *(const u32x4*)(src); vv[i] = *(const u32x4*)(src + 256); } } } while (0)
#define SW_QBASE(uu) (QKV + (size_t)((long)((uu) >> 7) * SEQ + (long)(((uu) >> 2) & 31) * 128 + 64 * (w & 1) + l15) * QKV_LD + (((uu) & 3) * 4 + (w >> 1)) * 64 + quad * 8)
    bf16x8 qc0 = (bf16x8){0, 0, 0, 0, 0, 0, 0, 0}, qc1 = qc0;
    if ((int)blockIdx.x < NU) { SW_LOAD((int)blockIdx.x); const bf16* q0p = SW_QBASE((int)blockIdx.x); qc0 = *(const bf16x8*)(q0p); qc1 = *(const bf16x8*)(q0p + 32); }
    for (int u = blockIdx.x; u < NU; u += gridDim.x) {
        const int kvh = u & 3, n = (u >> 2) & 31, b = u >> 7;
        const long mb = (long)b * SEQ + (long)n * 128;
        const int g = w >> 1, hq = kvh * 4 + g;
        const int un = (u + (int)gridDim.x < NU) ? u + (int)gridDim.x : u;
        const bf16* qbase = SW_QBASE(u);
        const bf16* qnext = SW_QBASE(un);
#pragma unroll
        for (int i = 0; i < 2; ++i) { const size_t pg = (size_t)u * 1024 + tid + 512 * i; const float* src = P.in[1] + (size_t)M * PLE + pg * 8;
            const f32x4 a = __builtin_nontemporal_load((const f32x4*)(src)), a2 = __builtin_nontemporal_load((const f32x4*)(src + 4));
            u32x4 o; o.x = pk2(a[0], a[1]); o.y = pk2(a[2], a[3]); o.z = pk2(a2[0], a2[1]); o.w = pk2(a2[2], a2[3]); *(u32x4*)((bf16*)(P.ws + PB1_OFF) + pg * 8) = o; }
        LBAR();
#pragma unroll
        for (int i = 0; i < 4; ++i) { const int idx = tid + 512 * i, jj = idx >> 3, pc = idx & 7;
            *(LAS u32x4*)(L + SW_K + jj * 144 + pc * 16) = kv[i]; *(LAS u32x4*)(L + SW_V + jj * 144 + pc * 16) = vv[i]; }
        LBAR();
        if (un != u) SW_LOAD(un);
        const float sink = sinks[hq];
#pragma unroll 1
        for (int qt = 0; qt < 4; ++qt) {
            const int q0 = 64 * (w & 1) + 16 * qt, kt0 = q0 >> 4, qi = q0 + l15;
            const bf16* qn = (qt < 3) ? qbase + (size_t)(16 * (qt + 1)) * QKV_LD : qnext;
            const bf16x8 qn0 = *(const bf16x8*)(qn), qn1 = *(const bf16x8*)(qn + 32);
            f32x4 sc[9];
#pragma unroll
            for (int t = 0; t < 9; ++t) { const LAS unsigned char* kb = L + SW_K + (16 * (kt0 + t) + l15) * 144 + quad * 16;
                f32x4 a = (f32x4){0.f, 0.f, 0.f, 0.f}; a = MFMA16(lds16(kb), qc0, a); a = MFMA16(lds16(kb + 64), qc1, a); sc[t] = a; }
            constexpr float C2 = 0.125f * 1.4426950408889634f;
            const float sink2 = sink * 1.4426950408889634f;
#pragma unroll
            for (int j = 0; j < 4; ++j) { if (!(4 * quad + j > l15)) sc[0][j] = -INFINITY; if (!(4 * quad + j <= l15)) sc[8][j] = -INFINITY; }
            float mraw = -INFINITY;
#pragma unroll
            for (int t = 0; t < 9; ++t)
#pragma unroll
                for (int j = 0; j < 4; ++j) mraw = fmaxf(mraw, sc[t][j]);
            mraw = fmaxf(mraw, __shfl_xor(mraw, 16)); mraw = fmaxf(mraw, __shfl_xor(mraw, 32));
            const float m2 = fmaxf(mraw * C2, sink2);
            float den = 0.f;
#pragma unroll
            for (int t = 0; t < 9; ++t)
#pragma unroll
                for (int j = 0; j < 4; ++j) { const float p = __builtin_amdgcn_exp2f(sc[t][j] * C2 - m2); sc[t][j] = p; den += p; }
            den += __shfl_xor(den, 16); den += __shfl_xor(den, 32);
            den += __builtin_amdgcn_exp2f(sink2 - m2);
            const float rden = __builtin_amdgcn_rcpf(den);
            f32x4 ot[4];
#pragma unroll
            for (int dt = 0; dt < 4; ++dt) ot[dt] = (f32x4){0.f, 0.f, 0.f, 0.f};
#pragma unroll
            for (int s2 = 0; s2 < 5; ++s2) {
                const f32x4 z4 = (f32x4){0.f, 0.f, 0.f, 0.f};
                const bf16x8 pf = pack8(sc[2 * s2], (s2 < 4) ? sc[(2 * s2 + 1 < 9) ? 2 * s2 + 1 : 8] : z4);
                const int ka = 16 * (kt0 + 2 * s2), kb2 = (s2 < 4) ? ka + 16 : ka;
#pragma unroll
                for (int dt = 0; dt < 4; ++dt) { const LAS unsigned char* vb = L + SW_V + (4 * quad + (l15 >> 2)) * 144 + 32 * dt + 8 * (l15 & 3);
                    const s16x4 lo = ldtr(vb + ka * 144), hi = ldtr(vb + kb2 * 144);
                    const bf16x8 vf = __builtin_shufflevector(lo, hi, 0, 1, 2, 3, 4, 5, 6, 7);
                    ot[dt] = MFMA16(vf, pf, ot[dt]); }
            }
            bf16* op = AO + (size_t)(mb + qi) * D + hq * 64 + 4 * quad;
#pragma unroll
            for (int dt = 0; dt < 4; ++dt) { u32x2 ow; ow.x = pk2(ot[dt][0] * rden, ot[dt][1] * rden); ow.y = pk2(ot[dt][2] * rden, ot[dt][3] * rden); *(u32x2*)(op + 16 * dt) = ow; }
            qc0 = qn0; qc1 = qn1;
        }
    }
    LBAR();
#undef SW_LOAD
#undef SW_QBASE
}

#define XB_TMO      128
#define XB_XCNT(j)  (256  + 64 * (j))
#define XB_XSUB(j)  (1280 + 64 * (j))
#define XB_XGEN(j)  (2304 + 64 * (j))
#define XB_TOP      3328
#define XB_TOPGEN   3392
#define XCD_BAR_WORDS 3456
#define XB_SPIN_CAP (1u << 18)

__device__ __forceinline__ unsigned xb_ld(unsigned* p)              { return __hip_atomic_load(p, __ATOMIC_RELAXED, __HIP_MEMORY_SCOPE_AGENT); }
__device__ __forceinline__ unsigned xb_add(unsigned* p, unsigned v) { return __hip_atomic_fetch_add(p, v, __ATOMIC_RELAXED, __HIP_MEMORY_SCOPE_AGENT); }
__device__ __forceinline__ unsigned xb_xcc_id() { return (unsigned)__builtin_amdgcn_s_getreg((3 << 11) | 20) & 0xFu; }
#define XB_SPIN(cond, bar) do { unsigned _sp = 0; while (cond) { __builtin_amdgcn_s_sleep(1); \
    if ((++_sp & 255u) == 0u) { if (xb_ld(&(bar)[XB_TMO])) break; if (_sp > XB_SPIN_CAP) { atomicAdd(&(bar)[XB_TMO], 1u); break; } } } } while (0)

struct XcdBarrier {
    unsigned* bar; unsigned x;
    volatile LAS unsigned* st;
};

__device__ __forceinline__ XcdBarrier xcd_barrier_post(unsigned* bar, volatile LAS unsigned* st) {
    XcdBarrier b; b.bar = bar; b.x = xb_xcc_id(); b.st = st;
    if (threadIdx.x == 0) (void)xb_add(&bar[XB_XCNT(b.x)], 1u);
    return b;
}
__device__ __forceinline__ void xcd_barrier_complete(unsigned* bar, unsigned x, unsigned& nloc, unsigned& nx) {
    const unsigned G = gridDim.x * gridDim.y * gridDim.z;
    unsigned sum, cnt, mine, sp = 0u;
    for (;;) {
        sum = 0u; cnt = 0u; mine = 0u;
#pragma unroll
        for (unsigned j = 0; j < 16; ++j) { const unsigned c = xb_ld(&bar[XB_XCNT(j)]); sum += c; cnt += (c > 0u) ? 1u : 0u; mine = (j == x) ? c : mine; }
        if (sum == G) break;
        __builtin_amdgcn_s_sleep(1);
        if ((++sp & 255u) == 0u) { if (xb_ld(&bar[XB_TMO])) break; if (sp > XB_SPIN_CAP) { atomicAdd(&bar[XB_TMO], 1u); break; } }
    }
    nloc = mine > 0u ? mine : 1u; nx = cnt > 0u ? cnt : 1u;
}

__device__ __forceinline__ void xcd_barrier(const XcdBarrier& b) {
    asm volatile("s_waitcnt vmcnt(0)" ::: "memory");
    __syncthreads();
    if (threadIdx.x == 0) {
        unsigned* bar = b.bar;
        __builtin_amdgcn_s_waitcnt(0);
        unsigned nloc = b.st[0], nx = b.st[1];
        if (nloc == 0u) { xcd_barrier_complete(bar, b.x, nloc, nx); b.st[0] = nloc; b.st[1] = nx; }
        const unsigned old = xb_add(&bar[XB_XSUB(b.x)], 1u);
        const unsigned gen = old / nloc;
        if (old + 1u == (gen + 1u) * nloc) {
            __builtin_amdgcn_fence(__ATOMIC_RELEASE, "agent");
            asm volatile("s_waitcnt vmcnt(0)" ::: "memory");
            const unsigned og = xb_add(&bar[XB_TOP], 1u);
            const unsigned tg = og / nx;
            if (og + 1u == (tg + 1u) * nx) xb_add(&bar[XB_TOPGEN], 1u);
            else XB_SPIN(xb_ld(&bar[XB_TOPGEN]) == tg, bar);
            __builtin_amdgcn_fence(__ATOMIC_ACQUIRE, "agent");
            xb_add(&bar[XB_XGEN(b.x)], 1u);
            asm volatile("s_waitcnt vmcnt(0)" ::: "memory");
        } else {
            XB_SPIN(xb_ld(&bar[XB_XGEN(b.x)]) == gen, bar);
            __builtin_amdgcn_fence(__ATOMIC_ACQUIRE, "agent");
            asm volatile("s_waitcnt vmcnt(0)" ::: "memory");
        }
    }
    __syncthreads();
}

__global__ void __launch_bounds__(NTHREADS, 2) mega_fwd(Params P) {
    extern __shared__ __attribute__((aligned(16))) unsigned char lds_raw[];
    cg::grid_group grid = cg::this_grid();
    Ctx F; F.lds = (LAS unsigned char*)lds_raw;
#define GSYNC() do { XcdBarrier b2_ = bar; unsigned long long bp_ = (unsigned long long)b2_.bar; unsigned bx_ = __builtin_amdgcn_readfirstlane(b2_.x); asm volatile("" : "+s"(bp_), "+s"(bx_)); b2_.bar = (unsigned*)bp_; b2_.x = bx_; xcd_barrier(b2_); } while (0)
#define REFRESH() do { int t_ = threadIdx.x; asm volatile("" : "+v"(t_)); F.tid = t_; F.lane = t_ & 63; F.wave = __builtin_amdgcn_readfirstlane(t_ >> 6); } while (0)
    REFRESH();
    unsigned char* ws = P.ws;
    const int G = gridDim.x, cid = blockIdx.x;
    volatile LAS unsigned* MISC = (volatile LAS unsigned*)(F.lds + 131072 + 320);
    if (threadIdx.x < 32) MISC[threadIdx.x] = 0u;
    __syncthreads();
    if (cid == 0) for (int i = threadIdx.x; i < XCD_BAR_WORDS; i += NTHREADS) __hip_atomic_store((unsigned*)(ws) + 1024 + i, 0u, __ATOMIC_RELAXED, __HIP_MEMORY_SCOPE_AGENT);
    grid.sync();
    XcdBarrier bar = xcd_barrier_post((unsigned*)(ws) + 1024, MISC + 8);
    bf16* A16 = (bf16*)(ws + R0); bf16* U16 = (bf16*)(ws + R2);
    bf16* Y1B = (bf16*)(ws + R1); bf16* Y2B = (bf16*)(ws + R1 + 64 * MiB); bf16* H3B = (bf16*)(ws + R2_H3B);
    float* ST1 = (float*)(ws + 504 * MiB); float* ST2 = (float*)(ws + 508 * MiB);
    LAS float* SX = (LAS float*)(F.lds + 131072 + 1024);

    p0_prologue(F, P);
    GSYNC();
    {
        pg8::Gemm g{A16, (const bf16*)(ws + W_IN_T), M, PROJ_LD, opq(D), D, D}; pg8::StaticOrder S; S.init(M, PROJ_LD, G, cid);
        pg8::EpiBf16 E{U16, PROJ_LD, nullptr, 1 << 30, nullptr};
        pg8::gemm_phase<pg8::EpiBf16, pg8::StaticOrder, true, true>(F.lds, g, S, E, SX);
    }
    GSYNC();
    REFRESH(); gla_pass_a(F, P);
    fold_finalize(P, cid * NTHREADS + F.tid, G * NTHREADS);
    GSYNC();
    REFRESH(); gla_scan_pass<true>(F, P);
    GSYNC();
#pragma unroll 1
    for (int layer = 0; layer < 2; ++layer) {
        const float* fin = (const float*)(ws + FIN(0)) + (size_t)layer * (64 * 1024 / 4);
        if (layer == 1) {
            {
                pg8::Gemm g{H3B, (const bf16*)(ws + W_QKV_T), M, QKV_LD, opq(D), D, D}; pg8::StaticOrder S; S.init(M, QKV_LD, G, cid);
                pg8::EpiBf16 E{(bf16*)(ws + R2_QKV), QKV_LD, P.in[8], 1 << 30, nullptr};
                pg8::gemm_phase<pg8::EpiBf16, pg8::StaticOrder, true, true>(F.lds, g, S, E, SX);
            }
            GSYNC();
            REFRESH(); swa_phase(F, P);
            GSYNC();
        }
        {
            const bf16* A = layer == 0 ? (const bf16*)(ws + R2) + 2048 : (const bf16*)A16;
            pg8::Gemm g{A, (const bf16*)(ws + (layer == 0 ? W_GOUT_T : W_SOUT_T)), M, D, opq(D), layer == 0 ? PROJ_LD : D, D}; pg8::StaticOrder S; S.init(M, D, G, cid);
            pg8::EpiY<false> E{layer == 0 ? (const void*)A16 : (const void*)H3B, 1, layer == 0 ? nullptr : P.in[11], nullptr, nullptr, nullptr, Y1B, ST1, ALPHA};
            pg8::gemm_phase<pg8::EpiY<false>, pg8::StaticOrder, true, true>(F.lds, g, S, E, SX);
        }
        GSYNC();
        {
            pg8::Gemm g{Y1B, (const bf16*)(ws + W_UP_T + (size_t)layer * W_LSTRIDE), M, FF, opq(D), D, D}; pg8::StaticOrder S; S.init(M, FF, G, cid);
            pg8::EpiUpLN E{ST1, fin, fin + 4096, U16, FF};
            pg8::gemm_phase<pg8::EpiUpLN, pg8::StaticOrder, true, true>(F.lds, g, S, E, SX);
        }
        GSYNC();
        {
            pg8::Gemm g{U16, (const bf16*)(ws + W_DN_T + (size_t)layer * W_LSTRIDE), M, D, opq(FF), FF, FF}; pg8::StaticOrder S; S.init(M, D, G, cid);
            pg8::EpiY<true> E{(const void*)Y1B, 1, nullptr, P.in[14] + layer * D, P.in[15] + layer * D, ST1, Y2B, ST2, ALPHA};
            pg8::gemm_phase<pg8::EpiY<true>, pg8::StaticOrder, true, true>(F.lds, g, S, E, SX);
        }
        GSYNC();
        {
            int kpp = opq(PLE); pg8::Gemm g{layer == 0 ? (const bf16*)P.out : (const bf16*)(ws + PB1_OFF), (const bf16*)(ws + W_PP_T + (size_t)layer * W_LSTRIDE), M, D, kpp, kpp, kpp}; pg8::StaticOrder S; S.init(M, D, G, cid);
            pg8::EpiPP E{(bf16*)(ws + R2_PP), D};
            pg8::gemm_phase<pg8::EpiPP, pg8::StaticOrder, true, true>(F.lds, g, S, E, SX);
        }
        __syncthreads();
        {
            pg8::Gemm g{Y2B, (const bf16*)(ws + W_GATE_T + (size_t)layer * W_LSTRIDE), M, D, opq(D), D, D}; pg8::StaticOrder S; S.init(M, D, G, cid);
            pg8::EpiGateLN E{ST2, Y2B, (const bf16*)(ws + R2_PP), fin + 8192, fin + 9216, P.in[16] + layer * D, P.in[17] + layer * D, P.out, layer == 0 ? H3B : nullptr};
            pg8::gemm_phase<pg8::EpiGateLN, pg8::StaticOrder, true, true>(F.lds, g, S, E, SX);
        }
        if (layer == 0) GSYNC();
    }
}

extern "C" void kernel_launch(void* const* d_in, const int* in_sizes, int n_in, void* d_out, int out_size, void* d_ws, size_t ws_size, hipStream_t stream) {
    static int grid = 0;
    if (grid == 0) {
        if (n_in != 21 || in_sizes[0] != M * D || out_size != M * D || ws_size < WS_END) { fprintf(stderr, "kernel_launch: unexpected shapes (n_in %d, in0 %d, out %d, ws %zu)\n", n_in, n_in > 0 ? in_sizes[0] : -1, out_size, ws_size); grid = -1; return; }
        int dev = 0, cus = 0, per_cu = 0;
        hipGetDevice(&dev); hipDeviceGetAttribute(&cus, hipDeviceAttributeMultiprocessorCount, dev);
        if (hipFuncSetAttribute((const void*)mega_fwd, hipFuncAttributeMaxDynamicSharedMemorySize, LDS_BYTES) != hipSuccess) { fprintf(stderr, "kernel_launch: hipFuncSetAttribute failed\n"); grid = -1; return; }
        if (hipOccupancyMaxActiveBlocksPerMultiprocessor(&per_cu, (const void*)mega_fwd, NTHREADS, LDS_BYTES) != hipSuccess || per_cu < 1) { fprintf(stderr, "kernel_launch: occupancy query says %d\n", per_cu); (void)hipGetLastError(); per_cu = 1; }
        grid = cus * 1;
        if (grid <= 0) grid = 256;
    }
    if (grid < 0) return;
    Params p{};
    for (int i = 0; i < 21; ++i) p.in[i] = (const float*)d_in[i];
    p.out = (float*)d_out; p.ws = (unsigned char*)d_ws;
    void* args[] = {&p};
    hipError_t e = hipLaunchCooperativeKernel((const void*)mega_fwd, dim3(grid), dim3(NTHREADS), args, LDS_BYTES, stream);
    if (e != hipSuccess) fprintf(stderr, "cooperative launch failed: %s (grid %d)\n", hipGetErrorString(e), grid);
}
```

```cpp
#include <hip/hip_runtime.h>
#include <hip/hip_cooperative_groups.h>
#include <cstdio>
#include <cstdint>
namespace cg = cooperative_groups;
namespace pg8 {
#define PG8_LAS __attribute__((address_space(3)))
typedef unsigned short bf16_t;
typedef short bf16x8 __attribute__((ext_vector_type(8)));
typedef float f32x4 __attribute__((ext_vector_type(4)));
typedef unsigned u32x4 __attribute__((ext_vector_type(4)));
constexpr int BM = 256, BK = 64, HALF = 128, HTB = HALF * BK * 2  , STAGE_BYTES = 8 * HTB, NXCD = 8, WGM = 8;

__host__ __device__ __forceinline__ int lds_byte(int r, int c) { const int st = (r >> 4) * 2 + (c >> 5), rr = r & 15, cc = c & 31, ob = rr * 64 + cc * 2; return st * 1024 + (ob ^ (((ob >> 9) & 1) << 5)); }
__host__ __device__ __forceinline__ void stage_rc(int b, int& R, int& C) { const int st = b / 1024, sb = b % 1024, swz = sb ^ (((sb >> 9) & 1) << 5); R = (st >> 1) * 16 + swz / 64; C = (st & 1) * 32 + (swz % 64) / 2; }
__host__ __device__ __forceinline__ int perm32(int rho) { const int n = rho >> 4, i = rho & 15; return 8 * (i >> 2) + 4 * n + (i & 3); }

struct Unit { int pm, pn; };
struct Gemm { const bf16_t* A; const bf16_t* Bt; int M, N, K, lda, ldb; };

struct StaticOrder {
    int nM, nN, nwg, G, c;
    __host__ __device__ void init(int M, int N, int G_, int c_) { nM = M / BM; nN = N / BM; nwg = nM * nN; G = G_; c = c_; }
    __host__ __device__ bool next(int i, Unit& u) const {
        const long L = (long)i * G + c; if (L >= nwg) return false;
        int wgid = (int)L; { const int q = nwg / NXCD, r = nwg % NXCD, xcd = wgid % NXCD, off = wgid / NXCD; wgid = (xcd < r ? xcd * (q + 1) : r * (q + 1) + (xcd - r) * q) + off; }
        const int nig = WGM * nN, gid = wgid / nig, fm = gid * WGM, gsz = (nM - fm) < WGM ? (nM - fm) : WGM;
        u.pm = fm + ((wgid % nig) % gsz); u.pn = (wgid % nig) / gsz; return true;
    }
    __device__ __forceinline__ void a_ready(const Unit&) const {}
    __device__ __forceinline__ void done(const Unit&) const {}
};


__device__ __forceinline__ unsigned cvt_pk_bf16(float lo, float hi) { unsigned r; asm volatile("v_cvt_pk_bf16_f32 %0, %1, %2" : "=v"(r) : "v"(lo), "v"(hi)); return r; }
typedef unsigned u32x2 __attribute__((ext_vector_type(2)));
typedef float f32x2 __attribute__((ext_vector_type(2)));
__device__ __forceinline__ float bf2f(unsigned short b) { return __uint_as_float(((unsigned)b) << 16); }
__device__ __forceinline__ void unpack8(const u32x4 w, float (&v)[8]) {
    v[0] = __uint_as_float(w.x << 16); v[1] = __uint_as_float(w.x & 0xffff0000u); v[2] = __uint_as_float(w.y << 16); v[3] = __uint_as_float(w.y & 0xffff0000u);
    v[4] = __uint_as_float(w.z << 16); v[5] = __uint_as_float(w.z & 0xffff0000u); v[6] = __uint_as_float(w.w << 16); v[7] = __uint_as_float(w.w & 0xffff0000u);
}
constexpr float EPI_LN_EPS = 1e-5f;
__device__ __forceinline__ void stats_pre(const float* ST, int pm, int slot, int tid, PG8_LAS float* sx) {
    if (tid < 256) {
        const f32x4* p = (const f32x4*)(ST + (size_t)(pm * BM + tid) * 32); float s = 0.f, q = 0.f;
#pragma unroll
        for (int i = 0; i < 8; ++i) { const f32x4 v = p[i]; s += v[0] + v[2]; q += v[1] + v[3]; }
        const float mean = s * (1.0f / 1024.0f), var = fmaxf(q * (1.0f / 1024.0f) - mean * mean, 0.f);
        *(PG8_LAS f32x2*)(sx + (slot * 256 + tid) * 2) = (f32x2){mean, 1.0f / sqrtf(var + EPI_LN_EPS)};
    }
}

struct EpiBf16 {
    static constexpr bool PERM = true, AFTER_DRAIN = false;
    bf16_t* O; int ldc; const float* bias; int gk_tile; float* GK;
    __device__ __forceinline__ void pre(const Unit&, int, int, PG8_LAS float*) const {}
    __device__ __forceinline__ void operator()(const f32x4 (&acc)[2][2][4][2], const Unit& u, int wr, int wc, int fr, int fq, int, PG8_LAS float*) const {
        const int row0 = u.pm * BM + wr * 64 + fr;
        if (u.pn >= gk_tile) {
            if (wc == 0 && fq < 2) {
#pragma unroll
                for (int ai = 0; ai < 2; ++ai)
#pragma unroll
                    for (int m = 0; m < 4; ++m) { float* gp = GK + (size_t)(row0 + ai * HALF + m * 16) * 16 + 8 * fq;
                        *(f32x4*)(gp) = acc[ai][0][m][0]; *(f32x4*)(gp + 4) = acc[ai][0][m][1]; }
            }
            return;
        }
        const int col0 = u.pn * BM + wc * 32 + 8 * fq;
#pragma unroll
        for (int bj = 0; bj < 2; ++bj) {
            f32x4 b0 = (f32x4){0.f, 0.f, 0.f, 0.f}, b1 = b0;
            if (bias) { b0 = *(const f32x4*)(bias + col0 + bj * HALF); b1 = *(const f32x4*)(bias + col0 + bj * HALF + 4); }
#pragma unroll
            for (int ai = 0; ai < 2; ++ai)
#pragma unroll
                for (int m = 0; m < 4; ++m) { const f32x4 v0 = acc[ai][bj][m][0] + b0, v1 = acc[ai][bj][m][1] + b1;
                    u32x4 w; w.x = cvt_pk_bf16(v0[0], v0[1]); w.y = cvt_pk_bf16(v0[2], v0[3]); w.z = cvt_pk_bf16(v1[0], v1[1]); w.w = cvt_pk_bf16(v1[2], v1[3]);
                    *(u32x4*)(O + (size_t)(row0 + ai * HALF + m * 16) * ldc + col0 + bj * HALF) = w; } }
    }
};

template <bool LN> struct EpiY {
    static constexpr bool PERM = true, AFTER_DRAIN = false;
    const void* res; int res_bf16; const float* bias; const float* g; const float* b; const float* ST_IN; bf16_t* Y; float* ST; float alpha;
    __device__ __forceinline__ void pre(const Unit& u, int slot, int tid, PG8_LAS float* sx) const { if (LN) stats_pre(ST_IN, u.pm, slot, tid, sx); }
    __device__ __forceinline__ void operator()(const f32x4 (&acc)[2][2][4][2], const Unit& u, int wr, int wc, int fr, int fq, int slot, PG8_LAS float* sx) const {
        const int col0 = u.pn * BM + wc * 32 + 8 * fq, rl0 = wr * 64 + fr; const size_t roff0 = (size_t)(u.pm * BM + rl0) * 1024;
        const bf16_t* R = (const bf16_t*)res;
        float ps[8], pq[8];
#pragma unroll
        for (int r = 0; r < 8; ++r) { ps[r] = 0.f; pq[r] = 0.f; }
#pragma unroll
        for (int bj = 0; bj < 2; ++bj) { const int c = col0 + bj * HALF;
            u32x4 rr[8];
#pragma unroll
            for (int r = 0; r < 8; ++r) rr[r] = *(const u32x4*)(R + roff0 + (size_t)((r >> 2) * HALF + (r & 3) * 16) * 1024 + c);
            f32x4 g0, g1, b0, b1, bb0, bb1;
            if (LN) { g0 = *(const f32x4*)(g + c); g1 = *(const f32x4*)(g + c + 4); b0 = *(const f32x4*)(b + c); b1 = *(const f32x4*)(b + c + 4); }
            if (bias) { bb0 = *(const f32x4*)(bias + c); bb1 = *(const f32x4*)(bias + c + 4); }
#pragma unroll
            for (int r = 0; r < 8; ++r) { const int ai = r >> 2, m = r & 3, rl = rl0 + ai * HALF + m * 16;
                float rv[8]; unpack8(rr[r], rv);
                if (LN) { const f32x2 mr = *(const PG8_LAS f32x2*)(sx + (slot * 256 + rl) * 2);
#pragma unroll
                    for (int i = 0; i < 4; ++i) { rv[i] = (rv[i] - mr[0]) * mr[1] * g0[i] + b0[i]; rv[4 + i] = (rv[4 + i] - mr[0]) * mr[1] * g1[i] + b1[i]; } }
                f32x4 v0 = acc[ai][bj][m][0], v1 = acc[ai][bj][m][1];
                if (bias) { v0 += bb0; v1 += bb1; }
                float y[8];
#pragma unroll
                for (int i = 0; i < 4; ++i) { y[i] = alpha * rv[i] + v0[i]; y[4 + i] = alpha * rv[4 + i] + v1[i]; }
                u32x4 w; w.x = cvt_pk_bf16(y[0], y[1]); w.y = cvt_pk_bf16(y[2], y[3]); w.z = cvt_pk_bf16(y[4], y[5]); w.w = cvt_pk_bf16(y[6], y[7]);
                *(u32x4*)(Y + roff0 + (size_t)(ai * HALF + m * 16) * 1024 + c) = w;
                float yr[8]; unpack8(w, yr);
#pragma unroll
                for (int i = 0; i < 8; ++i) { ps[r] += yr[i]; pq[r] += yr[i] * yr[i]; } }
        }
#pragma unroll
        for (int r = 0; r < 8; ++r) { float a = ps[r], q = pq[r];
            a += __shfl_xor(a, 16); a += __shfl_xor(a, 32); q += __shfl_xor(q, 16); q += __shfl_xor(q, 32);
            if (fq == 0) *(f32x2*)(ST + (size_t)(u.pm * BM + rl0 + (r >> 2) * HALF + (r & 3) * 16) * 32 + (u.pn * 4 + wc) * 2) = (f32x2){a, q}; }
    }
};

struct EpiUpLN {
    static constexpr bool PERM = true, AFTER_DRAIN = false;
    const float* ST_IN; const float* colsum; const float* bw; bf16_t* O; int ldc;
    __device__ __forceinline__ void pre(const Unit& u, int slot, int tid, PG8_LAS float* sx) const { stats_pre(ST_IN, u.pm, slot, tid, sx); }
    __device__ __forceinline__ void operator()(const f32x4 (&acc)[2][2][4][2], const Unit& u, int wr, int wc, int fr, int fq, int slot, PG8_LAS float* sx) const {
        const int col0 = u.pn * BM + wc * 32 + 8 * fq, rl0 = wr * 64 + fr;
#pragma unroll
        for (int bj = 0; bj < 2; ++bj) { const int c = col0 + bj * HALF;
            const f32x4 c0 = *(const f32x4*)(colsum + c), c1 = *(const f32x4*)(colsum + c + 4), w0 = *(const f32x4*)(bw + c), w1 = *(const f32x4*)(bw + c + 4);
#pragma unroll
            for (int r = 0; r < 8; ++r) { const int ai = r >> 2, m = r & 3, rl = rl0 + ai * HALF + m * 16;
                const f32x2 mr = *(const PG8_LAS f32x2*)(sx + (slot * 256 + rl) * 2);
                f32x4 v0 = (acc[ai][bj][m][0] - c0 * mr[0]) * mr[1] + w0, v1 = (acc[ai][bj][m][1] - c1 * mr[0]) * mr[1] + w1;
#pragma unroll
                for (int i = 0; i < 4; ++i) { const float a = fmaxf(v0[i], 0.f), b2 = fmaxf(v1[i], 0.f); v0[i] = a * a; v1[i] = b2 * b2; }
                u32x4 w; w.x = cvt_pk_bf16(v0[0], v0[1]); w.y = cvt_pk_bf16(v0[2], v0[3]); w.z = cvt_pk_bf16(v1[0], v1[1]); w.w = cvt_pk_bf16(v1[2], v1[3]);
                *(u32x4*)(O + (size_t)(u.pm * BM + rl) * ldc + c) = w; } }
    }
};

struct EpiPP {
    static constexpr bool PERM = true, AFTER_DRAIN = false;
    bf16_t* O; int ldc;
    __device__ __forceinline__ void pre(const Unit&, int, int, PG8_LAS float*) const {}
    __device__ __forceinline__ void operator()(const f32x4 (&acc)[2][2][4][2], const Unit& u, int wr, int wc, int fr, int fq, int, PG8_LAS float*) const {
        const int row0 = u.pm * BM + wr * 64 + fr, col0 = u.pn * BM + wc * 32 + 8 * fq;
#pragma unroll
        for (int ai = 0; ai < 2; ++ai)
#pragma unroll
            for (int m = 0; m < 4; ++m) { bf16_t* rowp = O + (size_t)(row0 + ai * HALF + m * 16) * ldc + col0;
#pragma unroll
                for (int bj = 0; bj < 2; ++bj) { const f32x4 v0 = acc[ai][bj][m][0], v1 = acc[ai][bj][m][1];
                    u32x4 w; w.x = cvt_pk_bf16(v0[0], v0[1]); w.y = cvt_pk_bf16(v0[2], v0[3]); w.z = cvt_pk_bf16(v1[0], v1[1]); w.w = cvt_pk_bf16(v1[2], v1[3]);
                    *(u32x4*)(rowp + bj * HALF) = w; } }
    }
};

struct EpiGateLN {
    static constexpr bool PERM = true, AFTER_DRAIN = false;
    const float* ST_IN; const bf16_t* YB; const bf16_t* pp; const float* colsum; const float* bz; const float* g; const float* b; float* out; bf16_t* ob;
    __device__ __forceinline__ void pre(const Unit& u, int slot, int tid, PG8_LAS float* sx) const { stats_pre(ST_IN, u.pm, slot, tid, sx); }
    __device__ __forceinline__ void operator()(const f32x4 (&acc)[2][2][4][2], const Unit& u, int wr, int wc, int fr, int fq, int slot, PG8_LAS float* sx) const {
        const int col0 = u.pn * BM + wc * 32 + 8 * fq, rl0 = wr * 64 + fr; const size_t roff0 = (size_t)(u.pm * BM + rl0) * 1024;
#pragma unroll
        for (int bj = 0; bj < 2; ++bj) { const int c = col0 + bj * HALF;
            f32x4 cs[2], zb[2], gg[2], bb[2];
#pragma unroll
            for (int hh = 0; hh < 2; ++hh) { cs[hh] = *(const f32x4*)(colsum + c + 4 * hh); zb[hh] = *(const f32x4*)(bz + c + 4 * hh); gg[hh] = *(const f32x4*)(g + c + 4 * hh); bb[hh] = *(const f32x4*)(b + c + 4 * hh); }
#pragma unroll
            for (int ai = 0; ai < 2; ++ai) {
                u32x4 yy[4], pw[4];
#pragma unroll
                for (int m = 0; m < 4; ++m) { const size_t o2 = roff0 + (size_t)(ai * HALF + m * 16) * 1024 + c; yy[m] = *(const u32x4*)(YB + o2); pw[m] = *(const u32x4*)(pp + o2); }
#pragma unroll
                for (int m = 0; m < 4; ++m) { const int rl = rl0 + ai * HALF + m * 16; const size_t o2 = roff0 + (size_t)(ai * HALF + m * 16) * 1024 + c;
                    const f32x2 mr = *(const PG8_LAS f32x2*)(sx + (slot * 256 + rl) * 2);
                    float y[8], p[8], o[8]; unpack8(yy[m], y); unpack8(pw[m], p);
#pragma unroll
                    for (int hh = 0; hh < 2; ++hh) { const f32x4 z = (acc[ai][bj][m][hh] - cs[hh] * mr[0]) * mr[1] + zb[hh];
#pragma unroll
                        for (int i = 0; i < 4; ++i) { const float h2 = (y[4 * hh + i] - mr[0]) * mr[1] * gg[hh][i] + bb[hh][i]; o[4 * hh + i] = h2 + p[4 * hh + i] * __builtin_amdgcn_rcpf(1.0f + __expf(-z[i])); } }
                    if (ob) { u32x4 w; w.x = cvt_pk_bf16(o[0], o[1]); w.y = cvt_pk_bf16(o[2], o[3]); w.z = cvt_pk_bf16(o[4], o[5]); w.w = cvt_pk_bf16(o[6], o[7]); *(u32x4*)(ob + o2) = w; }
                    else { *(f32x4*)(out + o2) = (f32x4){o[0], o[1], o[2], o[3]}; *(f32x4*)(out + o2 + 4) = (f32x4){o[4], o[5], o[6], o[7]}; } }
                asm volatile("" ::: "memory");
            } }
    }
};

template <class Epi, class Sched, bool ALIGN_EPI = false, bool SP2 = false>
__device__ __forceinline__ void gemm_phase(PG8_LAS unsigned char* lds, const Gemm g, const Sched& S, const Epi& E, PG8_LAS float* sx) {
    int tid_ = threadIdx.x; asm volatile("" : "+v"(tid_));
    const int tid = tid_, wid = __builtin_amdgcn_readfirstlane(tid >> 6), lane = tid & 63, wr = wid >> 2, wc = wid & 3, fr = lane & 15, fq = lane >> 4;
    const int K = g.K, nt = K / BK;
    unsigned voffA[2], voffB[2];
#pragma unroll
    for (int i = 0; i < 2; ++i) { int R, C; stage_rc(tid * 16 + i * 8192, R, C); const int Rb = Epi::PERM ? ((R & ~31) + perm32(R & 31)) : R;
        voffA[i] = (unsigned)(R * g.lda + C) * 2u; voffB[i] = (unsigned)(Rb * g.ldb + C) * 2u; }
    const size_t kstep = (size_t)(BK * 2);
    const size_t hstepA = (size_t)HALF * g.lda * 2, hstepB = (size_t)HALF * g.ldb * 2;
    const size_t tstepA = 2 * hstepA, tstepB = 2 * hstepB;
    const unsigned ldsw = (unsigned)wid * 1024u;
    const int aoff = lds_byte(wr * 64 + fr, fq * 8), boff = lds_byte(wc * 32 + fr, fq * 8);
#define PG8_SA(b, h) (((b) * 2 + (h)) * HTB)
#define PG8_SB(b, h) ((4 + (b) * 2 + (h)) * HTB)
#define PG8_STAGE(bufoff, gbase, voff) do { _Pragma("unroll") for (int _i = 0; _i < 2; ++_i) \
        __builtin_amdgcn_global_load_lds((const unsigned*)((const char*)(gbase) + (voff)[_i]), (PG8_LAS unsigned*)(lds + (bufoff) + ldsw + _i * 8192), 16, 0, 0); } while (0)
#define PG8_LDA(dst, b, h) do { _Pragma("unroll") for (int m = 0; m < 4; ++m) _Pragma("unroll") for (int k = 0; k < 2; ++k) dst[m][k] = *(const PG8_LAS bf16x8*)(lds + PG8_SA(b, h) + aoff + m * 2048 + k * 1024); } while (0)
#define PG8_LDB(dst, b, h) do { _Pragma("unroll") for (int n = 0; n < 2; ++n) _Pragma("unroll") for (int k = 0; k < 2; ++k) dst[n][k] = *(const PG8_LAS bf16x8*)(lds + PG8_SB(b, h) + boff + n * 2048 + k * 1024); } while (0)
#define PG8_MMA(ai, bj, At, Bt) do { __builtin_amdgcn_s_setprio(1); _Pragma("unroll") for (int m = 0; m < 4; ++m) _Pragma("unroll") for (int n = 0; n < 2; ++n) _Pragma("unroll") for (int k = 0; k < 2; ++k) \
        acc[ai][bj][m][n] = __builtin_amdgcn_mfma_f32_16x16x32_bf16(Bt[n][k], At[m][k], acc[ai][bj][m][n], 0, 0, 0); __builtin_amdgcn_s_setprio(0); } while (0)
#define PG8_WAIT_V(n) asm volatile("s_waitcnt vmcnt(" #n ")" ::: "memory")
#define PG8_WAIT_L(n) asm volatile("s_waitcnt lgkmcnt(" #n ")" ::: "memory")
#define PG8_BAR __builtin_amdgcn_s_barrier()
#define PG8_SCHED __builtin_amdgcn_sched_barrier(0)
    Unit cur, nxt; int ui = 0;
    if (!S.next(0, cur)) return;
    f32x4 acc[2][2][4][2];
#pragma unroll
    for (int a = 0; a < 2; ++a)
#pragma unroll
        for (int b = 0; b < 2; ++b)
#pragma unroll
            for (int m = 0; m < 4; ++m)
#pragma unroll
                for (int n = 0; n < 2; ++n) acc[a][b][m][n] = (f32x4){0.f, 0.f, 0.f, 0.f};
    bf16x8 At[4][2], B0[2][2], B1[2][2];
    const char* cA = (const char*)g.A + (size_t)cur.pm * tstepA; const char* cB = (const char*)g.Bt + (size_t)cur.pn * tstepB;
    S.a_ready(cur); E.pre(cur, 0, tid, sx);
    if constexpr (SP2) {
        PG8_STAGE(PG8_SB(0, 0), cB, voffB); PG8_STAGE(PG8_SB(0, 1), cB + hstepB, voffB); PG8_STAGE(PG8_SA(0, 0), cA, voffA); PG8_STAGE(PG8_SA(0, 1), cA + hstepA, voffA);
        if (wr == 1) PG8_BAR;
        PG8_WAIT_V(2); PG8_BAR;
        PG8_STAGE(PG8_SB(1, 0), cB + kstep, voffB); PG8_STAGE(PG8_SA(1, 0), cA + kstep, voffA); PG8_STAGE(PG8_SB(1, 1), cB + hstepB + kstep, voffB);
        PG8_WAIT_V(6); PG8_BAR;
    } else {
        PG8_STAGE(PG8_SB(0, 0), cB, voffB); PG8_STAGE(PG8_SA(0, 0), cA, voffA); PG8_STAGE(PG8_SB(0, 1), cB + hstepB, voffB); PG8_STAGE(PG8_SA(0, 1), cA + hstepA, voffA);
        if (wr == 1) PG8_BAR;
        PG8_WAIT_V(4); PG8_BAR;
        PG8_STAGE(PG8_SB(1, 0), cB + kstep, voffB); PG8_STAGE(PG8_SA(1, 0), cA + kstep, voffA); PG8_STAGE(PG8_SB(1, 1), cB + hstepB + kstep, voffB);
        PG8_WAIT_V(6); PG8_BAR;
    }
    for (;;) {
        const bool has_next = S.next(ui + 1, nxt);
        const char* nA = has_next ? (const char*)g.A + (size_t)nxt.pm * tstepA : cA; const char* nB = has_next ? (const char*)g.Bt + (size_t)nxt.pn * tstepB : cB;
        for (int t = 0; t < nt; t += 2) {
            const bool last = (t == nt - 2);
            const char* a1 = cA + (size_t)(t + 1) * kstep;
            const char* a2 = last ? nA : cA + (size_t)(t + 2) * kstep; const char* b2 = last ? nB : cB + (size_t)(t + 2) * kstep;
            const char* a3 = a2 + kstep; const char* b3 = b2 + kstep;
            if (last && has_next) { S.a_ready(nxt); E.pre(nxt, (ui + 1) & 1, tid, sx); }
            if constexpr (SP2) {
            PG8_LDB(B0, 0, 0); PG8_LDB(B1, 0, 1); PG8_SCHED; PG8_LDA(At, 0, 0); PG8_STAGE(PG8_SA(1, 1), a1 + hstepA, voffA);
            PG8_WAIT_V(8); PG8_WAIT_L(0); PG8_BAR; PG8_MMA(0, 0, At, B0); PG8_MMA(0, 1, At, B1); PG8_BAR; PG8_SCHED;
            PG8_LDA(At, 0, 1); PG8_STAGE(PG8_SB(0, 0), b2, voffB); PG8_STAGE(PG8_SB(0, 1), b2 + hstepB, voffB); PG8_STAGE(PG8_SA(0, 0), a2, voffA);
            PG8_WAIT_V(8); PG8_WAIT_L(0); PG8_BAR; PG8_MMA(1, 0, At, B0); PG8_MMA(1, 1, At, B1); PG8_BAR; PG8_SCHED;
            PG8_LDB(B0, 1, 0); PG8_LDB(B1, 1, 1); PG8_SCHED; PG8_LDA(At, 1, 0); PG8_STAGE(PG8_SA(0, 1), a2 + hstepA, voffA);
            PG8_WAIT_V(8); PG8_WAIT_L(0); PG8_BAR; PG8_MMA(0, 0, At, B0); PG8_MMA(0, 1, At, B1); PG8_BAR; PG8_SCHED;
            PG8_LDA(At, 1, 1); PG8_STAGE(PG8_SB(1, 0), b3, voffB); PG8_STAGE(PG8_SB(1, 1), b3 + hstepB, voffB); PG8_STAGE(PG8_SA(1, 0), a3, voffA);
            PG8_WAIT_V(8); PG8_WAIT_L(0); PG8_BAR; PG8_MMA(1, 0, At, B0); PG8_MMA(1, 1, At, B1); PG8_BAR; PG8_SCHED;
            } else {
            PG8_LDB(B0, 0, 0); PG8_SCHED; PG8_LDA(At, 0, 0); PG8_STAGE(PG8_SA(1, 1), a1 + hstepA, voffA);
            PG8_WAIT_L(8); PG8_BAR; PG8_WAIT_L(0); PG8_MMA(0, 0, At, B0); PG8_BAR; PG8_SCHED;
            PG8_LDB(B1, 0, 1); PG8_STAGE(PG8_SB(0, 0), b2, voffB);
            PG8_BAR; PG8_WAIT_L(0); PG8_MMA(0, 1, At, B1); PG8_BAR;
            PG8_LDA(At, 0, 1); PG8_STAGE(PG8_SA(0, 0), a2, voffA);
            PG8_BAR; PG8_WAIT_L(0); PG8_MMA(1, 0, At, B0); PG8_BAR; PG8_SCHED;
            PG8_STAGE(PG8_SB(0, 1), b2 + hstepB, voffB);
            PG8_WAIT_V(6); PG8_BAR; PG8_MMA(1, 1, At, B1); PG8_BAR;
            PG8_LDB(B0, 1, 0); PG8_SCHED; PG8_LDA(At, 1, 0); PG8_STAGE(PG8_SA(0, 1), a2 + hstepA, voffA);
            PG8_WAIT_L(8); PG8_BAR; PG8_WAIT_L(0); PG8_MMA(0, 0, At, B0); PG8_BAR; PG8_SCHED;
            PG8_LDB(B1, 1, 1); PG8_STAGE(PG8_SB(1, 0), b3, voffB);
            PG8_BAR; PG8_WAIT_L(0); PG8_MMA(0, 1, At, B1); PG8_BAR;
            PG8_LDA(At, 1, 1); PG8_STAGE(PG8_SA(1, 0), a3, voffA);
            PG8_BAR; PG8_WAIT_L(0); PG8_MMA(1, 0, At, B0); PG8_BAR; PG8_SCHED;
            PG8_STAGE(PG8_SB(1, 1), b3 + hstepB, voffB);
            PG8_WAIT_V(6); PG8_BAR; PG8_MMA(1, 1, At, B1); PG8_BAR;
            }
        }
        if constexpr (ALIGN_EPI) { if (wr == 0) PG8_BAR; }
        if constexpr (!Epi::AFTER_DRAIN) { E(acc, cur, wr, wc, fr, fq, ui & 1, sx); S.done(cur); }
        if (!has_next) break;
#pragma unroll
        for (int a = 0; a < 2; ++a)
#pragma unroll
            for (int b = 0; b < 2; ++b)
#pragma unroll
                for (int m = 0; m < 4; ++m)
#pragma unroll
                    for (int n = 0; n < 2; ++n) acc[a][b][m][n] = (f32x4){0.f, 0.f, 0.f, 0.f};
        cur = nxt; cA = nA; cB = nB; ++ui;
        if constexpr (ALIGN_EPI) { if (wr == 1) PG8_BAR; }
    }
    PG8_WAIT_V(0);
    if constexpr (!ALIGN_EPI) { if (wr == 0) PG8_BAR; }
    PG8_BAR;
    if constexpr (Epi::AFTER_DRAIN) { E.fused(acc, cur, wr, wc, fr, fq, lds, wid, lane); S.done(cur); }
#undef PG8_SA
#undef PG8_SB
#undef PG8_STAGE
#undef PG8_LDA
#undef PG8_LDB
#undef PG8_MMA
#undef PG8_WAIT_V
#undef PG8_WAIT_L
#undef PG8_BAR
#undef PG8_SCHED
}
}

#define LAS __attribute__((address_space(3)))
typedef unsigned short bf16;
typedef unsigned u32x4 __attribute__((ext_vector_type(4)));
typedef unsigned u32x2 __attribute__((ext_vector_type(2)));
typedef float f32x4 __attribute__((ext_vector_type(4)));
typedef short bf16x8 __attribute__((ext_vector_type(8)));
typedef short s16x4 __attribute__((ext_vector_type(4)));

constexpr int NTHREADS = 512, NWAVES = 8;
constexpr int BATCH = 8, SEQ = 4096, D = 1024, M = BATCH * SEQ, FF = 4096, PLE = 256;
constexpr int GLA_COLS = 3088, PROJ_LD = 3072;
constexpr int QKV_LD = 1536;
constexpr float LN_EPS = 1e-5f, RMS_EPS = 1e-5f;
constexpr float ALPHA = 1.4142135623730951f;
constexpr size_t MiB = 1u << 20;
constexpr size_t W_IN_T = 1 * MiB;
constexpr size_t W_GOUT_T = 7 * MiB;
constexpr size_t W_UP_T = 9 * MiB;
constexpr size_t W_DN_T = 17 * MiB;
constexpr size_t W_GATE_T = 25 * MiB;
constexpr size_t W_PP_T = 27 * MiB;
constexpr size_t W_QKV_T = 28 * MiB;
constexpr size_t W_SOUT_T = 31 * MiB;
constexpr size_t W_LSTRIDE = 24 * MiB;
constexpr size_t PB1_OFF = 1 * MiB;
constexpr size_t R0 = 56 * MiB;
constexpr size_t R1 = 120 * MiB;
constexpr size_t R2 = 248 * MiB;
constexpr size_t R2_GK = R2 + 192 * MiB;
constexpr size_t R2_PP = R2 + 16 * MiB;
constexpr size_t R2_H3B = R2 + 80 * MiB;
constexpr size_t R2_QKV = R2 + 144 * MiB;
constexpr size_t R0_BL = R1 + 80 * MiB;
constexpr size_t WS_END = 512 * MiB;
constexpr int LDS_BYTES = 147456;

__device__ __forceinline__ int opq(int v) { asm volatile("" : "+s"(v)); return v; }
struct Params { const float* in[21]; float* out; unsigned char* ws; };
#define LBAR() do { asm volatile("s_waitcnt lgkmcnt(0)" ::: "memory"); __builtin_amdgcn_s_barrier(); asm volatile("" ::: "memory"); } while (0)

struct Ctx { LAS unsigned char* lds; int tid, lane, wave; };

__device__ __forceinline__ float wave_sum(float v) {
#pragma unroll
    for (int o = 1; o < 64; o <<= 1) v += __shfl_xor(v, o);
    return v;
}
__device__ __forceinline__ unsigned pk2(float lo, float hi) { return pg8::cvt_pk_bf16(lo, hi); }
__device__ __forceinline__ float bf2f(unsigned short b) { return __uint_as_float(((unsigned)b) << 16); }
__device__ __forceinline__ bf16x8 pack8(const f32x4 a, const f32x4 b) {
    u32x4 w; w.x = pk2(a[0], a[1]); w.y = pk2(a[2], a[3]); w.z = pk2(b[0], b[1]); w.w = pk2(b[2], b[3]); return __builtin_bit_cast(bf16x8, w);
}
#define MFMA16(a, b, c) __builtin_amdgcn_mfma_f32_16x16x32_bf16((a), (b), (c), 0, 0, 0)
__device__ __forceinline__ bf16x8 lds16(const LAS unsigned char* p) { return *(const LAS bf16x8*)p; }
__device__ __forceinline__ bf16x8 lds8x2(const LAS unsigned char* p0, const LAS unsigned char* p1) {
    const s16x4 lo = *(const LAS s16x4*)p0, hi = *(const LAS s16x4*)p1; return __builtin_shufflevector(lo, hi, 0, 1, 2, 3, 4, 5, 6, 7);
}

template <bool FOLD>
__device__ __forceinline__ void transpose_item(const float* W, int ldw, int nblk, int K, bf16* WT, LAS float* scr, int item, int lane,
                                               const float* gv = nullptr, const float* bv = nullptr, float* csp = nullptr, float* bwp = nullptr) {
    const int kb = item / nblk, nb = item % nblk, k0 = 64 * kb, n0 = 32 * nb;
    { const int r8 = lane >> 3, c4 = lane & 7;
      f32x4 v[8];
#pragma unroll
      for (int it = 0; it < 8; ++it) v[it] = __builtin_nontemporal_load((const f32x4*)(W + (size_t)(k0 + 8 * it + r8) * ldw + n0 + 4 * c4));
#pragma unroll
      for (int it = 0; it < 8; ++it) { LAS float* d = scr + (8 * it + r8) * 33 + 4 * c4; d[0] = v[it][0]; d[1] = v[it][1]; d[2] = v[it][2]; d[3] = v[it][3]; } }
    asm volatile("s_waitcnt lgkmcnt(0)" ::: "memory");
    const int c = lane & 7;
    float gk[8], bk[8];
    if (FOLD) {
#pragma unroll
        for (int i = 0; i < 8; ++i) { gk[i] = gv[k0 + 8 * c + i]; bk[i] = bv[k0 + 8 * c + i]; }
    }
#pragma unroll
    for (int j = 0; j < 4; ++j) { const int n = (lane >> 3) + 8 * j; const LAS float* sp = scr + (8 * c) * 33 + n;
        float v[8];
#pragma unroll
        for (int i = 0; i < 8; ++i) v[i] = sp[i * 33];
        float bwv = 0.f;
        if (FOLD) {
#pragma unroll
            for (int i = 0; i < 8; ++i) { bwv += bk[i] * v[i]; v[i] *= gk[i]; }
        }
        u32x4 o; o.x = pk2(v[0], v[1]); o.y = pk2(v[2], v[3]); o.z = pk2(v[4], v[5]); o.w = pk2(v[6], v[7]);
        *(u32x4*)(WT + (size_t)(n0 + n) * K + k0 + 8 * c) = o;
        if (FOLD) {
            float r[8]; pg8::unpack8(o, r); float cs = ((r[0] + r[1]) + (r[2] + r[3])) + ((r[4] + r[5]) + (r[6] + r[7]));
            cs += __shfl_xor(cs, 1); cs += __shfl_xor(cs, 2); cs += __shfl_xor(cs, 4);
            bwv += __shfl_xor(bwv, 1); bwv += __shfl_xor(bwv, 2); bwv += __shfl_xor(bwv, 4);
            if (c == 0) { const int N = 32 * nblk; csp[(size_t)kb * N + n0 + n] = cs; bwp[(size_t)kb * N + n0 + n] = bwv; }
        }
    }
    asm volatile("s_waitcnt lgkmcnt(0)" ::: "memory");
}
constexpr size_t VEC = 52 * MiB;
__device__ __host__ constexpr size_t CSP_UP(int l) { return VEC + (size_t)l * 512 * 1024; }
__device__ __host__ constexpr size_t CSP_G(int l) { return VEC + MiB + (size_t)l * 128 * 1024; }
__device__ __host__ constexpr size_t FIN(int l) { return VEC + MiB + 512 * 1024 + (size_t)l * 64 * 1024; }
__device__ __forceinline__ void fold_finalize(const Params& P, int gtid, int gthreads) {
    for (int idx = gtid; idx < 2 * 5120; idx += gthreads) {
        const int l = idx / 5120, r = idx % 5120;
        float* fin = (float*)(P.ws + FIN(l));
        if (r < 4096) { const float* cp = (const float*)(P.ws + CSP_UP(l)); const float* bp = cp + 16 * 4096; float cs = 0.f, bw = 0.f;
#pragma unroll
            for (int kb = 0; kb < 16; ++kb) { cs += cp[kb * 4096 + r]; bw += bp[kb * 4096 + r]; }
            fin[r] = cs; fin[4096 + r] = bw; }
        else { const int n = r - 4096; const float* cp = (const float*)(P.ws + CSP_G(l)); const float* bp = cp + 16 * 1024; float cs = 0.f, bw = 0.f;
#pragma unroll
            for (int kb = 0; kb < 16; ++kb) { cs += cp[kb * 1024 + n]; bw += bp[kb * 1024 + n]; }
            fin[8192 + n] = cs; fin[9216 + n] = bw + P.in[20][l * D + n]; }
    }
}
__device__ __forceinline__ void p0_prologue(const Ctx& F, const Params& P) {
    LAS float* scr = (LAS float*)(F.lds + F.wave * 16384);
    const int gw = blockIdx.x * NWAVES + F.wave, NGW = gridDim.x * NWAVES;
    unsigned char* ws = P.ws;
    constexpr int I_IN = 16 * 96, I_SQ = 16 * 32, I_QKV = 16 * 48, I_UP = 16 * 128, I_DN = 64 * 32, I_PP = 4 * 32;
    constexpr int NITEMS = I_IN + 2 * I_SQ + I_QKV + 2 * I_UP + 2 * I_DN + 2 * I_SQ + 2 * I_PP;
    for (int it = gw; it < NITEMS; it += NGW) {
        int r = it;
        if (r < I_IN) { transpose_item<false>(P.in[2], GLA_COLS, 96, D, (bf16*)(ws + W_IN_T), scr, r, F.lane); continue; } r -= I_IN;
        if (r < I_SQ) { transpose_item<false>(P.in[6], D, 32, D, (bf16*)(ws + W_GOUT_T), scr, r, F.lane); continue; } r -= I_SQ;
        if (r < I_SQ) { transpose_item<false>(P.in[10], D, 32, D, (bf16*)(ws + W_SOUT_T), scr, r, F.lane); continue; } r -= I_SQ;
        if (r < I_QKV) { transpose_item<false>(P.in[7], QKV_LD, 48, D, (bf16*)(ws + W_QKV_T), scr, r, F.lane); continue; } r -= I_QKV;
        if (r < 2 * I_UP) { const int l = r / I_UP; transpose_item<true>(P.in[12] + (size_t)l * D * FF, FF, 128, D, (bf16*)(ws + W_UP_T + (size_t)l * W_LSTRIDE), scr, r % I_UP, F.lane, P.in[14] + l * D, P.in[15] + l * D, (float*)(ws + CSP_UP(l)), (float*)(ws + CSP_UP(l)) + 16 * 4096); continue; } r -= 2 * I_UP;
        if (r < 2 * I_DN) { const int l = r / I_DN; transpose_item<false>(P.in[13] + (size_t)l * D * FF, D, 32, FF, (bf16*)(ws + W_DN_T + (size_t)l * W_LSTRIDE), scr, r % I_DN, F.lane); continue; } r -= 2 * I_DN;
        if (r < 2 * I_SQ) { const int l = r / I_SQ; transpose_item<true>(P.in[19] + (size_t)l * D * D, D, 32, D, (bf16*)(ws + W_GATE_T + (size_t)l * W_LSTRIDE), scr, r % I_SQ, F.lane, P.in[16] + l * D, P.in[17] + l * D, (float*)(ws + CSP_G(l)), (float*)(ws + CSP_G(l)) + 16 * 1024); continue; } r -= 2 * I_SQ;
        { const int l = r / I_PP; transpose_item<false>(P.in[18] + (size_t)l * PLE * D, D, 32, PLE, (bf16*)(ws + W_PP_T + (size_t)l * W_LSTRIDE), scr, r % I_PP, F.lane); }
    }
    const int gtid = blockIdx.x * NTHREADS + F.tid, gthreads = gridDim.x * NTHREADS;
    {
        LAS float* wg = (LAS float*)F.lds;
        __syncthreads();
        for (int i = F.tid; i < 4096; i += NTHREADS) { const int k = i >> 2, c4 = i & 3, pos = (k & 3) * 256 + (k >> 2); *(LAS f32x4*)(wg + pos * 20 + 4 * c4) = *(const f32x4*)(P.in[2] + (size_t)k * GLA_COLS + 3072 + 4 * c4); }
        __syncthreads();
        const float* x = P.in[0]; bf16* xb = (bf16*)(ws + R0); float* GK = (float*)(ws + R2_GK);
        const int lane = F.lane;
#pragma unroll 1
        for (int r0 = gw * 4; r0 < M; r0 += NGW * 4) {
            f32x4 acc[16];
#pragma unroll
            for (int i = 0; i < 16; ++i) acc[i] = (f32x4){0.f, 0.f, 0.f, 0.f};
#pragma unroll 1
            for (int j = 0; j < 4; ++j) {
                float xs[4][4];
#pragma unroll
                for (int rr = 0; rr < 4; ++rr) { const f32x4 v = __builtin_nontemporal_load((const f32x4*)(x + (size_t)(r0 + rr) * D + 256 * j + 4 * lane));
                    u32x2 o; o.x = pk2(v[0], v[1]); o.y = pk2(v[2], v[3]); *(u32x2*)(xb + (size_t)(r0 + rr) * D + 256 * j + 4 * lane) = o;
                    xs[rr][0] = v[0]; xs[rr][1] = v[1]; xs[rr][2] = v[2]; xs[rr][3] = v[3]; }
#pragma unroll
                for (int i = 0; i < 4; ++i) { const LAS float* wp = wg + (i * 256 + 64 * j + lane) * 20;
                    const f32x4 w0 = *(const LAS f32x4*)(wp), w1 = *(const LAS f32x4*)(wp + 4), w2 = *(const LAS f32x4*)(wp + 8), w3 = *(const LAS f32x4*)(wp + 12);
#pragma unroll
                    for (int rr = 0; rr < 4; ++rr) { const float xv = xs[rr][i]; acc[rr * 4 + 0] += w0 * xv; acc[rr * 4 + 1] += w1 * xv; acc[rr * 4 + 2] += w2 * xv; acc[rr * 4 + 3] += w3 * xv; } }
            }
            float a[64];
#pragma unroll
            for (int i = 0; i < 16; ++i) { a[4 * i] = acc[i][0]; a[4 * i + 1] = acc[i][1]; a[4 * i + 2] = acc[i][2]; a[4 * i + 3] = acc[i][3]; }
#define TR_STEP(n) do { const bool hi_ = (lane & (n)) != 0; _Pragma("unroll") for (int i = 0; i < (n); ++i) { const float send = hi_ ? a[i] : a[i + (n)], keep = hi_ ? a[i + (n)] : a[i]; a[i] = keep + __shfl_xor(send, (n)); } } while (0)
            TR_STEP(32); TR_STEP(16); TR_STEP(8); TR_STEP(4); TR_STEP(2); TR_STEP(1);
#undef TR_STEP
            GK[(size_t)r0 * 16 + lane] = a[0];
        }
    }
}

typedef short v4i16_t __attribute__((ext_vector_type(4)));
__device__ __forceinline__ s16x4 ldtr(const LAS unsigned char* p) { return __builtin_bit_cast(s16x4, __builtin_amdgcn_ds_read_tr16_b64_v4i16((LAS v4i16_t*)p)); }
constexpr int GS_Q = 0, GS_K = 17408, GS_V = 34816, GS_ATT = 68608, GS_RS = 77824, GS_RSTD = 79872, GS_BL = 80128;
constexpr size_t R0_SLOC = R1, R0_GSEG = R1 + 40 * MiB;
template <bool FULL>
__device__ __forceinline__ void gla_scan_pass(const Ctx& F, const Params& P) {
    LAS unsigned char* L = F.lds;
    const int tid = F.tid, lane = F.lane, w = F.wave, l15 = lane & 15, quad = lane >> 4;
    bf16* PROJ = (bf16*)(P.ws + R2);
    const float* BL = (const float*)(P.ws + R0_BL);
    float* SLOC = (float*)(P.ws + R0_SLOC); float* GSEG = (float*)(P.ws + R0_GSEG);
    const float* norm_g = P.in[5];
    for (int item = blockIdx.x; item < BATCH * 4 * 8; item += gridDim.x) {
        const int seg = item & 7, bh = item >> 3, b = bh >> 2, h = bh & 3;
        if (!FULL && seg == 7) continue;
        f32x4 S[8][2];
#pragma unroll
        for (int dt = 0; dt < 8; ++dt) { S[dt][0] = (f32x4){0.f, 0.f, 0.f, 0.f}; S[dt][1] = (f32x4){0.f, 0.f, 0.f, 0.f}; }
        if (FULL) {
#pragma unroll 1
            for (int j = 0; j < seg; ++j) {
                const float* gj = GSEG + (size_t)(bh * 8 + j) * 128 + 4 * quad; const f32x4* sl = (const f32x4*)(SLOC + (size_t)(bh * 8 + j) * 32768) + tid;
#pragma unroll
                for (int dt = 0; dt < 8; ++dt) { const f32x4 gg = *(const f32x4*)(gj + 16 * dt);
                    f32x4 dec; dec[0] = __expf(gg[0]); dec[1] = __expf(gg[1]); dec[2] = __expf(gg[2]); dec[3] = __expf(gg[3]);
                    S[dt][0] = S[dt][0] * dec + sl[(dt * 2 + 0) * 512]; S[dt][1] = S[dt][1] * dec + sl[(dt * 2 + 1) * 512]; }
            }
        }
        float gsum = 0.f;
        u32x4 pq[2], pk[2], pv[4]; float pbl = 0.f;
#define GS_LOADC(cidx) do { const int u_ = (b * 64 + (cidx)) * 4 + h; const size_t m_ = (size_t)b * SEQ + (size_t)(cidx) * 64; int tl_ = tid; asm volatile("" : "+v"(tl_)); \
            _Pragma("unroll") for (int i = 0; i < 2; ++i) { const int idx = tl_ + 512 * i, row = idx >> 4, pc = idx & 15; const bf16* src = PROJ + (m_ + row) * PROJ_LD + h * 128 + pc * 8; \
                if (FULL) pq[i] = *(const u32x4*)(src); pk[i] = *(const u32x4*)(src + 512); } \
            _Pragma("unroll") for (int i = 0; i < 4; ++i) { const int idx = tl_ + 512 * i, row = idx >> 5, pc = idx & 31; pv[i] = *(const u32x4*)(PROJ + (m_ + row) * PROJ_LD + 1024 + h * 256 + pc * 8); } \
            if (tl_ < 128) pbl = BL[(size_t)u_ * 128 + tl_]; } while (0)
        GS_LOADC(seg * 8);
#pragma unroll 1
        for (int cc = 0; cc < 8; ++cc) {
            const int c = seg * 8 + cc;
            const size_t m0 = (size_t)b * SEQ + (size_t)c * 64;
#pragma unroll
            for (int i = 0; i < 2; ++i) { const int idx = tid + 512 * i, row = idx >> 4, pc = idx & 15;
                if (FULL) *(LAS u32x4*)(L + GS_Q + row * 272 + pc * 16) = pq[i];
                *(LAS u32x4*)(L + GS_K + row * 272 + pc * 16) = pk[i]; }
#pragma unroll
            for (int i = 0; i < 4; ++i) { const int idx = tid + 512 * i, row = idx >> 5, pc = idx & 31; *(LAS u32x4*)(L + GS_V + row * 528 + pc * 16) = pv[i]; }
            if (tid < 128) { ((LAS float*)(L + GS_BL))[tid] = pbl; gsum += pbl; }
            LBAR();
            if (cc < 7) GS_LOADC(c + 1);
            u32x2 rw[4][2];
            if (FULL) { const bf16* rp = PROJ + (m0 + l15) * PROJ_LD + 2048 + h * 256 + 32 * w + 4 * quad;
#pragma unroll
                for (int it = 0; it < 4; ++it) { rw[it][0] = *(const u32x2*)(rp); rw[it][1] = *(const u32x2*)(rp + 16); rp += 16 * PROJ_LD; asm volatile("" : "+v"(rp)); } }
#define GS_VF(dst) do { _Pragma("unroll") for (int s2 = 0; s2 < 2; ++s2) _Pragma("unroll") for (int et = 0; et < 2; ++et) { \
                const LAS unsigned char* a_ = L + GS_V + (32 * s2 + 8 * quad + (l15 >> 2)) * 528 + (32 * w + 16 * et) * 2 + 8 * (l15 & 3); \
                const s16x4 lo_ = ldtr(a_), hi_ = ldtr(a_ + 4 * 528); dst[s2][et] = __builtin_shufflevector(lo_, hi_, 0, 1, 2, 3, 4, 5, 6, 7); } } while (0)
            f32x4 o[4][2];
            if (FULL) {
                { const int it = w >> 1;
#pragma unroll
                  for (int x = 0; x < 2; ++x) { const int jt = 2 * (w & 1) + x; f32x4 a = (f32x4){0.f, 0.f, 0.f, 0.f};
                      if (jt <= it) {
#pragma unroll
                          for (int ks = 0; ks < 4; ++ks) { const bf16x8 kf = lds16(L + GS_K + (16 * jt + l15) * 272 + ks * 64 + quad * 16), qf = lds16(L + GS_Q + (16 * it + l15) * 272 + ks * 64 + quad * 16);
                              a = MFMA16(kf, qf, a); }
                          const int ii = 16 * it + l15, j0 = 16 * jt + 4 * quad;
#pragma unroll
                          for (int j = 0; j < 4; ++j) if (j0 + j > ii) a[j] = 0.f;
                      }
                      u32x2 ww; ww.x = pk2(a[0], a[1]); ww.y = pk2(a[2], a[3]);
                      *(LAS u32x2*)(L + GS_ATT + (16 * it + l15) * 144 + (16 * jt + 4 * quad) * 2) = ww; } }
                LBAR();
#pragma unroll
                for (int it = 0; it < 4; ++it) { o[it][0] = (f32x4){0.f, 0.f, 0.f, 0.f}; o[it][1] = (f32x4){0.f, 0.f, 0.f, 0.f}; }
#pragma unroll
                for (int s2 = 0; s2 < 4; ++s2) {
                    bf16x8 sf[2]; sf[0] = pack8(S[2 * s2][0], S[2 * s2 + 1][0]); sf[1] = pack8(S[2 * s2][1], S[2 * s2 + 1][1]);
#pragma unroll
                    for (int it = 0; it < 4; ++it) { const LAS unsigned char* qb = L + GS_Q + (16 * it + l15) * 272 + (32 * s2 + 4 * quad) * 2;
                        const bf16x8 qf = lds8x2(qb, qb + 32);
                        o[it][0] = MFMA16(sf[0], qf, o[it][0]); o[it][1] = MFMA16(sf[1], qf, o[it][1]); }
                }
                { bf16x8 vf[2][2]; GS_VF(vf);
#pragma unroll
                  for (int s2 = 0; s2 < 2; ++s2)
#pragma unroll
                    for (int it = 0; it < 4; ++it) { const bf16x8 af = lds16(L + GS_ATT + (16 * it + l15) * 144 + s2 * 64 + quad * 16);
                        o[it][0] = MFMA16(vf[s2][0], af, o[it][0]); o[it][1] = MFMA16(vf[s2][1], af, o[it][1]); } }
            }
            bf16x8 vf[2][2]; GS_VF(vf);
#pragma unroll
            for (int dt = 0; dt < 8; ++dt) {
                const f32x4 bl = *(const LAS f32x4*)(L + GS_BL + (16 * dt + 4 * quad) * 4);
                f32x4 dec; dec[0] = __expf(bl[0]); dec[1] = __expf(bl[1]); dec[2] = __expf(bl[2]); dec[3] = __expf(bl[3]);
#pragma unroll
                for (int s2 = 0; s2 < 2; ++s2) {
                    const LAS unsigned char* ka = L + GS_K + (32 * s2 + 8 * quad + (l15 >> 2)) * 272 + (16 * dt) * 2 + 8 * (l15 & 3);
                    const s16x4 klo = ldtr(ka), khi = ldtr(ka + 4 * 272); const bf16x8 kf = __builtin_shufflevector(klo, khi, 0, 1, 2, 3, 4, 5, 6, 7);
                    S[dt][0] = MFMA16(kf, vf[s2][0], S[dt][0]); S[dt][1] = MFMA16(kf, vf[s2][1], S[dt][1]); }
                S[dt][0] = S[dt][0] * dec; S[dt][1] = S[dt][1] * dec;
            }
            if (FULL) {
#pragma unroll
                for (int it = 0; it < 4; ++it) { float ss = 0.f;
#pragma unroll
                    for (int et = 0; et < 2; ++et) ss += (o[it][et][0] * o[it][et][0] + o[it][et][1] * o[it][et][1]) + (o[it][et][2] * o[it][et][2] + o[it][et][3] * o[it][et][3]);
                    ss += __shfl_xor(ss, 16); ss += __shfl_xor(ss, 32);
                    if (quad == 0) ((LAS float*)(L + GS_RS))[w * 64 + 16 * it + l15] = ss; }
            }
            LBAR();
            if (FULL) {
                if (tid < 64) { float t = 0.f;
#pragma unroll
                    for (int ww = 0; ww < 8; ++ww) t += ((const LAS float*)(L + GS_RS))[ww * 64 + tid];
                    ((LAS float*)(L + GS_RSTD))[tid] = 1.0f / sqrtf(t * (1.0f / 256.0f) + RMS_EPS); }
                LBAR();
#pragma unroll
                for (int it = 0; it < 4; ++it) { const float rs = ((const LAS float*)(L + GS_RSTD))[16 * it + l15];
#pragma unroll
                    for (int et = 0; et < 2; ++et) { const int e0 = 32 * w + 16 * et + 4 * quad;
                        bf16* wp = PROJ + (m0 + 16 * it + l15) * PROJ_LD + 2048 + h * 256 + e0;
                        const u32x2 r2 = rw[it][et]; const f32x4 gg = *(const f32x4*)(norm_g + e0);
                        float rv[4]; rv[0] = __uint_as_float(r2.x << 16); rv[1] = __uint_as_float(r2.x & 0xffff0000u); rv[2] = __uint_as_float(r2.y << 16); rv[3] = __uint_as_float(r2.y & 0xffff0000u);
                        float ov[4];
#pragma unroll
                        for (int j = 0; j < 4; ++j) ov[j] = o[it][et][j] * rs * gg[j] * (rv[j] * __builtin_amdgcn_rcpf(1.0f + __expf(-rv[j])));
                        u32x2 ow; ow.x = pk2(ov[0], ov[1]); ow.y = pk2(ov[2], ov[3]); *(u32x2*)wp = ow; } }
            }
        }
#undef GS_LOADC
#undef GS_VF
        if (!FULL) {
            f32x4* sl = (f32x4*)(SLOC + (size_t)(bh * 8 + seg) * 32768) + tid;
#pragma unroll
            for (int dt = 0; dt < 8; ++dt) { sl[(dt * 2 + 0) * 512] = S[dt][0]; sl[(dt * 2 + 1) * 512] = S[dt][1]; }
            if (tid < 128) GSEG[(size_t)(bh * 8 + seg) * 128 + tid] = gsum;
        }
        LBAR();
    }
}

__device__ __forceinline__ void gla_pass_a(const Ctx& F, const Params& P) {
    LAS unsigned char* L = F.lds;
    LAS float* gk_s = (LAS float*)(L);
    LAS float* part = (LAS float*)(L + 4096);
    const int tid = F.tid, lane = F.lane, w = F.wave, l15 = lane & 15, quad = lane >> 4, d = tid & 127, g = tid >> 7;
    bf16* PROJ = (bf16*)(P.ws + R2); const float* GK = (const float*)(P.ws + R2_GK);
    float* BL = (float*)(P.ws + R0_BL); float* SLOC = (float*)(P.ws + R0_SLOC); float* GSEG = (float*)(P.ws + R0_GSEG);
    for (int item = blockIdx.x; item < BATCH * 4 * 8; item += gridDim.x) {
        const int seg = item & 7, bh = item >> 3, b = bh >> 2, h = bh & 3;
        float wv[16];
#pragma unroll
        for (int r = 0; r < 16; ++r) wv[r] = P.in[3][r * 512 + h * 128 + d];
        const float bias = P.in[4][h * 128 + d];
        f32x4 S[8][2];
#pragma unroll
        for (int dt = 0; dt < 8; ++dt) { S[dt][0] = (f32x4){0.f, 0.f, 0.f, 0.f}; S[dt][1] = (f32x4){0.f, 0.f, 0.f, 0.f}; }
        float gsum = 0.f;
        u32x4 pv[4]; f32x4 gkn = (f32x4){0.f, 0.f, 0.f, 0.f};
#define PA_LOAD(cidx) do { const size_t m_ = (size_t)b * SEQ + (size_t)(cidx) * 64; int tl_ = tid; asm volatile("" : "+v"(tl_)); \
            _Pragma("unroll") for (int i = 0; i < 4; ++i) { const int idx = tl_ + 512 * i, row = idx >> 5, pc = idx & 31; pv[i] = *(const u32x4*)(PROJ + (m_ + row) * PROJ_LD + 1024 + h * 256 + pc * 8); } \
            if (tl_ < 256) gkn = *(const f32x4*)(GK + m_ * 16 + (size_t)tl_ * 4); } while (0)
        PA_LOAD(seg * 8 + 7);
        float accd = 0.f;
#pragma unroll 1
        for (int cc = 7; cc >= 0; --cc) {
            const int c = seg * 8 + cc, u = (b * 64 + c) * 4 + h;
            const size_t m0 = (size_t)b * SEQ + (size_t)c * 64;
            if (tid < 256) ((LAS f32x4*)gk_s)[tid] = gkn;
#pragma unroll
            for (int i = 0; i < 4; ++i) { const int idx = tid + 512 * i, row = idx >> 5, pc = idx & 31; *(LAS u32x4*)(L + GS_V + row * 528 + pc * 16) = pv[i]; }
            bf16* qp = PROJ + (m0 + 16 * g) * PROJ_LD + h * 128 + d; bf16* kp = qp + 512;
            unsigned qk[16];
            { const bf16* rp = qp;
#pragma unroll
              for (int tt = 0; tt < 16; ++tt) { qk[tt] = (unsigned)rp[0] | ((unsigned)rp[512] << 16); rp += PROJ_LD; asm volatile("" : "+v"(rp)); } }
            { const size_t pgrp = ((size_t)(item * 8 + cc)) * 512 + tid;
              const f32x4 a = __builtin_nontemporal_load((const f32x4*)(P.in[1] + pgrp * 8)), a2 = __builtin_nontemporal_load((const f32x4*)(P.in[1] + pgrp * 8 + 4));
              u32x4 o; o.x = pk2(a[0], a[1]); o.y = pk2(a[2], a[3]); o.z = pk2(a2[0], a2[1]); o.w = pk2(a2[2], a2[3]); *(u32x4*)((bf16*)P.out + pgrp * 8) = o; }
            LBAR();
            float cs[16]; float run = 0.f;
#pragma unroll
            for (int tt = 0; tt < 16; ++tt) {
                const int t = 16 * g + tt; float z = bias;
#pragma unroll
                for (int r4 = 0; r4 < 4; ++r4) { const f32x4 a = ((const LAS f32x4*)gk_s)[t * 4 + r4]; z += a[0] * wv[4 * r4] + a[1] * wv[4 * r4 + 1] + a[2] * wv[4 * r4 + 2] + a[3] * wv[4 * r4 + 3]; }
                const float ls = fminf(z, 0.f) - __logf(1.0f + __expf(-fabsf(z)));
                run += ls * (1.0f / 16.0f); cs[tt] = run;
                if ((tt & 1) == 1) asm volatile("" ::: "memory");
            }
            part[g * 128 + d] = run;
            LBAR();
            if (cc > 0) PA_LOAD(c - 1);
            float off = 0.f, tot = 0.f;
#pragma unroll
            for (int gg = 0; gg < 4; ++gg) { const float pvv = part[gg * 128 + d]; tot += pvv; if (gg < g) off += pvv; }
            bf16* wq = qp;
#pragma unroll
            for (int tt = 0; tt < 16; ++tt) {
                const float bc = cs[tt] + off;
                const float qv = __uint_as_float(qk[tt] << 16), kv = __uint_as_float(qk[tt] & 0xffff0000u);
                const float e1 = __expf(bc), e2 = __expf(-bc);
                wq[0] = (bf16)(pk2(qv * 0.08838834764831845f * e1, 0.f) & 0xffffu);
                const bf16 kt = (bf16)(pk2(kv * e2, 0.f) & 0xffffu);
                wq[512] = kt; wq += PROJ_LD; asm volatile("" : "+v"(wq));
                *(LAS bf16*)(L + GS_K + (16 * g + tt) * 272 + d * 2) = (bf16)(pk2(kv * __expf(tot - bc + accd), 0.f) & 0xffffu);
            }
            if (g == 0) { BL[(size_t)u * 128 + d] = tot; gsum += tot; }
            accd += tot;
            LBAR();
            if (seg < 7) {
                bf16x8 vf[2][2];
#pragma unroll
                for (int s2 = 0; s2 < 2; ++s2)
#pragma unroll
                    for (int et = 0; et < 2; ++et) { const LAS unsigned char* a_ = L + GS_V + (32 * s2 + 8 * quad + (l15 >> 2)) * 528 + (32 * w + 16 * et) * 2 + 8 * (l15 & 3);
                        const s16x4 lo_ = ldtr(a_), hi_ = ldtr(a_ + 4 * 528); vf[s2][et] = __builtin_shufflevector(lo_, hi_, 0, 1, 2, 3, 4, 5, 6, 7); }
#pragma unroll
                for (int dt = 0; dt < 8; ++dt) {
#pragma unroll
                    for (int s2 = 0; s2 < 2; ++s2) {
                        const LAS unsigned char* ka = L + GS_K + (32 * s2 + 8 * quad + (l15 >> 2)) * 272 + (16 * dt) * 2 + 8 * (l15 & 3);
                        const s16x4 klo = ldtr(ka), khi = ldtr(ka + 4 * 272); const bf16x8 kf = __builtin_shufflevector(klo, khi, 0, 1, 2, 3, 4, 5, 6, 7);
                        S[dt][0] = MFMA16(kf, vf[s2][0], S[dt][0]); S[dt][1] = MFMA16(kf, vf[s2][1], S[dt][1]); }
                }
            }
            LBAR();
        }
#undef PA_LOAD
        if (seg < 7) {
            f32x4* sl = (f32x4*)(SLOC + (size_t)(bh * 8 + seg) * 32768) + tid;
#pragma unroll
            for (int dt = 0; dt < 8; ++dt) { sl[(dt * 2 + 0) * 512] = S[dt][0]; sl[(dt * 2 + 1) * 512] = S[dt][1]; }
            if (tid < 128) GSEG[(size_t)(bh * 8 + seg) * 128 + tid] = gsum;
        }
    }
}

constexpr int SW_K = 0, SW_V = 36864;
__device__ __forceinline__ void swa_phase(const Ctx& F, const Params& P) {
    LAS unsigned char* L = F.lds;
    const int tid = F.tid, lane = F.lane, w = F.wave, l15 = lane & 15, quad = lane >> 4;
    const bf16* QKV = (const bf16*)(P.ws + R2_QKV); bf16* AO = (bf16*)(P.ws + R0);
    const float* sinks = P.in[9];
    constexpr int NU = BATCH * 32 * 4;
    u32x4 kv[4], vv[4];
#define SW_LOAD(uu) do { const int kvh_ = (uu) & 3, n_ = ((uu) >> 2) & 31, b_ = (uu) >> 7; const long mb_ = (long)b_ * SEQ + (long)n_ * 128; \
        _Pragma("unroll") for (int i = 0; i < 4; ++i) { const int idx = tid + 512 * i, jj = idx >> 3, pc = idx & 7; \
            kv[i] = (u32x4){0u, 0u, 0u, 0u}; vv[i] = (u32x4){0u, 0u, 0u, 0u}; \
            if (n_ > 0 || jj >= 128) { const bf16* src = QKV + (size_t)(mb_ - 128 + jj) * QKV_LD + 1024 + kvh_ * 64 + pc * 8; kv[i] = *(const u32x4*)(src); vv[i] = *(const u32x4*)(src + 256); } } } while (0)
#define SW_QBASE(uu) (QKV + (size_t)((long)((uu) >> 7) * SEQ + (long)(((uu) >> 2) & 31) * 128 + 64 * (w & 1) + l15) * QKV_LD + (((uu) & 3) * 4 + (w >> 1)) * 64 + quad * 8)
    bf16x8 qc0 = (bf16x8){0, 0, 0, 0, 0, 0, 0, 0}, qc1 = qc0;
    if ((int)blockIdx.x < NU) { SW_LOAD((int)blockIdx.x); const bf16* q0p = SW_QBASE((int)blockIdx.x); qc0 = *(const bf16x8*)(q0p); qc1 = *(const bf16x8*)(q0p + 32); }
    for (int u = blockIdx.x; u < NU; u += gridDim.x) {
        const int kvh = u & 3, n = (u >> 2) & 31, b = u >> 7;
        const long mb = (long)b * SEQ + (long)n * 128;
        const int g = w >> 1, hq = kvh * 4 + g;
        const int un = (u + (int)gridDim.x < NU) ? u + (int)gridDim.x : u;
        const bf16* qbase = SW_QBASE(u);
        const bf16* qnext = SW_QBASE(un);
#pragma unroll
        for (int i = 0; i < 2; ++i) { const size_t pg = (size_t)u * 1024 + tid + 512 * i; const float* src = P.in[1] + (size_t)M * PLE + pg * 8;
            const f32x4 a = __builtin_nontemporal_load((const f32x4*)(src)), a2 = __builtin_nontemporal_load((const f32x4*)(src + 4));
            u32x4 o; o.x = pk2(a[0], a[1]); o.y = pk2(a[2], a[3]); o.z = pk2(a2[0], a2[1]); o.w = pk2(a2[2], a2[3]); *(u32x4*)((bf16*)(P.ws + PB1_OFF) + pg * 8) = o; }
        LBAR();
#pragma unroll
        for (int i = 0; i < 4; ++i) { const int idx = tid + 512 * i, jj = idx >> 3, pc = idx & 7;
            *(LAS u32x4*)(L + SW_K + jj * 144 + pc * 16) = kv[i]; *(LAS u32x4*)(L + SW_V + jj * 144 + pc * 16) = vv[i]; }
        LBAR();
        if (un != u) SW_LOAD(un);
        const float sink = sinks[hq];
#pragma unroll 1
        for (int qt = 0; qt < 4; ++qt) {
            const int q0 = 64 * (w & 1) + 16 * qt, kt0 = q0 >> 4, qi = q0 + l15;
            const bf16* qn = (qt < 3) ? qbase + (size_t)(16 * (qt + 1)) * QKV_LD : qnext;
            const bf16x8 qn0 = *(const bf16x8*)(qn), qn1 = *(const bf16x8*)(qn + 32);
            f32x4 sc[9];
#pragma unroll
            for (int t = 0; t < 9; ++t) { const LAS unsigned char* kb = L + SW_K + (16 * (kt0 + t) + l15) * 144 + quad * 16;
                f32x4 a = (f32x4){0.f, 0.f, 0.f, 0.f}; a = MFMA16(lds16(kb), qc0, a); a = MFMA16(lds16(kb + 64), qc1, a); sc[t] = a; }
            constexpr float C2 = 0.125f * 1.4426950408889634f;
            const float sink2 = sink * 1.4426950408889634f;
#pragma unroll
            for (int j = 0; j < 4; ++j) { if (!(4 * quad + j > l15)) sc[0][j] = -INFINITY; if (!(4 * quad + j <= l15)) sc[8][j] = -INFINITY; }
            float mraw = -INFINITY;
#pragma unroll
            for (int t = 0; t < 9; ++t)
#pragma unroll
                for (int j = 0; j < 4; ++j) mraw = fmaxf(mraw, sc[t][j]);
            mraw = fmaxf(mraw, __shfl_xor(mraw, 16)); mraw = fmaxf(mraw, __shfl_xor(mraw, 32));
            const float m2 = fmaxf(mraw * C2, sink2);
            float den = 0.f;
#pragma unroll
            for (int t = 0; t < 9; ++t)
#pragma unroll
                for (int j = 0; j < 4; ++j) { const float p = __builtin_amdgcn_exp2f(sc[t][j] * C2 - m2); sc[t][j] = p; den += p; }
            den += __shfl_xor(den, 16); den += __shfl_xor(den, 32);
            den += __builtin_amdgcn_exp2f(sink2 - m2);
            const float rden = __builtin_amdgcn_rcpf(den);
            f32x4 ot[4];
#pragma unroll
            for (int dt = 0; dt < 4; ++dt) ot[dt] = (f32x4){0.f, 0.f, 0.f, 0.f};
#pragma unroll
            for (int s2 = 0; s2 < 5; ++s2) {
                const f32x4 z4 = (f32x4){0.f, 0.f, 0.f, 0.f};
                const bf16x8 pf = pack8(sc[2 * s2], (s2 < 4) ? sc[(2 * s2 + 1 < 9) ? 2 * s2 + 1 : 8] : z4);
                const int ka = 16 * (kt0 + 2 * s2), kb2 = (s2 < 4) ? ka + 16 : ka;
#pragma unroll
                for (int dt = 0; dt < 4; ++dt) { const LAS unsigned char* vb = L + SW_V + (4 * quad + (l15 >> 2)) * 144 + 32 * dt + 8 * (l15 & 3);
                    const s16x4 lo = ldtr(vb + ka * 144), hi = ldtr(vb + kb2 * 144);
                    const bf16x8 vf = __builtin_shufflevector(lo, hi, 0, 1, 2, 3, 4, 5, 6, 7);
                    ot[dt] = MFMA16(vf, pf, ot[dt]); }
            }
            bf16* op = AO + (size_t)(mb + qi) * D + hq * 64 + 4 * quad;
#pragma unroll
            for (int dt = 0; dt < 4; ++dt) { u32x2 ow; ow.x = pk2(ot[dt][0] * rden, ot[dt][1] * rden); ow.y = pk2(ot[dt][2] * rden, ot[dt][3] * rden); *(u32x2*)(op + 16 * dt) = ow; }
            qc0 = qn0; qc1 = qn1;
        }
    }
    LBAR();
#undef SW_LOAD
#undef SW_QBASE
}

#define XB_TMO      128
#define XB_XCNT(j)  (256  + 64 * (j))
#define XB_XSUB(j)  (1280 + 64 * (j))
#define XB_XGEN(j)  (2304 + 64 * (j))
#define XB_TOP      3328
#define XB_TOPGEN   3392
#define XCD_BAR_WORDS 3456
#define XB_SPIN_CAP (1u << 18)

__device__ __forceinline__ unsigned xb_ld(unsigned* p)              { return __hip_atomic_load(p, __ATOMIC_RELAXED, __HIP_MEMORY_SCOPE_AGENT); }
__device__ __forceinline__ unsigned xb_add(unsigned* p, unsigned v) { return __hip_atomic_fetch_add(p, v, __ATOMIC_RELAXED, __HIP_MEMORY_SCOPE_AGENT); }
__device__ __forceinline__ unsigned xb_xcc_id() { return (unsigned)__builtin_amdgcn_s_getreg((3 << 11) | 20) & 0xFu; }
#define XB_SPIN(cond, bar) do { unsigned _sp = 0; while (cond) { __builtin_amdgcn_s_sleep(1); \
    if ((++_sp & 255u) == 0u) { if (xb_ld(&(bar)[XB_TMO])) break; if (_sp > XB_SPIN_CAP) { atomicAdd(&(bar)[XB_TMO], 1u); break; } } } } while (0)

struct XcdBarrier {
    unsigned* bar; unsigned x;
    volatile LAS unsigned* st;
};

__device__ __forceinline__ XcdBarrier xcd_barrier_post(unsigned* bar, volatile LAS unsigned* st) {
    XcdBarrier b; b.bar = bar; b.x = xb_xcc_id(); b.st = st;
    if (threadIdx.x == 0) (void)xb_add(&bar[XB_XCNT(b.x)], 1u);
    return b;
}
__device__ __forceinline__ void xcd_barrier_complete(unsigned* bar, unsigned x, unsigned& nloc, unsigned& nx) {
    const unsigned G = gridDim.x * gridDim.y * gridDim.z;
    unsigned sum, cnt, mine, sp = 0u;
    for (;;) {
        sum = 0u; cnt = 0u; mine = 0u;
#pragma unroll
        for (unsigned j = 0; j < 16; ++j) { const unsigned c = xb_ld(&bar[XB_XCNT(j)]); sum += c; cnt += (c > 0u) ? 1u : 0u; mine = (j == x) ? c : mine; }
        if (sum == G) break;
        __builtin_amdgcn_s_sleep(1);
        if ((++sp & 255u) == 0u) { if (xb_ld(&bar[XB_TMO])) break; if (sp > XB_SPIN_CAP) { atomicAdd(&bar[XB_TMO], 1u); break; } }
    }
    nloc = mine > 0u ? mine : 1u; nx = cnt > 0u ? cnt : 1u;
}

__device__ __forceinline__ void xcd_barrier(const XcdBarrier& b) {
    asm volatile("s_waitcnt vmcnt(0)" ::: "memory");
    __syncthreads();
    if (threadIdx.x == 0) {
        unsigned* bar = b.bar;
        __builtin_amdgcn_s_waitcnt(0);
        unsigned nloc = b.st[0], nx = b.st[1];
        if (nloc == 0u) { xcd_barrier_complete(bar, b.x, nloc, nx); b.st[0] = nloc; b.st[1] = nx; }
        const unsigned old = xb_add(&bar[XB_XSUB(b.x)], 1u);
        const unsigned gen = old / nloc;
        if (old + 1u == (gen + 1u) * nloc) {
            __builtin_amdgcn_fence(__ATOMIC_RELEASE, "agent");
            asm volatile("s_waitcnt vmcnt(0)" ::: "memory");
            const unsigned og = xb_add(&bar[XB_TOP], 1u);
            const unsigned tg = og / nx;
            if (og + 1u == (tg + 1u) * nx) xb_add(&bar[XB_TOPGEN], 1u);
            else XB_SPIN(xb_ld(&bar[XB_TOPGEN]) == tg, bar);
            __builtin_amdgcn_fence(__ATOMIC_ACQUIRE, "agent");
            xb_add(&bar[XB_XGEN(b.x)], 1u);
            asm volatile("s_waitcnt vmcnt(0)" ::: "memory");
        } else {
            XB_SPIN(xb_ld(&bar[XB_XGEN(b.x)]) == gen, bar);
            __builtin_amdgcn_fence(__ATOMIC_ACQUIRE, "agent");
            asm volatile("s_waitcnt vmcnt(0)" ::: "memory");
        }
    }
    __syncthreads();
}

__global__ void __launch_bounds__(NTHREADS, 2) mega_fwd(Params P) {
    extern __shared__ __attribute__((aligned(16))) unsigned char lds_raw[];
    cg::grid_group grid = cg::this_grid();
    Ctx F; F.lds = (LAS unsigned char*)lds_raw;
#define GSYNC() do { XcdBarrier b2_ = bar; unsigned long long bp_ = (unsigned long long)b2_.bar; unsigned bx_ = __builtin_amdgcn_readfirstlane(b2_.x); asm volatile("" : "+s"(bp_), "+s"(bx_)); b2_.bar = (unsigned*)bp_; b2_.x = bx_; xcd_barrier(b2_); } while (0)
#define REFRESH() do { int t_ = threadIdx.x; asm volatile("" : "+v"(t_)); F.tid = t_; F.lane = t_ & 63; F.wave = __builtin_amdgcn_readfirstlane(t_ >> 6); } while (0)
    REFRESH();
    unsigned char* ws = P.ws;
    const int G = gridDim.x, cid = blockIdx.x;
    volatile LAS unsigned* MISC = (volatile LAS unsigned*)(F.lds + 131072 + 320);
    if (threadIdx.x < 32) MISC[threadIdx.x] = 0u;
    __syncthreads();
    if (cid == 0) for (int i = threadIdx.x; i < XCD_BAR_WORDS; i += NTHREADS) __hip_atomic_store((unsigned*)(ws) + 1024 + i, 0u, __ATOMIC_RELAXED, __HIP_MEMORY_SCOPE_AGENT);
    grid.sync();
    XcdBarrier bar = xcd_barrier_post((unsigned*)(ws) + 1024, MISC + 8);
    bf16* A16 = (bf16*)(ws + R0); bf16* U16 = (bf16*)(ws + R2);
    bf16* Y1B = (bf16*)(ws + R1); bf16* Y2B = (bf16*)(ws + R1 + 64 * MiB); bf16* H3B = (bf16*)(ws + R2_H3B);
    float* ST1 = (float*)(ws + 504 * MiB); float* ST2 = (float*)(ws + 508 * MiB);
    LAS float* SX = (LAS float*)(F.lds + 131072 + 1024);

    p0_prologue(F, P);
    GSYNC();
    {
        pg8::Gemm g{A16, (const bf16*)(ws + W_IN_T), M, PROJ_LD, opq(D), D, D}; pg8::StaticOrder S; S.init(M, PROJ_LD, G, cid);
        pg8::EpiBf16 E{U16, PROJ_LD, nullptr, 1 << 30, nullptr};
        pg8::gemm_phase<pg8::EpiBf16, pg8::StaticOrder, true, true>(F.lds, g, S, E, SX);
    }
    GSYNC();
    REFRESH(); gla_pass_a(F, P);
    fold_finalize(P, cid * NTHREADS + F.tid, G * NTHREADS);
    GSYNC();
    REFRESH(); gla_scan_pass<true>(F, P);
    GSYNC();
#pragma unroll 1
    for (int layer = 0; layer < 2; ++layer) {
        const float* fin = (const float*)(ws + FIN(0)) + (size_t)layer * (64 * 1024 / 4);
        if (layer == 1) {
            {
                pg8::Gemm g{H3B, (const bf16*)(ws + W_QKV_T), M, QKV_LD, opq(D), D, D}; pg8::StaticOrder S; S.init(M, QKV_LD, G, cid);
                pg8::EpiBf16 E{(bf16*)(ws + R2_QKV), QKV_LD, P.in[8], 1 << 30, nullptr};
                pg8::gemm_phase<pg8::EpiBf16, pg8::StaticOrder, true, true>(F.lds, g, S, E, SX);
            }
            GSYNC();
            REFRESH(); swa_phase(F, P);
            GSYNC();
        }
        {
            const bf16* A = layer == 0 ? (const bf16*)(ws + R2) + 2048 : (const bf16*)A16;
            pg8::Gemm g{A, (const bf16*)(ws + (layer == 0 ? W_GOUT_T : W_SOUT_T)), M, D, opq(D), layer == 0 ? PROJ_LD : D, D}; pg8::StaticOrder S; S.init(M, D, G, cid);
            pg8::EpiY<false> E{layer == 0 ? (const void*)A16 : (const void*)H3B, 1, layer == 0 ? nullptr : P.in[11], nullptr, nullptr, nullptr, Y1B, ST1, ALPHA};
            pg8::gemm_phase<pg8::EpiY<false>, pg8::StaticOrder, true, true>(F.lds, g, S, E, SX);
        }
        GSYNC();
        {
            pg8::Gemm g{Y1B, (const bf16*)(ws + W_UP_T + (size_t)layer * W_LSTRIDE), M, FF, opq(D), D, D}; pg8::StaticOrder S; S.init(M, FF, G, cid);
            pg8::EpiUpLN E{ST1, fin, fin + 4096, U16, FF};
            pg8::gemm_phase<pg8::EpiUpLN, pg8::StaticOrder, true, true>(F.lds, g, S, E, SX);
        }
        GSYNC();
        {
            pg8::Gemm g{U16, (const bf16*)(ws + W_DN_T + (size_t)layer * W_LSTRIDE), M, D, opq(FF), FF, FF}; pg8::StaticOrder S; S.init(M, D, G, cid);
            pg8::EpiY<true> E{(const void*)Y1B, 1, nullptr, P.in[14] + layer * D, P.in[15] + layer * D, ST1, Y2B, ST2, ALPHA};
            pg8::gemm_phase<pg8::EpiY<true>, pg8::StaticOrder, true, true>(F.lds, g, S, E, SX);
        }
        GSYNC();
        {
            int kpp = opq(PLE); pg8::Gemm g{layer == 0 ? (const bf16*)P.out : (const bf16*)(ws + PB1_OFF), (const bf16*)(ws + W_PP_T + (size_t)layer * W_LSTRIDE), M, D, kpp, kpp, kpp}; pg8::StaticOrder S; S.init(M, D, G, cid);
            pg8::EpiPP E{(bf16*)(ws + R2_PP), D};
            pg8::gemm_phase<pg8::EpiPP, pg8::StaticOrder, true, true>(F.lds, g, S, E, SX);
        }
        __syncthreads();
        {
            pg8::Gemm g{Y2B, (const bf16*)(ws + W_GATE_T + (size_t)layer * W_LSTRIDE), M, D, opq(D), D, D}; pg8::StaticOrder S; S.init(M, D, G, cid);
            pg8::EpiGateLN E{ST2, Y2B, (const bf16*)(ws + R2_PP), fin + 8192, fin + 9216, P.in[16] + layer * D, P.in[17] + layer * D, P.out, layer == 0 ? H3B : nullptr};
            pg8::gemm_phase<pg8::EpiGateLN, pg8::StaticOrder, true, true>(F.lds, g, S, E, SX);
        }
        if (layer == 0) GSYNC();
    }
}

extern "C" void kernel_launch(void* const* d_in, const int* in_sizes, int n_in, void* d_out, int out_size, void* d_ws, size_t ws_size, hipStream_t stream) {
    static int grid = 0;
    if (grid == 0) {
        if (n_in != 21 || in_sizes[0] != M * D || out_size != M * D || ws_size < WS_END) { fprintf(stderr, "kernel_launch: unexpected shapes (n_in %d, in0 %d, out %d, ws %zu)\n", n_in, n_in > 0 ? in_sizes[0] : -1, out_size, ws_size); grid = -1; return; }
        int dev = 0, cus = 0, per_cu = 0;
        hipGetDevice(&dev); hipDeviceGetAttribute(&cus, hipDeviceAttributeMultiprocessorCount, dev);
        if (hipFuncSetAttribute((const void*)mega_fwd, hipFuncAttributeMaxDynamicSharedMemorySize, LDS_BYTES) != hipSuccess) { fprintf(stderr, "kernel_launch: hipFuncSetAttribute failed\n"); grid = -1; return; }
        if (hipOccupancyMaxActiveBlocksPerMultiprocessor(&per_cu, (const void*)mega_fwd, NTHREADS, LDS_BYTES) != hipSuccess || per_cu < 1) { fprintf(stderr, "kernel_launch: occupancy query says %d\n", per_cu); (void)hipGetLastError(); per_cu = 1; }
        grid = cus * 1;
        if (grid <= 0) grid = 256;
    }
    if (grid < 0) return;
    Params p{};
    for (int i = 0; i < 21; ++i) p.in[i] = (const float*)d_in[i];
    p.out = (float*)d_out; p.ws = (unsigned char*)d_ws;
    void* args[] = {&p};
    hipError_t e = hipLaunchCooperativeKernel((const void*)mega_fwd, dim3(grid), dim3(NTHREADS), args, LDS_BYTES, stream);
    if (e != hipSuccess) fprintf(stderr, "cooperative launch failed: %s (grid %d)\n", hipGetErrorString(e), grid);
}
```

```cpp
#include <hip/hip_runtime.h>
#include <hip/hip_cooperative_groups.h>
#include <cstdio>
#include <cstdint>
namespace cg = cooperative_groups;
namespace pg8 {
#define PG8_LAS __attribute__((address_space(3)))
typedef unsigned short bf16_t;
typedef short bf16x8 __attribute__((ext_vector_type(8)));
typedef float f32x4 __attribute__((ext_vector_type(4)));
typedef unsigned u32x4 __attribute__((ext_vector_type(4)));
constexpr int BM = 256, BK = 64, HALF = 128, HTB = HALF * BK * 2  , STAGE_BYTES = 8 * HTB, NXCD = 8, WGM = 8;

__host__ __device__ __forceinline__ int lds_byte(int r, int c) { const int st = (r >> 4) * 2 + (c >> 5), rr = r & 15, cc = c & 31, ob = rr * 64 + cc * 2; return st * 1024 + (ob ^ (((ob >> 9) & 1) << 5)); }
__host__ __device__ __forceinline__ void stage_rc(int b, int& R, int& C) { const int st = b / 1024, sb = b % 1024, swz = sb ^ (((sb >> 9) & 1) << 5); R = (st >> 1) * 16 + swz / 64; C = (st & 1) * 32 + (swz % 64) / 2; }
__host__ __device__ __forceinline__ int perm32(int rho) { const int n = rho >> 4, i = rho & 15; return 8 * (i >> 2) + 4 * n + (i & 3); }

struct Unit { int pm, pn; };
struct Gemm { const bf16_t* A; const bf16_t* Bt; int M, N, K, lda, ldb; };

struct StaticOrder {
    int nM, nN, nwg, G, c, rev;
    __host__ __device__ void init(int M, int N, int G_, int c_, int rev_ = 0) { nM = M / BM; nN = N / BM; nwg = nM * nN; G = G_; c = c_; rev = rev_; }
    __host__ __device__ bool next(int i, Unit& u) const {
        const long L = (long)i * G + c; if (L >= nwg) return false;
        int wgid = (int)L; { const int q = nwg / NXCD, r = nwg % NXCD, xcd = wgid % NXCD, off = wgid / NXCD; wgid = (xcd < r ? xcd * (q + 1) : r * (q + 1) + (xcd - r) * q) + off; }
        const int nig = WGM * nN, gid = wgid / nig, fm = gid * WGM, gsz = (nM - fm) < WGM ? (nM - fm) : WGM;
        u.pm = fm + ((wgid % nig) % gsz); u.pn = (wgid % nig) / gsz; if (rev) u.pm = nM - 1 - u.pm; return true;
    }
    __device__ __forceinline__ void a_ready(const Unit&) const {}
    __device__ __forceinline__ void done(const Unit&) const {}
};


__device__ __forceinline__ unsigned cvt_pk_bf16(float lo, float hi) { unsigned r; asm volatile("v_cvt_pk_bf16_f32 %0, %1, %2" : "=v"(r) : "v"(lo), "v"(hi)); return r; }
typedef unsigned u32x2 __attribute__((ext_vector_type(2)));
typedef float f32x2 __attribute__((ext_vector_type(2)));
__device__ __forceinline__ float bf2f(unsigned short b) { return __uint_as_float(((unsigned)b) << 16); }
__device__ __forceinline__ void unpack8(const u32x4 w, float (&v)[8]) {
    v[0] = __uint_as_float(w.x << 16); v[1] = __uint_as_float(w.x & 0xffff0000u); v[2] = __uint_as_float(w.y << 16); v[3] = __uint_as_float(w.y & 0xffff0000u);
    v[4] = __uint_as_float(w.z << 16); v[5] = __uint_as_float(w.z & 0xffff0000u); v[6] = __uint_as_float(w.w << 16); v[7] = __uint_as_float(w.w & 0xffff0000u);
}
constexpr float EPI_LN_EPS = 1e-5f;
__device__ __forceinline__ void stats_pre(const float* ST, int pm, int slot, int tid, PG8_LAS float* sx) {
    if (tid < 256) {
        const f32x4* p = (const f32x4*)(ST + (size_t)(pm * BM + tid) * 32); float s = 0.f, q = 0.f;
#pragma unroll
        for (int i = 0; i < 8; ++i) { const f32x4 v = p[i]; s += v[0] + v[2]; q += v[1] + v[3]; }
        const float mean = s * (1.0f / 1024.0f), var = fmaxf(q * (1.0f / 1024.0f) - mean * mean, 0.f);
        *(PG8_LAS f32x2*)(sx + (slot * 256 + tid) * 2) = (f32x2){mean, 1.0f / sqrtf(var + EPI_LN_EPS)};
    }
}

struct EpiBf16 {
    static constexpr bool PERM = true, AFTER_DRAIN = false;
    bf16_t* O; int ldc; const float* bias; int gk_tile; float* GK;
    __device__ __forceinline__ void pre(const Unit&, int, int, PG8_LAS float*) const {}
    __device__ __forceinline__ void operator()(const f32x4 (&acc)[2][2][4][2], const Unit& u, int wr, int wc, int fr, int fq, int, PG8_LAS float*) const {
        const int row0 = u.pm * BM + wr * 64 + fr;
        if (u.pn >= gk_tile) {
            if (wc == 0 && fq < 2) {
#pragma unroll
                for (int ai = 0; ai < 2; ++ai)
#pragma unroll
                    for (int m = 0; m < 4; ++m) { float* gp = GK + (size_t)(row0 + ai * HALF + m * 16) * 16 + 8 * fq;
                        *(f32x4*)(gp) = acc[ai][0][m][0]; *(f32x4*)(gp + 4) = acc[ai][0][m][1]; }
            }
            return;
        }
        const int col0 = u.pn * BM + wc * 32 + 8 * fq;
#pragma unroll
        for (int bj = 0; bj < 2; ++bj) {
            f32x4 b0 = (f32x4){0.f, 0.f, 0.f, 0.f}, b1 = b0;
            if (bias) { b0 = *(const f32x4*)(bias + col0 + bj * HALF); b1 = *(const f32x4*)(bias + col0 + bj * HALF + 4); }
#pragma unroll
            for (int ai = 0; ai < 2; ++ai)
#pragma unroll
                for (int m = 0; m < 4; ++m) { const f32x4 v0 = acc[ai][bj][m][0] + b0, v1 = acc[ai][bj][m][1] + b1;
                    u32x4 w; w.x = cvt_pk_bf16(v0[0], v0[1]); w.y = cvt_pk_bf16(v0[2], v0[3]); w.z = cvt_pk_bf16(v1[0], v1[1]); w.w = cvt_pk_bf16(v1[2], v1[3]);
                    *(u32x4*)(O + (size_t)(row0 + ai * HALF + m * 16) * ldc + col0 + bj * HALF) = w; } }
    }
};

template <bool LN> struct EpiY {
    static constexpr bool PERM = true, AFTER_DRAIN = false;
    const void* res; int res_bf16; const float* bias; const float* g; const float* b; const float* ST_IN; bf16_t* Y; float* ST; float alpha;
    __device__ __forceinline__ void pre(const Unit& u, int slot, int tid, PG8_LAS float* sx) const { if (LN) stats_pre(ST_IN, u.pm, slot, tid, sx); }
    __device__ __forceinline__ void operator()(const f32x4 (&acc)[2][2][4][2], const Unit& u, int wr, int wc, int fr, int fq, int slot, PG8_LAS float* sx) const {
        const int col0 = u.pn * BM + wc * 32 + 8 * fq, rl0 = wr * 64 + fr; const size_t roff0 = (size_t)(u.pm * BM + rl0) * 1024;
        const bf16_t* R = (const bf16_t*)res;
        float ps[8], pq[8];
#pragma unroll
        for (int r = 0; r < 8; ++r) { ps[r] = 0.f; pq[r] = 0.f; }
#pragma unroll
        for (int bj = 0; bj < 2; ++bj) { const int c = col0 + bj * HALF;
            u32x4 rr[8];
#pragma unroll
            for (int r = 0; r < 8; ++r) rr[r] = *(const u32x4*)(R + roff0 + (size_t)((r >> 2) * HALF + (r & 3) * 16) * 1024 + c);
            f32x4 g0, g1, b0, b1, bb0, bb1;
            if (LN) { g0 = *(const f32x4*)(g + c); g1 = *(const f32x4*)(g + c + 4); b0 = *(const f32x4*)(b + c); b1 = *(const f32x4*)(b + c + 4); }
            if (bias) { bb0 = *(const f32x4*)(bias + c); bb1 = *(const f32x4*)(bias + c + 4); }
#pragma unroll
            for (int r = 0; r < 8; ++r) { const int ai = r >> 2, m = r & 3, rl = rl0 + ai * HALF + m * 16;
                float rv[8]; unpack8(rr[r], rv);
                if (LN) { const f32x2 mr = *(const PG8_LAS f32x2*)(sx + (slot * 256 + rl) * 2);
#pragma unroll
                    for (int i = 0; i < 4; ++i) { rv[i] = (rv[i] - mr[0]) * mr[1] * g0[i] + b0[i]; rv[4 + i] = (rv[4 + i] - mr[0]) * mr[1] * g1[i] + b1[i]; } }
                f32x4 v0 = acc[ai][bj][m][0], v1 = acc[ai][bj][m][1];
                if (bias) { v0 += bb0; v1 += bb1; }
                float y[8];
#pragma unroll
                for (int i = 0; i < 4; ++i) { y[i] = alpha * rv[i] + v0[i]; y[4 + i] = alpha * rv[4 + i] + v1[i]; }
                u32x4 w; w.x = cvt_pk_bf16(y[0], y[1]); w.y = cvt_pk_bf16(y[2], y[3]); w.z = cvt_pk_bf16(y[4], y[5]); w.w = cvt_pk_bf16(y[6], y[7]);
                *(u32x4*)(Y + roff0 + (size_t)(ai * HALF + m * 16) * 1024 + c) = w;
                float yr[8]; unpack8(w, yr);
#pragma unroll
                for (int i = 0; i < 8; ++i) { ps[r] += yr[i]; pq[r] += yr[i] * yr[i]; } }
        }
#pragma unroll
        for (int r = 0; r < 8; ++r) { float a = ps[r], q = pq[r];
            a += __shfl_xor(a, 16); a += __shfl_xor(a, 32); q += __shfl_xor(q, 16); q += __shfl_xor(q, 32);
            if (fq == 0) *(f32x2*)(ST + (size_t)(u.pm * BM + rl0 + (r >> 2) * HALF + (r & 3) * 16) * 32 + (u.pn * 4 + wc) * 2) = (f32x2){a, q}; }
    }
};

struct EpiUpLN {
    static constexpr bool PERM = true, AFTER_DRAIN = false;
    const float* ST_IN; const float* colsum; const float* bw; bf16_t* O; int ldc;
    __device__ __forceinline__ void pre(const Unit& u, int slot, int tid, PG8_LAS float* sx) const { stats_pre(ST_IN, u.pm, slot, tid, sx); }
    __device__ __forceinline__ void operator()(const f32x4 (&acc)[2][2][4][2], const Unit& u, int wr, int wc, int fr, int fq, int slot, PG8_LAS float* sx) const {
        const int col0 = u.pn * BM + wc * 32 + 8 * fq, rl0 = wr * 64 + fr;
#pragma unroll
        for (int bj = 0; bj < 2; ++bj) { const int c = col0 + bj * HALF;
            const f32x4 c0 = *(const f32x4*)(colsum + c), c1 = *(const f32x4*)(colsum + c + 4), w0 = *(const f32x4*)(bw + c), w1 = *(const f32x4*)(bw + c + 4);
#pragma unroll
            for (int r = 0; r < 8; ++r) { const int ai = r >> 2, m = r & 3, rl = rl0 + ai * HALF + m * 16;
                const f32x2 mr = *(const PG8_LAS f32x2*)(sx + (slot * 256 + rl) * 2);
                f32x4 v0 = (acc[ai][bj][m][0] - c0 * mr[0]) * mr[1] + w0, v1 = (acc[ai][bj][m][1] - c1 * mr[0]) * mr[1] + w1;
#pragma unroll
                for (int i = 0; i < 4; ++i) { const float a = fmaxf(v0[i], 0.f), b2 = fmaxf(v1[i], 0.f); v0[i] = a * a; v1[i] = b2 * b2; }
                u32x4 w; w.x = cvt_pk_bf16(v0[0], v0[1]); w.y = cvt_pk_bf16(v0[2], v0[3]); w.z = cvt_pk_bf16(v1[0], v1[1]); w.w = cvt_pk_bf16(v1[2], v1[3]);
                *(u32x4*)(O + (size_t)(u.pm * BM + rl) * ldc + c) = w; } }
    }
};

struct EpiPP {
    static constexpr bool PERM = true, AFTER_DRAIN = false;
    bf16_t* O; int ldc;
    __device__ __forceinline__ void pre(const Unit&, int, int, PG8_LAS float*) const {}
    __device__ __forceinline__ void operator()(const f32x4 (&acc)[2][2][4][2], const Unit& u, int wr, int wc, int fr, int fq, int, PG8_LAS float*) const {
        const int row0 = u.pm * BM + wr * 64 + fr, col0 = u.pn * BM + wc * 32 + 8 * fq;
#pragma unroll
        for (int ai = 0; ai < 2; ++ai)
#pragma unroll
            for (int m = 0; m < 4; ++m) { bf16_t* rowp = O + (size_t)(row0 + ai * HALF + m * 16) * ldc + col0;
#pragma unroll
                for (int bj = 0; bj < 2; ++bj) { const f32x4 v0 = acc[ai][bj][m][0], v1 = acc[ai][bj][m][1];
                    u32x4 w; w.x = cvt_pk_bf16(v0[0], v0[1]); w.y = cvt_pk_bf16(v0[2], v0[3]); w.z = cvt_pk_bf16(v1[0], v1[1]); w.w = cvt_pk_bf16(v1[2], v1[3]);
                    *(u32x4*)(rowp + bj * HALF) = w; } }
    }
};

struct EpiGateLN {
    static constexpr bool PERM = true, AFTER_DRAIN = false;
    const float* ST_IN; const bf16_t* YB; const bf16_t* pp; const float* colsum; const float* bz; const float* g; const float* b; float* out; bf16_t* ob;
    __device__ __forceinline__ void pre(const Unit& u, int slot, int tid, PG8_LAS float* sx) const { stats_pre(ST_IN, u.pm, slot, tid, sx); }
    __device__ __forceinline__ void operator()(const f32x4 (&acc)[2][2][4][2], const Unit& u, int wr, int wc, int fr, int fq, int slot, PG8_LAS float* sx) const {
        const int col0 = u.pn * BM + wc * 32 + 8 * fq, rl0 = wr * 64 + fr; const size_t roff0 = (size_t)(u.pm * BM + rl0) * 1024;
#pragma unroll
        for (int bj = 0; bj < 2; ++bj) { const int c = col0 + bj * HALF;
            f32x4 cs[2], zb[2], gg[2], bb[2];
#pragma unroll
            for (int hh = 0; hh < 2; ++hh) { cs[hh] = *(const f32x4*)(colsum + c + 4 * hh); zb[hh] = *(const f32x4*)(bz + c + 4 * hh); gg[hh] = *(const f32x4*)(g + c + 4 * hh); bb[hh] = *(const f32x4*)(b + c + 4 * hh); }
#pragma unroll
            for (int ai = 0; ai < 2; ++ai) {
                u32x4 yy[4], pw[4];
#pragma unroll
                for (int m = 0; m < 4; ++m) { const size_t o2 = roff0 + (size_t)(ai * HALF + m * 16) * 1024 + c; yy[m] = *(const u32x4*)(YB + o2); pw[m] = *(const u32x4*)(pp + o2); }
#pragma unroll
                for (int m = 0; m < 4; ++m) { const int rl = rl0 + ai * HALF + m * 16; const size_t o2 = roff0 + (size_t)(ai * HALF + m * 16) * 1024 + c;
                    const f32x2 mr = *(const PG8_LAS f32x2*)(sx + (slot * 256 + rl) * 2);
                    float y[8], p[8], o[8]; unpack8(yy[m], y); unpack8(pw[m], p);
#pragma unroll
                    for (int hh = 0; hh < 2; ++hh) { const f32x4 z = (acc[ai][bj][m][hh] - cs[hh] * mr[0]) * mr[1] + zb[hh];
#pragma unroll
                        for (int i = 0; i < 4; ++i) { const float h2 = (y[4 * hh + i] - mr[0]) * mr[1] * gg[hh][i] + bb[hh][i]; o[4 * hh + i] = h2 + p[4 * hh + i] * __builtin_amdgcn_rcpf(1.0f + __expf(-z[i])); } }
                    if (ob) { u32x4 w; w.x = cvt_pk_bf16(o[0], o[1]); w.y = cvt_pk_bf16(o[2], o[3]); w.z = cvt_pk_bf16(o[4], o[5]); w.w = cvt_pk_bf16(o[6], o[7]); *(u32x4*)(ob + o2) = w; }
                    else { *(f32x4*)(out + o2) = (f32x4){o[0], o[1], o[2], o[3]}; *(f32x4*)(out + o2 + 4) = (f32x4){o[4], o[5], o[6], o[7]}; } }
                asm volatile("" ::: "memory");
            } }
    }
};

template <class Epi, class Sched, bool ALIGN_EPI = false, bool SP2 = false>
__device__ __forceinline__ void gemm_phase(PG8_LAS unsigned char* lds, const Gemm g, const Sched& S, const Epi& E, PG8_LAS float* sx) {
    int tid_ = threadIdx.x; asm volatile("" : "+v"(tid_));
    const int tid = tid_, wid = __builtin_amdgcn_readfirstlane(tid >> 6), lane = tid & 63, wr = wid >> 2, wc = wid & 3, fr = lane & 15, fq = lane >> 4;
    const int K = g.K, nt = K / BK;
    unsigned voffA[2], voffB[2];
#pragma unroll
    for (int i = 0; i < 2; ++i) { int R, C; stage_rc(tid * 16 + i * 8192, R, C); const int Rb = Epi::PERM ? ((R & ~31) + perm32(R & 31)) : R;
        voffA[i] = (unsigned)(R * g.lda + C) * 2u; voffB[i] = (unsigned)(Rb * g.ldb + C) * 2u; }
    const size_t kstep = (size_t)(BK * 2);
    const size_t hstepA = (size_t)HALF * g.lda * 2, hstepB = (size_t)HALF * g.ldb * 2;
    const size_t tstepA = 2 * hstepA, tstepB = 2 * hstepB;
    const unsigned ldsw = (unsigned)wid * 1024u;
    const int aoff = lds_byte(wr * 64 + fr, fq * 8), boff = lds_byte(wc * 32 + fr, fq * 8);
#define PG8_SA(b, h) (((b) * 2 + (h)) * HTB)
#define PG8_SB(b, h) ((4 + (b) * 2 + (h)) * HTB)
#define PG8_STAGE(bufoff, gbase, voff) do { _Pragma("unroll") for (int _i = 0; _i < 2; ++_i) \
        __builtin_amdgcn_global_load_lds((const unsigned*)((const char*)(gbase) + (voff)[_i]), (PG8_LAS unsigned*)(lds + (bufoff) + ldsw + _i * 8192), 16, 0, 0); } while (0)
#define PG8_LDA(dst, b, h) do { _Pragma("unroll") for (int m = 0; m < 4; ++m) _Pragma("unroll") for (int k = 0; k < 2; ++k) dst[m][k] = *(const PG8_LAS bf16x8*)(lds + PG8_SA(b, h) + aoff + m * 2048 + k * 1024); } while (0)
#define PG8_LDB(dst, b, h) do { _Pragma("unroll") for (int n = 0; n < 2; ++n) _Pragma("unroll") for (int k = 0; k < 2; ++k) dst[n][k] = *(const PG8_LAS bf16x8*)(lds + PG8_SB(b, h) + boff + n * 2048 + k * 1024); } while (0)
#define PG8_MMA(ai, bj, At, Bt) do { __builtin_amdgcn_s_setprio(1); _Pragma("unroll") for (int m = 0; m < 4; ++m) _Pragma("unroll") for (int n = 0; n < 2; ++n) _Pragma("unroll") for (int k = 0; k < 2; ++k) \
        acc[ai][bj][m][n] = __builtin_amdgcn_mfma_f32_16x16x32_bf16(Bt[n][k], At[m][k], acc[ai][bj][m][n], 0, 0, 0); __builtin_amdgcn_s_setprio(0); } while (0)
#define PG8_WAIT_V(n) asm volatile("s_waitcnt vmcnt(" #n ")" ::: "memory")
#define PG8_WAIT_L(n) asm volatile("s_waitcnt lgkmcnt(" #n ")" ::: "memory")
#define PG8_BAR __builtin_amdgcn_s_barrier()
#define PG8_SCHED __builtin_amdgcn_sched_barrier(0)
    Unit cur, nxt; int ui = 0;
    if (!S.next(0, cur)) return;
    f32x4 acc[2][2][4][2];
#pragma unroll
    for (int a = 0; a < 2; ++a)
#pragma unroll
        for (int b = 0; b < 2; ++b)
#pragma unroll
            for (int m = 0; m < 4; ++m)
#pragma unroll
                for (int n = 0; n < 2; ++n) acc[a][b][m][n] = (f32x4){0.f, 0.f, 0.f, 0.f};
    bf16x8 At[4][2], B0[2][2], B1[2][2];
    const char* cA = (const char*)g.A + (size_t)cur.pm * tstepA; const char* cB = (const char*)g.Bt + (size_t)cur.pn * tstepB;
    S.a_ready(cur); E.pre(cur, 0, tid, sx);
    if constexpr (SP2) {
        PG8_STAGE(PG8_SB(0, 0), cB, voffB); PG8_STAGE(PG8_SB(0, 1), cB + hstepB, voffB); PG8_STAGE(PG8_SA(0, 0), cA, voffA); PG8_STAGE(PG8_SA(0, 1), cA + hstepA, voffA);
        if (wr == 1) PG8_BAR;
        PG8_WAIT_V(2); PG8_BAR;
        PG8_STAGE(PG8_SB(1, 0), cB + kstep, voffB); PG8_STAGE(PG8_SA(1, 0), cA + kstep, voffA); PG8_STAGE(PG8_SB(1, 1), cB + hstepB + kstep, voffB);
        PG8_WAIT_V(6); PG8_BAR;
    } else {
        PG8_STAGE(PG8_SB(0, 0), cB, voffB); PG8_STAGE(PG8_SA(0, 0), cA, voffA); PG8_STAGE(PG8_SB(0, 1), cB + hstepB, voffB); PG8_STAGE(PG8_SA(0, 1), cA + hstepA, voffA);
        if (wr == 1) PG8_BAR;
        PG8_WAIT_V(4); PG8_BAR;
        PG8_STAGE(PG8_SB(1, 0), cB + kstep, voffB); PG8_STAGE(PG8_SA(1, 0), cA + kstep, voffA); PG8_STAGE(PG8_SB(1, 1), cB + hstepB + kstep, voffB);
        PG8_WAIT_V(6); PG8_BAR;
    }
    for (;;) {
        const bool has_next = S.next(ui + 1, nxt);
        const char* nA = has_next ? (const char*)g.A + (size_t)nxt.pm * tstepA : cA; const char* nB = has_next ? (const char*)g.Bt + (size_t)nxt.pn * tstepB : cB;
        for (int t = 0; t < nt; t += 2) {
            const bool last = (t == nt - 2);
            const char* a1 = cA + (size_t)(t + 1) * kstep;
            const char* a2 = last ? nA : cA + (size_t)(t + 2) * kstep; const char* b2 = last ? nB : cB + (size_t)(t + 2) * kstep;
            const char* a3 = a2 + kstep; const char* b3 = b2 + kstep;
            if (last && has_next) { S.a_ready(nxt); E.pre(nxt, (ui + 1) & 1, tid, sx); }
            if constexpr (SP2) {
            PG8_LDB(B0, 0, 0); PG8_LDB(B1, 0, 1); PG8_SCHED; PG8_LDA(At, 0, 0); PG8_STAGE(PG8_SA(1, 1), a1 + hstepA, voffA);
            PG8_WAIT_V(8); PG8_WAIT_L(0); PG8_BAR; PG8_MMA(0, 0, At, B0); PG8_MMA(0, 1, At, B1); PG8_BAR; PG8_SCHED;
            PG8_LDA(At, 0, 1); PG8_STAGE(PG8_SB(0, 0), b2, voffB); PG8_STAGE(PG8_SB(0, 1), b2 + hstepB, voffB); PG8_STAGE(PG8_SA(0, 0), a2, voffA);
            PG8_WAIT_V(8); PG8_WAIT_L(0); PG8_BAR; PG8_MMA(1, 0, At, B0); PG8_MMA(1, 1, At, B1); PG8_BAR; PG8_SCHED;
            PG8_LDB(B0, 1, 0); PG8_LDB(B1, 1, 1); PG8_SCHED; PG8_LDA(At, 1, 0); PG8_STAGE(PG8_SA(0, 1), a2 + hstepA, voffA);
            PG8_WAIT_V(8); PG8_WAIT_L(0); PG8_BAR; PG8_MMA(0, 0, At, B0); PG8_MMA(0, 1, At, B1); PG8_BAR; PG8_SCHED;
            PG8_LDA(At, 1, 1); PG8_STAGE(PG8_SB(1, 0), b3, voffB); PG8_STAGE(PG8_SB(1, 1), b3 + hstepB, voffB); PG8_STAGE(PG8_SA(1, 0), a3, voffA);
            PG8_WAIT_V(8); PG8_WAIT_L(0); PG8_BAR; PG8_MMA(1, 0, At, B0); PG8_MMA(1, 1, At, B1); PG8_BAR; PG8_SCHED;
            } else {
            PG8_LDB(B0, 0, 0); PG8_SCHED; PG8_LDA(At, 0, 0); PG8_STAGE(PG8_SA(1, 1), a1 + hstepA, voffA);
            PG8_WAIT_L(8); PG8_BAR; PG8_WAIT_L(0); PG8_MMA(0, 0, At, B0); PG8_BAR; PG8_SCHED;
            PG8_LDB(B1, 0, 1); PG8_STAGE(PG8_SB(0, 0), b2, voffB);
            PG8_BAR; PG8_WAIT_L(0); PG8_MMA(0, 1, At, B1); PG8_BAR;
            PG8_LDA(At, 0, 1); PG8_STAGE(PG8_SA(0, 0), a2, voffA);
            PG8_BAR; PG8_WAIT_L(0); PG8_MMA(1, 0, At, B0); PG8_BAR; PG8_SCHED;
            PG8_STAGE(PG8_SB(0, 1), b2 + hstepB, voffB);
            PG8_WAIT_V(6); PG8_BAR; PG8_MMA(1, 1, At, B1); PG8_BAR;
            PG8_LDB(B0, 1, 0); PG8_SCHED; PG8_LDA(At, 1, 0); PG8_STAGE(PG8_SA(0, 1), a2 + hstepA, voffA);
            PG8_WAIT_L(8); PG8_BAR; PG8_WAIT_L(0); PG8_MMA(0, 0, At, B0); PG8_BAR; PG8_SCHED;
            PG8_LDB(B1, 1, 1); PG8_STAGE(PG8_SB(1, 0), b3, voffB);
            PG8_BAR; PG8_WAIT_L(0); PG8_MMA(0, 1, At, B1); PG8_BAR;
            PG8_LDA(At, 1, 1); PG8_STAGE(PG8_SA(1, 0), a3, voffA);
            PG8_BAR; PG8_WAIT_L(0); PG8_MMA(1, 0, At, B0); PG8_BAR; PG8_SCHED;
            PG8_STAGE(PG8_SB(1, 1), b3 + hstepB, voffB);
            PG8_WAIT_V(6); PG8_BAR; PG8_MMA(1, 1, At, B1); PG8_BAR;
            }
        }
        if constexpr (ALIGN_EPI) { if (wr == 0) PG8_BAR; }
        if constexpr (!Epi::AFTER_DRAIN) { E(acc, cur, wr, wc, fr, fq, ui & 1, sx); S.done(cur); }
        if (!has_next) break;
#pragma unroll
        for (int a = 0; a < 2; ++a)
#pragma unroll
            for (int b = 0; b < 2; ++b)
#pragma unroll
                for (int m = 0; m < 4; ++m)
#pragma unroll
                    for (int n = 0; n < 2; ++n) acc[a][b][m][n] = (f32x4){0.f, 0.f, 0.f, 0.f};
        cur = nxt; cA = nA; cB = nB; ++ui;
        if constexpr (ALIGN_EPI) { if (wr == 1) PG8_BAR; }
    }
    PG8_WAIT_V(0);
    if constexpr (!ALIGN_EPI) { if (wr == 0) PG8_BAR; }
    PG8_BAR;
    if constexpr (Epi::AFTER_DRAIN) { E.fused(acc, cur, wr, wc, fr, fq, lds, wid, lane); S.done(cur); }
#undef PG8_SA
#undef PG8_SB
#undef PG8_STAGE
#undef PG8_LDA
#undef PG8_LDB
#undef PG8_MMA
#undef PG8_WAIT_V
#undef PG8_WAIT_L
#undef PG8_BAR
#undef PG8_SCHED
}
}

#define LAS __attribute__((address_space(3)))
typedef unsigned short bf16;
typedef unsigned u32x4 __attribute__((ext_vector_type(4)));
typedef unsigned u32x2 __attribute__((ext_vector_type(2)));
typedef float f32x4 __attribute__((ext_vector_type(4)));
typedef short bf16x8 __attribute__((ext_vector_type(8)));
typedef short s16x4 __attribute__((ext_vector_type(4)));

constexpr int NTHREADS = 512, NWAVES = 8;
constexpr int BATCH = 8, SEQ = 4096, D = 1024, M = BATCH * SEQ, FF = 4096, PLE = 256;
constexpr int GLA_COLS = 3088, PROJ_LD = 3072;
constexpr int QKV_LD = 1536;
constexpr float LN_EPS = 1e-5f, RMS_EPS = 1e-5f;
constexpr float ALPHA = 1.4142135623730951f;
constexpr size_t MiB = 1u << 20;
constexpr size_t W_IN_T = 1 * MiB;
constexpr size_t W_GOUT_T = 7 * MiB;
constexpr size_t W_UP_T = 9 * MiB;
constexpr size_t W_DN_T = 17 * MiB;
constexpr size_t W_GATE_T = 25 * MiB;
constexpr size_t W_PP_T = 27 * MiB;
constexpr size_t W_QKV_T = 28 * MiB;
constexpr size_t W_SOUT_T = 31 * MiB;
constexpr size_t W_LSTRIDE = 24 * MiB;
constexpr size_t PB1_OFF = 1 * MiB;
constexpr size_t R0 = 56 * MiB;
constexpr size_t R1 = 120 * MiB;
constexpr size_t R2 = 248 * MiB;
constexpr size_t R2_GK = R2 + 192 * MiB;
constexpr size_t R2_PP = R2 + 16 * MiB;
constexpr size_t R2_H3B = R2 + 80 * MiB;
constexpr size_t R2_QKV = R2 + 144 * MiB;
constexpr size_t R0_BL = R1 + 80 * MiB;
constexpr size_t WS_END = 512 * MiB;
constexpr int LDS_BYTES = 147456;

__device__ __forceinline__ int opq(int v) { asm volatile("" : "+s"(v)); return v; }
struct Params { const float* in[21]; float* out; unsigned char* ws; };
#define LBAR() do { asm volatile("s_waitcnt lgkmcnt(0)" ::: "memory"); __builtin_amdgcn_s_barrier(); asm volatile("" ::: "memory"); } while (0)

struct Ctx { LAS unsigned char* lds; int tid, lane, wave; };

__device__ __forceinline__ float wave_sum(float v) {
#pragma unroll
    for (int o = 1; o < 64; o <<= 1) v += __shfl_xor(v, o);
    return v;
}
__device__ __forceinline__ unsigned pk2(float lo, float hi) { return pg8::cvt_pk_bf16(lo, hi); }
__device__ __forceinline__ float bf2f(unsigned short b) { return __uint_as_float(((unsigned)b) << 16); }
__device__ __forceinline__ bf16x8 pack8(const f32x4 a, const f32x4 b) {
    u32x4 w; w.x = pk2(a[0], a[1]); w.y = pk2(a[2], a[3]); w.z = pk2(b[0], b[1]); w.w = pk2(b[2], b[3]); return __builtin_bit_cast(bf16x8, w);
}
#define MFMA16(a, b, c) __builtin_amdgcn_mfma_f32_16x16x32_bf16((a), (b), (c), 0, 0, 0)
__device__ __forceinline__ bf16x8 lds16(const LAS unsigned char* p) { return *(const LAS bf16x8*)p; }
__device__ __forceinline__ bf16x8 lds8x2(const LAS unsigned char* p0, const LAS unsigned char* p1) {
    const s16x4 lo = *(const LAS s16x4*)p0, hi = *(const LAS s16x4*)p1; return __builtin_shufflevector(lo, hi, 0, 1, 2, 3, 4, 5, 6, 7);
}

template <bool FOLD>
__device__ __forceinline__ void transpose_item(const float* W, int ldw, int nblk, int K, bf16* WT, LAS float* scr, int item, int lane,
                                               const float* gv = nullptr, const float* bv = nullptr, float* csp = nullptr, float* bwp = nullptr) {
    const int kb = item / nblk, nb = item % nblk, k0 = 64 * kb, n0 = 32 * nb;
    { const int r8 = lane >> 3, c4 = lane & 7;
      f32x4 v[8];
#pragma unroll
      for (int it = 0; it < 8; ++it) v[it] = __builtin_nontemporal_load((const f32x4*)(W + (size_t)(k0 + 8 * it + r8) * ldw + n0 + 4 * c4));
#pragma unroll
      for (int it = 0; it < 8; ++it) { LAS float* d = scr + (8 * it + r8) * 33 + 4 * c4; d[0] = v[it][0]; d[1] = v[it][1]; d[2] = v[it][2]; d[3] = v[it][3]; } }
    asm volatile("s_waitcnt lgkmcnt(0)" ::: "memory");
    const int c = lane & 7;
    float gk[8], bk[8];
    if (FOLD) {
#pragma unroll
        for (int i = 0; i < 8; ++i) { gk[i] = gv[k0 + 8 * c + i]; bk[i] = bv[k0 + 8 * c + i]; }
    }
#pragma unroll
    for (int j = 0; j < 4; ++j) { const int n = (lane >> 3) + 8 * j; const LAS float* sp = scr + (8 * c) * 33 + n;
        float v[8];
#pragma unroll
        for (int i = 0; i < 8; ++i) v[i] = sp[i * 33];
        float bwv = 0.f;
        if (FOLD) {
#pragma unroll
            for (int i = 0; i < 8; ++i) { bwv += bk[i] * v[i]; v[i] *= gk[i]; }
        }
        u32x4 o; o.x = pk2(v[0], v[1]); o.y = pk2(v[2], v[3]); o.z = pk2(v[4], v[5]); o.w = pk2(v[6], v[7]);
        *(u32x4*)(WT + (size_t)(n0 + n) * K + k0 + 8 * c) = o;
        if (FOLD) {
            float r[8]; pg8::unpack8(o, r); float cs = ((r[0] + r[1]) + (r[2] + r[3])) + ((r[4] + r[5]) + (r[6] + r[7]));
            cs += __shfl_xor(cs, 1); cs += __shfl_xor(cs, 2); cs += __shfl_xor(cs, 4);
            bwv += __shfl_xor(bwv, 1); bwv += __shfl_xor(bwv, 2); bwv += __shfl_xor(bwv, 4);
            if (c == 0) { const int N = 32 * nblk; csp[(size_t)kb * N + n0 + n] = cs; bwp[(size_t)kb * N + n0 + n] = bwv; }
        }
    }
    asm volatile("s_waitcnt lgkmcnt(0)" ::: "memory");
}
constexpr size_t VEC = 52 * MiB;
__device__ __host__ constexpr size_t CSP_UP(int l) { return VEC + (size_t)l * 512 * 1024; }
__device__ __host__ constexpr size_t CSP_G(int l) { return VEC + MiB + (size_t)l * 128 * 1024; }
__device__ __host__ constexpr size_t FIN(int l) { return VEC + MiB + 512 * 1024 + (size_t)l * 64 * 1024; }
__device__ __forceinline__ void fold_finalize(const Params& P, int gtid, int gthreads) {
    for (int idx = gtid; idx < 2 * 5120; idx += gthreads) {
        const int l = idx / 5120, r = idx % 5120;
        float* fin = (float*)(P.ws + FIN(l));
        if (r < 4096) { const float* cp = (const float*)(P.ws + CSP_UP(l)); const float* bp = cp + 16 * 4096; float cs = 0.f, bw = 0.f;
#pragma unroll
            for (int kb = 0; kb < 16; ++kb) { cs += cp[kb * 4096 + r]; bw += bp[kb * 4096 + r]; }
            fin[r] = cs; fin[4096 + r] = bw; }
        else { const int n = r - 4096; const float* cp = (const float*)(P.ws + CSP_G(l)); const float* bp = cp + 16 * 1024; float cs = 0.f, bw = 0.f;
#pragma unroll
            for (int kb = 0; kb < 16; ++kb) { cs += cp[kb * 1024 + n]; bw += bp[kb * 1024 + n]; }
            fin[8192 + n] = cs; fin[9216 + n] = bw + P.in[20][l * D + n]; }
    }
}
__device__ __forceinline__ void p0_prologue(const Ctx& F, const Params& P) {
    LAS float* scr = (LAS float*)(F.lds + F.wave * 16384);
    const int gw = blockIdx.x * NWAVES + F.wave, NGW = gridDim.x * NWAVES;
    unsigned char* ws = P.ws;
    constexpr int I_IN = 16 * 96, I_SQ = 16 * 32, I_QKV = 16 * 48, I_UP = 16 * 128, I_DN = 64 * 32, I_PP = 4 * 32;
    constexpr int NITEMS = I_IN + 2 * I_SQ + I_QKV + 2 * I_UP + 2 * I_DN + 2 * I_SQ + 2 * I_PP;
    for (int it = gw; it < NITEMS; it += NGW) {
        int r = it;
        if (r < I_IN) { transpose_item<false>(P.in[2], GLA_COLS, 96, D, (bf16*)(ws + W_IN_T), scr, r, F.lane); continue; } r -= I_IN;
        if (r < I_SQ) { transpose_item<false>(P.in[6], D, 32, D, (bf16*)(ws + W_GOUT_T), scr, r, F.lane); continue; } r -= I_SQ;
        if (r < I_SQ) { transpose_item<false>(P.in[10], D, 32, D, (bf16*)(ws + W_SOUT_T), scr, r, F.lane); continue; } r -= I_SQ;
        if (r < I_QKV) { transpose_item<false>(P.in[7], QKV_LD, 48, D, (bf16*)(ws + W_QKV_T), scr, r, F.lane); continue; } r -= I_QKV;
        if (r < 2 * I_UP) { const int l = r / I_UP; transpose_item<true>(P.in[12] + (size_t)l * D * FF, FF, 128, D, (bf16*)(ws + W_UP_T + (size_t)l * W_LSTRIDE), scr, r % I_UP, F.lane, P.in[14] + l * D, P.in[15] + l * D, (float*)(ws + CSP_UP(l)), (float*)(ws + CSP_UP(l)) + 16 * 4096); continue; } r -= 2 * I_UP;
        if (r < 2 * I_DN) { const int l = r / I_DN; transpose_item<false>(P.in[13] + (size_t)l * D * FF, D, 32, FF, (bf16*)(ws + W_DN_T + (size_t)l * W_LSTRIDE), scr, r % I_DN, F.lane); continue; } r -= 2 * I_DN;
        if (r < 2 * I_SQ) { const int l = r / I_SQ; transpose_item<true>(P.in[19] + (size_t)l * D * D, D, 32, D, (bf16*)(ws + W_GATE_T + (size_t)l * W_LSTRIDE), scr, r % I_SQ, F.lane, P.in[16] + l * D, P.in[17] + l * D, (float*)(ws + CSP_G(l)), (float*)(ws + CSP_G(l)) + 16 * 1024); continue; } r -= 2 * I_SQ;
        { const int l = r / I_PP; transpose_item<false>(P.in[18] + (size_t)l * PLE * D, D, 32, PLE, (bf16*)(ws + W_PP_T + (size_t)l * W_LSTRIDE), scr, r % I_PP, F.lane); }
    }
    const int gtid = blockIdx.x * NTHREADS + F.tid, gthreads = gridDim.x * NTHREADS;
    {
        LAS float* wg = (LAS float*)F.lds;
        __syncthreads();
        for (int i = F.tid; i < 4096; i += NTHREADS) { const int k = i >> 2, c4 = i & 3, pos = (k & 3) * 256 + (k >> 2); *(LAS f32x4*)(wg + pos * 20 + 4 * c4) = *(const f32x4*)(P.in[2] + (size_t)k * GLA_COLS + 3072 + 4 * c4); }
        __syncthreads();
        const float* x = P.in[0]; bf16* xb = (bf16*)(ws + R0); float* GK = (float*)(ws + R2_GK);
        const int lane = F.lane;
#pragma unroll 1
        for (int r0 = gw * 4; r0 < M; r0 += NGW * 4) {
            f32x4 acc[16];
#pragma unroll
            for (int i = 0; i < 16; ++i) acc[i] = (f32x4){0.f, 0.f, 0.f, 0.f};
#pragma unroll 1
            for (int j = 0; j < 4; ++j) {
                float xs[4][4];
#pragma unroll
                for (int rr = 0; rr < 4; ++rr) { const f32x4 v = __builtin_nontemporal_load((const f32x4*)(x + (size_t)(r0 + rr) * D + 256 * j + 4 * lane));
                    u32x2 o; o.x = pk2(v[0], v[1]); o.y = pk2(v[2], v[3]); *(u32x2*)(xb + (size_t)(r0 + rr) * D + 256 * j + 4 * lane) = o;
                    xs[rr][0] = v[0]; xs[rr][1] = v[1]; xs[rr][2] = v[2]; xs[rr][3] = v[3]; }
#pragma unroll
                for (int i = 0; i < 4; ++i) { const LAS float* wp = wg + (i * 256 + 64 * j + lane) * 20;
                    const f32x4 w0 = *(const LAS f32x4*)(wp), w1 = *(const LAS f32x4*)(wp + 4), w2 = *(const LAS f32x4*)(wp + 8), w3 = *(const LAS f32x4*)(wp + 12);
#pragma unroll
                    for (int rr = 0; rr < 4; ++rr) { const float xv = xs[rr][i]; acc[rr * 4 + 0] += w0 * xv; acc[rr * 4 + 1] += w1 * xv; acc[rr * 4 + 2] += w2 * xv; acc[rr * 4 + 3] += w3 * xv; } }
            }
            float a[64];
#pragma unroll
            for (int i = 0; i < 16; ++i) { a[4 * i] = acc[i][0]; a[4 * i + 1] = acc[i][1]; a[4 * i + 2] = acc[i][2]; a[4 * i + 3] = acc[i][3]; }
#define TR_STEP(n) do { const bool hi_ = (lane & (n)) != 0; _Pragma("unroll") for (int i = 0; i < (n); ++i) { const float send = hi_ ? a[i] : a[i + (n)], keep = hi_ ? a[i + (n)] : a[i]; a[i] = keep + __shfl_xor(send, (n)); } } while (0)
            TR_STEP(32); TR_STEP(16); TR_STEP(8); TR_STEP(4); TR_STEP(2); TR_STEP(1);
#undef TR_STEP
            GK[(size_t)r0 * 16 + lane] = a[0];
        }
    }
}

typedef short v4i16_t __attribute__((ext_vector_type(4)));
__device__ __forceinline__ s16x4 ldtr(const LAS unsigned char* p) { return __builtin_bit_cast(s16x4, __builtin_amdgcn_ds_read_tr16_b64_v4i16((LAS v4i16_t*)p)); }
constexpr int GS_Q = 0, GS_K = 17408, GS_V = 34816, GS_ATT = 68608, GS_RS = 77824, GS_RSTD = 79872, GS_BL = 80128;
constexpr size_t R0_SLOC = R1, R0_GSEG = R1 + 40 * MiB;
template <bool FULL>
__device__ __forceinline__ void gla_scan_pass(const Ctx& F, const Params& P) {
    LAS unsigned char* L = F.lds;
    const int tid = F.tid, lane = F.lane, w = F.wave, l15 = lane & 15, quad = lane >> 4;
    bf16* PROJ = (bf16*)(P.ws + R2);
    const float* BL = (const float*)(P.ws + R0_BL);
    float* SLOC = (float*)(P.ws + R0_SLOC); float* GSEG = (float*)(P.ws + R0_GSEG);
    const float* norm_g = P.in[5];
    for (int item = blockIdx.x; item < BATCH * 4 * 8; item += gridDim.x) {
        const int seg = item & 7, bh = item >> 3, b = bh >> 2, h = bh & 3;
        if (!FULL && seg == 7) continue;
        f32x4 S[8][2];
#pragma unroll
        for (int dt = 0; dt < 8; ++dt) { S[dt][0] = (f32x4){0.f, 0.f, 0.f, 0.f}; S[dt][1] = (f32x4){0.f, 0.f, 0.f, 0.f}; }
        if (FULL) {
#pragma unroll 1
            for (int j = 0; j < seg; ++j) {
                const float* gj = GSEG + (size_t)(bh * 8 + j) * 128 + 4 * quad; const f32x4* sl = (const f32x4*)(SLOC + (size_t)(bh * 8 + j) * 32768) + tid;
#pragma unroll
                for (int dt = 0; dt < 8; ++dt) { const f32x4 gg = *(const f32x4*)(gj + 16 * dt);
                    f32x4 dec; dec[0] = __expf(gg[0]); dec[1] = __expf(gg[1]); dec[2] = __expf(gg[2]); dec[3] = __expf(gg[3]);
                    S[dt][0] = S[dt][0] * dec + sl[(dt * 2 + 0) * 512]; S[dt][1] = S[dt][1] * dec + sl[(dt * 2 + 1) * 512]; }
            }
        }
        float gsum = 0.f;
        u32x4 pq[2], pk[2], pv[4]; float pbl = 0.f;
#define GS_LOADC(cidx) do { const int u_ = (b * 64 + (cidx)) * 4 + h; const size_t m_ = (size_t)b * SEQ + (size_t)(cidx) * 64; int tl_ = tid; asm volatile("" : "+v"(tl_)); \
            _Pragma("unroll") for (int i = 0; i < 2; ++i) { const int idx = tl_ + 512 * i, row = idx >> 4, pc = idx & 15; const bf16* src = PROJ + (m_ + row) * PROJ_LD + h * 128 + pc * 8; \
                if (FULL) pq[i] = *(const u32x4*)(src); pk[i] = *(const u32x4*)(src + 512); } \
            _Pragma("unroll") for (int i = 0; i < 4; ++i) { const int idx = tl_ + 512 * i, row = idx >> 5, pc = idx & 31; pv[i] = *(const u32x4*)(PROJ + (m_ + row) * PROJ_LD + 1024 + h * 256 + pc * 8); } \
            if (tl_ < 128) pbl = BL[(size_t)u_ * 128 + tl_]; } while (0)
        GS_LOADC(seg * 8);
#pragma unroll 1
        for (int cc = 0; cc < 8; ++cc) {
            const int c = seg * 8 + cc;
            const size_t m0 = (size_t)b * SEQ + (size_t)c * 64;
#pragma unroll
            for (int i = 0; i < 2; ++i) { const int idx = tid + 512 * i, row = idx >> 4, pc = idx & 15;
                if (FULL) *(LAS u32x4*)(L + GS_Q + row * 272 + pc * 16) = pq[i];
                *(LAS u32x4*)(L + GS_K + row * 272 + pc * 16) = pk[i]; }
#pragma unroll
            for (int i = 0; i < 4; ++i) { const int idx = tid + 512 * i, row = idx >> 5, pc = idx & 31; *(LAS u32x4*)(L + GS_V + row * 528 + pc * 16) = pv[i]; }
            if (tid < 128) { ((LAS float*)(L + GS_BL))[tid] = pbl; gsum += pbl; }
            LBAR();
            if (cc < 7) GS_LOADC(c + 1);
            u32x2 rw[4][2];
            if (FULL) { const bf16* rp = PROJ + (m0 + l15) * PROJ_LD + 2048 + h * 256 + 32 * w + 4 * quad;
#pragma unroll
                for (int it = 0; it < 4; ++it) { rw[it][0] = *(const u32x2*)(rp); rw[it][1] = *(const u32x2*)(rp + 16); rp += 16 * PROJ_LD; asm volatile("" : "+v"(rp)); } }
#define GS_VF(dst) do { _Pragma("unroll") for (int s2 = 0; s2 < 2; ++s2) _Pragma("unroll") for (int et = 0; et < 2; ++et) { \
                const LAS unsigned char* a_ = L + GS_V + (32 * s2 + 8 * quad + (l15 >> 2)) * 528 + (32 * w + 16 * et) * 2 + 8 * (l15 & 3); \
                const s16x4 lo_ = ldtr(a_), hi_ = ldtr(a_ + 4 * 528); dst[s2][et] = __builtin_shufflevector(lo_, hi_, 0, 1, 2, 3, 4, 5, 6, 7); } } while (0)
            f32x4 o[4][2];
            if (FULL) {
                { const int it = w >> 1;
#pragma unroll
                  for (int x = 0; x < 2; ++x) { const int jt = 2 * (w & 1) + x; f32x4 a = (f32x4){0.f, 0.f, 0.f, 0.f};
                      if (jt <= it) {
#pragma unroll
                          for (int ks = 0; ks < 4; ++ks) { const bf16x8 kf = lds16(L + GS_K + (16 * jt + l15) * 272 + ks * 64 + quad * 16), qf = lds16(L + GS_Q + (16 * it + l15) * 272 + ks * 64 + quad * 16);
                              a = MFMA16(kf, qf, a); }
                          const int ii = 16 * it + l15, j0 = 16 * jt + 4 * quad;
#pragma unroll
                          for (int j = 0; j < 4; ++j) if (j0 + j > ii) a[j] = 0.f;
                      }
                      u32x2 ww; ww.x = pk2(a[0], a[1]); ww.y = pk2(a[2], a[3]);
                      *(LAS u32x2*)(L + GS_ATT + (16 * it + l15) * 144 + (16 * jt + 4 * quad) * 2) = ww; } }
                LBAR();
#pragma unroll
                for (int it = 0; it < 4; ++it) { o[it][0] = (f32x4){0.f, 0.f, 0.f, 0.f}; o[it][1] = (f32x4){0.f, 0.f, 0.f, 0.f}; }
#pragma unroll
                for (int s2 = 0; s2 < 4; ++s2) {
                    bf16x8 sf[2]; sf[0] = pack8(S[2 * s2][0], S[2 * s2 + 1][0]); sf[1] = pack8(S[2 * s2][1], S[2 * s2 + 1][1]);
#pragma unroll
                    for (int it = 0; it < 4; ++it) { const LAS unsigned char* qb = L + GS_Q + (16 * it + l15) * 272 + (32 * s2 + 4 * quad) * 2;
                        const bf16x8 qf = lds8x2(qb, qb + 32);
                        o[it][0] = MFMA16(sf[0], qf, o[it][0]); o[it][1] = MFMA16(sf[1], qf, o[it][1]); }
                }
                { bf16x8 vf[2][2]; GS_VF(vf);
#pragma unroll
                  for (int s2 = 0; s2 < 2; ++s2)
#pragma unroll
                    for (int it = 0; it < 4; ++it) { const bf16x8 af = lds16(L + GS_ATT + (16 * it + l15) * 144 + s2 * 64 + quad * 16);
                        o[it][0] = MFMA16(vf[s2][0], af, o[it][0]); o[it][1] = MFMA16(vf[s2][1], af, o[it][1]); } }
            }
            bf16x8 vf[2][2]; GS_VF(vf);
#pragma unroll
            for (int dt = 0; dt < 8; ++dt) {
                const f32x4 bl = *(const LAS f32x4*)(L + GS_BL + (16 * dt + 4 * quad) * 4);
                f32x4 dec; dec[0] = __expf(bl[0]); dec[1] = __expf(bl[1]); dec[2] = __expf(bl[2]); dec[3] = __expf(bl[3]);
#pragma unroll
                for (int s2 = 0; s2 < 2; ++s2) {
                    const LAS unsigned char* ka = L + GS_K + (32 * s2 + 8 * quad + (l15 >> 2)) * 272 + (16 * dt) * 2 + 8 * (l15 & 3);
                    const s16x4 klo = ldtr(ka), khi = ldtr(ka + 4 * 272); const bf16x8 kf = __builtin_shufflevector(klo, khi, 0, 1, 2, 3, 4, 5, 6, 7);
                    S[dt][0] = MFMA16(kf, vf[s2][0], S[dt][0]); S[dt][1] = MFMA16(kf, vf[s2][1], S[dt][1]); }
                S[dt][0] = S[dt][0] * dec; S[dt][1] = S[dt][1] * dec;
            }
            if (FULL) {
#pragma unroll
                for (int it = 0; it < 4; ++it) { float ss = 0.f;
#pragma unroll
                    for (int et = 0; et < 2; ++et) ss += (o[it][et][0] * o[it][et][0] + o[it][et][1] * o[it][et][1]) + (o[it][et][2] * o[it][et][2] + o[it][et][3] * o[it][et][3]);
                    ss += __shfl_xor(ss, 16); ss += __shfl_xor(ss, 32);
                    if (quad == 0) ((LAS float*)(L + GS_RS))[w * 64 + 16 * it + l15] = ss; }
            }
            LBAR();
            if (FULL) {
                if (tid < 64) { float t = 0.f;
#pragma unroll
                    for (int ww = 0; ww < 8; ++ww) t += ((const LAS float*)(L + GS_RS))[ww * 64 + tid];
                    ((LAS float*)(L + GS_RSTD))[tid] = 1.0f / sqrtf(t * (1.0f / 256.0f) + RMS_EPS); }
                LBAR();
#pragma unroll
                for (int it = 0; it < 4; ++it) { const float rs = ((const LAS float*)(L + GS_RSTD))[16 * it + l15];
#pragma unroll
                    for (int et = 0; et < 2; ++et) { const int e0 = 32 * w + 16 * et + 4 * quad;
                        bf16* wp = PROJ + (m0 + 16 * it + l15) * PROJ_LD + 2048 + h * 256 + e0;
                        const u32x2 r2 = rw[it][et]; const f32x4 gg = *(const f32x4*)(norm_g + e0);
                        float rv[4]; rv[0] = __uint_as_float(r2.x << 16); rv[1] = __uint_as_float(r2.x & 0xffff0000u); rv[2] = __uint_as_float(r2.y << 16); rv[3] = __uint_as_float(r2.y & 0xffff0000u);
                        float ov[4];
#pragma unroll
                        for (int j = 0; j < 4; ++j) ov[j] = o[it][et][j] * rs * gg[j] * (rv[j] * __builtin_amdgcn_rcpf(1.0f + __expf(-rv[j])));
                        u32x2 ow; ow.x = pk2(ov[0], ov[1]); ow.y = pk2(ov[2], ov[3]); *(u32x2*)wp = ow; } }
            }
        }
#undef GS_LOADC
#undef GS_VF
        if (!FULL) {
            f32x4* sl = (f32x4*)(SLOC + (size_t)(bh * 8 + seg) * 32768) + tid;
#pragma unroll
            for (int dt = 0; dt < 8; ++dt) { sl[(dt * 2 + 0) * 512] = S[dt][0]; sl[(dt * 2 + 1) * 512] = S[dt][1]; }
            if (tid < 128) GSEG[(size_t)(bh * 8 + seg) * 128 + tid] = gsum;
        }
        LBAR();
    }
}

__device__ __forceinline__ void gla_pass_a(const Ctx& F, const Params& P) {
    LAS unsigned char* L = F.lds;
    LAS float* gk_s = (LAS float*)(L);
    LAS float* part = (LAS float*)(L + 4096);
    const int tid = F.tid, lane = F.lane, w = F.wave, l15 = lane & 15, quad = lane >> 4, d = tid & 127, g = tid >> 7;
    bf16* PROJ = (bf16*)(P.ws + R2); const float* GK = (const float*)(P.ws + R2_GK);
    float* BL = (float*)(P.ws + R0_BL); float* SLOC = (float*)(P.ws + R0_SLOC); float* GSEG = (float*)(P.ws + R0_GSEG);
    for (int item = blockIdx.x; item < BATCH * 4 * 8; item += gridDim.x) {
        const int seg = item & 7, bh = item >> 3, b = bh >> 2, h = bh & 3;
        float wv[16];
#pragma unroll
        for (int r = 0; r < 16; ++r) wv[r] = P.in[3][r * 512 + h * 128 + d];
        const float bias = P.in[4][h * 128 + d];
        f32x4 S[8][2];
#pragma unroll
        for (int dt = 0; dt < 8; ++dt) { S[dt][0] = (f32x4){0.f, 0.f, 0.f, 0.f}; S[dt][1] = (f32x4){0.f, 0.f, 0.f, 0.f}; }
        float gsum = 0.f;
        u32x4 pv[4]; f32x4 gkn = (f32x4){0.f, 0.f, 0.f, 0.f};
#define PA_LOAD(cidx) do { const size_t m_ = (size_t)b * SEQ + (size_t)(cidx) * 64; int tl_ = tid; asm volatile("" : "+v"(tl_)); \
            _Pragma("unroll") for (int i = 0; i < 4; ++i) { const int idx = tl_ + 512 * i, row = idx >> 5, pc = idx & 31; pv[i] = *(const u32x4*)(PROJ + (m_ + row) * PROJ_LD + 1024 + h * 256 + pc * 8); } \
            if (tl_ < 256) gkn = *(const f32x4*)(GK + m_ * 16 + (size_t)tl_ * 4); } while (0)
        PA_LOAD(seg * 8 + 7);
        float accd = 0.f;
#pragma unroll 1
        for (int cc = 7; cc >= 0; --cc) {
            const int c = seg * 8 + cc, u = (b * 64 + c) * 4 + h;
            const size_t m0 = (size_t)b * SEQ + (size_t)c * 64;
            if (tid < 256) ((LAS f32x4*)gk_s)[tid] = gkn;
#pragma unroll
            for (int i = 0; i < 4; ++i) { const int idx = tid + 512 * i, row = idx >> 5, pc = idx & 31; *(LAS u32x4*)(L + GS_V + row * 528 + pc * 16) = pv[i]; }
            bf16* qp = PROJ + (m0 + 16 * g) * PROJ_LD + h * 128 + d; bf16* kp = qp + 512;
            unsigned qk[16];
            { const bf16* rp = qp;
#pragma unroll
              for (int tt = 0; tt < 16; ++tt) { qk[tt] = (unsigned)rp[0] | ((unsigned)rp[512] << 16); rp += PROJ_LD; asm volatile("" : "+v"(rp)); } }
            { const size_t pgrp = ((size_t)(item * 8 + cc)) * 512 + tid;
              const f32x4 a = __builtin_nontemporal_load((const f32x4*)(P.in[1] + pgrp * 8)), a2 = __builtin_nontemporal_load((const f32x4*)(P.in[1] + pgrp * 8 + 4));
              u32x4 o; o.x = pk2(a[0], a[1]); o.y = pk2(a[2], a[3]); o.z = pk2(a2[0], a2[1]); o.w = pk2(a2[2], a2[3]); *(u32x4*)((bf16*)P.out + pgrp * 8) = o; }
            LBAR();
            float cs[16]; float run = 0.f;
#pragma unroll
            for (int tt = 0; tt < 16; ++tt) {
                const int t = 16 * g + tt; float z = bias;
#pragma unroll
                for (int r4 = 0; r4 < 4; ++r4) { const f32x4 a = ((const LAS f32x4*)gk_s)[t * 4 + r4]; z += a[0] * wv[4 * r4] + a[1] * wv[4 * r4 + 1] + a[2] * wv[4 * r4 + 2] + a[3] * wv[4 * r4 + 3]; }
                const float ls = fminf(z, 0.f) - __logf(1.0f + __expf(-fabsf(z)));
                run += ls * (1.0f / 16.0f); cs[tt] = run;
                if ((tt & 1) == 1) asm volatile("" ::: "memory");
            }
            part[g * 128 + d] = run;
            LBAR();
            if (cc > 0) PA_LOAD(c - 1);
            float off = 0.f, tot = 0.f;
#pragma unroll
            for (int gg = 0; gg < 4; ++gg) { const float pvv = part[gg * 128 + d]; tot += pvv; if (gg < g) off += pvv; }
            bf16* wq = qp;
#pragma unroll
            for (int tt = 0; tt < 16; ++tt) {
                const float bc = cs[tt] + off;
                const float qv = __uint_as_float(qk[tt] << 16), kv = __uint_as_float(qk[tt] & 0xffff0000u);
                const float e1 = __expf(bc), e2 = __expf(-bc);
                wq[0] = (bf16)(pk2(qv * 0.08838834764831845f * e1, 0.f) & 0xffffu);
                const bf16 kt = (bf16)(pk2(kv * e2, 0.f) & 0xffffu);
                wq[512] = kt; wq += PROJ_LD; asm volatile("" : "+v"(wq));
                *(LAS bf16*)(L + GS_K + (16 * g + tt) * 272 + d * 2) = (bf16)(pk2(kv * __expf(tot - bc + accd), 0.f) & 0xffffu);
            }
            if (g == 0) { BL[(size_t)u * 128 + d] = tot; gsum += tot; }
            accd += tot;
            LBAR();
            if (seg < 7) {
                bf16x8 vf[2][2];
#pragma unroll
                for (int s2 = 0; s2 < 2; ++s2)
#pragma unroll
                    for (int et = 0; et < 2; ++et) { const LAS unsigned char* a_ = L + GS_V + (32 * s2 + 8 * quad + (l15 >> 2)) * 528 + (32 * w + 16 * et) * 2 + 8 * (l15 & 3);
                        const s16x4 lo_ = ldtr(a_), hi_ = ldtr(a_ + 4 * 528); vf[s2][et] = __builtin_shufflevector(lo_, hi_, 0, 1, 2, 3, 4, 5, 6, 7); }
#pragma unroll
                for (int dt = 0; dt < 8; ++dt) {
#pragma unroll
                    for (int s2 = 0; s2 < 2; ++s2) {
                        const LAS unsigned char* ka = L + GS_K + (32 * s2 + 8 * quad + (l15 >> 2)) * 272 + (16 * dt) * 2 + 8 * (l15 & 3);
                        const s16x4 klo = ldtr(ka), khi = ldtr(ka + 4 * 272); const bf16x8 kf = __builtin_shufflevector(klo, khi, 0, 1, 2, 3, 4, 5, 6, 7);
                        S[dt][0] = MFMA16(kf, vf[s2][0], S[dt][0]); S[dt][1] = MFMA16(kf, vf[s2][1], S[dt][1]); }
                }
            }
            LBAR();
        }
#undef PA_LOAD
        if (seg < 7) {
            f32x4* sl = (f32x4*)(SLOC + (size_t)(bh * 8 + seg) * 32768) + tid;
#pragma unroll
            for (int dt = 0; dt < 8; ++dt) { sl[(dt * 2 + 0) * 512] = S[dt][0]; sl[(dt * 2 + 1) * 512] = S[dt][1]; }
            if (tid < 128) GSEG[(size_t)(bh * 8 + seg) * 128 + tid] = gsum;
        }
    }
}

constexpr int SW_K = 0, SW_V = 36864;
__device__ __forceinline__ void swa_phase(const Ctx& F, const Params& P) {
    LAS unsigned char* L = F.lds;
    const int tid = F.tid, lane = F.lane, w = F.wave, l15 = lane & 15, quad = lane >> 4;
    const bf16* QKV = (const bf16*)(P.ws + R2_QKV); bf16* AO = (bf16*)(P.ws + R0);
    const float* sinks = P.in[9];
    constexpr int NU = BATCH * 32 * 4;
    u32x4 kv[4], vv[4];
#define SW_LOAD(uu) do { const int kvh_ = (uu) & 3, n_ = ((uu) >> 2) & 31, b_ = (uu) >> 7; const long mb_ = (long)b_ * SEQ + (long)n_ * 128; \
        _Pragma("unroll") for (int i = 0; i < 4; ++i) { const int idx = tid + 512 * i, jj = idx >> 3, pc = idx & 7; \
            kv[i] = (u32x4){0u, 0u, 0u, 0u}; vv[i] = (u32x4){0u, 0u, 0u, 0u}; \
            if (n_ > 0 || jj >= 128) { const bf16* src = QKV + (size_t)(mb_ - 128 + jj) * QKV_LD + 1024 + kvh_ * 64 + pc * 8; kv[i] = *(const u32x4*)(src); vv[i] = *(const u32x4*)(src + 256); } } } while (0)
#define SW_QBASE(uu) (QKV + (size_t)((long)((uu) >> 7) * SEQ + (long)(((uu) >> 2) & 31) * 128 + 64 * (w & 1) + l15) * QKV_LD + (((uu) & 3) * 4 + (w >> 1)) * 64 + quad * 8)
    bf16x8 qc0 = (bf16x8){0, 0, 0, 0, 0, 0, 0, 0}, qc1 = qc0;
    if ((int)blockIdx.x < NU) { SW_LOAD((int)blockIdx.x); const bf16* q0p = SW_QBASE((int)blockIdx.x); qc0 = *(const bf16x8*)(q0p); qc1 = *(const bf16x8*)(q0p + 32); }
    for (int u = blockIdx.x; u < NU; u += gridDim.x) {
        const int kvh = u & 3, n = (u >> 2) & 31, b = u >> 7;
        const long mb = (long)b * SEQ + (long)n * 128;
        const int g = w >> 1, hq = kvh * 4 + g;
        const int un = (u + (int)gridDim.x < NU) ? u + (int)gridDim.x : u;
        const bf16* qbase = SW_QBASE(u);
        const bf16* qnext = SW_QBASE(un);
#pragma unroll
        for (int i = 0; i < 2; ++i) { const size_t pg = (size_t)u * 1024 + tid + 512 * i; const float* src = P.in[1] + (size_t)M * PLE + pg * 8;
            const f32x4 a = __builtin_nontemporal_load((const f32x4*)(src)), a2 = __builtin_nontemporal_load((const f32x4*)(src + 4));
            u32x4 o; o.x = pk2(a[0], a[1]); o.y = pk2(a[2], a[3]); o.z = pk2(a2[0], a2[1]); o.w = pk2(a2[2], a2[3]); *(u32x4*)((bf16*)(P.ws + PB1_OFF) + pg * 8) = o; }
        LBAR();
#pragma unroll
        for (int i = 0; i < 4; ++i) { const int idx = tid + 512 * i, jj = idx >> 3, pc = idx & 7;
            *(LAS u32x4*)(L + SW_K + jj * 144 + pc * 16) = kv[i]; *(LAS u32x4*)(L + SW_V + jj * 144 + pc * 16) = vv[i]; }
        LBAR();
        if (un != u) SW_LOAD(un);
        const float sink = sinks[hq];
#pragma unroll 1
        for (int qt = 0; qt < 4; ++qt) {
            const int q0 = 64 * (w & 1) + 16 * qt, kt0 = q0 >> 4, qi = q0 + l15;
            const bf16* qn = (qt < 3) ? qbase + (size_t)(16 * (qt + 1)) * QKV_LD : qnext;
            const bf16x8 qn0 = *(const bf16x8*)(qn), qn1 = *(const bf16x8*)(qn + 32);
            f32x4 sc[9];
#pragma unroll
            for (int t = 0; t < 9; ++t) { const LAS unsigned char* kb = L + SW_K + (16 * (kt0 + t) + l15) * 144 + quad * 16;
                f32x4 a = (f32x4){0.f, 0.f, 0.f, 0.f}; a = MFMA16(lds16(kb), qc0, a); a = MFMA16(lds16(kb + 64), qc1, a); sc[t] = a; }
            constexpr float C2 = 0.125f * 1.4426950408889634f;
            const float sink2 = sink * 1.4426950408889634f;
#pragma unroll
            for (int j = 0; j < 4; ++j) { if (!(4 * quad + j > l15)) sc[0][j] = -INFINITY; if (!(4 * quad + j <= l15)) sc[8][j] = -INFINITY; }
            float mraw = -INFINITY;
#pragma unroll
            for (int t = 0; t < 9; ++t)
#pragma unroll
                for (int j = 0; j < 4; ++j) mraw = fmaxf(mraw, sc[t][j]);
            mraw = fmaxf(mraw, __shfl_xor(mraw, 16)); mraw = fmaxf(mraw, __shfl_xor(mraw, 32));
            const float m2 = fmaxf(mraw * C2, sink2);
            float den = 0.f;
#pragma unroll
            for (int t = 0; t < 9; ++t)
#pragma unroll
                for (int j = 0; j < 4; ++j) { const float p = __builtin_amdgcn_exp2f(sc[t][j] * C2 - m2); sc[t][j] = p; den += p; }
            den += __shfl_xor(den, 16); den += __shfl_xor(den, 32);
            den += __builtin_amdgcn_exp2f(sink2 - m2);
            const float rden = __builtin_amdgcn_rcpf(den);
            f32x4 ot[4];
#pragma unroll
            for (int dt = 0; dt < 4; ++dt) ot[dt] = (f32x4){0.f, 0.f, 0.f, 0.f};
#pragma unroll
            for (int s2 = 0; s2 < 5; ++s2) {
                const f32x4 z4 = (f32x4){0.f, 0.f, 0.f, 0.f};
                const bf16x8 pf = pack8(sc[2 * s2], (s2 < 4) ? sc[(2 * s2 + 1 < 9) ? 2 * s2 + 1 : 8] : z4);
                const int ka = 16 * (kt0 + 2 * s2), kb2 = (s2 < 4) ? ka + 16 : ka;
#pragma unroll
                for (int dt = 0; dt < 4; ++dt) { const LAS unsigned char* vb = L + SW_V + (4 * quad + (l15 >> 2)) * 144 + 32 * dt + 8 * (l15 & 3);
                    const s16x4 lo = ldtr(vb + ka * 144), hi = ldtr(vb + kb2 * 144);
                    const bf16x8 vf = __builtin_shufflevector(lo, hi, 0, 1, 2, 3, 4, 5, 6, 7);
                    ot[dt] = MFMA16(vf, pf, ot[dt]); }
            }
            bf16* op = AO + (size_t)(mb + qi) * D + hq * 64 + 4 * quad;
#pragma unroll
            for (int dt = 0; dt < 4; ++dt) { u32x2 ow; ow.x = pk2(ot[dt][0] * rden, ot[dt][1] * rden); ow.y = pk2(ot[dt][2] * rden, ot[dt][3] * rden); *(u32x2*)(op + 16 * dt) = ow; }
            qc0 = qn0; qc1 = qn1;
        }
    }
    LBAR();
#undef SW_LOAD
#undef SW_QBASE
}

#define XB_TMO      128
#define XB_XCNT(j)  (256  + 64 * (j))
#define XB_XSUB(j)  (1280 + 64 * (j))
#define XB_XGEN(j)  (2304 + 64 * (j))
#define XB_TOP      3328
#define XB_TOPGEN   3392
#define XCD_BAR_WORDS 3456
#define XB_SPIN_CAP (1u << 18)

__device__ __forceinline__ unsigned xb_ld(unsigned* p)              { return __hip_atomic_load(p, __ATOMIC_RELAXED, __HIP_MEMORY_SCOPE_AGENT); }
__device__ __forceinline__ unsigned xb_add(unsigned* p, unsigned v) { return __hip_atomic_fetch_add(p, v, __ATOMIC_RELAXED, __HIP_MEMORY_SCOPE_AGENT); }
__device__ __forceinline__ unsigned xb_xcc_id() { return (unsigned)__builtin_amdgcn_s_getreg((3 << 11) | 20) & 0xFu; }
#define XB_SPIN(cond, bar) do { unsigned _sp = 0; while (cond) { __builtin_amdgcn_s_sleep(1); \
    if ((++_sp & 255u) == 0u) { if (xb_ld(&(bar)[XB_TMO])) break; if (_sp > XB_SPIN_CAP) { atomicAdd(&(bar)[XB_TMO], 1u); break; } } } } while (0)

struct XcdBarrier {
    unsigned* bar; unsigned x;
    volatile LAS unsigned* st;
};

__device__ __forceinline__ XcdBarrier xcd_barrier_post(unsigned* bar, volatile LAS unsigned* st) {
    XcdBarrier b; b.bar = bar; b.x = xb_xcc_id(); b.st = st;
    if (threadIdx.x == 0) (void)xb_add(&bar[XB_XCNT(b.x)], 1u);
    return b;
}
__device__ __forceinline__ void xcd_barrier_complete(unsigned* bar, unsigned x, unsigned& nloc, unsigned& nx) {
    const unsigned G = gridDim.x * gridDim.y * gridDim.z;
    unsigned sum, cnt, mine, sp = 0u;
    for (;;) {
        sum = 0u; cnt = 0u; mine = 0u;
#pragma unroll
        for (unsigned j = 0; j < 16; ++j) { const unsigned c = xb_ld(&bar[XB_XCNT(j)]); sum += c; cnt += (c > 0u) ? 1u : 0u; mine = (j == x) ? c : mine; }
        if (sum == G) break;
        __builtin_amdgcn_s_sleep(1);
        if ((++sp & 255u) == 0u) { if (xb_ld(&bar[XB_TMO])) break; if (sp > XB_SPIN_CAP) { atomicAdd(&bar[XB_TMO], 1u); break; } }
    }
    nloc = mine > 0u ? mine : 1u; nx = cnt > 0u ? cnt : 1u;
}

__device__ __forceinline__ void xcd_barrier(const XcdBarrier& b) {
    asm volatile("s_waitcnt vmcnt(0)" ::: "memory");
    __syncthreads();
    if (threadIdx.x == 0) {
        unsigned* bar = b.bar;
        __builtin_amdgcn_s_waitcnt(0);
        unsigned nloc = b.st[0], nx = b.st[1];
        if (nloc == 0u) { xcd_barrier_complete(bar, b.x, nloc, nx); b.st[0] = nloc; b.st[1] = nx; }
        const unsigned old = xb_add(&bar[XB_XSUB(b.x)], 1u);
        const unsigned gen = old / nloc;
        if (old + 1u == (gen + 1u) * nloc) {
            __builtin_amdgcn_fence(__ATOMIC_RELEASE, "agent");
            asm volatile("s_waitcnt vmcnt(0)" ::: "memory");
            const unsigned og = xb_add(&bar[XB_TOP], 1u);
            const unsigned tg = og / nx;
            if (og + 1u == (tg + 1u) * nx) xb_add(&bar[XB_TOPGEN], 1u);
            else XB_SPIN(xb_ld(&bar[XB_TOPGEN]) == tg, bar);
            __builtin_amdgcn_fence(__ATOMIC_ACQUIRE, "agent");
            xb_add(&bar[XB_XGEN(b.x)], 1u);
            asm volatile("s_waitcnt vmcnt(0)" ::: "memory");
        } else {
            XB_SPIN(xb_ld(&bar[XB_XGEN(b.x)]) == gen, bar);
            __builtin_amdgcn_fence(__ATOMIC_ACQUIRE, "agent");
            asm volatile("s_waitcnt vmcnt(0)" ::: "memory");
        }
    }
    __syncthreads();
}

__global__ void __launch_bounds__(NTHREADS, 2) mega_fwd(Params P) {
    extern __shared__ __attribute__((aligned(16))) unsigned char lds_raw[];
    cg::grid_group grid = cg::this_grid();
    Ctx F; F.lds = (LAS unsigned char*)lds_raw;
#define GSYNC() do { XcdBarrier b2_ = bar; unsigned long long bp_ = (unsigned long long)b2_.bar; unsigned bx_ = __builtin_amdgcn_readfirstlane(b2_.x); asm volatile("" : "+s"(bp_), "+s"(bx_)); b2_.bar = (unsigned*)bp_; b2_.x = bx_; xcd_barrier(b2_); } while (0)
#define REFRESH() do { int t_ = threadIdx.x; asm volatile("" : "+v"(t_)); F.tid = t_; F.lane = t_ & 63; F.wave = __builtin_amdgcn_readfirstlane(t_ >> 6); } while (0)
    REFRESH();
    unsigned char* ws = P.ws;
    const int G = gridDim.x, cid = blockIdx.x;
    volatile LAS unsigned* MISC = (volatile LAS unsigned*)(F.lds + 131072 + 320);
    if (threadIdx.x < 32) MISC[threadIdx.x] = 0u;
    __syncthreads();
    if (cid == 0) for (int i = threadIdx.x; i < XCD_BAR_WORDS; i += NTHREADS) __hip_atomic_store((unsigned*)(ws) + 1024 + i, 0u, __ATOMIC_RELAXED, __HIP_MEMORY_SCOPE_AGENT);
    grid.sync();
    XcdBarrier bar = xcd_barrier_post((unsigned*)(ws) + 1024, MISC + 8);
    bf16* A16 = (bf16*)(ws + R0); bf16* U16 = (bf16*)(ws + R2);
    bf16* Y1B = (bf16*)(ws + R1); bf16* Y2B = (bf16*)(ws + R1 + 64 * MiB); bf16* H3B = (bf16*)(ws + R2_H3B);
    float* ST1 = (float*)(ws + 504 * MiB); float* ST2 = (float*)(ws + 508 * MiB);
    LAS float* SX = (LAS float*)(F.lds + 131072 + 1024);

    p0_prologue(F, P);
    GSYNC();
    {
        pg8::Gemm g{A16, (const bf16*)(ws + W_IN_T), M, PROJ_LD, opq(D), D, D}; pg8::StaticOrder S; S.init(M, PROJ_LD, G, cid);
        pg8::EpiBf16 E{U16, PROJ_LD, nullptr, 1 << 30, nullptr};
        pg8::gemm_phase<pg8::EpiBf16, pg8::StaticOrder, true, true>(F.lds, g, S, E, SX);
    }
    GSYNC();
    REFRESH(); gla_pass_a(F, P);
    fold_finalize(P, cid * NTHREADS + F.tid, G * NTHREADS);
    GSYNC();
    REFRESH(); gla_scan_pass<true>(F, P);
    GSYNC();
#pragma unroll 1
    for (int layer = 0; layer < 2; ++layer) {
        const float* fin = (const float*)(ws + FIN(0)) + (size_t)layer * (64 * 1024 / 4);
        if (layer == 1) {
            {
                pg8::Gemm g{H3B, (const bf16*)(ws + W_QKV_T), M, QKV_LD, opq(D), D, D}; pg8::StaticOrder S; S.init(M, QKV_LD, G, cid);
                pg8::EpiBf16 E{(bf16*)(ws + R2_QKV), QKV_LD, P.in[8], 1 << 30, nullptr};
                pg8::gemm_phase<pg8::EpiBf16, pg8::StaticOrder, true, true>(F.lds, g, S, E, SX);
            }
            GSYNC();
            REFRESH(); swa_phase(F, P);
            GSYNC();
        }
        {
            const bf16* A = layer == 0 ? (const bf16*)(ws + R2) + 2048 : (const bf16*)A16;
            pg8::Gemm g{A, (const bf16*)(ws + (layer == 0 ? W_GOUT_T : W_SOUT_T)), M, D, opq(D), layer == 0 ? PROJ_LD : D, D}; pg8::StaticOrder S; S.init(M, D, G, cid);
            pg8::EpiY<false> E{layer == 0 ? (const void*)A16 : (const void*)H3B, 1, layer == 0 ? nullptr : P.in[11], nullptr, nullptr, nullptr, Y1B, ST1, ALPHA};
            pg8::gemm_phase<pg8::EpiY<false>, pg8::StaticOrder, true, true>(F.lds, g, S, E, SX);
        }
        GSYNC();
        {
            pg8::Gemm g{Y1B, (const bf16*)(ws + W_UP_T + (size_t)layer * W_LSTRIDE), M, FF, opq(D), D, D}; pg8::StaticOrder S; S.init(M, FF, G, cid);
            pg8::EpiUpLN E{ST1, fin, fin + 4096, U16, FF};
            pg8::gemm_phase<pg8::EpiUpLN, pg8::StaticOrder, true, true>(F.lds, g, S, E, SX);
        }
        GSYNC();
        {
            pg8::Gemm g{U16, (const bf16*)(ws + W_DN_T + (size_t)layer * W_LSTRIDE), M, D, opq(FF), FF, FF}; pg8::StaticOrder S; S.init(M, D, G, cid, 1);
            pg8::EpiY<true> E{(const void*)Y1B, 1, nullptr, P.in[14] + layer * D, P.in[15] + layer * D, ST1, Y2B, ST2, ALPHA};
            pg8::gemm_phase<pg8::EpiY<true>, pg8::StaticOrder, true, true>(F.lds, g, S, E, SX);
        }
        GSYNC();
        {
            int kpp = opq(PLE); pg8::Gemm g{layer == 0 ? (const bf16*)P.out : (const bf16*)(ws + PB1_OFF), (const bf16*)(ws + W_PP_T + (size_t)layer * W_LSTRIDE), M, D, kpp, kpp, kpp}; pg8::StaticOrder S; S.init(M, D, G, cid);
            pg8::EpiPP E{(bf16*)(ws + R2_PP), D};
            pg8::gemm_phase<pg8::EpiPP, pg8::StaticOrder, true, true>(F.lds, g, S, E, SX);
        }
        __syncthreads();
        {
            pg8::Gemm g{Y2B, (const bf16*)(ws + W_GATE_T + (size_t)layer * W_LSTRIDE), M, D, opq(D), D, D}; pg8::StaticOrder S; S.init(M, D, G, cid);
            pg8::EpiGateLN E{ST2, Y2B, (const bf16*)(ws + R2_PP), fin + 8192, fin + 9216, P.in[16] + layer * D, P.in[17] + layer * D, P.out, layer == 0 ? H3B : nullptr};
            pg8::gemm_phase<pg8::EpiGateLN, pg8::StaticOrder, true, true>(F.lds, g, S, E, SX);
        }
        if (layer == 0) GSYNC();
    }
}

extern "C" void kernel_launch(void* const* d_in, const int* in_sizes, int n_in, void* d_out, int out_size, void* d_ws, size_t ws_size, hipStream_t stream) {
    static int grid = 0;
    if (grid == 0) {
        if (n_in != 21 || in_sizes[0] != M * D || out_size != M * D || ws_size < WS_END) { fprintf(stderr, "kernel_launch: unexpected shapes (n_in %d, in0 %d, out %d, ws %zu)\n", n_in, n_in > 0 ? in_sizes[0] : -1, out_size, ws_size); grid = -1; return; }
        int dev = 0, cus = 0, per_cu = 0;
        hipGetDevice(&dev); hipDeviceGetAttribute(&cus, hipDeviceAttributeMultiprocessorCount, dev);
        if (hipFuncSetAttribute((const void*)mega_fwd, hipFuncAttributeMaxDynamicSharedMemorySize, LDS_BYTES) != hipSuccess) { fprintf(stderr, "kernel_launch: hipFuncSetAttribute failed\n"); grid = -1; return; }
        if (hipOccupancyMaxActiveBlocksPerMultiprocessor(&per_cu, (const void*)mega_fwd, NTHREADS, LDS_BYTES) != hipSuccess || per_cu < 1) { fprintf(stderr, "kernel_launch: occupancy query says %d\n", per_cu); (void)hipGetLastError(); per_cu = 1; }
        grid = cus * 1;
        if (grid <= 0) grid = 256;
    }
    if (grid < 0) return;
    Params p{};
    for (int i = 0; i < 21; ++i) p.in[i] = (const float*)d_in[i];
    p.out = (float*)d_out; p.ws = (unsigned char*)d_ws;
    void* args[] = {&p};
    hipError_t e = hipLaunchCooperativeKernel((const void*)mega_fwd, dim3(grid), dim3(NTHREADS), args, LDS_BYTES, stream);
    if (e != hipSuccess) fprintf(stderr, "cooperative launch failed: %s (grid %d)\n", hipGetErrorString(e), grid);
}
```
